# Optimizing an MI355X kernel written in HIP

```python
import math
import jax, jax.numpy as jnp
from jax import lax
import numpy as np

D_MODEL = 2048
BATCH = 8
SEQ = 4096
DEPTH = 2

LRU_WIDTH = 1024
LRU_BLOCKS = 16
LRU_BLOCK = LRU_WIDTH // LRU_BLOCKS
CONV_WIDTH = 4
LRU_C = 8.0
RET_HEADS = 8
RET_HEAD_DIM = 128
RET_WIDTH = RET_HEADS * RET_HEAD_DIM
RET_CHUNK = 128
RET_ROT_BASE = 10000.0
DIFF_HEADS = 8
DIFF_HEAD_DIM = 64
DIFF_V_DIM = 2 * DIFF_HEAD_DIM
DIFF_WIDTH = DIFF_HEADS * DIFF_V_DIM
Q_BLOCK = 128
ROPE_THETA = 500000.0
ROPE_DIM = DIFF_HEAD_DIM // 4
N_BRANCH = 3
EPS = 1e-6
IN_SPLITS = (LRU_WIDTH, LRU_WIDTH,
             RET_WIDTH, RET_WIDTH, RET_WIDTH, RET_WIDTH,
             DIFF_WIDTH, DIFF_WIDTH, DIFF_WIDTH, DIFF_WIDTH,
             N_BRANCH * D_MODEL)
D_IN = 2 * LRU_WIDTH + 4 * RET_WIDTH + 4 * DIFF_WIDTH + N_BRANCH * D_MODEL

kernel_name = "hybrid_rglru_retention_diffattn_block"


def rms_norm(x, g):
    xf = x.astype(jnp.float32)
    y = xf * lax.rsqrt(jnp.mean(xf * xf, axis=-1, keepdims=True) + EPS)
    return (y * g.astype(jnp.float32)).astype(x.dtype)


def causal_dwconv(x, w, b):
    y = lax.conv_general_dilated(
        x, w[:, None, :].astype(x.dtype), window_strides=(1,),
        padding=[(CONV_WIDTH - 1, 0)], dimension_numbers=('NWC', 'WIO', 'NWC'),
        feature_group_count=x.shape[-1])
    return y + b.astype(x.dtype)


def rg_lru(x, w_a, b_a, w_x, b_x, lam):
    Bsz, S, W = x.shape
    xb = x.reshape(Bsz, S, LRU_BLOCKS, LRU_BLOCK)
    r = jax.nn.sigmoid(jnp.einsum('bsnd,nde->bsne', xb, w_a).reshape(Bsz, S, W) + b_a)
    i = jax.nn.sigmoid(jnp.einsum('bsnd,nde->bsne', xb, w_x).reshape(Bsz, S, W) + b_x)
    log_a = (-LRU_C * r.astype(jnp.float32)) * jax.nn.softplus(-lam.astype(jnp.float32))
    a = jnp.exp(log_a)
    mult = jnp.sqrt(-jnp.expm1(2.0 * log_a))
    u = mult * (i * x).astype(jnp.float32)

    def combine(left, right):
        a1, b1 = left
        a2, b2 = right
        return a1 * a2, a2 * b1 + b2

    _, h = lax.associative_scan(combine, (a, u), axis=1)
    return h.astype(x.dtype)


def rotate_interleaved(x, cos, sin):
    x1 = x[..., 0::2]
    x2 = x[..., 1::2]
    c = cos[:, None, :].astype(x.dtype)
    s = sin[:, None, :].astype(x.dtype)
    out = jnp.stack([x1 * c - x2 * s, x1 * s + x2 * c], axis=-1)
    return out.reshape(x.shape)


def partial_rope(x, cos, sin):
    half = ROPE_DIM // 2
    x1 = x[..., :half]
    x2 = x[..., half:ROPE_DIM]
    xp = x[..., ROPE_DIM:]
    c = cos[:, None, None, :].astype(x.dtype)
    s = sin[:, None, None, :].astype(x.dtype)
    return jnp.concatenate([x1 * c - x2 * s, x1 * s + x2 * c, xp], axis=-1)


def retention(q, k, v):
    Bsz, S, H, dk = q.shape
    dv = v.shape[-1]
    C = RET_CHUNK
    N = S // C
    f32 = jnp.float32
    log_g = jnp.log1p(-jnp.exp2(-5.0 - jnp.arange(H, dtype=f32)))
    qc = q.astype(f32).reshape(Bsz, N, C, H, dk)
    kc = (k.astype(f32) * (dk ** -0.5)).reshape(Bsz, N, C, H, dk)
    vc = v.astype(f32).reshape(Bsz, N, C, H, dv)
    idx = jnp.arange(C, dtype=f32)
    rel = idx[:, None] - idx[None, :]
    intra = jnp.where(rel[None] >= 0,
                      jnp.exp(log_g[:, None, None] * jnp.maximum(rel, 0.0)[None]), 0.0)
    scores = jnp.einsum('bnihd,bnjhd->bnhij', qc, kc) * intra
    inner = jnp.einsum('bnhij,bnjhe->bnihe', scores, vc)
    k_decay = jnp.exp(log_g[:, None] * (C - 1.0 - idx)[None, :])
    kv = jnp.einsum('bnjhd,hj,bnjhe->nbhde', kc, k_decay, vc)
    chunk_decay = jnp.exp(log_g * C)[None, :, None, None]

    def step(state, kv_n):
        return state * chunk_decay + kv_n, state

    _, prev = lax.scan(step, jnp.zeros((Bsz, H, dk, dv), f32), kv)
    q_decay = jnp.exp(log_g[:, None] * (idx + 1.0)[None, :])
    cross = jnp.einsum('bnihd,hi,nbhde->bnihe', qc, q_decay, prev)
    out = (inner + cross).reshape(Bsz, S, H, dv)
    mu = jnp.mean(out, axis=-1, keepdims=True)
    var = jnp.mean(jnp.square(out - mu), axis=-1, keepdims=True)
    return (out - mu) * lax.rsqrt(var + EPS)


def diff_attention(q, k, v, lam, sub_g, lam_init):
    Bsz, S, H, _, d = q.shape
    nb = S // Q_BLOCK
    qb = q.reshape(Bsz, nb, Q_BLOCK, H, 2, d).transpose(1, 0, 3, 4, 2, 5)
    kt = k.transpose(0, 2, 3, 1, 4)
    vt = v.transpose(0, 2, 1, 3)
    key_pos = jnp.arange(S)
    scale = d ** -0.5

    def block(args):
        qblk, start = args
        s = jnp.einsum('bhcqd,bhckd->bhcqk', qblk, kt).astype(jnp.float32) * scale
        q_pos = start + jnp.arange(Q_BLOCK)
        mask = key_pos[None, :] <= q_pos[:, None]
        s = jnp.where(mask, s, -jnp.inf)
        p = jax.nn.softmax(s, axis=-1)
        w = p[:, :, 0] - lam * p[:, :, 1]
        return jnp.einsum('bhqk,bhke->bhqe', w.astype(vt.dtype), vt)

    starts = jnp.arange(nb) * Q_BLOCK
    o = lax.map(block, (qb, starts))
    o = o.transpose(1, 0, 3, 2, 4).reshape(Bsz, S, H, 2 * d)
    of = o.astype(jnp.float32)
    of = of * lax.rsqrt(jnp.mean(of * of, axis=-1, keepdims=True) + EPS) * sub_g.astype(jnp.float32)
    return (of * (1.0 - lam_init)).astype(v.dtype)


def hybrid_layer(x, layer_idx, cos_r, sin_r, cos_d, sin_d, pre_g, post_g, w_in, conv_w, conv_b,
                 lru_wa, lru_ba, lru_wx, lru_bx, lru_lambda, diff_lam, diff_sub,
                 w_br_a, w_br_b, w_br_c, w_out):
    Bsz, S, _ = x.shape
    h = rms_norm(x, pre_g)
    proj = jnp.einsum('bsd,de->bse', h, w_in)
    offsets = tuple(int(o) for o in np.cumsum(IN_SPLITS)[:-1])
    xa, ga, qr, kr, vr, gr, qd, kd, vd, gd, gm = jnp.split(proj, offsets, axis=-1)

    xa = causal_dwconv(xa, conv_w, conv_b)
    ya = rg_lru(xa, lru_wa, lru_ba, lru_wx, lru_bx, lru_lambda) * jax.nn.silu(ga)

    qr = rotate_interleaved(qr.reshape(Bsz, S, RET_HEADS, RET_HEAD_DIM), cos_r, sin_r)
    kr = rotate_interleaved(kr.reshape(Bsz, S, RET_HEADS, RET_HEAD_DIM), cos_r, sin_r)
    vr = vr.reshape(Bsz, S, RET_HEADS, RET_HEAD_DIM)
    yb = retention(qr, kr, vr).reshape(Bsz, S, RET_WIDTH).astype(x.dtype) * jax.nn.silu(gr)

    lam_init = 0.8 - 0.6 * math.exp(-0.3 * layer_idx)
    dl = diff_lam.astype(jnp.float32)
    lam = jnp.exp(jnp.sum(dl[0] * dl[1])) - jnp.exp(jnp.sum(dl[2] * dl[3])) + lam_init
    qd = partial_rope(qd.reshape(Bsz, S, DIFF_HEADS, 2, DIFF_HEAD_DIM), cos_d, sin_d)
    kd = partial_rope(kd.reshape(Bsz, S, DIFF_HEADS, 2, DIFF_HEAD_DIM), cos_d, sin_d)
    vd = vd.reshape(Bsz, S, DIFF_HEADS, DIFF_V_DIM)
    yc = diff_attention(qd, kd, vd, lam, diff_sub, lam_init).reshape(Bsz, S, DIFF_WIDTH) * jax.nn.silu(gd)

    gm = jax.nn.sigmoid(gm.reshape(Bsz, S, N_BRANCH, D_MODEL))
    m = (gm[:, :, 0] * jnp.einsum('bsw,wd->bsd', ya, w_br_a)
         + gm[:, :, 1] * jnp.einsum('bsw,wd->bsd', yb, w_br_b)
         + gm[:, :, 2] * jnp.einsum('bsw,wd->bsd', yc, w_br_c))
    o = jnp.einsum('bsd,de->bse', m, w_out)
    return x + rms_norm(o, post_g)


def setup_inputs(seed: int = 0) -> dict:
    key = jax.random.key(seed)
    ks = jax.random.split(key, 20)
    f32 = jnp.float32
    nrm = lambda k, shape, scale: jax.random.normal(k, shape, f32) * scale
    u = jax.random.uniform(ks[10], (DEPTH, LRU_WIDTH), f32, 0.9, 0.999)
    s = u ** (1.0 / LRU_C)
    lru_lambda = jnp.log(s) - jnp.log1p(-s)
    return {
        "x": nrm(ks[0], (BATCH, SEQ, D_MODEL), 1.0),
        "pre_norm": 1.0 + nrm(ks[1], (DEPTH, D_MODEL), 0.05),
        "post_norm": 1.0 + nrm(ks[2], (DEPTH, D_MODEL), 0.05),
        "w_in": nrm(ks[3], (DEPTH, D_MODEL, D_IN), D_MODEL ** -0.5),
        "conv_w": nrm(ks[4], (DEPTH, CONV_WIDTH, LRU_WIDTH), CONV_WIDTH ** -0.5),
        "conv_b": nrm(ks[5], (DEPTH, LRU_WIDTH), 0.02),
        "lru_wa": nrm(ks[6], (DEPTH, LRU_BLOCKS, LRU_BLOCK, LRU_BLOCK), LRU_BLOCK ** -0.5),
        "lru_ba": nrm(ks[7], (DEPTH, LRU_WIDTH), 0.02),
        "lru_wx": nrm(ks[8], (DEPTH, LRU_BLOCKS, LRU_BLOCK, LRU_BLOCK), LRU_BLOCK ** -0.5),
        "lru_bx": nrm(ks[9], (DEPTH, LRU_WIDTH), 0.02),
        "lru_lambda": lru_lambda,
        "diff_lambda": nrm(ks[11], (DEPTH, 4, DIFF_HEAD_DIM), 0.1),
        "diff_subln": 1.0 + nrm(ks[12], (DEPTH, DIFF_V_DIM), 0.05),
        "w_branch_a": nrm(ks[13], (DEPTH, LRU_WIDTH, D_MODEL), LRU_WIDTH ** -0.5),
        "w_branch_b": nrm(ks[14], (DEPTH, RET_WIDTH, D_MODEL), RET_WIDTH ** -0.5),
        "w_branch_c": nrm(ks[15], (DEPTH, DIFF_WIDTH, D_MODEL), DIFF_WIDTH ** -0.5),
        "w_out": nrm(ks[16], (DEPTH, D_MODEL, D_MODEL), D_MODEL ** -0.5),
    }


def reference(x, pre_norm, post_norm, w_in, conv_w, conv_b, lru_wa, lru_ba, lru_wx, lru_bx,
              lru_lambda, diff_lambda, diff_subln, w_branch_a, w_branch_b, w_branch_c, w_out):
    S = x.shape[1]
    pos = jnp.arange(S, dtype=jnp.float32)
    ret_freq = 1.0 / (RET_ROT_BASE ** jnp.linspace(0.0, 1.0, RET_HEAD_DIM // 2, dtype=jnp.float32))
    ang_r = pos[:, None] * ret_freq[None, :]
    cos_r, sin_r = jnp.cos(ang_r), jnp.sin(ang_r)
    inv_freq = ROPE_THETA ** (-jnp.arange(0, ROPE_DIM, 2, dtype=jnp.float32) / ROPE_DIM)
    ang_d = pos[:, None] * inv_freq[None, :]
    cos_d, sin_d = jnp.cos(ang_d), jnp.sin(ang_d)
    for l in range(DEPTH):
        x = hybrid_layer(x, l, cos_r, sin_r, cos_d, sin_d, pre_norm[l], post_norm[l], w_in[l],
                         conv_w[l], conv_b[l], lru_wa[l], lru_ba[l], lru_wx[l], lru_bx[l],
                         lru_lambda[l], diff_lambda[l], diff_subln[l], w_branch_a[l],
                         w_branch_b[l], w_branch_c[l], w_out[l])
    return x
```

```cpp
#include <hip/hip_runtime.h>
#include <cstdio>
#include <cstdint>

namespace pg8 {
#define PG8_LAS __attribute__((address_space(3)))
typedef unsigned short bf16_t;
typedef short bf16x8 __attribute__((ext_vector_type(8)));
typedef float f32x4 __attribute__((ext_vector_type(4)));
typedef unsigned u32x4 __attribute__((ext_vector_type(4)));
constexpr int BM = 256, BK = 64, HALF = 128, HTB = HALF * BK * 2  , STAGE_BYTES = 8 * HTB, NXCD = 8, WGM = 8;

__host__ __device__ __forceinline__ int lds_byte(int r, int c) { const int st = (r >> 4) * 2 + (c >> 5), rr = r & 15, cc = c & 31, ob = rr * 64 + cc * 2; return st * 1024 + (ob ^ (((ob >> 9) & 1) << 5)); }
__host__ __device__ __forceinline__ void stage_rc(int b, int& R, int& C) { const int st = b / 1024, sb = b % 1024, swz = sb ^ (((sb >> 9) & 1) << 5); R = (st >> 1) * 16 + swz / 64; C = (st & 1) * 32 + (swz % 64) / 2; }
__host__ __device__ __forceinline__ int perm32(int rho) { const int n = rho >> 4, i = rho & 15; return 8 * (i >> 2) + 4 * n + (i & 3); }

struct Unit { int pm, pn, sel; };

struct StaticOrder {
    int nM, nN, nwg, G, c;
    __host__ __device__ void init(int M, int N, int G_, int c_) { nM = M / BM; nN = N / BM; nwg = nM * nN; G = G_; c = c_; }
    __host__ __device__ bool next(int i, Unit& u) const {
        const long L = (long)i * G + c; if (L >= nwg) return false;
        int wgid = (int)L; { const int q = nwg / NXCD, r = nwg % NXCD, xcd = wgid % NXCD, off = wgid / NXCD; wgid = (xcd < r ? xcd * (q + 1) : r * (q + 1) + (xcd - r) * q) + off; }
        const int nig = WGM * nN, gid = wgid / nig, fm = gid * WGM, gsz = (nM - fm) < WGM ? (nM - fm) : WGM;
        u.pm = fm + ((wgid % nig) % gsz); u.pn = (wgid % nig) / gsz; u.sel = 0; return true;
    }
};
struct SchedPlain {
    StaticOrder so; const char* A; const char* Bt;
    __device__ __forceinline__ bool next(int i, Unit& u) const { return so.next(i, u); }
    __device__ __forceinline__ const char* a_base(const Unit& u, size_t tstep) const { return A + (size_t)u.pm * tstep; }
    __device__ __forceinline__ const char* b_base(const Unit& u, size_t tstep) const { return Bt + (size_t)u.pn * tstep; }
    __device__ __forceinline__ bool keep(const Unit&) const { return false; }
    __device__ __forceinline__ void a_ready(const Unit&) const {}
    __device__ __forceinline__ void done(const Unit&) const {}
};
struct SchedBranch {
    StaticOrder so; const char* A; const char* Bt; size_t strideA, strideB;
    __device__ __forceinline__ bool next(int i, Unit& u) const { const int t = i / 3; if (!so.next(t, u)) return false; u.sel = i - 3 * t; return true; }
    __device__ __forceinline__ const char* a_base(const Unit& u, size_t tstep) const { return A + (size_t)u.sel * strideA + (size_t)u.pm * tstep; }
    __device__ __forceinline__ const char* b_base(const Unit& u, size_t tstep) const { return Bt + (size_t)u.sel * strideB + (size_t)u.pn * tstep; }
    __device__ __forceinline__ bool keep(const Unit& u) const { return u.sel < 2; }
    __device__ __forceinline__ void a_ready(const Unit&) const {}
    __device__ __forceinline__ void done(const Unit&) const {}
};

__device__ __forceinline__ unsigned cvt_pk_bf16(float lo, float hi) { unsigned r; asm volatile("v_cvt_pk_bf16_f32 %0, %1, %2" : "=v"(r) : "v"(lo), "v"(hi)); return r; }
__device__ __forceinline__ float bf_lo(unsigned w) { return __uint_as_float(w << 16); }
__device__ __forceinline__ float bf_hi(unsigned w) { return __uint_as_float(w & 0xffff0000u); }
__device__ __forceinline__ float fast_sigmoid(float x) { return __builtin_amdgcn_rcpf(1.0f + __expf(-x)); }
__device__ __forceinline__ float fast_silu(float x) { return x * fast_sigmoid(x); }
__device__ __forceinline__ float lg2_gamma(int h) {
    const float x = __builtin_amdgcn_exp2f((float)(-5 - h));
    const float s = x * (1.0f + x * (0.5f + x * (0.33333334f + x * (0.25f + x * 0.2f))));
    return -s * 1.4426950408889634f;
}

struct EpiF32 {
    static constexpr bool PERM = false, AFTER_DRAIN = false;
    float* C; int ldc;
    __device__ __forceinline__ void operator()(f32x4 (&acc)[2][2][4][2], const Unit& u, int wr, int wc, int fr, int fq) const {
        const int row0 = u.pm * BM + wr * 64 + fr, col0 = u.pn * BM + wc * 32 + 4 * fq;
#pragma unroll
        for (int ai = 0; ai < 2; ++ai)
#pragma unroll
            for (int m = 0; m < 4; ++m) { float* rowp = C + (size_t)(row0 + ai * HALF + m * 16) * ldc + col0;
#pragma unroll
                for (int bj = 0; bj < 2; ++bj)
#pragma unroll
                    for (int n = 0; n < 2; ++n) *(f32x4*)(rowp + bj * HALF + n * 16) = acc[ai][bj][m][n]; }
    }
};

struct EpiProj {
    static constexpr bool PERM = true, AFTER_DRAIN = false;
    bf16_t* proj; bf16_t* gm; const float* cosr; const float* sinr; const float* cosd; const float* sind;
    __device__ __forceinline__ void operator()(f32x4 (&acc)[2][2][4][2], const Unit& u, int wr, int wc, int fr, int fq) const {
        const int row0 = u.pm * BM + wr * 64 + fr, colt = u.pn * BM, seg = colt >> 10, cl = wc * 32 + 8 * fq;
#pragma unroll
        for (int ai = 0; ai < 2; ++ai)
#pragma unroll
            for (int m = 0; m < 4; ++m) {
                const int row = row0 + ai * HALF + m * 16, pos = row & 4095;
#pragma unroll
                for (int bj = 0; bj < 2; ++bj) {
                    const int col = colt + bj * HALF + cl;
                    f32x4 v0 = acc[ai][bj][m][0], v1 = acc[ai][bj][m][1];
                    if (seg >= 10) {
#pragma unroll
                        for (int k = 0; k < 4; ++k) { v0[k] = fast_sigmoid(v0[k]); v1[k] = fast_sigmoid(v1[k]); }
                    } else if (seg == 1 || seg == 5 || seg == 9) {
#pragma unroll
                        for (int k = 0; k < 4; ++k) { v0[k] = fast_silu(v0[k]); v1[k] = fast_silu(v1[k]); }
                    } else if (seg == 2 || seg == 3) {
                        const int i0 = 16 * wc + 4 * fq;
                        const f32x4 c4 = *(const f32x4*)(cosr + pos * 64 + i0), s4 = *(const f32x4*)(sinr + pos * 64 + i0);
                        float sc = 1.0f;
                        if (seg == 3) { const int h = ((colt - 3072) >> 7) + bj; sc = 0.08838834764831845f * __builtin_amdgcn_exp2f(lg2_gamma(h) * (float)(127 - (pos & 127))); }
                        f32x4 o0, o1;
                        o0[0] = (v0[0] * c4[0] - v0[1] * s4[0]) * sc; o0[1] = (v0[0] * s4[0] + v0[1] * c4[0]) * sc;
                        o0[2] = (v0[2] * c4[1] - v0[3] * s4[1]) * sc; o0[3] = (v0[2] * s4[1] + v0[3] * c4[1]) * sc;
                        o1[0] = (v1[0] * c4[2] - v1[1] * s4[2]) * sc; o1[1] = (v1[0] * s4[2] + v1[1] * c4[2]) * sc;
                        o1[2] = (v1[2] * c4[3] - v1[3] * s4[3]) * sc; o1[3] = (v1[2] * s4[3] + v1[3] * c4[3]) * sc;
                        v0 = o0; v1 = o1;
                    } else if (seg == 6 || seg == 7) {
                        if ((wc & 1) == 0) {
                            f32x4 p0, p1;
#pragma unroll
                            for (int k = 0; k < 4; ++k) { p0[k] = __shfl_xor(v0[k], 16); p1[k] = __shfl_xor(v1[k], 16); }
                            const f32x4 ca = *(const f32x4*)(cosd + pos * 8), cb = *(const f32x4*)(cosd + pos * 8 + 4);
                            f32x4 sa = *(const f32x4*)(sind + pos * 8), sb = *(const f32x4*)(sind + pos * 8 + 4);
                            if (fq == 0) { sa = -sa; sb = -sb; }
                            if (fq < 2) { v0 = v0 * ca + p0 * sa; v1 = v1 * cb + p1 * sb; }
                        }
                        if (seg == 6) { v0 = v0 * 0.18033688011112042f; v1 = v1 * 0.18033688011112042f; }
                    }
                    u32x4 w; w.x = cvt_pk_bf16(v0[0], v0[1]); w.y = cvt_pk_bf16(v0[2], v0[3]); w.z = cvt_pk_bf16(v1[0], v1[1]); w.w = cvt_pk_bf16(v1[2], v1[3]);
                    if (seg >= 10) *(u32x4*)(gm + (size_t)row * 6144 + (col - 10240)) = w;
                    else *(u32x4*)(proj + (size_t)row * 10240 + col) = w;
                }
            }
    }
};

struct EpiMerge {
    static constexpr bool PERM = true, AFTER_DRAIN = false;
    const bf16_t* gm; bf16_t* mo;
    __device__ __forceinline__ void operator()(f32x4 (&acc)[2][2][4][2], const Unit& u, int wr, int wc, int fr, int fq) const {
        const int row0 = u.pm * BM + wr * 64 + fr, col0 = u.pn * BM + wc * 32 + 8 * fq, j = u.sel;
#pragma unroll
        for (int ai = 0; ai < 2; ++ai)
#pragma unroll
            for (int m = 0; m < 4; ++m) {
                const int row = row0 + ai * HALF + m * 16;
#pragma unroll
                for (int bj = 0; bj < 2; ++bj) {
                    const int col = col0 + bj * HALF;
                    const u32x4 gc = *(const u32x4*)(gm + (size_t)row * 6144 + j * 2048 + col);
                    f32x4 g0 = {bf_lo(gc.x), bf_hi(gc.x), bf_lo(gc.y), bf_hi(gc.y)}, g1 = {bf_lo(gc.z), bf_hi(gc.z), bf_lo(gc.w), bf_hi(gc.w)};
#pragma unroll
                    for (int k = 0; k < 4; ++k) { g0[k] = fmaxf(g0[k], 1e-18f); g1[k] = fmaxf(g1[k], 1e-18f); }
                    if (j < 2) {
                        const u32x4 gn = *(const u32x4*)(gm + (size_t)row * 6144 + (j + 1) * 2048 + col);
                        const f32x4 n0 = {bf_lo(gn.x), bf_hi(gn.x), bf_lo(gn.y), bf_hi(gn.y)}, n1 = {bf_lo(gn.z), bf_hi(gn.z), bf_lo(gn.w), bf_hi(gn.w)};
#pragma unroll
                        for (int k = 0; k < 4; ++k) { g0[k] = g0[k] * __builtin_amdgcn_rcpf(fmaxf(n0[k], 1e-18f)); g1[k] = g1[k] * __builtin_amdgcn_rcpf(fmaxf(n1[k], 1e-18f)); }
                        acc[ai][bj][m][0] = acc[ai][bj][m][0] * g0; acc[ai][bj][m][1] = acc[ai][bj][m][1] * g1;
                    } else {
                        const f32x4 v0 = acc[ai][bj][m][0] * g0, v1 = acc[ai][bj][m][1] * g1;
                        u32x4 w; w.x = cvt_pk_bf16(v0[0], v0[1]); w.y = cvt_pk_bf16(v0[2], v0[3]); w.z = cvt_pk_bf16(v1[0], v1[1]); w.w = cvt_pk_bf16(v1[2], v1[3]);
                        *(u32x4*)(mo + (size_t)row * 2048 + col) = w;
                    }
                }
            }
    }
};

template <class Epi, class Sched, bool ALIGN_EPI = false, bool SP2 = false>
__device__ __forceinline__ void gemm_phase(PG8_LAS unsigned char* lds, const int K_, const Sched& S, const Epi& E, const int tid) {
    const int wid = __builtin_amdgcn_readfirstlane(tid >> 6), lane = tid & 63, wr = wid >> 2, wc = wid & 3, fr = lane & 15, fq = lane >> 4;
    const int K = K_, nt = K / BK;
    unsigned voffA[2], voffB[2];
#pragma unroll
    for (int i = 0; i < 2; ++i) { int R, C; stage_rc(tid * 16 + i * 8192, R, C); const int Rb = Epi::PERM ? ((R & ~31) + perm32(R & 31)) : R;
        voffA[i] = (unsigned)(R * K + C) * 2u; voffB[i] = (unsigned)(Rb * K + C) * 2u; }
    const size_t kstep = (size_t)(BK * 2);
    const size_t hstep = (size_t)HALF * K * 2;
    const size_t tstep = 2 * hstep;
    const unsigned ldsw = (unsigned)wid * 1024u;
    const int aoff = lds_byte(wr * 64 + fr, fq * 8), boff = lds_byte(wc * 32 + fr, fq * 8);
#define PG8_SA(b, h) (((b) * 2 + (h)) * HTB)
#define PG8_SB(b, h) ((4 + (b) * 2 + (h)) * HTB)
#define PG8_STAGE(bufoff, gbase, voff) do { _Pragma("unroll") for (int _i = 0; _i < 2; ++_i) \
        __builtin_amdgcn_global_load_lds((const unsigned*)((const char*)(gbase) + (voff)[_i]), (PG8_LAS unsigned*)(lds + (bufoff) + ldsw + _i * 8192), 16, 0, 0); } while (0)
#define PG8_LDA(dst, b, h) do { _Pragma("unroll") for (int m = 0; m < 4; ++m) _Pragma("unroll") for (int k = 0; k < 2; ++k) dst[m][k] = *(const PG8_LAS bf16x8*)(lds + PG8_SA(b, h) + aoff + m * 2048 + k * 1024); } while (0)
#define PG8_LDB(dst, b, h) do { _Pragma("unroll") for (int n = 0; n < 2; ++n) _Pragma("unroll") for (int k = 0; k < 2; ++k) dst[n][k] = *(const PG8_LAS bf16x8*)(lds + PG8_SB(b, h) + boff + n * 2048 + k * 1024); } while (0)
#define PG8_MMA(ai, bj, At, Bt) do { __builtin_amdgcn_s_setprio(1); _Pragma("unroll") for (int m = 0; m < 4; ++m) _Pragma("unroll") for (int n = 0; n < 2; ++n) _Pragma("unroll") for (int k = 0; k < 2; ++k) \
        acc[ai][bj][m][n] = __builtin_amdgcn_mfma_f32_16x16x32_bf16(Bt[n][k], At[m][k], acc[ai][bj][m][n], 0, 0, 0); __builtin_amdgcn_s_setprio(0); } while (0)
#define PG8_WAIT_V(n) asm volatile("s_waitcnt vmcnt(" #n ")" ::: "memory")
#define PG8_WAIT_L(n) asm volatile("s_waitcnt lgkmcnt(" #n ")" ::: "memory")
#define PG8_BAR __builtin_amdgcn_s_barrier()
#define PG8_SCHED __builtin_amdgcn_sched_barrier(0)
    Unit cur, nxt; int ui = 0;
    if (!S.next(0, cur)) return;
    f32x4 acc[2][2][4][2];
#pragma unroll
    for (int a = 0; a < 2; ++a)
#pragma unroll
        for (int b = 0; b < 2; ++b)
#pragma unroll
            for (int m = 0; m < 4; ++m)
#pragma unroll
                for (int n = 0; n < 2; ++n) acc[a][b][m][n] = (f32x4){0.f, 0.f, 0.f, 0.f};
    bf16x8 At[4][2], B0[2][2], B1[2][2];
    const char* cA = S.a_base(cur, tstep); const char* cB = S.b_base(cur, tstep);
    S.a_ready(cur);
    if constexpr (SP2) {
        PG8_STAGE(PG8_SB(0, 0), cB, voffB); PG8_STAGE(PG8_SB(0, 1), cB + hstep, voffB); PG8_STAGE(PG8_SA(0, 0), cA, voffA); PG8_STAGE(PG8_SA(0, 1), cA + hstep, voffA);
        if (wr == 1) PG8_BAR;
        PG8_WAIT_V(2); PG8_BAR;
        PG8_STAGE(PG8_SB(1, 0), cB + kstep, voffB); PG8_STAGE(PG8_SA(1, 0), cA + kstep, voffA); PG8_STAGE(PG8_SB(1, 1), cB + hstep + kstep, voffB);
        PG8_WAIT_V(6); PG8_BAR;
    } else {
        PG8_STAGE(PG8_SB(0, 0), cB, voffB); PG8_STAGE(PG8_SA(0, 0), cA, voffA); PG8_STAGE(PG8_SB(0, 1), cB + hstep, voffB); PG8_STAGE(PG8_SA(0, 1), cA + hstep, voffA);
        if (wr == 1) PG8_BAR;
        PG8_WAIT_V(4); PG8_BAR;
        PG8_STAGE(PG8_SB(1, 0), cB + kstep, voffB); PG8_STAGE(PG8_SA(1, 0), cA + kstep, voffA); PG8_STAGE(PG8_SB(1, 1), cB + hstep + kstep, voffB);
        PG8_WAIT_V(6); PG8_BAR;
    }
    for (;;) {
        const bool has_next = S.next(ui + 1, nxt);
        const char* nA = has_next ? S.a_base(nxt, tstep) : cA; const char* nB = has_next ? S.b_base(nxt, tstep) : cB;
        for (int t = 0; t < nt; t += 2) {
            const bool last = (t == nt - 2);
            const char* a1 = cA + (size_t)(t + 1) * kstep;
            const char* a2 = last ? nA : cA + (size_t)(t + 2) * kstep; const char* b2 = last ? nB : cB + (size_t)(t + 2) * kstep;
            const char* a3 = a2 + kstep; const char* b3 = b2 + kstep;
            if (last && has_next) S.a_ready(nxt);
            if constexpr (SP2) {
            PG8_LDB(B0, 0, 0); PG8_LDB(B1, 0, 1); PG8_SCHED; PG8_LDA(At, 0, 0); PG8_STAGE(PG8_SA(1, 1), a1 + hstep, voffA);
            PG8_WAIT_V(8); PG8_WAIT_L(0); PG8_BAR; PG8_MMA(0, 0, At, B0); PG8_MMA(0, 1, At, B1); PG8_BAR; PG8_SCHED;
            PG8_LDA(At, 0, 1); PG8_STAGE(PG8_SB(0, 0), b2, voffB); PG8_STAGE(PG8_SB(0, 1), b2 + hstep, voffB); PG8_STAGE(PG8_SA(0, 0), a2, voffA);
            PG8_WAIT_V(8); PG8_WAIT_L(0); PG8_BAR; PG8_MMA(1, 0, At, B0); PG8_MMA(1, 1, At, B1); PG8_BAR; PG8_SCHED;
            PG8_LDB(B0, 1, 0); PG8_LDB(B1, 1, 1); PG8_SCHED; PG8_LDA(At, 1, 0); PG8_STAGE(PG8_SA(0, 1), a2 + hstep, voffA);
            PG8_WAIT_V(8); PG8_WAIT_L(0); PG8_BAR; PG8_MMA(0, 0, At, B0); PG8_MMA(0, 1, At, B1); PG8_BAR; PG8_SCHED;
            PG8_LDA(At, 1, 1); PG8_STAGE(PG8_SB(1, 0), b3, voffB); PG8_STAGE(PG8_SB(1, 1), b3 + hstep, voffB); PG8_STAGE(PG8_SA(1, 0), a3, voffA);
            PG8_WAIT_V(8); PG8_WAIT_L(0); PG8_BAR; PG8_MMA(1, 0, At, B0); PG8_MMA(1, 1, At, B1); PG8_BAR; PG8_SCHED;
            } else {
            PG8_LDB(B0, 0, 0); PG8_SCHED; PG8_LDA(At, 0, 0); PG8_STAGE(PG8_SA(1, 1), a1 + hstep, voffA);
            PG8_WAIT_L(8); PG8_BAR; PG8_WAIT_L(0); PG8_MMA(0, 0, At, B0); PG8_BAR; PG8_SCHED;
            PG8_LDB(B1, 0, 1); PG8_STAGE(PG8_SB(0, 0), b2, voffB);
            PG8_BAR; PG8_WAIT_L(0); PG8_MMA(0, 1, At, B1); PG8_BAR;
            PG8_LDA(At, 0, 1); PG8_STAGE(PG8_SA(0, 0), a2, voffA);
            PG8_BAR; PG8_WAIT_L(0); PG8_MMA(1, 0, At, B0); PG8_BAR; PG8_SCHED;
            PG8_STAGE(PG8_SB(0, 1), b2 + hstep, voffB);
            PG8_WAIT_V(6); PG8_BAR; PG8_MMA(1, 1, At, B1); PG8_BAR;
            PG8_LDB(B0, 1, 0); PG8_SCHED; PG8_LDA(At, 1, 0); PG8_STAGE(PG8_SA(0, 1), a2 + hstep, voffA);
            PG8_WAIT_L(8); PG8_BAR; PG8_WAIT_L(0); PG8_MMA(0, 0, At, B0); PG8_BAR; PG8_SCHED;
            PG8_LDB(B1, 1, 1); PG8_STAGE(PG8_SB(1, 0), b3, voffB);
            PG8_BAR; PG8_WAIT_L(0); PG8_MMA(0, 1, At, B1); PG8_BAR;
            PG8_LDA(At, 1, 1); PG8_STAGE(PG8_SA(1, 0), a3, voffA);
            PG8_BAR; PG8_WAIT_L(0); PG8_MMA(1, 0, At, B0); PG8_BAR; PG8_SCHED;
            PG8_STAGE(PG8_SB(1, 1), b3 + hstep, voffB);
            PG8_WAIT_V(6); PG8_BAR; PG8_MMA(1, 1, At, B1); PG8_BAR;
            }
        }
        if constexpr (ALIGN_EPI) { if (wr == 0) PG8_BAR; }
        if constexpr (!Epi::AFTER_DRAIN) { E(acc, cur, wr, wc, fr, fq); S.done(cur); }
        if (!has_next) break;
        if (!S.keep(cur)) {
#pragma unroll
        for (int a = 0; a < 2; ++a)
#pragma unroll
            for (int b = 0; b < 2; ++b)
#pragma unroll
                for (int m = 0; m < 4; ++m)
#pragma unroll
                    for (int n = 0; n < 2; ++n) acc[a][b][m][n] = (f32x4){0.f, 0.f, 0.f, 0.f};
        }
        cur = nxt; cA = nA; cB = nB; ++ui;
        if constexpr (ALIGN_EPI) { if (wr == 1) PG8_BAR; }
    }
    PG8_WAIT_V(0);
    if constexpr (!ALIGN_EPI) { if (wr == 0) PG8_BAR; }
    PG8_BAR;
    if constexpr (Epi::AFTER_DRAIN) { E.fused(acc, cur, wr, wc, fr, fq, lds, wid, lane); S.done(cur); }
#undef PG8_SA
#undef PG8_SB
#undef PG8_STAGE
#undef PG8_LDA
#undef PG8_LDB
#undef PG8_MMA
#undef PG8_WAIT_V
#undef PG8_WAIT_L
#undef PG8_BAR
#undef PG8_SCHED
}
}
#define GAS __attribute__((address_space(1)))
#define LAS __attribute__((address_space(3)))
typedef unsigned short bf16;
typedef unsigned v4u __attribute__((ext_vector_type(4)));
typedef float f32x4 __attribute__((ext_vector_type(4)));
typedef short bf16x8 __attribute__((ext_vector_type(8)));
typedef GAS unsigned gu32;
typedef GAS unsigned long long gu64;
#define RLX_AGENT __ATOMIC_RELAXED, __HIP_MEMORY_SCOPE_AGENT
#define LDS_WAIT() asm volatile("s_waitcnt lgkmcnt(0)" ::: "memory")
#define VM_WAIT() asm volatile("s_waitcnt vmcnt(0)" ::: "memory")
__device__ __forceinline__ unsigned long long rt() { return __builtin_amdgcn_s_memrealtime(); }
__device__ __forceinline__ unsigned f2bf(float f) { unsigned u = __builtin_bit_cast(unsigned, f); return (u + 0x7fffu + ((u >> 16) & 1u)) >> 16; }
__device__ __forceinline__ unsigned pk2(float lo, float hi) { return f2bf(lo) | (f2bf(hi) << 16); }

#define XB_TMO      128
#define XB_XCNT(j)  (256  + 64 * (j))
#define XB_XSUB(j)  (1280 + 64 * (j))
#define XB_XGEN(j)  (2304 + 64 * (j))
#define XB_TOP      3328
#define XB_TOPGEN   3392
#define XCD_BAR_WORDS 3456
#define XB_SPIN_CAP (1u << 18)

__device__ __forceinline__ unsigned xb_ld(unsigned* p)              { return __hip_atomic_load(p, __ATOMIC_RELAXED, __HIP_MEMORY_SCOPE_AGENT); }
__device__ __forceinline__ unsigned xb_add(unsigned* p, unsigned v) { return __hip_atomic_fetch_add(p, v, __ATOMIC_RELAXED, __HIP_MEMORY_SCOPE_AGENT); }
__device__ __forceinline__ unsigned xb_xcc_id() { return (unsigned)__builtin_amdgcn_s_getreg((3 << 11) | 20) & 0xFu; }
#define XB_SPIN(cond, bar) do { unsigned _sp = 0; while (cond) { __builtin_amdgcn_s_sleep(1); \
    if ((++_sp & 255u) == 0u) { if (xb_ld(&(bar)[XB_TMO])) break; if (_sp > XB_SPIN_CAP) { atomicAdd(&(bar)[XB_TMO], 1u); break; } } } } while (0)

struct XcdBarrier {
    unsigned* bar; unsigned x;
    volatile LAS unsigned* st;
};

__device__ __forceinline__ XcdBarrier xcd_barrier_post(unsigned* bar, volatile LAS unsigned* st) {
    XcdBarrier b; b.bar = bar; b.x = xb_xcc_id(); b.st = st;
    if (threadIdx.x == 0) (void)xb_add(&bar[XB_XCNT(b.x)], 1u);
    return b;
}
__device__ __forceinline__ void xcd_barrier_complete(unsigned* bar, unsigned x, unsigned& nloc, unsigned& nx) {
    const unsigned G = gridDim.x * gridDim.y * gridDim.z;
    unsigned sum, cnt, mine, sp = 0u;
    for (;;) {
        sum = 0u; cnt = 0u; mine = 0u;
#pragma unroll
        for (unsigned j = 0; j < 16; ++j) { const unsigned c = xb_ld(&bar[XB_XCNT(j)]); sum += c; cnt += (c > 0u) ? 1u : 0u; mine = (j == x) ? c : mine; }
        if (sum == G) break;
        __builtin_amdgcn_s_sleep(1);
        if ((++sp & 255u) == 0u) { if (xb_ld(&bar[XB_TMO])) break; if (sp > XB_SPIN_CAP) { atomicAdd(&bar[XB_TMO], 1u); break; } }
    }
    nloc = mine > 0u ? mine : 1u; nx = cnt > 0u ? cnt : 1u;
}

__device__ __forceinline__ void xcd_barrier(const XcdBarrier& b) {
    asm volatile("s_waitcnt vmcnt(0)" ::: "memory");
    __syncthreads();
    if (threadIdx.x == 0) {
        unsigned* bar = b.bar;
        __builtin_amdgcn_s_waitcnt(0);
        unsigned nloc = b.st[0], nx = b.st[1];
        if (nloc == 0u) { xcd_barrier_complete(bar, b.x, nloc, nx); b.st[0] = nloc; b.st[1] = nx; }
        const unsigned old = xb_add(&bar[XB_XSUB(b.x)], 1u);
        const unsigned gen = old / nloc;
        if (old + 1u == (gen + 1u) * nloc) {
            __builtin_amdgcn_fence(__ATOMIC_RELEASE, "agent");
            asm volatile("s_waitcnt vmcnt(0)" ::: "memory");
            const unsigned og = xb_add(&bar[XB_TOP], 1u);
            const unsigned tg = og / nx;
            if (og + 1u == (tg + 1u) * nx) xb_add(&bar[XB_TOPGEN], 1u);
            else XB_SPIN(xb_ld(&bar[XB_TOPGEN]) == tg, bar);
            __builtin_amdgcn_fence(__ATOMIC_ACQUIRE, "agent");
            xb_add(&bar[XB_XGEN(b.x)], 1u);
            asm volatile("s_waitcnt vmcnt(0)" ::: "memory");
        } else {
            XB_SPIN(xb_ld(&bar[XB_XGEN(b.x)]) == gen, bar);
            __builtin_amdgcn_fence(__ATOMIC_ACQUIRE, "agent");
            asm volatile("s_waitcnt vmcnt(0)" ::: "memory");
        }
    }
    __syncthreads();
}

constexpr int D_MODEL = 2048, SEQ = 4096, BATCH = 8, DEPTH = 2, M_ALL = BATCH * SEQ, D_IN = 16384;
constexpr int BG = 4, TG = BG * SEQ, NGROUP = BATCH / BG;
constexpr int PPITCH = 10240, GPITCH = 6144;
constexpr int C_XA = 0, C_GA = 1024, C_QR = 2048, C_KR = 3072, C_VR = 4096, C_GR = 5120, C_QD = 6144, C_KD = 7168, C_VD = 8192, C_GD = 9216;
constexpr float EPS = 1e-6f;
constexpr int NWAVES = 8;
constexpr size_t MiB = 1u << 20;
constexpr size_t WS_CTL = 0, CTL_ZERO_BYTES = 1 * MiB;
constexpr size_t WS_COSR = 1 * MiB, WS_SINR = 2 * MiB, WS_COSD = 3 * MiB, WS_SIND = 3 * MiB + 128 * 1024, WS_LAMS = 3 * MiB + 512 * 1024;
constexpr size_t WS_WIN = 4 * MiB;
constexpr size_t WS_WBR = 132 * MiB;
constexpr size_t WS_WOUT = 156 * MiB;
constexpr size_t WS_H = 172 * MiB;
constexpr size_t WS_Y = 300 * MiB;
constexpr size_t WS_GM = 396 * MiB;
constexpr size_t WS_PROJ = 588 * MiB;
constexpr size_t WS_O = 588 * MiB;
constexpr size_t WS_M = 716 * MiB;
constexpr size_t WS_END = 908 * MiB;
static_assert(WS_M + (size_t)TG * 2048 * 2 <= WS_END && WS_O + (size_t)TG * 2048 * 4 <= WS_M && WS_PROJ + (size_t)TG * PPITCH * 2 == WS_END, "d_ws map");
constexpr int CW_TMO = 0;
constexpr int CW_BAR = 4096;
constexpr int CW_Q = 16384;
constexpr int RING_BYTES = 131072, LDSCTL_OFF = RING_BYTES, MISC_OFF = LDSCTL_OFF + 320, LDS_BYTES = 147456;

typedef float f32x16 __attribute__((ext_vector_type(16)));
typedef short s16x4 __attribute__((ext_vector_type(4)));
typedef short v4i16_t __attribute__((ext_vector_type(4)));
typedef unsigned u32x2 __attribute__((ext_vector_type(2)));
typedef LAS unsigned char* ldsp;
using pg8::cvt_pk_bf16; using pg8::bf_lo; using pg8::bf_hi; using pg8::fast_sigmoid; using pg8::lg2_gamma;

__device__ __forceinline__ float wave_sum(float v) {
#pragma unroll
    for (int o = 1; o < 64; o <<= 1) v += __shfl_xor(v, o);
    return v;
}
__device__ __forceinline__ unsigned offb(unsigned row, unsigned ch) { return 256u * row + 16u * (ch ^ (((row & 3u) << 2) | ((row >> 2) & 3u))); }
__device__ __forceinline__ unsigned tr_nat(int lane, int k0, int t, int c) { const int h = lane >> 5, blk = (lane >> 4) & 1, q = (lane & 15) >> 2, p = lane & 3; return offb(k0 + 8 * h + 4 * t + q, 4 * c + 2 * blk + (p >> 1)) + 8 * (p & 1); }
__device__ __forceinline__ unsigned tr_perm(int lane, int k0, int t, int c) { const int h = lane >> 5, blk = (lane >> 4) & 1, q = (lane & 15) >> 2, p = lane & 3; return offb(k0 + 8 * t + 4 * h + q, 4 * c + 2 * blk + (p >> 1)) + 8 * (p & 1); }
__device__ __forceinline__ f32x16 mfma32(bf16x8 a, bf16x8 b, f32x16 c) { return __builtin_amdgcn_mfma_f32_32x32x16_bf16(a, b, c, 0, 0, 0); }
__device__ __forceinline__ s16x4 trr(ldsp p) { return __builtin_bit_cast(s16x4, __builtin_amdgcn_ds_read_tr16_b64_v4i16((LAS v4i16_t*)p)); }
__device__ __forceinline__ bf16x8 cat8(s16x4 lo, s16x4 hi) { return (bf16x8){lo[0], lo[1], lo[2], lo[3], hi[0], hi[1], hi[2], hi[3]}; }
template <int B> __device__ __forceinline__ bf16x8 pack8(const f32x16& x) {
    v4u w = {cvt_pk_bf16(x[B], x[B + 1]), cvt_pk_bf16(x[B + 2], x[B + 3]), cvt_pk_bf16(x[B + 4], x[B + 5]), cvt_pk_bf16(x[B + 6], x[B + 7])};
    return __builtin_bit_cast(bf16x8, w);
}
__device__ __forceinline__ f32x16 zero16() { f32x16 z;
#pragma unroll
    for (int i = 0; i < 16; ++i) z[i] = 0.f; return z; }

__device__ __forceinline__ void p0_transpose_item(const float* W, int K, int N, bf16* WT, LAS float* scr, int item, int lane) {
    const int nblk = N / 32, kb = item / nblk, nb = item % nblk, k0 = 64 * kb, n0 = 32 * nb;
#pragma unroll 8
    for (int i = 0; i < 32; ++i) { const int kk = 2 * i + (lane >> 5); scr[kk * 33 + (lane & 31)] = W[(size_t)(k0 + kk) * N + n0 + (lane & 31)]; }
    LDS_WAIT(); asm volatile("" ::: "memory");
    const int c = lane & 7;
#pragma unroll
    for (int j = 0; j < 4; ++j) { const int n = (lane >> 3) + 8 * j; const LAS float* s = scr + (8 * c) * 33 + n;
        v4u o; o.x = pk2(s[0 * 33], s[1 * 33]); o.y = pk2(s[2 * 33], s[3 * 33]); o.z = pk2(s[4 * 33], s[5 * 33]); o.w = pk2(s[6 * 33], s[7 * 33]);
        *(GAS v4u*)(WT + (size_t)(n0 + n) * K + k0 + 8 * c) = o; }
    LDS_WAIT(); asm volatile("" ::: "memory");
}
__device__ __forceinline__ void rms_row_to_bf16(const float* xrow, const float* g, bf16* orow, int lane) {
    const f32x4* xr = (const f32x4*)xrow + lane; const f32x4* gr = (const f32x4*)g + lane;
    f32x4 v[8]; float s = 0.f;
#pragma unroll
    for (int j = 0; j < 8; ++j) { v[j] = xr[64 * j]; s += (v[j].x * v[j].x + v[j].y * v[j].y) + (v[j].z * v[j].z + v[j].w * v[j].w); }
    const float rs = rsqrtf(wave_sum(s) * (1.f / D_MODEL) + EPS);
    u32x2* o8 = (u32x2*)orow + lane;
#pragma unroll
    for (int j = 0; j < 8; ++j) { const f32x4 gg = gr[64 * j]; u32x2 w; w.x = cvt_pk_bf16(v[j].x * rs * gg.x, v[j].y * rs * gg.y); w.y = cvt_pk_bf16(v[j].z * rs * gg.z, v[j].w * rs * gg.w); o8[64 * j] = w; }
}

__device__ __forceinline__ void ret_unit(const int tid, ldsp lds, int b, int h, const bf16* proj, bf16* yb) {
    const int lane = tid & 63, w = __builtin_amdgcn_readfirstlane(tid >> 6), r32 = lane & 31, hi = lane >> 5;
    const int it = w >> 1, eh = w & 1;
    constexpr int O_ST = 0, O_KD = 32768, O_VV = 65536;
    LAS float* STAT = (LAS float*)(lds + 98304);
    for (int i = tid; i < 2048; i += 512) ((LAS v4u*)(lds + O_ST))[i] = (v4u){0u, 0u, 0u, 0u};
    ldsp rb[8];
#pragma unroll
    for (int s = 0; s < 8; ++s) rb[s] = lds + offb(r32, 2 * s + hi);
    ldsp tnk0 = lds + O_KD + tr_nat(lane, 0, 0, it), tnk1 = lds + O_KD + tr_nat(lane, 0, 1, it);
    ldsp tnv00 = lds + O_VV + tr_nat(lane, 0, 0, 2 * eh), tnv01 = lds + O_VV + tr_nat(lane, 0, 1, 2 * eh), tnv10 = lds + O_VV + tr_nat(lane, 0, 0, 2 * eh + 1), tnv11 = lds + O_VV + tr_nat(lane, 0, 1, 2 * eh + 1);
    ldsp tpv00 = lds + O_VV + tr_perm(lane, 0, 0, 2 * eh), tpv01 = lds + O_VV + tr_perm(lane, 0, 1, 2 * eh), tpv10 = lds + O_VV + tr_perm(lane, 0, 0, 2 * eh + 1), tpv11 = lds + O_VV + tr_perm(lane, 0, 1, 2 * eh + 1);
    const int srow = tid >> 4, sch = tid & 15;
    ldsp stk = lds + O_KD + offb(srow, sch), stv = lds + O_VV + offb(srow, sch);
    const bf16* base = proj + (size_t)b * SEQ * PPITCH + h * 128;
    const bf16* Qp = base + C_QR; const bf16* Kp = base + C_KR; const bf16* Vp = base + C_VR; const bf16* Gp = base + C_GR;
    bf16* Yp = yb + (size_t)b * SEQ * 1024 + h * 128;
    const float lg = lg2_gamma(h), cd = __builtin_amdgcn_exp2f(128.f * lg), cout = __builtin_amdgcn_exp2f(lg * (float)(32 * it + r32 - 127));
    f32x16 Dacc0 = zero16(), Dacc1 = zero16();
    bf16x8 sk0, sk1, sk2, sk3, sv0, sv1, sv2, sv3;
#define RET_ISSUE(n_) do { const bf16* kp_ = Kp + (size_t)((n_) * 128 + srow) * PPITCH + sch * 8; const bf16* vp_ = Vp + (size_t)((n_) * 128 + srow) * PPITCH + sch * 8; \
        sk0 = *(const bf16x8*)kp_; sk1 = *(const bf16x8*)(kp_ + 32 * PPITCH); sk2 = *(const bf16x8*)(kp_ + 64 * PPITCH); sk3 = *(const bf16x8*)(kp_ + 96 * PPITCH); \
        sv0 = *(const bf16x8*)vp_; sv1 = *(const bf16x8*)(vp_ + 32 * PPITCH); sv2 = *(const bf16x8*)(vp_ + 64 * PPITCH); sv3 = *(const bf16x8*)(vp_ + 96 * PPITCH); } while (0)
    RET_ISSUE(0);
    for (int n = 0; n < 32; ++n) {
        *(LAS bf16x8*)(stk) = sk0; *(LAS bf16x8*)(stk + 8192) = sk1; *(LAS bf16x8*)(stk + 16384) = sk2; *(LAS bf16x8*)(stk + 24576) = sk3;
        *(LAS bf16x8*)(stv) = sv0; *(LAS bf16x8*)(stv + 8192) = sv1; *(LAS bf16x8*)(stv + 16384) = sv2; *(LAS bf16x8*)(stv + 24576) = sv3;
        const int rowi = n * 128 + 32 * it + r32;
        bf16x8 qf[8];
#pragma unroll
        for (int s = 0; s < 8; ++s) qf[s] = *(const bf16x8*)(Qp + (size_t)rowi * PPITCH + 16 * s + 8 * hi);
        __syncthreads();
        f32x16 acc0 = zero16(), acc1 = zero16();
#pragma unroll
        for (int jt = 0; jt < 4; ++jt) if (jt <= it) {
            f32x16 X = zero16();
#pragma unroll
            for (int s = 0; s < 8; ++s) X = mfma32(*(const LAS bf16x8*)(rb[s] + O_KD + 8192 * jt), qf[s], X);
            if (jt == it) {
#pragma unroll
                for (int r = 0; r < 16; ++r) { const int j = (r & 3) + 8 * (r >> 2) + 4 * hi; if (j > r32) X[r] = 0.f; }
            }
            const bf16x8 pf0 = pack8<0>(X), pf1 = pack8<8>(X);
            acc0 = mfma32(cat8(trr(tpv00 + 8192 * jt), trr(tpv01 + 8192 * jt)), pf0, acc0);
            acc1 = mfma32(cat8(trr(tpv10 + 8192 * jt), trr(tpv11 + 8192 * jt)), pf0, acc1);
            acc0 = mfma32(cat8(trr(tpv00 + 8192 * jt + 4096), trr(tpv01 + 8192 * jt + 4096)), pf1, acc0);
            acc1 = mfma32(cat8(trr(tpv10 + 8192 * jt + 4096), trr(tpv11 + 8192 * jt + 4096)), pf1, acc1);
        }
        if (n + 1 < 32) RET_ISSUE(n + 1);
        {
            ldsp st0 = lds + 16384 * eh;
#pragma unroll
            for (int s = 0; s < 8; ++s) {
                const unsigned o_ = (unsigned)(rb[s] - lds);
                acc0 = mfma32(*(const LAS bf16x8*)(st0 + o_ + O_ST), qf[s], acc0);
                acc1 = mfma32(*(const LAS bf16x8*)(st0 + o_ + O_ST + 8192), qf[s], acc1);
            }
        }
#pragma unroll
        for (int ks = 0; ks < 8; ++ks) {
            const bf16x8 a = cat8(trr(tnk0 + 4096 * ks), trr(tnk1 + 4096 * ks));
            Dacc0 = mfma32(a, cat8(trr(tnv00 + 4096 * ks), trr(tnv01 + 4096 * ks)), Dacc0);
            Dacc1 = mfma32(a, cat8(trr(tnv10 + 4096 * ks), trr(tnv11 + 4096 * ks)), Dacc1);
        }
        float s1 = 0.f, s2 = 0.f;
#pragma unroll
        for (int r = 0; r < 16; ++r) { s1 += acc0[r] + acc1[r]; s2 += acc0[r] * acc0[r] + acc1[r] * acc1[r]; }
        s1 += __shfl_xor(s1, 32); s2 += __shfl_xor(s2, 32);
        if (hi == 0) { STAT[(32 * it + r32) * 4 + eh * 2] = s1; STAT[(32 * it + r32) * 4 + eh * 2 + 1] = s2; }
        __syncthreads();
        {
            const LAS float* st = STAT + (32 * it + r32) * 4;
            const float mean = (st[0] + st[2]) * (1.f / 128.f); float var = (st[1] + st[3]) * (1.f / 128.f) - mean * mean; var = fmaxf(var, 0.f);
            const float rs = cout * rsqrtf(cout * cout * var + EPS);
            const bf16* grow = Gp + (size_t)rowi * PPITCH + 64 * eh + 4 * hi; bf16* yrow = Yp + (size_t)rowi * 1024 + 64 * eh + 4 * hi;
#pragma unroll
            for (int e2 = 0; e2 < 2; ++e2)
#pragma unroll
                for (int q4 = 0; q4 < 4; ++q4) {
                    const f32x16& A = e2 ? acc1 : acc0; const u32x2 g = *(const u32x2*)(grow + 32 * e2 + 8 * q4);
                    u32x2 o; o.x = cvt_pk_bf16((A[4 * q4] - mean) * rs * bf_lo(g.x), (A[4 * q4 + 1] - mean) * rs * bf_hi(g.x));
                    o.y = cvt_pk_bf16((A[4 * q4 + 2] - mean) * rs * bf_lo(g.y), (A[4 * q4 + 3] - mean) * rs * bf_hi(g.y));
                    *(u32x2*)(yrow + 32 * e2 + 8 * q4) = o;
                }
        }
#pragma unroll
        for (int r = 0; r < 16; ++r) { Dacc0[r] *= cd; Dacc1[r] *= cd; }
        {
            ldsp sw0 = lds + O_ST + 16384 * eh + 256 * r32 + 8 * hi; const unsigned swr = ((r32 & 3) << 2) | ((r32 >> 2) & 3);
#pragma unroll
            for (int q4 = 0; q4 < 4; ++q4) {
                u32x2 o0, o1; o0.x = cvt_pk_bf16(Dacc0[4 * q4], Dacc0[4 * q4 + 1]); o0.y = cvt_pk_bf16(Dacc0[4 * q4 + 2], Dacc0[4 * q4 + 3]);
                o1.x = cvt_pk_bf16(Dacc1[4 * q4], Dacc1[4 * q4 + 1]); o1.y = cvt_pk_bf16(Dacc1[4 * q4 + 2], Dacc1[4 * q4 + 3]);
                const unsigned co = 16u * ((unsigned)(4 * it + q4) ^ swr);
                *(LAS u32x2*)(sw0 + co) = o0; *(LAS u32x2*)(sw0 + co + 8192) = o1;
            }
        }
    }
#undef RET_ISSUE
}

__device__ __forceinline__ void lru_unit(const int tid, ldsp lds, int b, int nb, const bf16* proj, bf16* ya, const float* convw, const float* convb,
                                         const float* wa, const float* ba, const float* wx, const float* bx, const float* lam) {
    const int lane = tid & 63, w = __builtin_amdgcn_readfirstlane(tid >> 6), r32 = lane & 31, hi = lane >> 5;
    const int c0 = nb * 64;
    LAS bf16* XA = (LAS bf16*)lds; ldsp XC = lds + 17408; LAS float* XF = (LAS float*)(lds + 35840); LAS float* AF = (LAS float*)(lds + 68608);
    ldsp WT = lds + 101376; LAS float* SEG = (LAS float*)(lds + 119808); LAS float* PAR = (LAS float*)(lds + 123904);
    if (tid < 64) { const int c = c0 + tid;
        PAR[tid] = convw[c]; PAR[64 + tid] = convw[1024 + c]; PAR[128 + tid] = convw[2048 + c]; PAR[192 + tid] = convw[3072 + c];
        PAR[256 + tid] = convb[c]; PAR[320 + tid] = ba[c]; PAR[384 + tid] = bx[c];
        const float z = __expf(-lam[c]); PAR[448 + tid] = log1pf(z); }
    for (int idx = tid; idx < 4096; idx += 512) { const int d = idx >> 6, e = idx & 63;
        ((LAS bf16*)WT)[e * 72 + d] = (bf16)f2bf(wa[nb * 4096 + idx]); ((LAS bf16*)(WT + 9216))[e * 72 + d] = (bf16)f2bf(wx[nb * 4096 + idx]); }
    const bf16* xab = proj + (size_t)b * SEQ * PPITCH + C_XA + c0;
    const bf16* gab = proj + (size_t)b * SEQ * PPITCH + C_GA + c0;
    bf16* yp = ya + (size_t)b * SEQ * 1024 + c0;
    const int e = tid & 63;
    float hcarry = 0.f;
    for (int n = 0; n < 32; ++n) {
        const int t0 = n * 128;
        __syncthreads();
        for (int idx = tid; idx < 1048; idx += 512) { const int r = idx >> 3, ch = idx & 7, t = t0 - 3 + r; v4u v = {0u, 0u, 0u, 0u};
            if (t >= 0) v = *(const v4u*)(xab + (size_t)t * PPITCH + ch * 8);
            *(LAS v4u*)((ldsp)XA + r * 128 + ch * 16) = v; }
        __syncthreads();
        { const int c = tid & 63; const float w0 = PAR[c], w1 = PAR[64 + c], w2 = PAR[128 + c], w3 = PAR[192 + c], cb = PAR[256 + c];
#pragma unroll 4
          for (int k = 0; k < 16; ++k) { const int t = (tid >> 6) + 8 * k;
              const float x0 = __uint_as_float((unsigned)XA[t * 64 + c] << 16), x1 = __uint_as_float((unsigned)XA[(t + 1) * 64 + c] << 16),
                          x2 = __uint_as_float((unsigned)XA[(t + 2) * 64 + c] << 16), x3 = __uint_as_float((unsigned)XA[(t + 3) * 64 + c] << 16);
              const float xc = cb + w0 * x0 + w1 * x1 + w2 * x2 + w3 * x3;
              XF[t * 64 + c] = xc; ((LAS bf16*)XC)[t * 72 + c] = (bf16)f2bf(xc); } }
        __syncthreads();
        { const int tt = w >> 1, et = w & 1;
          f32x16 gr = zero16(), gi = zero16();
#pragma unroll
          for (int s = 0; s < 4; ++s) {
              const bf16x8 a = *(const LAS bf16x8*)(XC + (32 * tt + r32) * 144 + (16 * s + 8 * hi) * 2);
              const bf16x8 br = *(const LAS bf16x8*)(WT + (32 * et + r32) * 144 + (16 * s + 8 * hi) * 2);
              const bf16x8 bi = *(const LAS bf16x8*)(WT + 9216 + (32 * et + r32) * 144 + (16 * s + 8 * hi) * 2);
              gr = mfma32(a, br, gr); gi = mfma32(a, bi, gi); }
          const int ee = 32 * et + r32; const float bar_ = PAR[320 + ee], bxr = PAR[384 + ee], sp = PAR[448 + ee];
#pragma unroll
          for (int r = 0; r < 16; ++r) { const int t = 32 * tt + (r & 3) + 8 * (r >> 2) + 4 * hi;
              const float xc = XF[t * 64 + ee];
              const float rg = fast_sigmoid(gr[r] + bar_), ig = fast_sigmoid(gi[r] + bxr);
              const float la = -8.0f * rg * sp, a = __expf(la), x2 = 2.0f * la;
              const float em_series = -x2 * (1.0f + x2 * (0.5f + x2 * (0.16666667f + x2 * (0.041666668f + x2 * (0.008333334f + x2 * 0.0013888889f)))));
              const float em = x2 < -0.25f ? 1.0f - a * a : em_series;
              AF[t * 64 + ee] = a; XF[t * 64 + ee] = sqrtf(em) * ig * xc; } }
        __syncthreads();
        { float A = 1.f, H = 0.f;
#pragma unroll
          for (int k = 0; k < 16; ++k) { const int t = 16 * w + k; const float a = AF[t * 64 + e], u = XF[t * 64 + e]; H = a * H + u; A *= a; }
          SEG[(w * 64 + e) * 2] = A; SEG[(w * 64 + e) * 2 + 1] = H; }
        bf16 gt[16];
#pragma unroll
        for (int k = 0; k < 16; ++k) gt[k] = gab[(size_t)(t0 + 16 * w + k) * PPITCH + e];
        __syncthreads();
        float hs = hcarry, hst = 0.f;
#pragma unroll
        for (int s = 0; s < 8; ++s) { const float A = SEG[(s * 64 + e) * 2], H = SEG[(s * 64 + e) * 2 + 1]; if (s == w) hst = hs; hs = A * hs + H; }
        hcarry = hs;
        float hh = hst;
#pragma unroll
        for (int k = 0; k < 16; ++k) { const int t = 16 * w + k; hh = AF[t * 64 + e] * hh + XF[t * 64 + e];
            yp[(size_t)(t0 + t) * 1024 + e] = (bf16)f2bf(hh * __uint_as_float((unsigned)gt[k] << 16)); }
    }
}

struct AttState { f32x16 O0, O1, O2, O3; float m, l; };
template <int BUF> __device__ __forceinline__ void attn_tile(AttState& S, const bf16x8 (&qf)[4], ldsp rk0, ldsp rk1, ldsp rk2, ldsp rk3,
                                                             ldsp tv00, ldsp tv01, ldsp tv10, ldsp tv11, ldsp tv20, ldsp tv21, ldsp tv30, ldsp tv31, int kb, int qw, int r32, int hi) {
    constexpr int KO = BUF * 32768, VO = BUF * 32768 + 16384;
    f32x16 p0 = zero16(), p1 = zero16();
    p0 = mfma32(*(const LAS bf16x8*)(rk0 + KO), qf[0], p0); p1 = mfma32(*(const LAS bf16x8*)(rk0 + KO + 8192), qf[0], p1);
    p0 = mfma32(*(const LAS bf16x8*)(rk1 + KO), qf[1], p0); p1 = mfma32(*(const LAS bf16x8*)(rk1 + KO + 8192), qf[1], p1);
    p0 = mfma32(*(const LAS bf16x8*)(rk2 + KO), qf[2], p0); p1 = mfma32(*(const LAS bf16x8*)(rk2 + KO + 8192), qf[2], p1);
    p0 = mfma32(*(const LAS bf16x8*)(rk3 + KO), qf[3], p0); p1 = mfma32(*(const LAS bf16x8*)(rk3 + KO + 8192), qf[3], p1);
    if (kb + 63 > qw) { const int dq = qw + r32 - kb - 4 * hi; const float NEG = -__builtin_inff();
#pragma unroll
        for (int r = 0; r < 16; ++r) { const int cr = (r & 3) + 8 * (r >> 2); if (cr > dq) p0[r] = NEG; if (cr + 32 > dq) p1[r] = NEG; } }
    float mx = fmaxf(p0[0], p1[0]);
#pragma unroll
    for (int r = 1; r < 16; ++r) mx = fmaxf(mx, fmaxf(p0[r], p1[r]));
    mx = fmaxf(mx, __shfl_xor(mx, 32));
    const float mnew = fmaxf(S.m, mx);
    if (__any(mnew > S.m)) { const float al = __builtin_amdgcn_exp2f(S.m - mnew);
#pragma unroll
        for (int r = 0; r < 16; ++r) { S.O0[r] *= al; S.O1[r] *= al; S.O2[r] *= al; S.O3[r] *= al; }
        S.l *= al; S.m = mnew; }
    float ps = 0.f;
#pragma unroll
    for (int r = 0; r < 16; ++r) { p0[r] = __builtin_amdgcn_exp2f(p0[r] - S.m); p1[r] = __builtin_amdgcn_exp2f(p1[r] - S.m); ps += p0[r] + p1[r]; }
    S.l += ps;
    const bf16x8 pf0 = pack8<0>(p0), pf1 = pack8<8>(p0), pf2 = pack8<0>(p1), pf3 = pack8<8>(p1);
#define ATT_PV(KS, PF) do { \
    S.O0 = mfma32(cat8(trr(tv00 + VO + 4096 * KS), trr(tv01 + VO + 4096 * KS)), PF, S.O0); \
    S.O1 = mfma32(cat8(trr(tv10 + VO + 4096 * KS), trr(tv11 + VO + 4096 * KS)), PF, S.O1); \
    S.O2 = mfma32(cat8(trr(tv20 + VO + 4096 * KS), trr(tv21 + VO + 4096 * KS)), PF, S.O2); \
    S.O3 = mfma32(cat8(trr(tv30 + VO + 4096 * KS), trr(tv31 + VO + 4096 * KS)), PF, S.O3); } while (0)
    ATT_PV(0, pf0); ATT_PV(1, pf1); ATT_PV(2, pf2); ATT_PV(3, pf3);
#undef ATT_PV
}
__device__ __forceinline__ void attn_unit(const int tid, ldsp lds, int b, int h, int qb, const bf16* proj, bf16* yc, float lam, float oml, const float* subg) {
    const int lane = tid & 63, w = __builtin_amdgcn_readfirstlane(tid >> 6), r32 = lane & 31, hi = lane >> 5;
    const int c = w >> 2, it = w & 3;
    const int qw = qb * 128 + 32 * it, NT = 2 * qb + 2;
    const bf16* base = proj + (size_t)b * SEQ * PPITCH + h * 128;
    const bf16* Kp = base + C_KD; const bf16* Vp = base + C_VD; const bf16* Gp = base + C_GD;
    bf16x8 qf[4];
#pragma unroll
    for (int s = 0; s < 4; ++s) qf[s] = *(const bf16x8*)(base + C_QD + (size_t)(qw + r32) * PPITCH + 64 * c + 16 * s + 8 * hi);
    ldsp rk0 = lds + offb(r32, 8 * c + 0 + hi), rk1 = lds + offb(r32, 8 * c + 2 + hi), rk2 = lds + offb(r32, 8 * c + 4 + hi), rk3 = lds + offb(r32, 8 * c + 6 + hi);
    ldsp tv00 = lds + tr_perm(lane, 0, 0, 0), tv01 = lds + tr_perm(lane, 0, 1, 0), tv10 = lds + tr_perm(lane, 0, 0, 1), tv11 = lds + tr_perm(lane, 0, 1, 1);
    ldsp tv20 = lds + tr_perm(lane, 0, 0, 2), tv21 = lds + tr_perm(lane, 0, 1, 2), tv30 = lds + tr_perm(lane, 0, 0, 3), tv31 = lds + tr_perm(lane, 0, 1, 3);
    const int srow = tid >> 4, sch = tid & 15;
    ldsp stw = lds + offb(srow, sch);
    bf16x8 sk0, sk1, sv0, sv1;
#define ATT_ISSUE(t_) do { const bf16* kp_ = Kp + (size_t)(64 * (t_) + srow) * PPITCH + sch * 8; const bf16* vp_ = Vp + (size_t)(64 * (t_) + srow) * PPITCH + sch * 8; \
        sk0 = *(const bf16x8*)kp_; sk1 = *(const bf16x8*)(kp_ + 32 * PPITCH); sv0 = *(const bf16x8*)vp_; sv1 = *(const bf16x8*)(vp_ + 32 * PPITCH); } while (0)
#define ATT_WRITE(BUF) do { *(LAS bf16x8*)(stw + (BUF) * 32768) = sk0; *(LAS bf16x8*)(stw + (BUF) * 32768 + 8192) = sk1; \
        *(LAS bf16x8*)(stw + (BUF) * 32768 + 16384) = sv0; *(LAS bf16x8*)(stw + (BUF) * 32768 + 16384 + 8192) = sv1; } while (0)
    AttState S; S.O0 = zero16(); S.O1 = zero16(); S.O2 = zero16(); S.O3 = zero16(); S.m = -1e30f; S.l = 0.f;
    ATT_ISSUE(0);
    for (int t = 0; t < NT; t += 2) {
        ATT_WRITE(0);
        __syncthreads();
        ATT_ISSUE(t + 1);
        if (64 * t <= qw + 31) attn_tile<0>(S, qf, rk0, rk1, rk2, rk3, tv00, tv01, tv10, tv11, tv20, tv21, tv30, tv31, 64 * t, qw, r32, hi);
        ATT_WRITE(1);
        __syncthreads();
        if (t + 2 < NT) ATT_ISSUE(t + 2);
        if (64 * (t + 1) <= qw + 31) attn_tile<1>(S, qf, rk0, rk1, rk2, rk3, tv00, tv01, tv10, tv11, tv20, tv21, tv30, tv31, 64 * (t + 1), qw, r32, hi);
    }
#undef ATT_ISSUE
#undef ATT_WRITE
    float l = S.l; l += __shfl_xor(l, 32);
    const float inv = 1.0f / l;
    __syncthreads();
    LAS float* XB = (LAS float*)lds + it * 4096 + lane;
    if (c == 1) { const float f = lam * inv;
#pragma unroll
        for (int r = 0; r < 16; ++r) { XB[(0 * 16 + r) * 64] = S.O0[r] * f; XB[(1 * 16 + r) * 64] = S.O1[r] * f; XB[(2 * 16 + r) * 64] = S.O2[r] * f; XB[(3 * 16 + r) * 64] = S.O3[r] * f; } }
    __syncthreads();
    if (c == 0) {
        float ss = 0.f;
#pragma unroll
        for (int r = 0; r < 16; ++r) {
            S.O0[r] = S.O0[r] * inv - XB[(0 * 16 + r) * 64]; S.O1[r] = S.O1[r] * inv - XB[(1 * 16 + r) * 64];
            S.O2[r] = S.O2[r] * inv - XB[(2 * 16 + r) * 64]; S.O3[r] = S.O3[r] * inv - XB[(3 * 16 + r) * 64];
            ss += S.O0[r] * S.O0[r] + S.O1[r] * S.O1[r] + S.O2[r] * S.O2[r] + S.O3[r] * S.O3[r]; }
        ss += __shfl_xor(ss, 32);
        const float rs = rsqrtf(ss * (1.f / 128.f) + EPS) * oml;
        const size_t rowl = (size_t)(qw + r32);
        bf16* yrow = yc + ((size_t)b * SEQ + rowl) * 1024 + h * 128 + 4 * hi; const bf16* grow = Gp + rowl * PPITCH + 4 * hi; const float* sgp = subg + 4 * hi;
#pragma unroll
        for (int et = 0; et < 4; ++et)
#pragma unroll
            for (int q4 = 0; q4 < 4; ++q4) {
                const f32x16& A = et == 0 ? S.O0 : et == 1 ? S.O1 : et == 2 ? S.O2 : S.O3;
                const int e0 = 32 * et + 8 * q4;
                const f32x4 sg = *(const f32x4*)(sgp + e0); const u32x2 g = *(const u32x2*)(grow + e0);
                u32x2 o; o.x = cvt_pk_bf16(A[4 * q4] * rs * sg.x * bf_lo(g.x), A[4 * q4 + 1] * rs * sg.y * bf_hi(g.x));
                o.y = cvt_pk_bf16(A[4 * q4 + 2] * rs * sg.z * bf_lo(g.y), A[4 * q4 + 3] * rs * sg.w * bf_hi(g.y));
                *(u32x2*)(yrow + e0) = o;
            }
    }
}

__device__ __forceinline__ int fetch_item(const int tid, gu32* ctr, volatile LAS unsigned* slot) {
    __syncthreads();
    if (tid == 0) *slot = __hip_atomic_fetch_add(ctr, 1u, RLX_AGENT);
    __syncthreads();
    return __builtin_amdgcn_readfirstlane((int)*slot);
}

#define LAUNDER_V(x) asm volatile("" : "+v"(x))
#define LAUNDER_S(x) asm volatile("" : "+s"(x))

#ifndef MK_N_LAUNCHES
#define MK_N_LAUNCHES 1
#endif
constexpr int N_PHASES = 1 + NGROUP * DEPTH * 5;
struct Args { const float* in[17]; float* out; unsigned char* ws; int ph_lo, ph_hi, li, pad; };
__global__ void __launch_bounds__(NWAVES * 64, 2) hyb_fwd(Args args) {
    extern __shared__ __attribute__((aligned(16))) unsigned char lds_raw[];
    ldsp lds = (ldsp)lds_raw;
    volatile LAS unsigned* MISC = (volatile LAS unsigned*)(lds + MISC_OFF);
    for (int u = threadIdx.x; u < (LDS_BYTES - LDSCTL_OFF) / 4; u += NWAVES * 64) ((LAS unsigned*)(lds + LDSCTL_OFF))[u] = 0u;
    __syncthreads();
    XcdBarrier bar = xcd_barrier_post((unsigned*)((gu32*)(args.ws + WS_CTL) + CW_BAR) + args.li * XCD_BAR_WORDS, MISC + 8);
    const int lo = args.ph_lo, hi_ = args.ph_hi;
#define IN(k) (lo <= (k) && (k) < hi_)
#define BOTH(k) (IN(k) && IN((k) + 1))
#define PHASE_ENTRY() int tid = threadIdx.x; LAUNDER_V(tid); unsigned long long z_ = 0ull; LAUNDER_S(z_); unsigned char* ws = args.ws + z_; const int G = gridDim.x; \
    const int lane = tid & 63, wave = __builtin_amdgcn_readfirstlane(tid >> 6); (void)lane; (void)wave; (void)G

    if (IN(0)) {
        PHASE_ENTRY();
        const int gw = blockIdx.x * NWAVES + wave, NGW = G * NWAVES;
        float* cosr = (float*)(ws + WS_COSR); float* sinr = (float*)(ws + WS_SINR); float* cosd = (float*)(ws + WS_COSD); float* sind = (float*)(ws + WS_SIND); float* lams = (float*)(ws + WS_LAMS);
        bf16* WIN = (bf16*)(ws + WS_WIN); bf16* WBR = (bf16*)(ws + WS_WBR); bf16* WOUT = (bf16*)(ws + WS_WOUT); bf16* HB = (bf16*)(ws + WS_H);
        LAS float* scr = (LAS float*)(lds + wave * 16384);
        constexpr int I_IN = (2048 / 64) * (16384 / 32), I_BR = (1024 / 64) * (2048 / 32), I_OUT = (2048 / 64) * (2048 / 32);
        constexpr int NITEMS = 2 * I_IN + 6 * I_BR + 2 * I_OUT;
        for (int it = gw; it < NITEMS; it += NGW) {
            int r = it;
            if (r < 2 * I_IN) { const int l = r / I_IN; r -= l * I_IN; p0_transpose_item(args.in[3] + (size_t)l * 2048 * 16384, 2048, 16384, WIN + (size_t)l * 16384 * 2048, scr, r, lane); continue; }
            r -= 2 * I_IN;
            if (r < 6 * I_BR) { const int lj = r / I_BR; r -= lj * I_BR; const int l = lj / 3, j = lj - 3 * l;
                const float* src = j == 0 ? args.in[13] : j == 1 ? args.in[14] : args.in[15];
                p0_transpose_item(src + (size_t)l * 1024 * 2048, 1024, 2048, WBR + (size_t)lj * 2048 * 1024, scr, r, lane); continue; }
            r -= 6 * I_BR;
            { const int l = r / I_OUT; r -= l * I_OUT; p0_transpose_item(args.in[16] + (size_t)l * 2048 * 2048, 2048, 2048, WOUT + (size_t)l * 2048 * 2048, scr, r, lane); }
        }
        for (int idx = blockIdx.x * 512 + tid; idx < SEQ * 72; idx += G * 512) {
            int pos, i; float fr;
            if (idx < SEQ * 64) { pos = idx >> 6; i = idx & 63; fr = __builtin_amdgcn_exp2f(-(float)i * (13.287712379549449f / 63.0f)); }
            else { const int k = idx - SEQ * 64; pos = k >> 3; i = k & 7; fr = __builtin_amdgcn_exp2f(-(float)i * (18.931568569324174f / 8.0f)); }
            const double rev = (double)pos * (double)fr * 0.15915494309189535;
            const float rf = (float)(rev - floor(rev));
            const float cv = __builtin_amdgcn_cosf(rf), sv = __builtin_amdgcn_sinf(rf);
            if (idx < SEQ * 64) { cosr[idx] = cv; sinr[idx] = sv; } else { cosd[idx - SEQ * 64] = cv; sind[idx - SEQ * 64] = sv; }
        }
        if (blockIdx.x == 0 && wave == 0) {
            for (int l = 0; l < DEPTH; ++l) { const float* dl = args.in[11] + l * 256;
                const float s01 = wave_sum(dl[lane] * dl[64 + lane]), s23 = wave_sum(dl[128 + lane] * dl[192 + lane]);
                const float lam_init = 0.8f - 0.6f * __expf(-0.3f * (float)l);
                if (lane == 0) { lams[2 * l] = __expf(s01) - __expf(s23) + lam_init; lams[2 * l + 1] = 1.0f - lam_init; } }
        }
        for (int m = gw; m < M_ALL; m += NGW) rms_row_to_bf16(args.in[0] + (size_t)m * D_MODEL, args.in[1], HB + (size_t)m * D_MODEL, lane);
        if (BOTH(0)) xcd_barrier(bar);
    }

    for (int g = 0; g < NGROUP; ++g)
        for (int l = 0; l < DEPTH; ++l) {
            const int pb = 1 + (g * DEPTH + l) * 5;
            if (IN(pb)) {
                PHASE_ENTRY();
                pg8::SchedPlain S; S.so.init(TG, D_IN, G, (int)blockIdx.x); S.A = (const char*)(ws + WS_H) + (size_t)g * TG * D_MODEL * 2; S.Bt = (const char*)(ws + WS_WIN) + (size_t)l * D_IN * D_MODEL * 2;
                pg8::EpiProj E{(bf16*)(ws + WS_PROJ), (bf16*)(ws + WS_GM), (const float*)(ws + WS_COSR), (const float*)(ws + WS_SINR), (const float*)(ws + WS_COSD), (const float*)(ws + WS_SIND)};
#ifndef SKIP_P1
                pg8::gemm_phase<pg8::EpiProj, pg8::SchedPlain, true, true>(lds, D_MODEL, S, E, tid);
#endif
                if (BOTH(pb)) xcd_barrier(bar);
            }
            if (IN(pb + 1)) {
#ifndef SKIP_RET
                { PHASE_ENTRY(); gu32* q = (gu32*)(ws + WS_CTL) + CW_Q + 64 * 3 * (g * DEPTH + l);
                  const bf16* PROJ = (const bf16*)(ws + WS_PROJ); bf16* YB = (bf16*)(ws + WS_Y);
                  for (;;) { const int it = fetch_item(tid, q, MISC + 16); if (it >= BG * 8) break; ret_unit(tid, lds, it >> 3, it & 7, PROJ, YB + (size_t)TG * 1024); } }
#endif
#ifndef SKIP_LRU
                { PHASE_ENTRY(); gu32* q = (gu32*)(ws + WS_CTL) + CW_Q + 64 * 3 * (g * DEPTH + l);
                  const bf16* PROJ = (const bf16*)(ws + WS_PROJ); bf16* YB = (bf16*)(ws + WS_Y);
                  for (;;) { const int it = fetch_item(tid, q + 64, MISC + 16); if (it >= BG * 16) break;
                    lru_unit(tid, lds, it >> 4, it & 15, PROJ, YB, args.in[4] + l * 4096, args.in[5] + l * 1024, args.in[6] + (size_t)l * 65536, args.in[7] + l * 1024,
                             args.in[8] + (size_t)l * 65536, args.in[9] + l * 1024, args.in[10] + l * 1024); } }
#endif
#ifndef SKIP_ATT
                { PHASE_ENTRY(); gu32* q = (gu32*)(ws + WS_CTL) + CW_Q + 64 * 3 * (g * DEPTH + l);
                  const bf16* PROJ = (const bf16*)(ws + WS_PROJ); bf16* YB = (bf16*)(ws + WS_Y); const float* lams = (const float*)(ws + WS_LAMS);
                  const float lam = lams[2 * l], oml = lams[2 * l + 1];
                  for (;;) { const int it = fetch_item(tid, q + 128, MISC + 16); if (it >= BG * 8 * 32) break; const int qb = 31 - (it >> 5), bh = it & 31;
                    attn_unit(tid, lds, bh >> 3, bh & 7, qb, PROJ, YB + (size_t)2 * TG * 1024, lam, oml, args.in[12] + l * 128); } }
#endif
                if (BOTH(pb + 1)) xcd_barrier(bar);
            }
            if (IN(pb + 2)) {
                PHASE_ENTRY();
                pg8::SchedBranch S; S.so.init(TG, D_MODEL, G, (int)blockIdx.x); S.A = (const char*)(ws + WS_Y); S.strideA = (size_t)TG * 1024 * 2;
                S.Bt = (const char*)(ws + WS_WBR) + (size_t)l * 3 * 2048 * 1024 * 2; S.strideB = (size_t)2048 * 1024 * 2;
                pg8::EpiMerge E{(const bf16*)(ws + WS_GM), (bf16*)(ws + WS_M)};
#ifndef SKIP_P3
                pg8::gemm_phase<pg8::EpiMerge, pg8::SchedBranch, true, true>(lds, 1024, S, E, tid);
#endif
                if (BOTH(pb + 2)) xcd_barrier(bar);
            }
            if (IN(pb + 3)) {
                PHASE_ENTRY();
                pg8::SchedPlain S; S.so.init(TG, D_MODEL, G, (int)blockIdx.x); S.A = (const char*)(ws + WS_M); S.Bt = (const char*)(ws + WS_WOUT) + (size_t)l * D_MODEL * D_MODEL * 2;
                pg8::EpiF32 E{(float*)(ws + WS_O), D_MODEL};
#ifndef SKIP_P4
                pg8::gemm_phase<pg8::EpiF32, pg8::SchedPlain, true, true>(lds, D_MODEL, S, E, tid);
#endif
                if (BOTH(pb + 3)) xcd_barrier(bar);
            }
            if (IN(pb + 4)) {
                PHASE_ENTRY();
                const int gw = blockIdx.x * NWAVES + wave, NGW = G * NWAVES;
                const bool dead = __hip_atomic_load((gu32*)(ws + WS_CTL) + CW_BAR + XB_TMO, RLX_AGENT) != 0u;
                const float* xsrc = l == 0 ? args.in[0] : args.out;
                const float* OB = (const float*)(ws + WS_O); bf16* HB = (bf16*)(ws + WS_H);
                const f32x4* pg = (const f32x4*)(args.in[2] + l * D_MODEL) + lane;
                const f32x4* ng = (const f32x4*)(args.in[1] + D_MODEL) + lane;
                for (int m = gw; m < TG; m += NGW) {
                    const size_t row = (size_t)g * TG + m;
                    const f32x4* orow = (const f32x4*)(OB + (size_t)m * D_MODEL) + lane; const f32x4* xrow = (const f32x4*)(xsrc + row * D_MODEL) + lane;
                    f32x4 v[8]; float s = 0.f;
#pragma unroll
                    for (int j = 0; j < 8; ++j) { v[j] = orow[64 * j]; s += (v[j].x * v[j].x + v[j].y * v[j].y) + (v[j].z * v[j].z + v[j].w * v[j].w); }
                    const float rs = rsqrtf(wave_sum(s) * (1.f / D_MODEL) + EPS); float s2 = 0.f;
                    f32x4* drow = (f32x4*)(args.out + row * D_MODEL) + lane;
#pragma unroll
                    for (int j = 0; j < 8; ++j) { const f32x4 xx = xrow[64 * j]; v[j] = xx + v[j] * rs * pg[64 * j];
                        if (dead) { const float qn = __builtin_nanf(""); v[j] = (f32x4){qn, qn, qn, qn}; }
                        drow[64 * j] = v[j]; s2 += (v[j].x * v[j].x + v[j].y * v[j].y) + (v[j].z * v[j].z + v[j].w * v[j].w); }
                    if (l == 0) {
                        const float rs2 = rsqrtf(wave_sum(s2) * (1.f / D_MODEL) + EPS);
                        u32x2* o8 = (u32x2*)(HB + row * D_MODEL) + lane;
#pragma unroll
                        for (int j = 0; j < 8; ++j) { const f32x4 gg = ng[64 * j]; u32x2 wv; wv.x = cvt_pk_bf16(v[j].x * rs2 * gg.x, v[j].y * rs2 * gg.y); wv.y = cvt_pk_bf16(v[j].z * rs2 * gg.z, v[j].w * rs2 * gg.w); o8[64 * j] = wv; }
                    }
                }
                if (BOTH(pb + 4)) xcd_barrier(bar);
            }
        }
#undef IN
#undef BOTH
#undef PHASE_ENTRY
}

extern "C" void kernel_launch(void* const* d_in, const int* in_sizes, int n_in, void* d_out, int out_size, void* d_ws, size_t ws_size, hipStream_t stream) {
    static int grid = 0;
    if (grid == 0) {
        if (n_in != 17 || in_sizes[0] != M_ALL * D_MODEL || out_size != M_ALL * D_MODEL || ws_size < WS_END) {
            fprintf(stderr, "kernel_launch: unexpected shapes (n_in %d, in0 %d, out %d, ws %zu < %zu); nothing launched\n", n_in, n_in > 0 ? in_sizes[0] : -1, out_size, ws_size, (size_t)WS_END); grid = -1; return; }
        int dev = 0, cus = 0, per_cu = 0;
        if (hipGetDevice(&dev) != hipSuccess || hipDeviceGetAttribute(&cus, hipDeviceAttributeMultiprocessorCount, dev) != hipSuccess) { grid = -1; return; }
        if (hipFuncSetAttribute((const void*)hyb_fwd, hipFuncAttributeMaxDynamicSharedMemorySize, LDS_BYTES) != hipSuccess) { fprintf(stderr, "kernel_launch: hipFuncSetAttribute failed\n"); grid = -1; return; }
        if (hipOccupancyMaxActiveBlocksPerMultiprocessor(&per_cu, (const void*)hyb_fwd, NWAVES * 64, LDS_BYTES) != hipSuccess || per_cu < 1)
            fprintf(stderr, "kernel_launch: note: occupancy query reports %d workgroups per CU\n", per_cu);
        (void)hipGetLastError();
        grid = cus;
    }
    if (grid < 0) return;
    if (hipMemsetAsync((char*)d_ws + WS_CTL, 0, CTL_ZERO_BYTES, stream) != hipSuccess) return;
    Args a{};
    for (int i = 0; i < 17; ++i) a.in[i] = (const float*)d_in[i];
    a.out = (float*)d_out; a.ws = (unsigned char*)d_ws;
#if MK_N_LAUNCHES == 1
    a.ph_lo = 0; a.ph_hi = N_PHASES; a.li = 0; a.pad = 0;
    hipLaunchKernelGGL(hyb_fwd, dim3(grid), dim3(NWAVES * 64), LDS_BYTES, stream, a);
#else
    for (int p = 0; p < N_PHASES; ++p) { a.ph_lo = p; a.ph_hi = p + 1; a.li = 0; a.pad = 0;
        hipLaunchKernelGGL(hyb_fwd, dim3(grid), dim3(NWAVES * 64), LDS_BYTES, stream, a); }
#endif
}
```

```cpp
#include <hip/hip_runtime.h>
#include <cstdio>
#include <cstdint>

namespace pg8 {
#define PG8_LAS __attribute__((address_space(3)))
typedef unsigned short bf16_t;
typedef short bf16x8 __attribute__((ext_vector_type(8)));
typedef float f32x4 __attribute__((ext_vector_type(4)));
typedef unsigned u32x4 __attribute__((ext_vector_type(4)));
constexpr int BM = 256, BK = 64, HALF = 128, HTB = HALF * BK * 2  , STAGE_BYTES = 8 * HTB, NXCD = 8, WGM = 8;

__host__ __device__ __forceinline__ int lds_byte(int r, int c) { const int st = (r >> 4) * 2 + (c >> 5), rr = r & 15, cc = c & 31, ob = rr * 64 + cc * 2; return st * 1024 + (ob ^ (((ob >> 9) & 1) << 5)); }
__host__ __device__ __forceinline__ void stage_rc(int b, int& R, int& C) { const int st = b / 1024, sb = b % 1024, swz = sb ^ (((sb >> 9) & 1) << 5); R = (st >> 1) * 16 + swz / 64; C = (st & 1) * 32 + (swz % 64) / 2; }
__host__ __device__ __forceinline__ int perm32(int rho) { const int n = rho >> 4, i = rho & 15; return 8 * (i >> 2) + 4 * n + (i & 3); }

struct Unit { int pm, pn, sel; };

struct StaticOrder {
    int nM, nN, nwg, G, c;
    __host__ __device__ void init(int M, int N, int G_, int c_) { nM = M / BM; nN = N / BM; nwg = nM * nN; G = G_; c = c_; }
    __host__ __device__ bool next(int i, Unit& u) const {
        const long L = (long)i * G + c; if (L >= nwg) return false;
        int wgid = (int)L; { const int q = nwg / NXCD, r = nwg % NXCD, xcd = wgid % NXCD, off = wgid / NXCD; wgid = (xcd < r ? xcd * (q + 1) : r * (q + 1) + (xcd - r) * q) + off; }
        const int nig = WGM * nN, gid = wgid / nig, fm = gid * WGM, gsz = (nM - fm) < WGM ? (nM - fm) : WGM;
        u.pm = fm + ((wgid % nig) % gsz); u.pn = (wgid % nig) / gsz; u.sel = 0; return true;
    }
};
struct SchedPlain {
    StaticOrder so; const char* A; const char* Bt;
    __device__ __forceinline__ bool next(int i, Unit& u) const { return so.next(i, u); }
    __device__ __forceinline__ const char* a_base(const Unit& u, size_t tstep) const { return A + (size_t)u.pm * tstep; }
    __device__ __forceinline__ const char* b_base(const Unit& u, size_t tstep) const { return Bt + (size_t)u.pn * tstep; }
    __device__ __forceinline__ bool keep(const Unit&) const { return false; }
    __device__ __forceinline__ void a_ready(const Unit&) const {}
    __device__ __forceinline__ void done(const Unit&) const {}
};
struct SchedBranch {
    StaticOrder so; const char* A; const char* Bt; size_t strideA, strideB;
    __device__ __forceinline__ bool next(int i, Unit& u) const { const int t = i / 3; if (!so.next(t, u)) return false; u.sel = i - 3 * t; return true; }
    __device__ __forceinline__ const char* a_base(const Unit& u, size_t tstep) const { return A + (size_t)u.sel * strideA + (size_t)u.pm * tstep; }
    __device__ __forceinline__ const char* b_base(const Unit& u, size_t tstep) const { return Bt + (size_t)u.sel * strideB + (size_t)u.pn * tstep; }
    __device__ __forceinline__ bool keep(const Unit& u) const { return u.sel < 2; }
    __device__ __forceinline__ void a_ready(const Unit&) const {}
    __device__ __forceinline__ void done(const Unit&) const {}
};

typedef float f32x2_cv __attribute__((ext_vector_type(2))); typedef __bf16 bf16x2_cv __attribute__((ext_vector_type(2)));
__device__ __forceinline__ unsigned cvt_pk_bf16(float lo, float hi) { const f32x2_cv v = {lo, hi}; const bf16x2_cv b = __builtin_convertvector(v, bf16x2_cv); return __builtin_bit_cast(unsigned, b); }
__device__ __forceinline__ float bf_lo(unsigned w) { return __uint_as_float(w << 16); }
__device__ __forceinline__ float bf_hi(unsigned w) { return __uint_as_float(w & 0xffff0000u); }
__device__ __forceinline__ float fast_sigmoid(float x) { return __builtin_amdgcn_rcpf(1.0f + __expf(-x)); }
__device__ __forceinline__ float fast_silu(float x) { return x * fast_sigmoid(x); }
__device__ __forceinline__ float lg2_gamma(int h) {
    const float x = __builtin_amdgcn_exp2f((float)(-5 - h));
    const float s = x * (1.0f + x * (0.5f + x * (0.33333334f + x * (0.25f + x * 0.2f))));
    return -s * 1.4426950408889634f;
}

template <int MASK> __device__ __forceinline__ float swz_xor(float v) { return __builtin_bit_cast(float, __builtin_amdgcn_ds_swizzle(__builtin_bit_cast(int, v), (MASK << 10) | 0x1f)); }
__device__ __forceinline__ float swz_xor16(float v) { return swz_xor<16>(v); }
__device__ __forceinline__ void half_swap(unsigned& a, unsigned& b) { asm volatile("s_nop 1\n\tv_permlane32_swap_b32 %0, %1" : "+v"(a), "+v"(b)); }
__device__ __forceinline__ float half_sum(float v) { unsigned a = __builtin_bit_cast(unsigned, v), b = a; half_swap(a, b); return __builtin_bit_cast(float, a) + __builtin_bit_cast(float, b); }
__device__ __forceinline__ float half_max(float v) { unsigned a = __builtin_bit_cast(unsigned, v), b = a; half_swap(a, b); return fmaxf(__builtin_bit_cast(float, a), __builtin_bit_cast(float, b)); }

__host__ __device__ __forceinline__ size_t blk_idx(int row, int col, int nbc  ) { return ((size_t)(row >> 4) * nbc + (col >> 5)) * 512 + (size_t)((row & 15) * 32 + (col & 31)); }

struct EpiF32 {
    static constexpr bool PERM = false, AFTER_DRAIN = false;
    float* C; int ldc;
    __device__ __forceinline__ void operator()(f32x4 (&acc)[2][2][4][2], const Unit& u, int wr, int wc, int fr, int fq) const {
        const int row0 = u.pm * BM + wr * 64 + fr, col0 = u.pn * BM + wc * 32 + 4 * fq;
#pragma unroll
        for (int ai = 0; ai < 2; ++ai)
#pragma unroll
            for (int m = 0; m < 4; ++m) { float* rowp = C + (size_t)(row0 + ai * HALF + m * 16) * ldc + col0;
#pragma unroll
                for (int bj = 0; bj < 2; ++bj)
#pragma unroll
                    for (int n = 0; n < 2; ++n) *(f32x4*)(rowp + bj * HALF + n * 16) = acc[ai][bj][m][n]; }
    }
};

__host__ __device__ __forceinline__ size_t gm8_idx(int row, int bc) { return ((size_t)(row >> 4) * 96 + (bc >> 6)) * 1024 + (size_t)((row & 15) * 64 + (bc & 63)); }
__device__ __forceinline__ unsigned gate_q8x4(const f32x4& g) {
    const unsigned q0 = max((unsigned)(g[0] * 255.f + 0.5f), 1u), q1 = max((unsigned)(g[1] * 255.f + 0.5f), 1u), q2 = max((unsigned)(g[2] * 255.f + 0.5f), 1u), q3 = max((unsigned)(g[3] * 255.f + 0.5f), 1u);
    return q0 | (q1 << 8) | (q2 << 16) | (q3 << 24); }
__device__ __forceinline__ f32x4 gate_unq4(unsigned w) { return (f32x4){(float)(w & 0xffu), (float)((w >> 8) & 0xffu), (float)((w >> 16) & 0xffu), (float)(w >> 24)}; }
struct EpiProj {
    static constexpr bool PERM = true, AFTER_DRAIN = false;
    bf16_t* proj; bf16_t* gm; int mode;
    template <int KIND> __device__ __forceinline__ void run(f32x4 (&acc)[2][2][4][2], const Unit& u, int wr, int wc, int fr, int fq) const {
        const int row0 = u.pm * BM + wr * 64 + fr, colt = u.pn * BM, cl = wc * 32 + 8 * fq;
        constexpr double FRD[8] = {0.15915494309189535, 0.030863763158420102, 0.00598518567638293, 0.001160663620968869, 0.00022507907904105155, 4.3647954811733995e-05, 8.464331128654902e-06, 1.6414263867044143e-06};
#pragma unroll
        for (int ai = 0; ai < 2; ++ai)
#pragma unroll
            for (int m = 0; m < 4; ++m) {
                const int row = row0 + ai * HALF + m * 16, pos = row & 4095;
                float cs[8], sn[8];
                if constexpr (KIND == 2 || KIND == 3) {
                    int fqo = fq; asm volatile("" : "+v"(fqo));
#pragma unroll
                    for (int k = 0; k < 4; ++k) { const double fv = (double)__builtin_amdgcn_exp2f(-(float)(16 * wc + 4 * fqo + k) * (13.287712379549449f / 63.0f)) * 0.15915494309189535;
                        const double ph = (double)pos * fv; const float r = (float)(ph - __builtin_floor(ph)); cs[k] = __builtin_amdgcn_cosf(r); sn[k] = __builtin_amdgcn_sinf(r); }
                }
                if constexpr (KIND == 4 || KIND == 5) {
                    if ((wc & 1) == 0) {
#pragma unroll
                        for (int k = 0; k < 8; ++k) { const double ph = (double)pos * FRD[k]; const float r = (float)(ph - __builtin_floor(ph)); cs[k] = __builtin_amdgcn_cosf(r); sn[k] = __builtin_amdgcn_sinf(r); if (fq == 0) sn[k] = -sn[k]; }
                    }
                }
                u32x4 w8 = {0u, 0u, 0u, 0u};
#pragma unroll
                for (int bj = 0; bj < 2; ++bj) {
                    const int col = colt + bj * HALF + cl;
                    f32x4 v0 = acc[ai][bj][m][0], v1 = acc[ai][bj][m][1];
                    if constexpr (KIND == 0) {
#pragma unroll
                        for (int k = 0; k < 4; ++k) { v0[k] = fast_sigmoid(v0[k]); v1[k] = fast_sigmoid(v1[k]); }
                        if (bj == 0) { w8.x = gate_q8x4(v0); w8.y = gate_q8x4(v1); } else { w8.z = gate_q8x4(v0); w8.w = gate_q8x4(v1); }
                    } else if constexpr (KIND == 1) {
#pragma unroll
                        for (int k = 0; k < 4; ++k) { v0[k] = fast_silu(v0[k]); v1[k] = fast_silu(v1[k]); }
                    } else if constexpr (KIND == 2 || KIND == 3) {
                        float sc = 1.0f;
                        if constexpr (KIND == 3) { int hh = ((colt - 3072) >> 7) + bj; asm volatile("" : "+s"(hh));
                            sc = 0.08838834764831845f * __builtin_amdgcn_exp2f(lg2_gamma(hh) * (float)(127 - (pos & 127))); }
                        const f32x4 ca = {cs[0] * sc, cs[0] * sc, cs[1] * sc, cs[1] * sc}, sa = {sn[0] * sc, sn[0] * sc, sn[1] * sc, sn[1] * sc};
                        const f32x4 cb = {cs[2] * sc, cs[2] * sc, cs[3] * sc, cs[3] * sc}, sb = {sn[2] * sc, sn[2] * sc, sn[3] * sc, sn[3] * sc};
                        const f32x4 w0 = {-v0[1], v0[0], -v0[3], v0[2]}, w1 = {-v1[1], v1[0], -v1[3], v1[2]};
                        v0 = v0 * ca + w0 * sa; v1 = v1 * cb + w1 * sb;
                    } else if constexpr (KIND == 4 || KIND == 5) {
                        if ((wc & 1) == 0) {
                            f32x4 p0, p1;
#pragma unroll
                            for (int k = 0; k < 4; ++k) { p0[k] = swz_xor16(v0[k]); p1[k] = swz_xor16(v1[k]); }
                            if (fq < 2) {
#pragma unroll
                                for (int k = 0; k < 4; ++k) { v0[k] = v0[k] * cs[k] + p0[k] * sn[k]; v1[k] = v1[k] * cs[4 + k] + p1[k] * sn[4 + k]; }
                            }
                        }
                        if constexpr (KIND == 4) { v0 = v0 * 0.18033688011112042f; v1 = v1 * 0.18033688011112042f; }
                    }
                    if constexpr (KIND != 0) {
                        u32x4 w; w.x = cvt_pk_bf16(v0[0], v0[1]); w.y = cvt_pk_bf16(v0[2], v0[3]); w.z = cvt_pk_bf16(v1[0], v1[1]); w.w = cvt_pk_bf16(v1[2], v1[3]);
                        if constexpr (KIND == 7) *(u32x4*)(gm + blk_idx(row, col - 10240, 192)) = w;
                        else *(u32x4*)(proj + blk_idx(row, col, 320)) = w;
                    }
                }
                if constexpr (KIND == 0) *(u32x4*)((unsigned char*)gm + gm8_idx(row, colt - 10240 + 2 * cl)) = w8;
            }
    }
    __device__ __forceinline__ void operator()(f32x4 (&acc)[2][2][4][2], const Unit& u, int wr, int wc, int fr, int fq) const {
        const int seg = (u.pn * BM) >> 10;
        if (mode == 1) return;
        if (mode == 2) { if (seg >= 10) run<7>(acc, u, wr, wc, fr, fq); else run<6>(acc, u, wr, wc, fr, fq); return; }
        if (seg >= 10) run<0>(acc, u, wr, wc, fr, fq);
        else if (seg == 1 || seg == 5 || seg == 9) run<1>(acc, u, wr, wc, fr, fq);
        else if (seg == 2) run<2>(acc, u, wr, wc, fr, fq);
        else if (seg == 3) run<3>(acc, u, wr, wc, fr, fq);
        else if (seg == 6) run<4>(acc, u, wr, wc, fr, fq);
        else if (seg == 7) run<5>(acc, u, wr, wc, fr, fq);
        else run<6>(acc, u, wr, wc, fr, fq);
    }
};

struct EpiBf16Plain {
    static constexpr bool PERM = true, AFTER_DRAIN = false;
    bf16_t* O; int ldc;
    __device__ __forceinline__ void operator()(f32x4 (&acc)[2][2][4][2], const Unit& u, int wr, int wc, int fr, int fq) const {
        const int row0 = u.pm * BM + wr * 64 + fr, col0 = u.pn * BM + wc * 32 + 8 * fq;
#pragma unroll
        for (int ai = 0; ai < 2; ++ai)
#pragma unroll
            for (int m = 0; m < 4; ++m) { bf16_t* rowp = O + (size_t)(row0 + ai * HALF + m * 16) * ldc + col0;
#pragma unroll
                for (int bj = 0; bj < 2; ++bj) { const f32x4 v0 = acc[ai][bj][m][0], v1 = acc[ai][bj][m][1];
                    u32x4 w; w.x = cvt_pk_bf16(v0[0], v0[1]); w.y = cvt_pk_bf16(v0[2], v0[3]); w.z = cvt_pk_bf16(v1[0], v1[1]); w.w = cvt_pk_bf16(v1[2], v1[3]);
                    *(u32x4*)(rowp + bj * HALF) = w; } }
    }
};

struct EpiMerge {
    static constexpr bool PERM = true, AFTER_DRAIN = false;
    const unsigned char* gm; bf16_t* mo;
    __device__ __forceinline__ void load_batch(const int bt, const int row0, const int gbc, const int j, u32x4 (&gc)[2], u32x4 (&gn)[2]) const {
        const int ai = bt >> 1, mh = bt & 1;
#pragma unroll
        for (int mm = 0; mm < 2; ++mm) { const unsigned char* p = gm + gm8_idx(row0 + ai * HALF + (2 * mh + mm) * 16, gbc);
            gc[mm] = *(const u32x4*)p; if (j < 2) gn[mm] = *(const u32x4*)(p + (size_t)32 * 1024); else gn[mm] = gc[mm]; }
    }
    __device__ __forceinline__ void apply_batch(const int bt, f32x4 (&acc)[2][2][4][2], const int row0, const int col0, const int j, const u32x4 (&gc)[2], const u32x4 (&gn)[2]) const {
        const int ai = bt >> 1, mh = bt & 1;
#pragma unroll
        for (int mm = 0; mm < 2; ++mm)
#pragma unroll
            for (int bj = 0; bj < 2; ++bj) {
                const int m = 2 * mh + mm; const u32x4 c = gc[mm];
                f32x4 g0 = gate_unq4(bj == 0 ? c.x : c.z), g1 = gate_unq4(bj == 0 ? c.y : c.w);
                if (j < 2) {
                    const u32x4 n = gn[mm];
                    const f32x4 n0 = gate_unq4(bj == 0 ? n.x : n.z), n1 = gate_unq4(bj == 0 ? n.y : n.w);
#pragma unroll
                    for (int k = 0; k < 4; ++k) { g0[k] = g0[k] * __builtin_amdgcn_rcpf(n0[k]); g1[k] = g1[k] * __builtin_amdgcn_rcpf(n1[k]); }
                    acc[ai][bj][m][0] = acc[ai][bj][m][0] * g0; acc[ai][bj][m][1] = acc[ai][bj][m][1] * g1;
                } else {
                    const f32x4 v0 = acc[ai][bj][m][0] * (g0 * (1.0f / 255.0f)), v1 = acc[ai][bj][m][1] * (g1 * (1.0f / 255.0f));
                    u32x4 w; w.x = cvt_pk_bf16(v0[0], v0[1]); w.y = cvt_pk_bf16(v0[2], v0[3]); w.z = cvt_pk_bf16(v1[0], v1[1]); w.w = cvt_pk_bf16(v1[2], v1[3]);
                    *(u32x4*)(mo + (size_t)(row0 + ai * HALF + m * 16) * 2048 + col0 + bj * HALF) = w;
                }
            }
    }
    __device__ __forceinline__ void operator()(f32x4 (&acc)[2][2][4][2], const Unit& u, int wr, int wc, int fr, int fq) const {
        const int row0 = u.pm * BM + wr * 64 + fr, col0 = u.pn * BM + wc * 32 + 8 * fq, j = u.sel;
        const int gbc = j * 2048 + u.pn * 256 + 64 * wc + 16 * fq;
        u32x4 gcA[2], gnA[2], gcB[2], gnB[2], gcC[2], gnC[2], gcD[2], gnD[2];
        load_batch(0, row0, gbc, j, gcA, gnA);
        load_batch(1, row0, gbc, j, gcB, gnB);
        load_batch(2, row0, gbc, j, gcC, gnC);
        load_batch(3, row0, gbc, j, gcD, gnD);
        __builtin_amdgcn_sched_barrier(0);
        apply_batch(0, acc, row0, col0, j, gcA, gnA);
        __builtin_amdgcn_sched_barrier(0);
        apply_batch(1, acc, row0, col0, j, gcB, gnB);
        __builtin_amdgcn_sched_barrier(0);
        apply_batch(2, acc, row0, col0, j, gcC, gnC);
        __builtin_amdgcn_sched_barrier(0);
        apply_batch(3, acc, row0, col0, j, gcD, gnD);
    }
};

template <class Epi, class Sched, bool ALIGN_EPI = false, bool SP2 = false>
__device__ __forceinline__ void gemm_phase(PG8_LAS unsigned char* lds, const int K_, const Sched& S, const Epi& E, const int tid) {
    const int wid = __builtin_amdgcn_readfirstlane(tid >> 6), lane = tid & 63, wr = wid >> 2, wc = wid & 3, fr = lane & 15, fq = lane >> 4;
    const int K = K_, nt = K / BK;
    unsigned voffA[2], voffB[2];
#pragma unroll
    for (int i = 0; i < 2; ++i) { int R, C; stage_rc(tid * 16 + i * 8192, R, C); const int Rb = Epi::PERM ? ((R & ~31) + perm32(R & 31)) : R;
        voffA[i] = (unsigned)(R * K + C) * 2u; voffB[i] = (unsigned)(Rb * K + C) * 2u; }
    const size_t kstep = (size_t)(BK * 2);
    const size_t hstep = (size_t)HALF * K * 2;
    const size_t tstep = 2 * hstep;
    const unsigned ldsw = (unsigned)wid * 1024u;
    const int aoff = lds_byte(wr * 64 + fr, fq * 8), boff = lds_byte(wc * 32 + fr, fq * 8);
#define PG8_SA(b, h) (((b) * 2 + (h)) * HTB)
#define PG8_SB(b, h) ((4 + (b) * 2 + (h)) * HTB)
#define PG8_STAGE(bufoff, gbase, voff) do { _Pragma("unroll") for (int _i = 0; _i < 2; ++_i) \
        __builtin_amdgcn_global_load_lds((const unsigned*)((const char*)(gbase) + (voff)[_i]), (PG8_LAS unsigned*)(lds + (bufoff) + ldsw + _i * 8192), 16, 0, 0); } while (0)
#define PG8_LDA(dst, b, h) do { _Pragma("unroll") for (int m = 0; m < 4; ++m) _Pragma("unroll") for (int k = 0; k < 2; ++k) dst[m][k] = *(const PG8_LAS bf16x8*)(lds + PG8_SA(b, h) + aoff + m * 2048 + k * 1024); } while (0)
#define PG8_LDB(dst, b, h) do { _Pragma("unroll") for (int n = 0; n < 2; ++n) _Pragma("unroll") for (int k = 0; k < 2; ++k) dst[n][k] = *(const PG8_LAS bf16x8*)(lds + PG8_SB(b, h) + boff + n * 2048 + k * 1024); } while (0)
#define PG8_MMA(ai, bj, At, Bt) do { __builtin_amdgcn_s_setprio(1); _Pragma("unroll") for (int m = 0; m < 4; ++m) _Pragma("unroll") for (int n = 0; n < 2; ++n) _Pragma("unroll") for (int k = 0; k < 2; ++k) \
        acc[ai][bj][m][n] = __builtin_amdgcn_mfma_f32_16x16x32_bf16(Bt[n][k], At[m][k], acc[ai][bj][m][n], 0, 0, 0); __builtin_amdgcn_s_setprio(0); } while (0)
#define PG8_WAIT_V(n) asm volatile("s_waitcnt vmcnt(" #n ")" ::: "memory")
#define PG8_WAIT_L(n) asm volatile("s_waitcnt lgkmcnt(" #n ")" ::: "memory")
#define PG8_BAR __builtin_amdgcn_s_barrier()
#define PG8_SCHED __builtin_amdgcn_sched_barrier(0)
    Unit cur, nxt; int ui = 0;
    if (!S.next(0, cur)) return;
    f32x4 acc[2][2][4][2];
#pragma unroll
    for (int a = 0; a < 2; ++a)
#pragma unroll
        for (int b = 0; b < 2; ++b)
#pragma unroll
            for (int m = 0; m < 4; ++m)
#pragma unroll
                for (int n = 0; n < 2; ++n) acc[a][b][m][n] = (f32x4){0.f, 0.f, 0.f, 0.f};
    bf16x8 At[4][2], B0[2][2], B1[2][2];
    const char* cA = S.a_base(cur, tstep); const char* cB = S.b_base(cur, tstep);
    S.a_ready(cur);
    if constexpr (SP2) {
        PG8_STAGE(PG8_SB(0, 0), cB, voffB); PG8_STAGE(PG8_SB(0, 1), cB + hstep, voffB); PG8_STAGE(PG8_SA(0, 0), cA, voffA); PG8_STAGE(PG8_SA(0, 1), cA + hstep, voffA);
        if (wr == 1) PG8_BAR;
        PG8_WAIT_V(2); PG8_BAR;
        PG8_STAGE(PG8_SB(1, 0), cB + kstep, voffB); PG8_STAGE(PG8_SA(1, 0), cA + kstep, voffA); PG8_STAGE(PG8_SB(1, 1), cB + hstep + kstep, voffB);
        PG8_WAIT_V(6); PG8_BAR;
    } else {
        PG8_STAGE(PG8_SB(0, 0), cB, voffB); PG8_STAGE(PG8_SA(0, 0), cA, voffA); PG8_STAGE(PG8_SB(0, 1), cB + hstep, voffB); PG8_STAGE(PG8_SA(0, 1), cA + hstep, voffA);
        if (wr == 1) PG8_BAR;
        PG8_WAIT_V(4); PG8_BAR;
        PG8_STAGE(PG8_SB(1, 0), cB + kstep, voffB); PG8_STAGE(PG8_SA(1, 0), cA + kstep, voffA); PG8_STAGE(PG8_SB(1, 1), cB + hstep + kstep, voffB);
        PG8_WAIT_V(6); PG8_BAR;
    }
    for (;;) {
        const bool has_next = S.next(ui + 1, nxt);
        const char* nA = has_next ? S.a_base(nxt, tstep) : cA; const char* nB = has_next ? S.b_base(nxt, tstep) : cB;
        for (int t = 0; t < nt; t += 2) {
            const bool last = (t == nt - 2);
            const char* a1 = cA + (size_t)(t + 1) * kstep;
            const char* a2 = last ? nA : cA + (size_t)(t + 2) * kstep; const char* b2 = last ? nB : cB + (size_t)(t + 2) * kstep;
            const char* a3 = a2 + kstep; const char* b3 = b2 + kstep;
            if (last && has_next) S.a_ready(nxt);
            if constexpr (SP2) {
            PG8_LDB(B0, 0, 0); PG8_LDB(B1, 0, 1); PG8_SCHED; PG8_LDA(At, 0, 0); PG8_STAGE(PG8_SA(1, 1), a1 + hstep, voffA);
            PG8_WAIT_V(8); PG8_WAIT_L(0); PG8_BAR; PG8_MMA(0, 0, At, B0); PG8_MMA(0, 1, At, B1); PG8_BAR; PG8_SCHED;
            PG8_LDA(At, 0, 1); PG8_STAGE(PG8_SB(0, 0), b2, voffB); PG8_STAGE(PG8_SB(0, 1), b2 + hstep, voffB); PG8_STAGE(PG8_SA(0, 0), a2, voffA);
            PG8_WAIT_V(8); PG8_WAIT_L(0); PG8_BAR; PG8_MMA(1, 0, At, B0); PG8_MMA(1, 1, At, B1); PG8_BAR; PG8_SCHED;
            PG8_LDB(B0, 1, 0); PG8_LDB(B1, 1, 1); PG8_SCHED; PG8_LDA(At, 1, 0); PG8_STAGE(PG8_SA(0, 1), a2 + hstep, voffA);
            PG8_WAIT_V(8); PG8_WAIT_L(0); PG8_BAR; PG8_MMA(0, 0, At, B0); PG8_MMA(0, 1, At, B1); PG8_BAR; PG8_SCHED;
            PG8_LDA(At, 1, 1); PG8_STAGE(PG8_SB(1, 0), b3, voffB); PG8_STAGE(PG8_SB(1, 1), b3 + hstep, voffB); PG8_STAGE(PG8_SA(1, 0), a3, voffA);
            PG8_WAIT_V(8); PG8_WAIT_L(0); PG8_BAR; PG8_MMA(1, 0, At, B0); PG8_MMA(1, 1, At, B1); PG8_BAR; PG8_SCHED;
            } else {
            PG8_LDB(B0, 0, 0); PG8_SCHED; PG8_LDA(At, 0, 0); PG8_STAGE(PG8_SA(1, 1), a1 + hstep, voffA);
            PG8_WAIT_L(8); PG8_BAR; PG8_WAIT_L(0); PG8_MMA(0, 0, At, B0); PG8_BAR; PG8_SCHED;
            PG8_LDB(B1, 0, 1); PG8_STAGE(PG8_SB(0, 0), b2, voffB);
            PG8_BAR; PG8_WAIT_L(0); PG8_MMA(0, 1, At, B1); PG8_BAR;
            PG8_LDA(At, 0, 1); PG8_STAGE(PG8_SA(0, 0), a2, voffA);
            PG8_BAR; PG8_WAIT_L(0); PG8_MMA(1, 0, At, B0); PG8_BAR; PG8_SCHED;
            PG8_STAGE(PG8_SB(0, 1), b2 + hstep, voffB);
            PG8_WAIT_V(6); PG8_BAR; PG8_MMA(1, 1, At, B1); PG8_BAR;
            PG8_LDB(B0, 1, 0); PG8_SCHED; PG8_LDA(At, 1, 0); PG8_STAGE(PG8_SA(0, 1), a2 + hstep, voffA);
            PG8_WAIT_L(8); PG8_BAR; PG8_WAIT_L(0); PG8_MMA(0, 0, At, B0); PG8_BAR; PG8_SCHED;
            PG8_LDB(B1, 1, 1); PG8_STAGE(PG8_SB(1, 0), b3, voffB);
            PG8_BAR; PG8_WAIT_L(0); PG8_MMA(0, 1, At, B1); PG8_BAR;
            PG8_LDA(At, 1, 1); PG8_STAGE(PG8_SA(1, 0), a3, voffA);
            PG8_BAR; PG8_WAIT_L(0); PG8_MMA(1, 0, At, B0); PG8_BAR; PG8_SCHED;
            PG8_STAGE(PG8_SB(1, 1), b3 + hstep, voffB);
            PG8_WAIT_V(6); PG8_BAR; PG8_MMA(1, 1, At, B1); PG8_BAR;
            }
        }
        if constexpr (ALIGN_EPI) { if (wr == 0) PG8_BAR; }
        if constexpr (!Epi::AFTER_DRAIN) { E(acc, cur, wr, wc, fr, fq); S.done(cur); }
        if (!has_next) break;
        if (!S.keep(cur)) {
#pragma unroll
        for (int a = 0; a < 2; ++a)
#pragma unroll
            for (int b = 0; b < 2; ++b)
#pragma unroll
                for (int m = 0; m < 4; ++m)
#pragma unroll
                    for (int n = 0; n < 2; ++n) acc[a][b][m][n] = (f32x4){0.f, 0.f, 0.f, 0.f};
        }
        cur = nxt; cA = nA; cB = nB; ++ui;
        if constexpr (ALIGN_EPI) { if (wr == 1) PG8_BAR; }
    }
    PG8_WAIT_V(0);
    if constexpr (!ALIGN_EPI) { if (wr == 0) PG8_BAR; }
    PG8_BAR;
    if constexpr (Epi::AFTER_DRAIN) { E.fused(acc, cur, wr, wc, fr, fq, lds, wid, lane); S.done(cur); }
#undef PG8_SA
#undef PG8_SB
#undef PG8_STAGE
#undef PG8_LDA
#undef PG8_LDB
#undef PG8_MMA
#undef PG8_WAIT_V
#undef PG8_WAIT_L
#undef PG8_BAR
#undef PG8_SCHED
}
}
#define GAS __attribute__((address_space(1)))
#define LAS __attribute__((address_space(3)))
typedef unsigned short bf16;
typedef unsigned v4u __attribute__((ext_vector_type(4)));
typedef float f32x4 __attribute__((ext_vector_type(4)));
typedef short bf16x8 __attribute__((ext_vector_type(8)));
typedef GAS unsigned gu32;
typedef GAS unsigned long long gu64;
#define RLX_AGENT __ATOMIC_RELAXED, __HIP_MEMORY_SCOPE_AGENT
#define LDS_WAIT() asm volatile("s_waitcnt lgkmcnt(0)" ::: "memory")
#define VM_WAIT() asm volatile("s_waitcnt vmcnt(0)" ::: "memory")
__device__ __forceinline__ unsigned long long rt() { return __builtin_amdgcn_s_memrealtime(); }
__device__ __forceinline__ unsigned f2bf(float f) { unsigned u = __builtin_bit_cast(unsigned, f); return (u + 0x7fffu + ((u >> 16) & 1u)) >> 16; }
__device__ __forceinline__ unsigned pk2(float lo, float hi) { return f2bf(lo) | (f2bf(hi) << 16); }

#define XB_TMO      128
#define XB_XCNT(j)  (256  + 64 * (j))
#define XB_XSUB(j)  (1280 + 64 * (j))
#define XB_XGEN(j)  (2304 + 64 * (j))
#define XB_TOP      3328
#define XB_TOPGEN   3392
#define XCD_BAR_WORDS 3456
#define XB_SPIN_CAP (1u << 18)

__device__ __forceinline__ unsigned xb_ld(unsigned* p)              { return __hip_atomic_load(p, __ATOMIC_RELAXED, __HIP_MEMORY_SCOPE_AGENT); }
__device__ __forceinline__ unsigned xb_add(unsigned* p, unsigned v) { return __hip_atomic_fetch_add(p, v, __ATOMIC_RELAXED, __HIP_MEMORY_SCOPE_AGENT); }
__device__ __forceinline__ unsigned xb_xcc_id() { return (unsigned)__builtin_amdgcn_s_getreg((3 << 11) | 20) & 0xFu; }
#define XB_SPIN(cond, bar) do { unsigned _sp = 0; while (cond) { __builtin_amdgcn_s_sleep(1); \
    if ((++_sp & 255u) == 0u) { if (xb_ld(&(bar)[XB_TMO])) break; if (_sp > XB_SPIN_CAP) { atomicAdd(&(bar)[XB_TMO], 1u); break; } } } } while (0)

__device__ __forceinline__ unsigned xb_lane() { unsigned m = ~0u; asm volatile("" : "+s"(m)); return __builtin_amdgcn_mbcnt_hi(m, __builtin_amdgcn_mbcnt_lo(m, 0u)); }
struct XcdBarrier {
    unsigned wv;
    unsigned* bar; unsigned x;
    volatile LAS unsigned* st;
};

__device__ __forceinline__ XcdBarrier xcd_barrier_post(unsigned* bar, volatile LAS unsigned* st, unsigned wv) {
    XcdBarrier b; b.wv = wv; b.bar = bar; b.x = xb_xcc_id(); b.st = st;
    if (wv == 0u && xb_lane() == 0u) (void)xb_add(&bar[XB_XCNT(b.x)], 1u);
    return b;
}
__device__ __forceinline__ void xcd_barrier_complete(unsigned* bar, unsigned x, unsigned& nloc, unsigned& nx) {
    const unsigned G = gridDim.x * gridDim.y * gridDim.z;
    unsigned sum, cnt, mine, sp = 0u;
    for (;;) {
        sum = 0u; cnt = 0u; mine = 0u;
#pragma unroll
        for (unsigned j = 0; j < 16; ++j) { const unsigned c = xb_ld(&bar[XB_XCNT(j)]); sum += c; cnt += (c > 0u) ? 1u : 0u; mine = (j == x) ? c : mine; }
        if (sum == G) break;
        __builtin_amdgcn_s_sleep(1);
        if ((++sp & 255u) == 0u) { if (xb_ld(&bar[XB_TMO])) break; if (sp > XB_SPIN_CAP) { atomicAdd(&bar[XB_TMO], 1u); break; } }
    }
    nloc = mine > 0u ? mine : 1u; nx = cnt > 0u ? cnt : 1u;
}

__device__ __forceinline__ void xcd_barrier(const XcdBarrier& b) {
    asm volatile("s_waitcnt vmcnt(0)" ::: "memory");
    __syncthreads();
    if (b.wv == 0u && xb_lane() == 0u) {
        unsigned* bar = b.bar;
        __builtin_amdgcn_s_waitcnt(0);
        unsigned nloc = b.st[0], nx = b.st[1];
        if (nloc == 0u) { xcd_barrier_complete(bar, b.x, nloc, nx); b.st[0] = nloc; b.st[1] = nx; }
        const unsigned old = xb_add(&bar[XB_XSUB(b.x)], 1u);
        const unsigned gen = old / nloc;
        if (old + 1u == (gen + 1u) * nloc) {
            __builtin_amdgcn_fence(__ATOMIC_RELEASE, "agent");
            asm volatile("s_waitcnt vmcnt(0)" ::: "memory");
            const unsigned og = xb_add(&bar[XB_TOP], 1u);
            const unsigned tg = og / nx;
            if (og + 1u == (tg + 1u) * nx) xb_add(&bar[XB_TOPGEN], 1u);
            else XB_SPIN(xb_ld(&bar[XB_TOPGEN]) == tg, bar);
            __builtin_amdgcn_fence(__ATOMIC_ACQUIRE, "agent");
            xb_add(&bar[XB_XGEN(b.x)], 1u);
            asm volatile("s_waitcnt vmcnt(0)" ::: "memory");
        } else {
            XB_SPIN(xb_ld(&bar[XB_XGEN(b.x)]) == gen, bar);
            __builtin_amdgcn_fence(__ATOMIC_ACQUIRE, "agent");
            asm volatile("s_waitcnt vmcnt(0)" ::: "memory");
        }
    }
    __syncthreads();
}

constexpr int D_MODEL = 2048, SEQ = 4096, BATCH = 8, DEPTH = 2, M_ALL = BATCH * SEQ, D_IN = 16384;
constexpr int BG = 4, TG = BG * SEQ, NGROUP = BATCH / BG;
constexpr int PNBC = 320, PBROW = PNBC * 512;
__device__ __forceinline__ size_t pidx(int row, int col) { return pg8::blk_idx(row, col, PNBC); }
constexpr int C_XA = 0, C_GA = 1024, C_QR = 2048, C_KR = 3072, C_VR = 4096, C_GR = 5120, C_QD = 6144, C_KD = 7168, C_VD = 8192, C_GD = 9216;
constexpr float EPS = 1e-6f;
constexpr int NWAVES = 8;
constexpr size_t MiB = 1u << 20;
constexpr size_t WS_CTL = 0, CTL_ZERO_BYTES = 1 * MiB;
constexpr size_t WS_COSR = 1 * MiB, WS_SINR = 2 * MiB, WS_COSD = 3 * MiB, WS_SIND = 3 * MiB + 128 * 1024, WS_LAMS = 3 * MiB + 512 * 1024;
constexpr size_t WS_WIN = 4 * MiB;
constexpr size_t WS_WBR = 132 * MiB;
constexpr size_t WS_WOUT = 156 * MiB;
constexpr size_t WS_H = 172 * MiB;
constexpr size_t WS_Y = 300 * MiB;
constexpr size_t WS_GM = 396 * MiB;
constexpr size_t WS_PROJ = 588 * MiB;
constexpr size_t WS_O = 588 * MiB;
constexpr size_t WS_M = 716 * MiB;
constexpr size_t WS_X1 = 908 * MiB;
constexpr size_t WS_END = 972 * MiB;
static_assert(WS_M + (size_t)TG * 2048 * 2 <= WS_END && WS_O + (size_t)TG * 2048 * 4 <= WS_M && WS_PROJ + (size_t)TG * 10240 * 2 == WS_X1 && WS_X1 + (size_t)TG * 2048 * 2 == WS_END, "d_ws map");
constexpr int CW_TMO = 0;
constexpr int CW_BAR = 4096;
constexpr int CW_Q = 65536;
constexpr int RING_BYTES = 131072, LDSCTL_OFF = RING_BYTES, MISC_OFF = LDSCTL_OFF + 320, LDS_BYTES = 147456;

#define LAUNDER_V(x) asm volatile("" : "+v"(x))
#define LAUNDER_S(x) asm volatile("" : "+s"(x))
typedef float f32x16 __attribute__((ext_vector_type(16)));
typedef short s16x4 __attribute__((ext_vector_type(4)));
typedef short v4i16_t __attribute__((ext_vector_type(4)));
typedef unsigned u32x2 __attribute__((ext_vector_type(2)));
typedef LAS unsigned char* ldsp;
using pg8::blk_idx; using pg8::cvt_pk_bf16; using pg8::bf_lo; using pg8::bf_hi; using pg8::fast_sigmoid; using pg8::lg2_gamma;

using pg8::swz_xor; using pg8::half_sum; using pg8::half_max;
__device__ __forceinline__ float wave_sum(float v) {
    v += swz_xor<1>(v); v += swz_xor<2>(v); v += swz_xor<4>(v); v += swz_xor<8>(v); v += swz_xor<16>(v);
    return half_sum(v);
}
__device__ __forceinline__ unsigned offb(unsigned row, unsigned ch) { return 256u * row + 16u * (ch ^ (((row & 3u) << 2) | ((row >> 2) & 3u))); }
__device__ __forceinline__ unsigned tr_nat(int lane, int k0, int t, int c) { const int h = lane >> 5, blk = (lane >> 4) & 1, q = (lane & 15) >> 2, p = lane & 3; return offb(k0 + 8 * h + 4 * t + q, 4 * c + 2 * blk + (p >> 1)) + 8 * (p & 1); }
__device__ __forceinline__ unsigned tr_perm(int lane, int k0, int t, int c) { const int h = lane >> 5, blk = (lane >> 4) & 1, q = (lane & 15) >> 2, p = lane & 3; return offb(k0 + 8 * t + 4 * h + q, 4 * c + 2 * blk + (p >> 1)) + 8 * (p & 1); }
__device__ __forceinline__ f32x16 mfma32(bf16x8 a, bf16x8 b, f32x16 c) { return __builtin_amdgcn_mfma_f32_32x32x16_bf16(a, b, c, 0, 0, 0); }
__device__ __forceinline__ s16x4 trr(ldsp p) { return __builtin_bit_cast(s16x4, __builtin_amdgcn_ds_read_tr16_b64_v4i16((LAS v4i16_t*)p)); }
__device__ __forceinline__ bf16x8 cat8(s16x4 lo, s16x4 hi) { return (bf16x8){lo[0], lo[1], lo[2], lo[3], hi[0], hi[1], hi[2], hi[3]}; }
template <int B> __device__ __forceinline__ bf16x8 pack8(const f32x16& x) {
    v4u w = {cvt_pk_bf16(x[B], x[B + 1]), cvt_pk_bf16(x[B + 2], x[B + 3]), cvt_pk_bf16(x[B + 4], x[B + 5]), cvt_pk_bf16(x[B + 6], x[B + 7])};
    return __builtin_bit_cast(bf16x8, w);
}
__device__ __forceinline__ f32x16 zero16() { f32x16 z;
#pragma unroll
    for (int i = 0; i < 16; ++i) z[i] = 0.f; return z; }

__device__ __forceinline__ void p0_transpose_item(const float* W, int K, int N, bf16* WT, LAS float* scr, int item, int lane) {
    const int nblk = N / 32, kb = item / nblk, nb = item % nblk, k0 = 64 * kb, n0 = 32 * nb;
    { const int cg = lane & 7, rs = lane >> 3;
      f32x4 v[8];
#pragma unroll
      for (int i = 0; i < 8; ++i) v[i] = *(const f32x4*)(W + (size_t)(k0 + 8 * i + rs) * N + n0 + 4 * cg);
#pragma unroll
      for (int i = 0; i < 8; ++i) { LAS float* d = scr + (8 * i + rs) * 33 + 4 * cg; d[0] = v[i].x; d[1] = v[i].y; d[2] = v[i].z; d[3] = v[i].w; } }
    LDS_WAIT(); asm volatile("" ::: "memory");
    const int c = lane & 7;
#pragma unroll
    for (int j = 0; j < 4; ++j) { const int n = (lane >> 3) + 8 * j; const LAS float* s = scr + (8 * c) * 33 + n;
        v4u o; o.x = pk2(s[0 * 33], s[1 * 33]); o.y = pk2(s[2 * 33], s[3 * 33]); o.z = pk2(s[4 * 33], s[5 * 33]); o.w = pk2(s[6 * 33], s[7 * 33]);
        *(GAS v4u*)(WT + (size_t)(n0 + n) * K + k0 + 8 * c) = o; }
    LDS_WAIT(); asm volatile("" ::: "memory");
}
__device__ __forceinline__ void rms_row_to_bf16(const float* xrow, const f32x4 (&gv)[8], bf16* orow, int lane) {
    const float* xr = xrow + 8 * lane;
    f32x4 v[8]; float s = 0.f;
#pragma unroll
    for (int j = 0; j < 4; ++j) { v[2 * j] = *(const f32x4*)(xr + 512 * j); v[2 * j + 1] = *(const f32x4*)(xr + 512 * j + 4); }
#pragma unroll
    for (int j = 0; j < 8; ++j) s += (v[j].x * v[j].x + v[j].y * v[j].y) + (v[j].z * v[j].z + v[j].w * v[j].w);
    const float rs = rsqrtf(wave_sum(s) * (1.f / D_MODEL) + EPS);
    v4u* o16 = (v4u*)orow + lane;
#pragma unroll
    for (int j = 0; j < 4; ++j) { const f32x4 ga = gv[2 * j], gb = gv[2 * j + 1]; const f32x4 a = v[2 * j] * rs * ga, bq = v[2 * j + 1] * rs * gb;
        v4u w; w.x = cvt_pk_bf16(a.x, a.y); w.y = cvt_pk_bf16(a.z, a.w); w.z = cvt_pk_bf16(bq.x, bq.y); w.w = cvt_pk_bf16(bq.z, bq.w); o16[64 * j] = w; }
}

__device__ __forceinline__ void ret_unit(const int tid, ldsp lds, int b, int h, const bf16* proj, bf16* yb) {
    const int lane = tid & 63, w = __builtin_amdgcn_readfirstlane(tid >> 6), r32 = lane & 31, hi = lane >> 5;
    const int it = w >> 1, eh = w & 1;
    constexpr int O_ST = 0, O_KD = 32768, O_VV = 65536, O_Q = 98304;
    LAS float* STAT = (LAS float*)(lds + RING_BYTES + 1024);
    { unsigned z0 = 0u; LAUNDER_V(z0); for (int i = tid; i < 2048; i += 512) ((LAS v4u*)(lds + O_ST))[i] = (v4u){z0, z0, z0, z0}; }
    ldsp rb[8];
#pragma unroll
    for (int s = 0; s < 8; ++s) rb[s] = lds + offb(r32, 2 * s + hi);
    ldsp tnk0 = lds + O_KD + tr_perm(lane, 0, 0, it), tnk1 = lds + O_KD + tr_perm(lane, 0, 1, it);
    ldsp tpv00 = lds + O_VV + tr_perm(lane, 0, 0, 2 * eh), tpv01 = lds + O_VV + tr_perm(lane, 0, 1, 2 * eh), tpv10 = lds + O_VV + tr_perm(lane, 0, 0, 2 * eh + 1), tpv11 = lds + O_VV + tr_perm(lane, 0, 1, 2 * eh + 1);
    const int row00 = b * SEQ, hcol = h * 128;
    bf16* Yp = yb + (size_t)b * SEQ * 1024 + h * 128;
    const float lg = lg2_gamma(h), cd = __builtin_amdgcn_exp2f(128.f * lg), cout = __builtin_amdgcn_exp2f(lg * (float)(32 * it + r32 - 127));
    f32x16 Dacc0 = zero16(), Dacc1 = zero16();
#define RET_DMA(src_, n_, lane_, off_) do { _Pragma("unroll") for (int k_ = 0; k_ < 4; ++k_) { const int row_ = 16 * w + 4 * k_ + ((lane_) >> 4); \
        const int ch_ = ((lane_) & 15) ^ (((row_ & 3) << 2) | ((row_ >> 2) & 3)); \
        __builtin_amdgcn_global_load_lds((const unsigned*)(proj + pidx(row00 + (n_) * 128 + row_, (src_) + hcol + 8 * ch_)), (LAS unsigned*)(lds + (off_) + 4096 * w + 1024 * k_), 16, 0, 0); } } while (0)
#define RET_BAR() do { asm volatile("s_waitcnt lgkmcnt(0)" ::: "memory"); __builtin_amdgcn_s_barrier(); asm volatile("" ::: "memory"); } while (0)
    RET_DMA(C_KR, 0, lane, O_KD); RET_DMA(C_VR, 0, lane, O_VV); RET_DMA(C_QR, 0, lane, O_Q);
    for (int n = 0; n < 32; ++n) {
        int tid_c = tid; LAUNDER_V(tid_c);
        const int lane_c = tid_c & 63, r32c = lane_c & 31, hic = lane_c >> 5;
        const int rowi = n * 128 + 32 * it + r32c;
        const int nn = n + 1 < 32 ? n + 1 : 31;
        asm volatile("s_waitcnt vmcnt(0) lgkmcnt(0)" ::: "memory"); __builtin_amdgcn_s_barrier(); asm volatile("" ::: "memory");
        bf16x8 qf[8];
        { ldsp qb_ = lds + O_Q + 8192 * it;
#pragma unroll
          for (int s = 0; s < 8; ++s) qf[s] = *(const LAS bf16x8*)(qb_ + (unsigned)(rb[s] - lds)); }
#pragma unroll
        for (int ks = 0; ks < 8; ++ks) {
            const bf16x8 a = cat8(trr(tnk0 + 4096 * ks), trr(tnk1 + 4096 * ks));
            Dacc0 = mfma32(a, cat8(trr(tpv00 + 4096 * ks), trr(tpv01 + 4096 * ks)), Dacc0);
            Dacc1 = mfma32(a, cat8(trr(tpv10 + 4096 * ks), trr(tpv11 + 4096 * ks)), Dacc1);
            if (ks & 1) __builtin_amdgcn_sched_barrier(0);
        }
        f32x16 acc0 = zero16(), acc1 = zero16();
#pragma unroll
        for (int jt = 0; jt < 4; ++jt) if (jt <= it) {
            f32x16 X = zero16();
#pragma unroll
            for (int s = 0; s < 8; ++s) X = mfma32(*(const LAS bf16x8*)(rb[s] + O_KD + 8192 * jt), qf[s], X);
            __builtin_amdgcn_sched_barrier(0);
            if (jt == it) {
#pragma unroll
                for (int r = 0; r < 16; ++r) { const int j = (r & 3) + 8 * (r >> 2) + 4 * hic; if (j > r32c) X[r] = 0.f; }
            }
            const bf16x8 pf0 = pack8<0>(X), pf1 = pack8<8>(X);
            acc0 = mfma32(cat8(trr(tpv00 + 8192 * jt), trr(tpv01 + 8192 * jt)), pf0, acc0);
            acc1 = mfma32(cat8(trr(tpv10 + 8192 * jt), trr(tpv11 + 8192 * jt)), pf0, acc1);
            acc0 = mfma32(cat8(trr(tpv00 + 8192 * jt + 4096), trr(tpv01 + 8192 * jt + 4096)), pf1, acc0);
            acc1 = mfma32(cat8(trr(tpv10 + 8192 * jt + 4096), trr(tpv11 + 8192 * jt + 4096)), pf1, acc1);
            __builtin_amdgcn_sched_barrier(0);
        }
        RET_BAR();
        RET_DMA(C_KR, nn, lane_c, O_KD); RET_DMA(C_VR, nn, lane_c, O_VV); RET_DMA(C_QR, nn, lane_c, O_Q);
        u32x2 gg[8];
        { const bf16* grow = proj + pidx(row00 + rowi, C_GR + hcol + 64 * eh + 4 * hic);
#pragma unroll
          for (int e2 = 0; e2 < 2; ++e2)
#pragma unroll
              for (int q4 = 0; q4 < 4; ++q4) gg[4 * e2 + q4] = *(const u32x2*)(grow + 512 * e2 + 8 * q4); }
        {
            ldsp st0 = lds + 16384 * eh;
#pragma unroll
            for (int s = 0; s < 8; ++s) {
                const unsigned o_ = (unsigned)(rb[s] - lds);
                acc0 = mfma32(*(const LAS bf16x8*)(st0 + o_ + O_ST), qf[s], acc0);
                acc1 = mfma32(*(const LAS bf16x8*)(st0 + o_ + O_ST + 8192), qf[s], acc1);
                if ((s & 3) == 3) __builtin_amdgcn_sched_barrier(0);
            }
        }
        float s1 = 0.f, s2 = 0.f;
#pragma unroll
        for (int r = 0; r < 16; ++r) { s1 += acc0[r] + acc1[r]; s2 += acc0[r] * acc0[r] + acc1[r] * acc1[r]; }
        s1 = half_sum(s1); s2 = half_sum(s2);
        if (hic == 0) { STAT[(32 * it + r32c) * 4 + eh * 2] = s1; STAT[(32 * it + r32c) * 4 + eh * 2 + 1] = s2; }
        RET_BAR();
        {
            const LAS float* st = STAT + (32 * it + r32c) * 4;
            const float mean = (st[0] + st[2]) * (1.f / 128.f); float var = (st[1] + st[3]) * (1.f / 128.f) - mean * mean; var = fmaxf(var, 0.f);
            const float rs = cout * rsqrtf(cout * cout * var + EPS);
            bf16* yrow = Yp + (size_t)rowi * 1024 + 64 * eh + 8 * hic;
#pragma unroll
            for (int e2 = 0; e2 < 2; ++e2)
#pragma unroll
                for (int p = 0; p < 2; ++p) {
                    const f32x16& A = e2 ? acc1 : acc0; unsigned ox[2], oy[2];
#pragma unroll
                    for (int u = 0; u < 2; ++u) { const int q4 = 2 * p + u; const u32x2 g = gg[4 * e2 + q4];
                        ox[u] = cvt_pk_bf16((A[4 * q4] - mean) * rs * bf_lo(g.x), (A[4 * q4 + 1] - mean) * rs * bf_hi(g.x));
                        oy[u] = cvt_pk_bf16((A[4 * q4 + 2] - mean) * rs * bf_lo(g.y), (A[4 * q4 + 3] - mean) * rs * bf_hi(g.y)); }
                    pg8::half_swap(ox[0], ox[1]); pg8::half_swap(oy[0], oy[1]);
                    *(v4u*)(yrow + 32 * e2 + 16 * p) = (v4u){ox[0], oy[0], ox[1], oy[1]};
                }
        }
#pragma unroll
        for (int r = 0; r < 16; ++r) { Dacc0[r] *= cd; Dacc1[r] *= cd; }
        {
            ldsp sw0 = lds + O_ST + 16384 * eh + 256 * r32c + 8 * hic; const unsigned swr = ((r32c & 3) << 2) | ((r32c >> 2) & 3);
#pragma unroll
            for (int q4 = 0; q4 < 4; ++q4) {
                u32x2 o0, o1; o0.x = cvt_pk_bf16(Dacc0[4 * q4], Dacc0[4 * q4 + 1]); o0.y = cvt_pk_bf16(Dacc0[4 * q4 + 2], Dacc0[4 * q4 + 3]);
                o1.x = cvt_pk_bf16(Dacc1[4 * q4], Dacc1[4 * q4 + 1]); o1.y = cvt_pk_bf16(Dacc1[4 * q4 + 2], Dacc1[4 * q4 + 3]);
                const unsigned co = 16u * ((unsigned)(4 * it + q4) ^ swr);
                *(LAS u32x2*)(sw0 + co) = o0; *(LAS u32x2*)(sw0 + co + 8192) = o1;
            }
        }
    }
    asm volatile("s_waitcnt vmcnt(0)" ::: "memory");
#undef RET_DMA
#undef RET_BAR
}

__device__ __forceinline__ void lru_unit(const int tid, ldsp lds, int b, int nb, const bf16* proj, bf16* ya, const float* convw, const float* convb,
                                         const float* wa, const float* ba, const float* wx, const float* bx, const float* lam) {
    const int lane = tid & 63, w = __builtin_amdgcn_readfirstlane(tid >> 6), r32 = lane & 31, hi = lane >> 5;
    const int c0 = nb * 64;
    LAS bf16* XA = (LAS bf16*)lds; ldsp XC = lds + 17408; LAS float* XF = (LAS float*)(lds + 35840); LAS float* AF = (LAS float*)(lds + 68608);
    ldsp WT = lds + 101376; LAS float* SEG = (LAS float*)(lds + 119808); LAS float* PAR = (LAS float*)(lds + 123904);
    if (tid < 64) { const int c = c0 + tid;
        PAR[tid] = convw[c]; PAR[64 + tid] = convw[1024 + c]; PAR[128 + tid] = convw[2048 + c]; PAR[192 + tid] = convw[3072 + c];
        PAR[256 + tid] = convb[c]; PAR[320 + tid] = ba[c]; PAR[384 + tid] = bx[c];
        const float z = __expf(-lam[c]); PAR[448 + tid] = log1pf(z); }
    for (int idx = tid; idx < 4096; idx += 512) { const int d = idx >> 6, e = idx & 63;
        ((LAS bf16*)WT)[e * 72 + d] = (bf16)f2bf(wa[nb * 4096 + idx]); ((LAS bf16*)(WT + 9216))[e * 72 + d] = (bf16)f2bf(wx[nb * 4096 + idx]); }
    const int row00 = b * SEQ;
    bf16* yp = ya + (size_t)b * SEQ * 1024 + c0;
    const int e = tid & 63;
    float hcarry = 0.f;
    v4u xs0, xs1, xs2;
#define LRU_ISSUE(t0_) do { { const int r = tid >> 3, ch = tid & 7, t = (t0_) - 3 + r; { unsigned z0 = 0u; LAUNDER_V(z0); xs0 = (v4u){z0, z0, z0, z0}; } if (t >= 0) xs0 = *(const v4u*)(proj + pidx(row00 + t, C_XA + c0 + ch * 8)); } \
        { const int r = (tid + 512) >> 3, ch = tid & 7, t = (t0_) - 3 + r; xs1 = *(const v4u*)(proj + pidx(row00 + t, C_XA + c0 + ch * 8)); } \
        if (tid < 24) { const int r = (tid + 1024) >> 3, ch = tid & 7, t = (t0_) - 3 + r; xs2 = *(const v4u*)(proj + pidx(row00 + t, C_XA + c0 + ch * 8)); } } while (0)
    LRU_ISSUE(0);
    for (int n = 0; n < 32; ++n) {
        const int t0 = n * 128;
        __syncthreads();
        *(LAS v4u*)((ldsp)XA + tid * 16) = xs0; *(LAS v4u*)((ldsp)XA + (tid + 512) * 16) = xs1; if (tid < 24) *(LAS v4u*)((ldsp)XA + (tid + 1024) * 16) = xs2;
        __syncthreads();
        { const int c = tid & 63; const float w0 = PAR[c], w1 = PAR[64 + c], w2 = PAR[128 + c], w3 = PAR[192 + c], cb = PAR[256 + c];
#pragma unroll 4
          for (int k = 0; k < 16; ++k) { const int t = (tid >> 6) + 8 * k;
              const float x0 = __uint_as_float((unsigned)XA[t * 64 + c] << 16), x1 = __uint_as_float((unsigned)XA[(t + 1) * 64 + c] << 16),
                          x2 = __uint_as_float((unsigned)XA[(t + 2) * 64 + c] << 16), x3 = __uint_as_float((unsigned)XA[(t + 3) * 64 + c] << 16);
              const float xc = cb + w0 * x0 + w1 * x1 + w2 * x2 + w3 * x3;
              XF[t * 64 + c] = xc; ((LAS bf16*)XC)[t * 72 + c] = (bf16)f2bf(xc); } }
        __syncthreads();
        if (n + 1 < 32) LRU_ISSUE(t0 + 128);
        bf16 gt[16];
#pragma unroll
        for (int k = 0; k < 16; ++k) gt[k] = proj[pidx(row00 + t0 + 16 * w + k, C_GA + c0 + e)];
        { const int tt = w >> 1, et = w & 1;
          f32x16 gr = zero16(), gi = zero16();
#pragma unroll
          for (int s = 0; s < 4; ++s) {
              const bf16x8 a = *(const LAS bf16x8*)(XC + (32 * tt + r32) * 144 + (16 * s + 8 * hi) * 2);
              const bf16x8 br = *(const LAS bf16x8*)(WT + (32 * et + r32) * 144 + (16 * s + 8 * hi) * 2);
              const bf16x8 bi = *(const LAS bf16x8*)(WT + 9216 + (32 * et + r32) * 144 + (16 * s + 8 * hi) * 2);
              gr = mfma32(a, br, gr); gi = mfma32(a, bi, gi); }
          const int ee = 32 * et + r32; const float bar_ = PAR[320 + ee], bxr = PAR[384 + ee], sp = PAR[448 + ee];
#pragma unroll
          for (int r = 0; r < 16; ++r) { const int t = 32 * tt + (r & 3) + 8 * (r >> 2) + 4 * hi;
              const float xc = XF[t * 64 + ee];
              const float rg = fast_sigmoid(gr[r] + bar_), ig = fast_sigmoid(gi[r] + bxr);
              const float la = -8.0f * rg * sp, a = __expf(la), x2 = 2.0f * la;
              const float em_series = -x2 * (1.0f + x2 * (0.5f + x2 * (0.16666667f + x2 * (0.041666668f + x2 * (0.008333334f + x2 * 0.0013888889f)))));
              const float em = x2 < -0.25f ? 1.0f - a * a : em_series;
              AF[t * 64 + ee] = a; XF[t * 64 + ee] = sqrtf(em) * ig * xc; } }
        __syncthreads();
        { float A = 1.f, H = 0.f;
#pragma unroll
          for (int k = 0; k < 16; ++k) { const int t = 16 * w + k; const float a = AF[t * 64 + e], u = XF[t * 64 + e]; H = a * H + u; A *= a; }
          SEG[(w * 64 + e) * 2] = A; SEG[(w * 64 + e) * 2 + 1] = H; }
        __syncthreads();
        float hs = hcarry, hst = 0.f;
#pragma unroll
        for (int s = 0; s < 8; ++s) { const float A = SEG[(s * 64 + e) * 2], H = SEG[(s * 64 + e) * 2 + 1]; if (s == w) hst = hs; hs = A * hs + H; }
        hcarry = hs;
        float hh = hst;
#pragma unroll
        for (int k = 0; k < 16; ++k) { const int t = 16 * w + k; hh = AF[t * 64 + e] * hh + XF[t * 64 + e];
            yp[(size_t)(t0 + t) * 1024 + e] = (bf16)f2bf(hh * __uint_as_float((unsigned)gt[k] << 16)); }
    }
#undef LRU_ISSUE
}

typedef float f32x2 __attribute__((ext_vector_type(2)));
struct AttS { f32x16 O0, O1, O2, O3, p0, p1; bf16x8 pf0, pf1, pf2, pf3; bf16x8 k0, k1, k2, k3, k4, k5, k6, k7; float mref, l, alpha; int rp; };
#define ATT_THR 8.0f
constexpr int ATT_V0 = 0, ATT_K0 = 49152, ATT_SLOT = 16384;
#define ATT_PIN(X_) asm volatile("" : "+v"(X_))
#define ATT_SB() __builtin_amdgcn_sched_barrier(0)
__device__ __forceinline__ float attn_rowmax(const f32x16& a, const f32x16& b) {
    float d = fmaxf(a[0], b[0]);
#pragma unroll
    for (int r = 1; r < 16; ++r) d = fmaxf(d, fmaxf(a[r], b[r]));
    return half_max(d);
}
__device__ __forceinline__ int attn_rowmax_bits(const f32x16& a, const f32x16& b) {
    int d = max(__float_as_int(a[0]), __float_as_int(b[0]));
#pragma unroll
    for (int r = 1; r < 16; ++r) d = max(d, max(__float_as_int(a[r]), __float_as_int(b[r])));
    unsigned x = (unsigned)d, y = x; pg8::half_swap(x, y);
    return max((int)x, (int)y);
}
template <int B> __device__ __forceinline__ f32x2 attn_sum8(const f32x16& a, f32x2 s) {
#pragma unroll
    for (int r = B; r < B + 8; r += 2) s += (f32x2){a[r], a[r + 1]};
    return s;
}
#define ATT_EXP4(P_, B_) do { _Pragma("unroll") for (int r_ = 0; r_ < 4; ++r_) P_[(B_) + r_] = __builtin_amdgcn_exp2f(P_[(B_) + r_]); } while (0)
#define ATT_SUB4(P_, B_) do { _Pragma("unroll") for (int r_ = 0; r_ < 4; ++r_) P_[(B_) + r_] -= st.mref; } while (0)
#define ATT_VF(TV_, KS, ET) cat8(trr((TV_) + 4096 * (ET) + 1024 * (KS)), trr((TV_) + 4096 * (ET) + 1024 * (KS) + 512))
#define ATT_KF(RK_, O_) (*(const LAS bf16x8*)((RK_) + (O_)))
#define ATT_MASK(Q0_, Q1_, t_) do { const int kb_ = 64 * (t_); \
        if (kb_ + 63 > qw) { const int dq_ = qw + r32 - kb_ - 4 * hi; const float NEG_ = -__builtin_inff(); \
            _Pragma("unroll") for (int r_ = 0; r_ < 16; ++r_) { const int cr_ = (r_ & 3) + 8 * (r_ >> 2); if (cr_ > dq_) Q0_[r_] = NEG_; if (cr_ + 32 > dq_) Q1_[r_] = NEG_; } } } while (0)
#define ATT_OSCALE() do { if (st.rp) { _Pragma("unroll") for (int r_ = 0; r_ < 16; ++r_) { st.O0[r_] *= st.alpha; st.O1[r_] *= st.alpha; st.O2[r_] *= st.alpha; st.O3[r_] *= st.alpha; } } } while (0)
#define ATT_EXP1(Q0_, Q1_, I_) do { if ((I_) < 16) Q0_[(I_) & 15] = __builtin_amdgcn_exp2f(Q0_[(I_) & 15]); else Q1_[(I_) & 15] = __builtin_amdgcn_exp2f(Q1_[(I_) & 15]); } while (0)
#define ATT_EXP3(Q0_, Q1_, I_) do { ATT_EXP1(Q0_, Q1_, (I_)); ATT_EXP1(Q0_, Q1_, (I_) + 1); ATT_EXP1(Q0_, Q1_, (I_) + 2); } while (0)
__device__ __forceinline__ f32x16 attn_splat(const float v) { f32x16 z;
#pragma unroll
    for (int i = 0; i < 16; ++i) z[i] = v; return z; }
__device__ __forceinline__ void attn_step(AttS& st, const int t, const int qw, const int r32, const int hi, const bf16x8 (&qf)[4], ldsp tv, ldsp rn0, ldsp rn1, ldsp rn2, ldsp rn3) {
    ATT_OSCALE();
    const f32x16 negm = attn_splat(-st.mref);
    f32x16 q0 = mfma32(st.k0, qf[0], negm); bf16x8 va0 = ATT_VF(tv, 0, 0);
    f32x16 q1 = mfma32(st.k1, qf[0], negm); bf16x8 va1 = ATT_VF(tv, 0, 1);
    ATT_SB();
    q0 = mfma32(st.k2, qf[1], q0); bf16x8 va2 = ATT_VF(tv, 0, 2);
    q1 = mfma32(st.k3, qf[1], q1); bf16x8 va3 = ATT_VF(tv, 0, 3);
    ATT_SB();
    q0 = mfma32(st.k4, qf[2], q0); bf16x8 vb0 = ATT_VF(tv, 1, 0);
    q1 = mfma32(st.k5, qf[2], q1); bf16x8 vb1 = ATT_VF(tv, 1, 1);
    st.pf2 = pack8<0>(st.p1); ATT_PIN(st.pf2);
    ATT_SB();
    q0 = mfma32(st.k6, qf[3], q0); bf16x8 vb2 = ATT_VF(tv, 1, 2);
    q1 = mfma32(st.k7, qf[3], q1); bf16x8 vb3 = ATT_VF(tv, 1, 3);
    st.pf3 = pack8<8>(st.p1); ATT_PIN(st.pf3);
    ATT_SB();
    ATT_MASK(q0, q1, t);
    st.O0 = mfma32(va0, st.pf0, st.O0); va0 = ATT_VF(tv, 2, 0); ATT_EXP3(q0, q1, 0);
    ATT_SB();
    st.O1 = mfma32(va1, st.pf0, st.O1); va1 = ATT_VF(tv, 2, 1); ATT_EXP3(q0, q1, 3);
    ATT_SB();
    st.O2 = mfma32(va2, st.pf0, st.O2); va2 = ATT_VF(tv, 2, 2); ATT_EXP3(q0, q1, 6);
    ATT_SB();
    st.O3 = mfma32(va3, st.pf0, st.O3); va3 = ATT_VF(tv, 2, 3); ATT_EXP3(q0, q1, 9);
    ATT_SB();
    st.O0 = mfma32(vb0, st.pf1, st.O0); vb0 = ATT_VF(tv, 3, 0); ATT_EXP3(q0, q1, 12);
    ATT_SB();
    st.O1 = mfma32(vb1, st.pf1, st.O1); vb1 = ATT_VF(tv, 3, 1); ATT_EXP3(q0, q1, 15);
    ATT_PIN(q0);
    ATT_SB();
    st.O2 = mfma32(vb2, st.pf1, st.O2); vb2 = ATT_VF(tv, 3, 2); ATT_EXP3(q0, q1, 18);
    ATT_SB();
    st.O3 = mfma32(vb3, st.pf1, st.O3); vb3 = ATT_VF(tv, 3, 3); ATT_EXP3(q0, q1, 21);
    ATT_SB();
    st.O0 = mfma32(va0, st.pf2, st.O0); ATT_EXP3(q0, q1, 24); ATT_EXP1(q0, q1, 27);
    ATT_SB();
    st.O1 = mfma32(va1, st.pf2, st.O1); ATT_EXP3(q0, q1, 28); ATT_EXP1(q0, q1, 31);
    ATT_PIN(q1);
    ATT_SB();
    st.O2 = mfma32(va2, st.pf2, st.O2);
    f32x2 ps = attn_sum8<0>(q0, (f32x2){0.f, 0.f}); ps = attn_sum8<8>(q0, ps); ATT_PIN(ps);
    ATT_SB();
    st.O3 = mfma32(va3, st.pf2, st.O3);
    ps = attn_sum8<0>(q1, ps); ps = attn_sum8<8>(q1, ps);
    float psum = ps.x + ps.y; ATT_PIN(psum);
    ATT_SB();
    const bool resc = __any(psum > 256.0f);
    st.rp = resc; st.alpha = 1.f;
    if (resc) {
        const f32x16 nm2 = attn_splat(-st.mref);
        q0 = mfma32(st.k0, qf[0], nm2); q1 = mfma32(st.k1, qf[0], nm2);
        q0 = mfma32(st.k2, qf[1], q0); q1 = mfma32(st.k3, qf[1], q1);
        q0 = mfma32(st.k4, qf[2], q0); q1 = mfma32(st.k5, qf[2], q1);
        q0 = mfma32(st.k6, qf[3], q0); q1 = mfma32(st.k7, qf[3], q1);
        ATT_MASK(q0, q1, t);
        const float d = attn_rowmax(q0, q1);
        const float dl = fmaxf(d, 0.f); st.mref += dl; st.alpha = __builtin_amdgcn_exp2f(-dl); st.l *= st.alpha;
#pragma unroll
        for (int r = 0; r < 16; ++r) { q0[r] = __builtin_amdgcn_exp2f(q0[r] - dl); q1[r] = __builtin_amdgcn_exp2f(q1[r] - dl); }
        f32x2 p2 = attn_sum8<0>(q0, (f32x2){0.f, 0.f}); p2 = attn_sum8<8>(q0, p2); p2 = attn_sum8<0>(q1, p2); p2 = attn_sum8<8>(q1, p2); psum = p2.x + p2.y;
    }
    st.l += psum;
    st.O0 = mfma32(vb0, st.pf3, st.O0); st.k0 = ATT_KF(rn0, 0); st.k1 = ATT_KF(rn0, 8192);
    ATT_PIN(st.l);
    ATT_SB();
    st.O1 = mfma32(vb1, st.pf3, st.O1); st.k2 = ATT_KF(rn1, 0); st.k3 = ATT_KF(rn1, 8192);
    ATT_SB();
    st.O2 = mfma32(vb2, st.pf3, st.O2); st.k4 = ATT_KF(rn2, 0); st.k5 = ATT_KF(rn2, 8192);
    st.pf0 = pack8<0>(q0); ATT_PIN(st.pf0);
    ATT_SB();
    st.O3 = mfma32(vb3, st.pf3, st.O3); st.k6 = ATT_KF(rn3, 0); st.k7 = ATT_KF(rn3, 8192);
    st.pf1 = pack8<8>(q0); ATT_PIN(st.pf1);
    ATT_SB();
    st.p1 = q1;
}
__device__ __forceinline__ void attn_unit(const int tid, ldsp lds, int b, int h, int qb, const bf16* proj, bf16* yc, const float* lamp, const float* subg) {
    const int lane = tid & 63, w = __builtin_amdgcn_readfirstlane(tid >> 6), r32 = lane & 31, hi = lane >> 5;
    const int c = w >> 2, it = w & 3;
    const int qw = qb * 128 + 32 * it, NT = 2 * qb + 2;
    const int row00 = b * SEQ, hcol = h * 128;
    bf16x8 qf[4];
#pragma unroll
    for (int s = 0; s < 4; ++s) qf[s] = *(const bf16x8*)(proj + pidx(row00 + qw + r32, C_QD + hcol + 64 * c + 16 * s + 8 * hi));
    ldsp rk0 = lds + ATT_K0 + offb(r32, 8 * c + 0 + hi), rk1 = lds + ATT_K0 + offb(r32, 8 * c + 2 + hi), rk2 = lds + ATT_K0 + offb(r32, 8 * c + 4 + hi), rk3 = lds + ATT_K0 + offb(r32, 8 * c + 6 + hi);
    ldsp tvb = lds + ATT_V0 + (4 * hi + ((lane & 15) >> 2)) * 64 + 32 * ((lane >> 4) & 1) + 8 * (lane & 3);
    const int kr0 = 8 * w + (lane >> 4), kc0 = (lane & 15) ^ (((kr0 & 3) << 2) | ((kr0 >> 2) & 3)), kr1 = kr0 + 4, kc1 = (lane & 15) ^ (((kr1 & 3) << 2) | ((kr1 >> 2) & 3));
    const unsigned oK0 = 2u * (unsigned)pidx(kr0, C_KD + hcol + 8 * kc0), oK1 = 2u * (unsigned)pidx(kr1, C_KD + hcol + 8 * kc1);
    const unsigned oV0 = 2u * (unsigned)pidx(32 * (w & 1) + (lane >> 2), C_VD + hcol + 32 * (w >> 1) + 8 * (lane & 3));
    const unsigned char* gb = (const unsigned char*)(proj + (size_t)(row00 >> 4) * PBROW);
    const int dK = 2048 * w, dV = 4096 * (w >> 1) + 2048 * (w & 1);
    const unsigned ldsb = (unsigned)__builtin_amdgcn_readfirstlane((int)(unsigned)(unsigned long long)lds);
#define ATT_GLDS(g_, d_) do { unsigned keep_; asm volatile("s_mov_b32 %0, m0\n\ts_mov_b32 m0, %2\n\ts_nop 0\n\tglobal_load_lds_dwordx4 %1, off\n\ts_mov_b32 m0, %0" : "=&s"(keep_) : "v"(g_), "s"(d_) : "memory"); } while (0)
#define ATT_DMA_K(tk_, so_) do { const unsigned char* p_ = gb + (size_t)(4 * (tk_)) * (2 * PBROW); const unsigned d_ = ldsb + ATT_K0 + (so_) + dK; \
        ATT_GLDS(p_ + oK0, d_); ATT_GLDS(p_ + oK1, d_ + 1024u); } while (0)
#define ATT_DMA_V(tv_, so_) do { const unsigned char* p_ = gb + (size_t)(4 * (tv_)) * (2 * PBROW); const unsigned d_ = ldsb + ATT_V0 + (so_) + dV; \
        ATT_GLDS(p_ + oV0, d_); ATT_GLDS(p_ + oV0 + 2 * PBROW, d_ + 1024u); } while (0)
#define ATT_WAITBAR() do { asm volatile("s_waitcnt vmcnt(4) lgkmcnt(0)" ::: "memory"); __builtin_amdgcn_s_barrier(); asm volatile("" ::: "memory"); } while (0)
    const int TL = NT - 1;
    ATT_DMA_K(0, 0);
    ATT_DMA_K(1, ATT_SLOT);
    { const int t2 = 2 < TL ? 2 : TL; ATT_DMA_K(t2, 2 * ATT_SLOT); }
    ATT_DMA_V(0, 0);
    AttS st; st.O0 = zero16(); st.O1 = zero16(); st.O2 = zero16(); st.O3 = zero16();
    st.mref = 0.f; st.l = 0.f; st.alpha = 1.f; st.rp = 0;
    asm volatile("s_waitcnt vmcnt(6)" ::: "memory"); __builtin_amdgcn_s_barrier(); asm volatile("" ::: "memory");
    st.k0 = ATT_KF(rk0, 0); st.k1 = ATT_KF(rk0, 8192); st.k2 = ATT_KF(rk1, 0); st.k3 = ATT_KF(rk1, 8192);
    st.k4 = ATT_KF(rk2, 0); st.k5 = ATT_KF(rk2, 8192); st.k6 = ATT_KF(rk3, 0); st.k7 = ATT_KF(rk3, 8192);
    ATT_WAITBAR();
    { const int t3 = 3 < TL ? 3 : TL, t1 = 1 < TL ? 1 : TL; ATT_DMA_K(t3, 0); ATT_DMA_V(t1, ATT_SLOT); }
    st.p0 = mfma32(st.k0, qf[0], zero16()); st.p1 = mfma32(st.k1, qf[0], zero16());
    st.p0 = mfma32(st.k2, qf[1], st.p0); st.p1 = mfma32(st.k3, qf[1], st.p1);
    st.p0 = mfma32(st.k4, qf[2], st.p0); st.p1 = mfma32(st.k5, qf[2], st.p1);
    st.p0 = mfma32(st.k6, qf[3], st.p0); st.p1 = mfma32(st.k7, qf[3], st.p1);
    ATT_SB();
    st.k0 = ATT_KF(rk0, ATT_SLOT); st.k1 = ATT_KF(rk0, ATT_SLOT + 8192); st.k2 = ATT_KF(rk1, ATT_SLOT); st.k3 = ATT_KF(rk1, ATT_SLOT + 8192);
    st.k4 = ATT_KF(rk2, ATT_SLOT); st.k5 = ATT_KF(rk2, ATT_SLOT + 8192); st.k6 = ATT_KF(rk3, ATT_SLOT); st.k7 = ATT_KF(rk3, ATT_SLOT + 8192);
    ATT_MASK(st.p0, st.p1, 0);
    st.mref = attn_rowmax(st.p0, st.p1);
#pragma unroll
    for (int r = 0; r < 16; ++r) { st.p0[r] = __builtin_amdgcn_exp2f(st.p0[r] - st.mref); st.p1[r] = __builtin_amdgcn_exp2f(st.p1[r] - st.mref); }
    { f32x2 ps = attn_sum8<0>(st.p0, (f32x2){0.f, 0.f}); ps = attn_sum8<8>(st.p0, ps); ps = attn_sum8<0>(st.p1, ps); ps = attn_sum8<8>(st.p1, ps); st.l += ps.x + ps.y; }
    st.pf0 = pack8<0>(st.p0); st.pf1 = pack8<8>(st.p0);
    ATT_PIN(st.pf0); ATT_PIN(st.pf1); ATT_PIN(st.p1);
    int sa = ATT_SLOT, sb = 2 * ATT_SLOT, sc = 0;
    if (c == 1) __builtin_amdgcn_s_setprio(1);
    for (int t = 1; t <= TL; ++t) {
        ATT_WAITBAR();
        { const int tk = t + 3 < TL ? t + 3 : TL, tv = t + 1 < TL ? t + 1 : TL; ATT_DMA_K(tk, sa); ATT_DMA_V(tv, sb); }
        attn_step(st, t, qw, r32, hi, qf, tvb + sc, rk0 + sb, rk1 + sb, rk2 + sb, rk3 + sb);
        const int s0 = sa; sa = sb; sb = sc; sc = s0;
    }
    if (c == 1) __builtin_amdgcn_s_setprio(0);
    ATT_WAITBAR();
    ATT_OSCALE();
    st.pf2 = pack8<0>(st.p1); st.pf3 = pack8<8>(st.p1);
    { ldsp tv = tvb + sc;
      { const bf16x8 v0 = ATT_VF(tv, 0, 0), v1 = ATT_VF(tv, 0, 1), v2 = ATT_VF(tv, 0, 2), v3 = ATT_VF(tv, 0, 3);
        st.O0 = mfma32(v0, st.pf0, st.O0); st.O1 = mfma32(v1, st.pf0, st.O1); st.O2 = mfma32(v2, st.pf0, st.O2); st.O3 = mfma32(v3, st.pf0, st.O3); }
      { const bf16x8 v0 = ATT_VF(tv, 1, 0), v1 = ATT_VF(tv, 1, 1), v2 = ATT_VF(tv, 1, 2), v3 = ATT_VF(tv, 1, 3);
        st.O0 = mfma32(v0, st.pf1, st.O0); st.O1 = mfma32(v1, st.pf1, st.O1); st.O2 = mfma32(v2, st.pf1, st.O2); st.O3 = mfma32(v3, st.pf1, st.O3); }
      { const bf16x8 v0 = ATT_VF(tv, 2, 0), v1 = ATT_VF(tv, 2, 1), v2 = ATT_VF(tv, 2, 2), v3 = ATT_VF(tv, 2, 3);
        st.O0 = mfma32(v0, st.pf2, st.O0); st.O1 = mfma32(v1, st.pf2, st.O1); st.O2 = mfma32(v2, st.pf2, st.O2); st.O3 = mfma32(v3, st.pf2, st.O3); }
      { const bf16x8 v0 = ATT_VF(tv, 3, 0), v1 = ATT_VF(tv, 3, 1), v2 = ATT_VF(tv, 3, 2), v3 = ATT_VF(tv, 3, 3);
        st.O0 = mfma32(v0, st.pf3, st.O0); st.O1 = mfma32(v1, st.pf3, st.O1); st.O2 = mfma32(v2, st.pf3, st.O2); st.O3 = mfma32(v3, st.pf3, st.O3); } }
#undef ATT_GLDS
#undef ATT_DMA_K
#undef ATT_DMA_V
#undef ATT_WAITBAR
    const float l = half_sum(st.l);
    const float inv = 1.0f / l;
    int tid_e = tid; LAUNDER_V(tid_e);
    const int lane_e = tid_e & 63, r32e = lane_e & 31, hie = lane_e >> 5;
    u32x2 gpre[16]; f32x4 spre[16];
    if (c == 0) { const bf16* grow = proj + pidx(row00 + qw + r32e, C_GD + hcol + 4 * hie); const float* sgp = subg + 4 * hie;
#pragma unroll
        for (int et = 0; et < 4; ++et)
#pragma unroll
            for (int q4 = 0; q4 < 4; ++q4) { gpre[4 * et + q4] = *(const u32x2*)(grow + 512 * et + 8 * q4); spre[4 * et + q4] = *(const f32x4*)(sgp + 32 * et + 8 * q4); }
        asm volatile("s_waitcnt vmcnt(32) lgkmcnt(0)" ::: "memory"); }
    else asm volatile("s_waitcnt vmcnt(0) lgkmcnt(0)" ::: "memory");
    __builtin_amdgcn_s_barrier(); asm volatile("" ::: "memory");
#define ATT_BAR() do { asm volatile("s_waitcnt lgkmcnt(0)" ::: "memory"); __builtin_amdgcn_s_barrier(); asm volatile("" ::: "memory"); } while (0)
    LAS float* XB = (LAS float*)lds + it * 4096 + lane_e;
    const float lam = lamp[0], oml = lamp[1];
    if (c == 1) { const float f = lam * inv;
#pragma unroll
        for (int r = 0; r < 16; ++r) { XB[(0 * 16 + r) * 64] = st.O0[r] * f; XB[(1 * 16 + r) * 64] = st.O1[r] * f; XB[(2 * 16 + r) * 64] = st.O2[r] * f; XB[(3 * 16 + r) * 64] = st.O3[r] * f; } }
    ATT_BAR();
    if (c == 0) {
        float ss = 0.f;
#pragma unroll
        for (int r = 0; r < 16; ++r) {
            st.O0[r] = st.O0[r] * inv - XB[(0 * 16 + r) * 64]; st.O1[r] = st.O1[r] * inv - XB[(1 * 16 + r) * 64];
            st.O2[r] = st.O2[r] * inv - XB[(2 * 16 + r) * 64]; st.O3[r] = st.O3[r] * inv - XB[(3 * 16 + r) * 64];
            ss += st.O0[r] * st.O0[r] + st.O1[r] * st.O1[r] + st.O2[r] * st.O2[r] + st.O3[r] * st.O3[r]; }
        ss = half_sum(ss);
        const float rs = rsqrtf(ss * (1.f / 128.f) + EPS) * oml;
        const size_t rowl = (size_t)(qw + r32e);
        bf16* yrow = yc + ((size_t)b * SEQ + rowl) * 1024 + h * 128 + 8 * hie;
#pragma unroll
        for (int et = 0; et < 4; ++et)
#pragma unroll
            for (int p = 0; p < 2; ++p) {
                const f32x16& A = et == 0 ? st.O0 : et == 1 ? st.O1 : et == 2 ? st.O2 : st.O3; unsigned ox[2], oy[2];
#pragma unroll
                for (int u = 0; u < 2; ++u) { const int q4 = 2 * p + u; const f32x4 sg4 = spre[4 * et + q4]; const u32x2 g = gpre[4 * et + q4];
                    ox[u] = cvt_pk_bf16(A[4 * q4] * rs * sg4.x * bf_lo(g.x), A[4 * q4 + 1] * rs * sg4.y * bf_hi(g.x));
                    oy[u] = cvt_pk_bf16(A[4 * q4 + 2] * rs * sg4.z * bf_lo(g.y), A[4 * q4 + 3] * rs * sg4.w * bf_hi(g.y)); }
                pg8::half_swap(ox[0], ox[1]); pg8::half_swap(oy[0], oy[1]);
                *(v4u*)(yrow + 32 * et + 16 * p) = (v4u){ox[0], oy[0], ox[1], oy[1]};
            }
    }
#undef ATT_BAR
#undef ATT_PIN
#undef ATT_SB
#undef ATT_EXP4
#undef ATT_SUB4
#undef ATT_EXP1
#undef ATT_EXP3
#undef ATT_VF
#undef ATT_KF
#undef ATT_MASK
#undef ATT_OSCALE
}

__device__ __forceinline__ int fetch_item(const int tid, gu32* ctr, volatile LAS unsigned* slot) {
    __syncthreads();
    if (tid == 0) *slot = __hip_atomic_fetch_add(ctr, 1u, RLX_AGENT);
    __syncthreads();
    return __builtin_amdgcn_readfirstlane((int)*slot);
}

#ifndef G1_ALIGN
#define G1_ALIGN true
#endif
#ifndef G1_SP2
#define G1_SP2 true
#endif
#ifndef G3_ALIGN
#define G3_ALIGN true
#endif
#ifndef G3_SP2
#define G3_SP2 true
#endif
#ifndef G4_ALIGN
#define G4_ALIGN true
#endif
#ifndef G4_SP2
#define G4_SP2 true
#endif
#ifndef PROBE_DUP
#define PROBE_DUP 0
#endif
#ifndef PROBE_EMODE
#define PROBE_EMODE 0
#endif
#ifndef PROBE_AMODE
#define PROBE_AMODE 0
#endif
#ifndef PROBE_P2SEL
#define PROBE_P2SEL 0
#endif
#ifndef MK_N_LAUNCHES
#define MK_N_LAUNCHES 1
#endif
constexpr int N_PHASES = 1 + NGROUP * DEPTH * 5;
struct Args { const float* in[17]; float* out; unsigned char* ws; int ph_lo, ph_hi, li, pad; };
__global__ void __launch_bounds__(NWAVES * 64, 2) hyb_fwd(Args args) {
    extern __shared__ __attribute__((aligned(16))) unsigned char lds_raw[];
    ldsp lds = (ldsp)lds_raw;
    volatile LAS unsigned* MISC = (volatile LAS unsigned*)(lds + MISC_OFF);
    for (int u = threadIdx.x; u < (LDS_BYTES - LDSCTL_OFF) / 4; u += NWAVES * 64) ((LAS unsigned*)(lds + LDSCTL_OFF))[u] = 0u;
    __syncthreads();
    XcdBarrier bar = xcd_barrier_post((unsigned*)((gu32*)(args.ws + WS_CTL) + CW_BAR) + args.li * XCD_BAR_WORDS, MISC + 8, (unsigned)__builtin_amdgcn_readfirstlane((int)threadIdx.x >> 6));
    int tidc = threadIdx.x;
    const int lo = args.ph_lo, hi_ = args.ph_hi;
#define IN(k) (lo <= (k) && (k) < hi_)
#define BOTH(k) (IN(k) && IN((k) + 1))
#define PHASE_ENTRY() LAUNDER_V(tidc); const int tid = tidc; unsigned long long z_ = 0ull; LAUNDER_S(z_); unsigned char* ws = args.ws + z_; const int G = gridDim.x; \
    const int lane = tid & 63, wave = __builtin_amdgcn_readfirstlane(tid >> 6); (void)lane; (void)wave; (void)G

    if (IN(0)) {
        PHASE_ENTRY();
        const int gw = blockIdx.x * NWAVES + wave, NGW = G * NWAVES;
        float* lams = (float*)(ws + WS_LAMS);
        bf16* WIN = (bf16*)(ws + WS_WIN); bf16* WBR = (bf16*)(ws + WS_WBR); bf16* WOUT = (bf16*)(ws + WS_WOUT); bf16* HB = (bf16*)(ws + WS_H);
        LAS float* scr = (LAS float*)(lds + wave * 16384);
        constexpr int I_IN = (2048 / 64) * (16384 / 32), I_BR = (1024 / 64) * (2048 / 32), I_OUT = (2048 / 64) * (2048 / 32);
        constexpr int NITEMS = 2 * I_IN + 6 * I_BR + 2 * I_OUT;
        for (int it = gw; it < NITEMS; it += NGW) {
            int r = it;
            if (r < 2 * I_IN) { const int l = r / I_IN; r -= l * I_IN; p0_transpose_item(args.in[3] + (size_t)l * 2048 * 16384, 2048, 16384, WIN + (size_t)l * 16384 * 2048, scr, r, lane); continue; }
            r -= 2 * I_IN;
            if (r < 6 * I_BR) { const int lj = r / I_BR; r -= lj * I_BR; const int l = lj / 3, j = lj - 3 * l;
                const float* src = j == 0 ? args.in[13] : j == 1 ? args.in[14] : args.in[15];
                p0_transpose_item(src + (size_t)l * 1024 * 2048, 1024, 2048, WBR + (size_t)lj * 2048 * 1024, scr, r, lane); continue; }
            r -= 6 * I_BR;
            { const int l = r / I_OUT; r -= l * I_OUT; p0_transpose_item(args.in[16] + (size_t)l * 2048 * 2048, 2048, 2048, WOUT + (size_t)l * 2048 * 2048, scr, r, lane); }
        }
        if (blockIdx.x == 0 && wave == 0) {
            for (int l = 0; l < DEPTH; ++l) { const float* dl = args.in[11] + l * 256;
                const float s01 = wave_sum(dl[lane] * dl[64 + lane]), s23 = wave_sum(dl[128 + lane] * dl[192 + lane]);
                const float lam_init = 0.8f - 0.6f * __expf(-0.3f * (float)l);
                if (lane == 0) { lams[2 * l] = __expf(s01) - __expf(s23) + lam_init; lams[2 * l + 1] = 1.0f - lam_init; } }
        }
        { f32x4 gv[8];
#pragma unroll
          for (int j = 0; j < 4; ++j) { gv[2 * j] = *(const f32x4*)(args.in[1] + 512 * j + 8 * lane); gv[2 * j + 1] = *(const f32x4*)(args.in[1] + 512 * j + 8 * lane + 4); }
          for (int m = gw; m < M_ALL; m += NGW) rms_row_to_bf16(args.in[0] + (size_t)m * D_MODEL, gv, HB + (size_t)m * D_MODEL, lane); }
        if (BOTH(0)) xcd_barrier(bar);
    }

    for (int g = 0; g < NGROUP; ++g)
        for (int l = 0; l < DEPTH; ++l) {
            const int pb = 1 + (g * DEPTH + l) * 5;
            if (IN(pb)) {
                PHASE_ENTRY();
                pg8::SchedPlain S; S.so.init(TG, D_IN, G, (int)blockIdx.x); S.A = (const char*)(ws + WS_H) + (size_t)g * TG * D_MODEL * 2; S.Bt = (const char*)(ws + WS_WIN) + (size_t)l * D_IN * D_MODEL * 2;
                pg8::EpiProj E{(bf16*)(ws + WS_PROJ), (bf16*)(ws + WS_GM), (PROBE_DUP == 1 && args.li > 0 && pb == lo) ? PROBE_EMODE : 0};
#ifndef SKIP_P1
                pg8::gemm_phase<pg8::EpiProj, pg8::SchedPlain, G1_ALIGN, G1_SP2>(lds, D_MODEL, S, E, tid);
#endif
                if (BOTH(pb)) xcd_barrier(bar);
            }
            if (IN(pb + 1)) {
                const bool only = PROBE_DUP == 2 && PROBE_P2SEL != 0 && args.li > 0 && (pb + 1) == lo;
#ifndef SKIP_RET
                if (!only || PROBE_P2SEL == 1) { PHASE_ENTRY(); gu32* q = (gu32*)(ws + WS_CTL) + CW_Q + 64 * 3 * (g * DEPTH + l) + args.li * 1024;
                  const bf16* PROJ = (const bf16*)(ws + WS_PROJ); bf16* YB = (bf16*)(ws + WS_Y);
                  for (;;) { LAUNDER_V(tidc); const int t2 = tidc; const int it = fetch_item(t2, q, MISC + 16); if (it >= BG * 8) break; ret_unit(t2, lds, it >> 3, it & 7, PROJ, YB + (size_t)TG * 1024); } }
#endif
#ifndef SKIP_LRU
                if (!only || PROBE_P2SEL == 2) { PHASE_ENTRY(); gu32* q = (gu32*)(ws + WS_CTL) + CW_Q + 64 * 3 * (g * DEPTH + l) + args.li * 1024;
                  const bf16* PROJ = (const bf16*)(ws + WS_PROJ); bf16* YB = (bf16*)(ws + WS_Y);
                  for (;;) { LAUNDER_V(tidc); const int t2 = tidc; const int it = fetch_item(t2, q + 64, MISC + 16); if (it >= BG * 16) break;
                    lru_unit(t2, lds, it >> 4, it & 15, PROJ, YB, args.in[4] + l * 4096, args.in[5] + l * 1024, args.in[6] + (size_t)l * 65536, args.in[7] + l * 1024,
                             args.in[8] + (size_t)l * 65536, args.in[9] + l * 1024, args.in[10] + l * 1024); } }
#endif
#ifndef SKIP_ATT
                if (!only || PROBE_P2SEL == 3) { PHASE_ENTRY(); gu32* q = (gu32*)(ws + WS_CTL) + CW_Q + 64 * 3 * (g * DEPTH + l) + args.li * 1024;
                  const bf16* PROJ = (const bf16*)(ws + WS_PROJ); bf16* YB = (bf16*)(ws + WS_Y); const float* lams = (const float*)(ws + WS_LAMS);
                  int it; { LAUNDER_V(tidc); const int t2 = tidc; it = fetch_item(t2, q + 128, MISC + 16); }
                  while (it < BG * 8 * 32) { LAUNDER_V(tidc); const int t2 = tidc; const int qb = 31 - (it >> 5), bh = it & 31;
                    unsigned pend = 0u; if (t2 == 0) pend = __hip_atomic_fetch_add(q + 128, 1u, RLX_AGENT);
                    attn_unit(t2, lds, bh >> 3, bh & 7, qb, PROJ, YB + (size_t)2 * TG * 1024, lams + 2 * l, args.in[12] + l * 128);
                    LAUNDER_V(tidc); const int t3 = tidc; volatile LAS unsigned* slot = MISC + 16;
                    __syncthreads(); if (t3 == 0) *slot = pend; __syncthreads(); it = __builtin_amdgcn_readfirstlane((int)*slot); } }
#endif
                if (BOTH(pb + 1)) xcd_barrier(bar);
            }
            if (IN(pb + 2)) {
                PHASE_ENTRY();
                pg8::SchedBranch S; S.so.init(TG, D_MODEL, G, (int)blockIdx.x); S.A = (const char*)(ws + WS_Y); S.strideA = (size_t)TG * 1024 * 2;
                S.Bt = (const char*)(ws + WS_WBR) + (size_t)l * 3 * 2048 * 1024 * 2; S.strideB = (size_t)2048 * 1024 * 2;
                pg8::EpiMerge E{(const unsigned char*)(ws + WS_GM), (bf16*)(ws + WS_M)};
#ifndef SKIP_P3
                pg8::gemm_phase<pg8::EpiMerge, pg8::SchedBranch, G3_ALIGN, G3_SP2>(lds, 1024, S, E, tid);
#endif
                if (BOTH(pb + 2)) xcd_barrier(bar);
            }
            if (IN(pb + 3)) {
                PHASE_ENTRY();
                pg8::SchedPlain S; S.so.init(TG, D_MODEL, G, (int)blockIdx.x); S.A = (const char*)(ws + WS_M); S.Bt = (const char*)(ws + WS_WOUT) + (size_t)l * D_MODEL * D_MODEL * 2;
                pg8::EpiBf16Plain E{(bf16*)(ws + WS_O), D_MODEL};
#ifndef SKIP_P4
                pg8::gemm_phase<pg8::EpiBf16Plain, pg8::SchedPlain, G4_ALIGN, G4_SP2>(lds, D_MODEL, S, E, tid);
#endif
                if (BOTH(pb + 3)) xcd_barrier(bar);
            }
            if (IN(pb + 4)) {
                PHASE_ENTRY();
                const int gw = blockIdx.x * NWAVES + wave, NGW = G * NWAVES;
                const bool dead = __hip_atomic_load((gu32*)(ws + WS_CTL) + CW_BAR + XB_TMO, RLX_AGENT) != 0u;
                const bf16* OB = (const bf16*)(ws + WS_O); bf16* HB = (bf16*)(ws + WS_H); bf16* X1 = (bf16*)(ws + WS_X1);
                f32x4 pgv[8], ngv[8];
                { const float* pg = args.in[2] + l * D_MODEL + 8 * lane; const float* ng = args.in[1] + D_MODEL + 8 * lane;
#pragma unroll
                  for (int j = 0; j < 4; ++j) { pgv[2 * j] = *(const f32x4*)(pg + 512 * j); pgv[2 * j + 1] = *(const f32x4*)(pg + 512 * j + 4); ngv[2 * j] = *(const f32x4*)(ng + 512 * j); ngv[2 * j + 1] = *(const f32x4*)(ng + 512 * j + 4); } }
                for (int m = gw; m < TG; m += NGW) {
                    const size_t row = (size_t)g * TG + m;
                    const v4u* orow = (const v4u*)(OB + (size_t)m * D_MODEL) + lane;
                    f32x4 v[8]; float s = 0.f;
#pragma unroll
                    for (int j = 0; j < 4; ++j) { const v4u ow = orow[64 * j]; v[2 * j] = (f32x4){bf_lo(ow.x), bf_hi(ow.x), bf_lo(ow.y), bf_hi(ow.y)}; v[2 * j + 1] = (f32x4){bf_lo(ow.z), bf_hi(ow.z), bf_lo(ow.w), bf_hi(ow.w)}; }
#pragma unroll
                    for (int j = 0; j < 8; ++j) s += (v[j].x * v[j].x + v[j].y * v[j].y) + (v[j].z * v[j].z + v[j].w * v[j].w);
                    const float rs = rsqrtf(wave_sum(s) * (1.f / D_MODEL) + EPS);
                    if (l == 0) {
                        const float* xrow = args.in[0] + row * D_MODEL + 8 * lane; float s2 = 0.f;
                        v4u* x8 = (v4u*)(X1 + (size_t)m * D_MODEL) + lane;
#pragma unroll
                        for (int j = 0; j < 4; ++j) {
                            const f32x4 xa = *(const f32x4*)(xrow + 512 * j), xb = *(const f32x4*)(xrow + 512 * j + 4), ga = pgv[2 * j], gb = pgv[2 * j + 1];
                            v[2 * j] = xa + v[2 * j] * rs * ga; v[2 * j + 1] = xb + v[2 * j + 1] * rs * gb;
                            v4u wv; wv.x = cvt_pk_bf16(v[2 * j].x, v[2 * j].y); wv.y = cvt_pk_bf16(v[2 * j].z, v[2 * j].w); wv.z = cvt_pk_bf16(v[2 * j + 1].x, v[2 * j + 1].y); wv.w = cvt_pk_bf16(v[2 * j + 1].z, v[2 * j + 1].w);
                            x8[64 * j] = wv; }
#pragma unroll
                        for (int j = 0; j < 8; ++j) s2 += (v[j].x * v[j].x + v[j].y * v[j].y) + (v[j].z * v[j].z + v[j].w * v[j].w);
                        const float rs2 = rsqrtf(wave_sum(s2) * (1.f / D_MODEL) + EPS);
                        v4u* o8 = (v4u*)(HB + row * D_MODEL) + lane;
#pragma unroll
                        for (int j = 0; j < 4; ++j) { const f32x4 ga = ngv[2 * j], gb = ngv[2 * j + 1]; const f32x4 a = v[2 * j] * rs2 * ga, bq = v[2 * j + 1] * rs2 * gb;
                            v4u wv; wv.x = cvt_pk_bf16(a.x, a.y); wv.y = cvt_pk_bf16(a.z, a.w); wv.z = cvt_pk_bf16(bq.x, bq.y); wv.w = cvt_pk_bf16(bq.z, bq.w); o8[64 * j] = wv; }
                    } else {
                        const v4u* x8 = (const v4u*)(X1 + (size_t)m * D_MODEL) + lane;
                        float* drow = args.out + row * D_MODEL + 8 * lane;
#pragma unroll
                        for (int j = 0; j < 4; ++j) { const v4u xw = x8[64 * j]; const f32x4 ga = pgv[2 * j], gb = pgv[2 * j + 1];
                            f32x4 a = (f32x4){bf_lo(xw.x), bf_hi(xw.x), bf_lo(xw.y), bf_hi(xw.y)} + v[2 * j] * rs * ga, bq = (f32x4){bf_lo(xw.z), bf_hi(xw.z), bf_lo(xw.w), bf_hi(xw.w)} + v[2 * j + 1] * rs * gb;
                            if (dead) { const float qn = __builtin_nanf(""); a = (f32x4){qn, qn, qn, qn}; bq = a; }
                            *(f32x4*)(drow + 512 * j) = a; *(f32x4*)(drow + 512 * j + 4) = bq; }
                    }
                }
                if (BOTH(pb + 4)) xcd_barrier(bar);
            }
        }
#undef IN
#undef BOTH
#undef PHASE_ENTRY
}

extern "C" void kernel_launch(void* const* d_in, const int* in_sizes, int n_in, void* d_out, int out_size, void* d_ws, size_t ws_size, hipStream_t stream) {
    static int grid = 0;
    if (grid == 0) {
        if (n_in != 17 || in_sizes[0] != M_ALL * D_MODEL || out_size != M_ALL * D_MODEL || ws_size < WS_END) {
            fprintf(stderr, "kernel_launch: unexpected shapes (n_in %d, in0 %d, out %d, ws %zu < %zu); nothing launched\n", n_in, n_in > 0 ? in_sizes[0] : -1, out_size, ws_size, (size_t)WS_END); grid = -1; return; }
        int dev = 0, cus = 0, per_cu = 0;
        if (hipGetDevice(&dev) != hipSuccess || hipDeviceGetAttribute(&cus, hipDeviceAttributeMultiprocessorCount, dev) != hipSuccess) { grid = -1; return; }
        if (hipFuncSetAttribute((const void*)hyb_fwd, hipFuncAttributeMaxDynamicSharedMemorySize, LDS_BYTES) != hipSuccess) { fprintf(stderr, "kernel_launch: hipFuncSetAttribute failed\n"); grid = -1; return; }
        if (hipOccupancyMaxActiveBlocksPerMultiprocessor(&per_cu, (const void*)hyb_fwd, NWAVES * 64, LDS_BYTES) != hipSuccess || per_cu < 1)
            fprintf(stderr, "kernel_launch: note: occupancy query reports %d workgroups per CU\n", per_cu);
        (void)hipGetLastError();
        grid = cus;
    }
    if (grid < 0) return;
    if (hipMemsetAsync((char*)d_ws + WS_CTL, 0, CTL_ZERO_BYTES, stream) != hipSuccess) return;
    Args a{};
    for (int i = 0; i < 17; ++i) a.in[i] = (const float*)d_in[i];
    a.out = (float*)d_out; a.ws = (unsigned char*)d_ws;
#if PROBE_DUP > 0
    { int lo = 0; for (int k = 0; k <= NGROUP * DEPTH; ++k) { const int p = 1 + k * 5 + (PROBE_DUP - 1); const int hi = k < NGROUP * DEPTH ? p + 1 : N_PHASES;
        a.ph_lo = lo; a.ph_hi = hi; a.li = k; a.pad = 0; hipLaunchKernelGGL(hyb_fwd, dim3(grid), dim3(NWAVES * 64), LDS_BYTES, stream, a); lo = p; } }
#elif MK_N_LAUNCHES == 1
    a.ph_lo = 0; a.ph_hi = N_PHASES; a.li = 0; a.pad = 0;
    hipLaunchKernelGGL(hyb_fwd, dim3(grid), dim3(NWAVES * 64), LDS_BYTES, stream, a);
#else
    for (int p = 0; p < N_PHASES; ++p) { a.ph_lo = p; a.ph_hi = p + 1; a.li = 0; a.pad = 0;
        hipLaunchKernelGGL(hyb_fwd, dim3(grid), dim3(NWAVES * 64), LDS_BYTES, stream, a); }
#endif
}
```

```cpp
#include <hip/hip_runtime.h>
#include <cstdio>
#include <cstdint>

namespace pg8 {
#define PG8_LAS __attribute__((address_space(3)))
typedef unsigned short bf16_t;
typedef short bf16x8 __attribute__((ext_vector_type(8)));
typedef float f32x4 __attribute__((ext_vector_type(4)));
typedef unsigned u32x4 __attribute__((ext_vector_type(4)));
constexpr int BM = 256, BK = 64, HALF = 128, HTB = HALF * BK * 2  , STAGE_BYTES = 8 * HTB, NXCD = 8, WGM = 8;

__host__ __device__ __forceinline__ int lds_byte(int r, int c) { const int st = (r >> 4) * 2 + (c >> 5), rr = r & 15, cc = c & 31, ob = rr * 64 + cc * 2; return st * 1024 + (ob ^ (((ob >> 9) & 1) << 5)); }
__host__ __device__ __forceinline__ void stage_rc(int b, int& R, int& C) { const int st = b / 1024, sb = b % 1024, swz = sb ^ (((sb >> 9) & 1) << 5); R = (st >> 1) * 16 + swz / 64; C = (st & 1) * 32 + (swz % 64) / 2; }
__host__ __device__ __forceinline__ int perm32(int rho) { const int n = rho >> 4, i = rho & 15; return 8 * (i >> 2) + 4 * n + (i & 3); }

struct Unit { int pm, pn, sel; };

struct StaticOrder {
    int nM, nN, nwg, G, c;
    __host__ __device__ void init(int M, int N, int G_, int c_) { nM = M / BM; nN = N / BM; nwg = nM * nN; G = G_; c = c_; }
    __host__ __device__ bool next(int i, Unit& u) const {
        const long L = (long)i * G + c; if (L >= nwg) return false;
        int wgid = (int)L; { const int q = nwg / NXCD, r = nwg % NXCD, xcd = wgid % NXCD, off = wgid / NXCD; wgid = (xcd < r ? xcd * (q + 1) : r * (q + 1) + (xcd - r) * q) + off; }
        const int nig = WGM * nN, gid = wgid / nig, fm = gid * WGM, gsz = (nM - fm) < WGM ? (nM - fm) : WGM;
        u.pm = fm + ((wgid % nig) % gsz); u.pn = (wgid % nig) / gsz; u.sel = 0; return true;
    }
};
struct SchedPlain {
    StaticOrder so; const char* A; const char* Bt;
    __device__ __forceinline__ bool next(int i, Unit& u) const { return so.next(i, u); }
    __device__ __forceinline__ const char* a_base(const Unit& u, size_t tstep) const { return A + (size_t)u.pm * tstep; }
    __device__ __forceinline__ const char* b_base(const Unit& u, size_t tstep) const { return Bt + (size_t)u.pn * tstep; }
    __device__ __forceinline__ bool keep(const Unit&) const { return false; }
    __device__ __forceinline__ void a_ready(const Unit&) const {}
    __device__ __forceinline__ void done(const Unit&) const {}
};
struct SchedBranch {
    StaticOrder so; const char* A; const char* Bt; size_t strideA, strideB;
    __device__ __forceinline__ bool next(int i, Unit& u) const { const int t = i / 3; if (!so.next(t, u)) return false; u.sel = i - 3 * t; return true; }
    __device__ __forceinline__ const char* a_base(const Unit& u, size_t tstep) const { return A + (size_t)u.sel * strideA + (size_t)u.pm * tstep; }
    __device__ __forceinline__ const char* b_base(const Unit& u, size_t tstep) const { return Bt + (size_t)u.sel * strideB + (size_t)u.pn * tstep; }
    __device__ __forceinline__ bool keep(const Unit& u) const { return u.sel < 2; }
    __device__ __forceinline__ void a_ready(const Unit&) const {}
    __device__ __forceinline__ void done(const Unit&) const {}
};

typedef float f32x2_cv __attribute__((ext_vector_type(2))); typedef __bf16 bf16x2_cv __attribute__((ext_vector_type(2)));
__device__ __forceinline__ unsigned cvt_pk_bf16(float lo, float hi) { const f32x2_cv v = {lo, hi}; const bf16x2_cv b = __builtin_convertvector(v, bf16x2_cv); return __builtin_bit_cast(unsigned, b); }
__device__ __forceinline__ float bf_lo(unsigned w) { return __uint_as_float(w << 16); }
__device__ __forceinline__ float bf_hi(unsigned w) { return __uint_as_float(w & 0xffff0000u); }
__device__ __forceinline__ float fast_sigmoid(float x) { return __builtin_amdgcn_rcpf(1.0f + __expf(-x)); }
__device__ __forceinline__ float fast_silu(float x) { return x * fast_sigmoid(x); }
__device__ __forceinline__ float lg2_gamma(int h) {
    const float x = __builtin_amdgcn_exp2f((float)(-5 - h));
    const float s = x * (1.0f + x * (0.5f + x * (0.33333334f + x * (0.25f + x * 0.2f))));
    return -s * 1.4426950408889634f;
}

template <int MASK> __device__ __forceinline__ float swz_xor(float v) { return __builtin_bit_cast(float, __builtin_amdgcn_ds_swizzle(__builtin_bit_cast(int, v), (MASK << 10) | 0x1f)); }
__device__ __forceinline__ float swz_xor16(float v) { return swz_xor<16>(v); }
__device__ __forceinline__ void half_swap(unsigned& a, unsigned& b) { asm volatile("s_nop 1\n\tv_permlane32_swap_b32 %0, %1" : "+v"(a), "+v"(b)); }
__device__ __forceinline__ float half_sum(float v) { unsigned a = __builtin_bit_cast(unsigned, v), b = a; half_swap(a, b); return __builtin_bit_cast(float, a) + __builtin_bit_cast(float, b); }
__device__ __forceinline__ float half_max(float v) { unsigned a = __builtin_bit_cast(unsigned, v), b = a; half_swap(a, b); return fmaxf(__builtin_bit_cast(float, a), __builtin_bit_cast(float, b)); }

__host__ __device__ __forceinline__ size_t blk_idx(int row, int col, int nbc  ) { return ((size_t)(row >> 4) * nbc + (col >> 5)) * 512 + (size_t)((row & 15) * 32 + (col & 31)); }

struct EpiF32 {
    static constexpr bool PERM = false, AFTER_DRAIN = false;
    float* C; int ldc;
    __device__ __forceinline__ void operator()(f32x4 (&acc)[2][2][4][2], const Unit& u, int wr, int wc, int fr, int fq) const {
        const int row0 = u.pm * BM + wr * 64 + fr, col0 = u.pn * BM + wc * 32 + 4 * fq;
#pragma unroll
        for (int ai = 0; ai < 2; ++ai)
#pragma unroll
            for (int m = 0; m < 4; ++m) { float* rowp = C + (size_t)(row0 + ai * HALF + m * 16) * ldc + col0;
#pragma unroll
                for (int bj = 0; bj < 2; ++bj)
#pragma unroll
                    for (int n = 0; n < 2; ++n) *(f32x4*)(rowp + bj * HALF + n * 16) = acc[ai][bj][m][n]; }
    }
};

__host__ __device__ __forceinline__ size_t gm8_idx(int row, int bc) { return ((size_t)(row >> 4) * 96 + (bc >> 6)) * 1024 + (size_t)((row & 15) * 64 + (bc & 63)); }
__device__ __forceinline__ unsigned gate_q8x4(const f32x4& g) {
    const unsigned q0 = max((unsigned)(g[0] * 255.f + 0.5f), 1u), q1 = max((unsigned)(g[1] * 255.f + 0.5f), 1u), q2 = max((unsigned)(g[2] * 255.f + 0.5f), 1u), q3 = max((unsigned)(g[3] * 255.f + 0.5f), 1u);
    return q0 | (q1 << 8) | (q2 << 16) | (q3 << 24); }
__device__ __forceinline__ f32x4 gate_unq4(unsigned w) { return (f32x4){(float)(w & 0xffu), (float)((w >> 8) & 0xffu), (float)((w >> 16) & 0xffu), (float)(w >> 24)}; }
struct EpiProj {
    static constexpr bool PERM = true, AFTER_DRAIN = false;
    bf16_t* proj; bf16_t* gm; int mode;
    template <int KIND> __device__ __forceinline__ void run(f32x4 (&acc)[2][2][4][2], const Unit& u, int wr, int wc, int fr, int fq) const {
        const int row0 = u.pm * BM + wr * 64 + fr, colt = u.pn * BM, cl = wc * 32 + 8 * fq;
        constexpr double FRD[8] = {0.15915494309189535, 0.030863763158420102, 0.00598518567638293, 0.001160663620968869, 0.00022507907904105155, 4.3647954811733995e-05, 8.464331128654902e-06, 1.6414263867044143e-06};
#pragma unroll
        for (int ai = 0; ai < 2; ++ai)
#pragma unroll
            for (int m = 0; m < 4; ++m) {
                const int row = row0 + ai * HALF + m * 16, pos = row & 4095;
                float cs[8], sn[8];
                if constexpr (KIND == 2 || KIND == 3) {
                    int fqo = fq; asm volatile("" : "+v"(fqo));
#pragma unroll
                    for (int k = 0; k < 4; ++k) { const double fv = (double)__builtin_amdgcn_exp2f(-(float)(16 * wc + 4 * fqo + k) * (13.287712379549449f / 63.0f)) * 0.15915494309189535;
                        const double ph = (double)pos * fv; const float r = (float)(ph - __builtin_floor(ph)); cs[k] = __builtin_amdgcn_cosf(r); sn[k] = __builtin_amdgcn_sinf(r); }
                }
                if constexpr (KIND == 4 || KIND == 5) {
                    if ((wc & 1) == 0) {
#pragma unroll
                        for (int k = 0; k < 8; ++k) { const double ph = (double)pos * FRD[k]; const float r = (float)(ph - __builtin_floor(ph)); cs[k] = __builtin_amdgcn_cosf(r); sn[k] = __builtin_amdgcn_sinf(r); if (fq == 0) sn[k] = -sn[k]; }
                    }
                }
                u32x4 w8 = {0u, 0u, 0u, 0u};
#pragma unroll
                for (int bj = 0; bj < 2; ++bj) {
                    const int col = colt + bj * HALF + cl;
                    f32x4 v0 = acc[ai][bj][m][0], v1 = acc[ai][bj][m][1];
                    if constexpr (KIND == 0) {
#pragma unroll
                        for (int k = 0; k < 4; ++k) { v0[k] = fast_sigmoid(v0[k]); v1[k] = fast_sigmoid(v1[k]); }
                        if (bj == 0) { w8.x = gate_q8x4(v0); w8.y = gate_q8x4(v1); } else { w8.z = gate_q8x4(v0); w8.w = gate_q8x4(v1); }
                    } else if constexpr (KIND == 1) {
#pragma unroll
                        for (int k = 0; k < 4; ++k) { v0[k] = fast_silu(v0[k]); v1[k] = fast_silu(v1[k]); }
                    } else if constexpr (KIND == 2 || KIND == 3) {
                        float sc = 1.0f;
                        if constexpr (KIND == 3) { int hh = ((colt - 3072) >> 7) + bj; asm volatile("" : "+s"(hh));
                            sc = 0.08838834764831845f * __builtin_amdgcn_exp2f(lg2_gamma(hh) * (float)(127 - (pos & 127))); }
                        const f32x4 ca = {cs[0] * sc, cs[0] * sc, cs[1] * sc, cs[1] * sc}, sa = {sn[0] * sc, sn[0] * sc, sn[1] * sc, sn[1] * sc};
                        const f32x4 cb = {cs[2] * sc, cs[2] * sc, cs[3] * sc, cs[3] * sc}, sb = {sn[2] * sc, sn[2] * sc, sn[3] * sc, sn[3] * sc};
                        const f32x4 w0 = {-v0[1], v0[0], -v0[3], v0[2]}, w1 = {-v1[1], v1[0], -v1[3], v1[2]};
                        v0 = v0 * ca + w0 * sa; v1 = v1 * cb + w1 * sb;
                    } else if constexpr (KIND == 4 || KIND == 5) {
                        if ((wc & 1) == 0) {
                            f32x4 p0, p1;
#pragma unroll
                            for (int k = 0; k < 4; ++k) { p0[k] = swz_xor16(v0[k]); p1[k] = swz_xor16(v1[k]); }
                            if (fq < 2) {
#pragma unroll
                                for (int k = 0; k < 4; ++k) { v0[k] = v0[k] * cs[k] + p0[k] * sn[k]; v1[k] = v1[k] * cs[4 + k] + p1[k] * sn[4 + k]; }
                            }
                        }
                        if constexpr (KIND == 4) { v0 = v0 * 0.18033688011112042f; v1 = v1 * 0.18033688011112042f; }
                    }
                    if constexpr (KIND != 0) {
                        u32x4 w; w.x = cvt_pk_bf16(v0[0], v0[1]); w.y = cvt_pk_bf16(v0[2], v0[3]); w.z = cvt_pk_bf16(v1[0], v1[1]); w.w = cvt_pk_bf16(v1[2], v1[3]);
                        if constexpr (KIND == 7) *(u32x4*)(gm + blk_idx(row, col - 10240, 192)) = w;
                        else *(u32x4*)(proj + blk_idx(row, col, 320)) = w;
                    }
                }
                if constexpr (KIND == 0) *(u32x4*)((unsigned char*)gm + gm8_idx(row, colt - 10240 + 2 * cl)) = w8;
            }
    }
    __device__ __forceinline__ void operator()(f32x4 (&acc)[2][2][4][2], const Unit& u, int wr, int wc, int fr, int fq) const {
        const int seg = (u.pn * BM) >> 10;
        if (mode == 1) return;
        if (mode == 2) { if (seg >= 10) run<7>(acc, u, wr, wc, fr, fq); else run<6>(acc, u, wr, wc, fr, fq); return; }
        if (seg >= 10) run<0>(acc, u, wr, wc, fr, fq);
        else if (seg == 1 || seg == 5 || seg == 9) run<1>(acc, u, wr, wc, fr, fq);
        else if (seg == 2) run<2>(acc, u, wr, wc, fr, fq);
        else if (seg == 3) run<3>(acc, u, wr, wc, fr, fq);
        else if (seg == 6) run<4>(acc, u, wr, wc, fr, fq);
        else if (seg == 7) run<5>(acc, u, wr, wc, fr, fq);
        else run<6>(acc, u, wr, wc, fr, fq);
    }
};

struct EpiBf16Plain {
    static constexpr bool PERM = true, AFTER_DRAIN = false;
    bf16_t* O; int ldc;
    __device__ __forceinline__ void operator()(f32x4 (&acc)[2][2][4][2], const Unit& u, int wr, int wc, int fr, int fq) const {
        const int row0 = u.pm * BM + wr * 64 + fr, col0 = u.pn * BM + wc * 32 + 8 * fq;
#pragma unroll
        for (int ai = 0; ai < 2; ++ai)
#pragma unroll
            for (int m = 0; m < 4; ++m) { bf16_t* rowp = O + (size_t)(row0 + ai * HALF + m * 16) * ldc + col0;
#pragma unroll
                for (int bj = 0; bj < 2; ++bj) { const f32x4 v0 = acc[ai][bj][m][0], v1 = acc[ai][bj][m][1];
                    u32x4 w; w.x = cvt_pk_bf16(v0[0], v0[1]); w.y = cvt_pk_bf16(v0[2], v0[3]); w.z = cvt_pk_bf16(v1[0], v1[1]); w.w = cvt_pk_bf16(v1[2], v1[3]);
                    *(u32x4*)(rowp + bj * HALF) = w; } }
    }
};

struct EpiMerge {
    static constexpr bool PERM = true, AFTER_DRAIN = false;
    const unsigned char* gm; bf16_t* mo;
    __device__ __forceinline__ void load_batch(const int bt, const int row0, const int gbc, const int j, u32x4 (&gc)[2], u32x4 (&gn)[2]) const {
        const int ai = bt >> 1, mh = bt & 1;
#pragma unroll
        for (int mm = 0; mm < 2; ++mm) { const unsigned char* p = gm + gm8_idx(row0 + ai * HALF + (2 * mh + mm) * 16, gbc);
            gc[mm] = *(const u32x4*)p; if (j < 2) gn[mm] = *(const u32x4*)(p + (size_t)32 * 1024); else gn[mm] = gc[mm]; }
    }
    __device__ __forceinline__ void apply_batch(const int bt, f32x4 (&acc)[2][2][4][2], const int row0, const int col0, const int j, const u32x4 (&gc)[2], const u32x4 (&gn)[2]) const {
        const int ai = bt >> 1, mh = bt & 1;
#pragma unroll
        for (int mm = 0; mm < 2; ++mm)
#pragma unroll
            for (int bj = 0; bj < 2; ++bj) {
                const int m = 2 * mh + mm; const u32x4 c = gc[mm];
                f32x4 g0 = gate_unq4(bj == 0 ? c.x : c.z), g1 = gate_unq4(bj == 0 ? c.y : c.w);
                if (j < 2) {
                    const u32x4 n = gn[mm];
                    const f32x4 n0 = gate_unq4(bj == 0 ? n.x : n.z), n1 = gate_unq4(bj == 0 ? n.y : n.w);
#pragma unroll
                    for (int k = 0; k < 4; ++k) { g0[k] = g0[k] * __builtin_amdgcn_rcpf(n0[k]); g1[k] = g1[k] * __builtin_amdgcn_rcpf(n1[k]); }
                    acc[ai][bj][m][0] = acc[ai][bj][m][0] * g0; acc[ai][bj][m][1] = acc[ai][bj][m][1] * g1;
                } else {
                    const f32x4 v0 = acc[ai][bj][m][0] * (g0 * (1.0f / 255.0f)), v1 = acc[ai][bj][m][1] * (g1 * (1.0f / 255.0f));
                    u32x4 w; w.x = cvt_pk_bf16(v0[0], v0[1]); w.y = cvt_pk_bf16(v0[2], v0[3]); w.z = cvt_pk_bf16(v1[0], v1[1]); w.w = cvt_pk_bf16(v1[2], v1[3]);
                    *(u32x4*)(mo + (size_t)(row0 + ai * HALF + m * 16) * 2048 + col0 + bj * HALF) = w;
                }
            }
    }
    __device__ __forceinline__ void operator()(f32x4 (&acc)[2][2][4][2], const Unit& u, int wr, int wc, int fr, int fq) const {
        const int row0 = u.pm * BM + wr * 64 + fr, col0 = u.pn * BM + wc * 32 + 8 * fq, j = u.sel;
        const int gbc = j * 2048 + u.pn * 256 + 64 * wc + 16 * fq;
        u32x4 gcA[2], gnA[2], gcB[2], gnB[2], gcC[2], gnC[2], gcD[2], gnD[2];
        load_batch(0, row0, gbc, j, gcA, gnA);
        load_batch(1, row0, gbc, j, gcB, gnB);
        load_batch(2, row0, gbc, j, gcC, gnC);
        load_batch(3, row0, gbc, j, gcD, gnD);
        __builtin_amdgcn_sched_barrier(0);
        apply_batch(0, acc, row0, col0, j, gcA, gnA);
        __builtin_amdgcn_sched_barrier(0);
        apply_batch(1, acc, row0, col0, j, gcB, gnB);
        __builtin_amdgcn_sched_barrier(0);
        apply_batch(2, acc, row0, col0, j, gcC, gnC);
        __builtin_amdgcn_sched_barrier(0);
        apply_batch(3, acc, row0, col0, j, gcD, gnD);
    }
};

template <class Epi, class Sched, bool ALIGN_EPI = false, bool SP2 = false>
__device__ __forceinline__ void gemm_phase(PG8_LAS unsigned char* lds, const int K_, const Sched& S, const Epi& E, const int tid) {
    const int wid = __builtin_amdgcn_readfirstlane(tid >> 6), lane = tid & 63, wr = wid >> 2, wc = wid & 3, fr = lane & 15, fq = lane >> 4;
    const int K = K_, nt = K / BK;
    unsigned voffA[2], voffB[2];
#pragma unroll
    for (int i = 0; i < 2; ++i) { int R, C; stage_rc(tid * 16 + i * 8192, R, C); const int Rb = Epi::PERM ? ((R & ~31) + perm32(R & 31)) : R;
        voffA[i] = (unsigned)(R * K + C) * 2u; voffB[i] = (unsigned)(Rb * K + C) * 2u; }
    const size_t kstep = (size_t)(BK * 2);
    const size_t hstep = (size_t)HALF * K * 2;
    const size_t tstep = 2 * hstep;
    const unsigned ldsw = (unsigned)wid * 1024u;
    const int aoff = lds_byte(wr * 64 + fr, fq * 8), boff = lds_byte(wc * 32 + fr, fq * 8);
#define PG8_SA(b, h) (((b) * 2 + (h)) * HTB)
#define PG8_SB(b, h) ((4 + (b) * 2 + (h)) * HTB)
#define PG8_STAGE(bufoff, gbase, voff) do { _Pragma("unroll") for (int _i = 0; _i < 2; ++_i) \
        __builtin_amdgcn_global_load_lds((const unsigned*)((const char*)(gbase) + (voff)[_i]), (PG8_LAS unsigned*)(lds + (bufoff) + ldsw + _i * 8192), 16, 0, 0); } while (0)
#define PG8_LDA(dst, b, h) do { _Pragma("unroll") for (int m = 0; m < 4; ++m) _Pragma("unroll") for (int k = 0; k < 2; ++k) dst[m][k] = *(const PG8_LAS bf16x8*)(lds + PG8_SA(b, h) + aoff + m * 2048 + k * 1024); } while (0)
#define PG8_LDB(dst, b, h) do { _Pragma("unroll") for (int n = 0; n < 2; ++n) _Pragma("unroll") for (int k = 0; k < 2; ++k) dst[n][k] = *(const PG8_LAS bf16x8*)(lds + PG8_SB(b, h) + boff + n * 2048 + k * 1024); } while (0)
#define PG8_MMA(ai, bj, At, Bt) do { __builtin_amdgcn_s_setprio(1); _Pragma("unroll") for (int m = 0; m < 4; ++m) _Pragma("unroll") for (int n = 0; n < 2; ++n) _Pragma("unroll") for (int k = 0; k < 2; ++k) \
        acc[ai][bj][m][n] = __builtin_amdgcn_mfma_f32_16x16x32_bf16(Bt[n][k], At[m][k], acc[ai][bj][m][n], 0, 0, 0); __builtin_amdgcn_s_setprio(0); } while (0)
#define PG8_WAIT_V(n) asm volatile("s_waitcnt vmcnt(" #n ")" ::: "memory")
#define PG8_WAIT_L(n) asm volatile("s_waitcnt lgkmcnt(" #n ")" ::: "memory")
#define PG8_BAR __builtin_amdgcn_s_barrier()
#define PG8_SCHED __builtin_amdgcn_sched_barrier(0)
    Unit cur, nxt; int ui = 0;
    if (!S.next(0, cur)) return;
    f32x4 acc[2][2][4][2];
#pragma unroll
    for (int a = 0; a < 2; ++a)
#pragma unroll
        for (int b = 0; b < 2; ++b)
#pragma unroll
            for (int m = 0; m < 4; ++m)
#pragma unroll
                for (int n = 0; n < 2; ++n) acc[a][b][m][n] = (f32x4){0.f, 0.f, 0.f, 0.f};
    bf16x8 At[4][2], B0[2][2], B1[2][2];
    const char* cA = S.a_base(cur, tstep); const char* cB = S.b_base(cur, tstep);
    S.a_ready(cur);
    if constexpr (SP2) {
        PG8_STAGE(PG8_SB(0, 0), cB, voffB); PG8_STAGE(PG8_SB(0, 1), cB + hstep, voffB); PG8_STAGE(PG8_SA(0, 0), cA, voffA); PG8_STAGE(PG8_SA(0, 1), cA + hstep, voffA);
        if (wr == 1) PG8_BAR;
        PG8_WAIT_V(2); PG8_BAR;
        PG8_STAGE(PG8_SB(1, 0), cB + kstep, voffB); PG8_STAGE(PG8_SA(1, 0), cA + kstep, voffA); PG8_STAGE(PG8_SB(1, 1), cB + hstep + kstep, voffB);
        PG8_WAIT_V(6); PG8_BAR;
    } else {
        PG8_STAGE(PG8_SB(0, 0), cB, voffB); PG8_STAGE(PG8_SA(0, 0), cA, voffA); PG8_STAGE(PG8_SB(0, 1), cB + hstep, voffB); PG8_STAGE(PG8_SA(0, 1), cA + hstep, voffA);
        if (wr == 1) PG8_BAR;
        PG8_WAIT_V(4); PG8_BAR;
        PG8_STAGE(PG8_SB(1, 0), cB + kstep, voffB); PG8_STAGE(PG8_SA(1, 0), cA + kstep, voffA); PG8_STAGE(PG8_SB(1, 1), cB + hstep + kstep, voffB);
        PG8_WAIT_V(6); PG8_BAR;
    }
    for (;;) {
        const bool has_next = S.next(ui + 1, nxt);
        const char* nA = has_next ? S.a_base(nxt, tstep) : cA; const char* nB = has_next ? S.b_base(nxt, tstep) : cB;
        for (int t = 0; t < nt; t += 2) {
            const bool last = (t == nt - 2);
            const char* a1 = cA + (size_t)(t + 1) * kstep;
            const char* a2 = last ? nA : cA + (size_t)(t + 2) * kstep; const char* b2 = last ? nB : cB + (size_t)(t + 2) * kstep;
            const char* a3 = a2 + kstep; const char* b3 = b2 + kstep;
            if (last && has_next) S.a_ready(nxt);
            if constexpr (SP2) {
            PG8_LDB(B0, 0, 0); PG8_LDB(B1, 0, 1); PG8_SCHED; PG8_LDA(At, 0, 0); PG8_STAGE(PG8_SA(1, 1), a1 + hstep, voffA);
            PG8_WAIT_V(8); PG8_WAIT_L(0); PG8_BAR; PG8_MMA(0, 0, At, B0); PG8_MMA(0, 1, At, B1); PG8_BAR; PG8_SCHED;
            PG8_LDA(At, 0, 1); PG8_STAGE(PG8_SB(0, 0), b2, voffB); PG8_STAGE(PG8_SB(0, 1), b2 + hstep, voffB); PG8_STAGE(PG8_SA(0, 0), a2, voffA);
            PG8_WAIT_V(8); PG8_WAIT_L(0); PG8_BAR; PG8_MMA(1, 0, At, B0); PG8_MMA(1, 1, At, B1); PG8_BAR; PG8_SCHED;
            PG8_LDB(B0, 1, 0); PG8_LDB(B1, 1, 1); PG8_SCHED; PG8_LDA(At, 1, 0); PG8_STAGE(PG8_SA(0, 1), a2 + hstep, voffA);
            PG8_WAIT_V(8); PG8_WAIT_L(0); PG8_BAR; PG8_MMA(0, 0, At, B0); PG8_MMA(0, 1, At, B1); PG8_BAR; PG8_SCHED;
            PG8_LDA(At, 1, 1); PG8_STAGE(PG8_SB(1, 0), b3, voffB); PG8_STAGE(PG8_SB(1, 1), b3 + hstep, voffB); PG8_STAGE(PG8_SA(1, 0), a3, voffA);
            PG8_WAIT_V(8); PG8_WAIT_L(0); PG8_BAR; PG8_MMA(1, 0, At, B0); PG8_MMA(1, 1, At, B1); PG8_BAR; PG8_SCHED;
            } else {
            PG8_LDB(B0, 0, 0); PG8_SCHED; PG8_LDA(At, 0, 0); PG8_STAGE(PG8_SA(1, 1), a1 + hstep, voffA);
            PG8_WAIT_L(8); PG8_BAR; PG8_WAIT_L(0); PG8_MMA(0, 0, At, B0); PG8_BAR; PG8_SCHED;
            PG8_LDB(B1, 0, 1); PG8_STAGE(PG8_SB(0, 0), b2, voffB);
            PG8_BAR; PG8_WAIT_L(0); PG8_MMA(0, 1, At, B1); PG8_BAR;
            PG8_LDA(At, 0, 1); PG8_STAGE(PG8_SA(0, 0), a2, voffA);
            PG8_BAR; PG8_WAIT_L(0); PG8_MMA(1, 0, At, B0); PG8_BAR; PG8_SCHED;
            PG8_STAGE(PG8_SB(0, 1), b2 + hstep, voffB);
            PG8_WAIT_V(6); PG8_BAR; PG8_MMA(1, 1, At, B1); PG8_BAR;
            PG8_LDB(B0, 1, 0); PG8_SCHED; PG8_LDA(At, 1, 0); PG8_STAGE(PG8_SA(0, 1), a2 + hstep, voffA);
            PG8_WAIT_L(8); PG8_BAR; PG8_WAIT_L(0); PG8_MMA(0, 0, At, B0); PG8_BAR; PG8_SCHED;
            PG8_LDB(B1, 1, 1); PG8_STAGE(PG8_SB(1, 0), b3, voffB);
            PG8_BAR; PG8_WAIT_L(0); PG8_MMA(0, 1, At, B1); PG8_BAR;
            PG8_LDA(At, 1, 1); PG8_STAGE(PG8_SA(1, 0), a3, voffA);
            PG8_BAR; PG8_WAIT_L(0); PG8_MMA(1, 0, At, B0); PG8_BAR; PG8_SCHED;
            PG8_STAGE(PG8_SB(1, 1), b3 + hstep, voffB);
            PG8_WAIT_V(6); PG8_BAR; PG8_MMA(1, 1, At, B1); PG8_BAR;
            }
        }
        if constexpr (ALIGN_EPI) { if (wr == 0) PG8_BAR; }
        if constexpr (!Epi::AFTER_DRAIN) { E(acc, cur, wr, wc, fr, fq); S.done(cur); }
        if (!has_next) break;
        if (!S.keep(cur)) {
#pragma unroll
        for (int a = 0; a < 2; ++a)
#pragma unroll
            for (int b = 0; b < 2; ++b)
#pragma unroll
                for (int m = 0; m < 4; ++m)
#pragma unroll
                    for (int n = 0; n < 2; ++n) acc[a][b][m][n] = (f32x4){0.f, 0.f, 0.f, 0.f};
        }
        cur = nxt; cA = nA; cB = nB; ++ui;
        if constexpr (ALIGN_EPI) { if (wr == 1) PG8_BAR; }
    }
    PG8_WAIT_V(0);
    if constexpr (!ALIGN_EPI) { if (wr == 0) PG8_BAR; }
    PG8_BAR;
    if constexpr (Epi::AFTER_DRAIN) { E.fused(acc, cur, wr, wc, fr, fq, lds, wid, lane); S.done(cur); }
#undef PG8_SA
#undef PG8_SB
#undef PG8_STAGE
#undef PG8_LDA
#undef PG8_LDB
#undef PG8_MMA
#undef PG8_WAIT_V
#undef PG8_WAIT_L
#undef PG8_BAR
#undef PG8_SCHED
}
}
#define GAS __attribute__((address_space(1)))
#define LAS __attribute__((address_space(3)))
typedef unsigned short bf16;
typedef unsigned v4u __attribute__((ext_vector_type(4)));
typedef float f32x4 __attribute__((ext_vector_type(4)));
typedef short bf16x8 __attribute__((ext_vector_type(8)));
typedef GAS unsigned gu32;
typedef GAS unsigned long long gu64;
#define RLX_AGENT __ATOMIC_RELAXED, __HIP_MEMORY_SCOPE_AGENT
#define LDS_WAIT() asm volatile("s_waitcnt lgkmcnt(0)" ::: "memory")
#define VM_WAIT() asm volatile("s_waitcnt vmcnt(0)" ::: "memory")
__device__ __forceinline__ unsigned long long rt() { return __builtin_amdgcn_s_memrealtime(); }
__device__ __forceinline__ unsigned f2bf(float f) { unsigned u = __builtin_bit_cast(unsigned, f); return (u + 0x7fffu + ((u >> 16) & 1u)) >> 16; }
__device__ __forceinline__ unsigned pk2(float lo, float hi) { return f2bf(lo) | (f2bf(hi) << 16); }

#define XB_TMO      128
#define XB_XCNT(j)  (256  + 64 * (j))
#define XB_XSUB(j)  (1280 + 64 * (j))
#define XB_XGEN(j)  (2304 + 64 * (j))
#define XB_TOP      3328
#define XB_TOPGEN   3392
#define XCD_BAR_WORDS 3456
#define XB_SPIN_CAP (1u << 18)

__device__ __forceinline__ unsigned xb_ld(unsigned* p)              { return __hip_atomic_load(p, __ATOMIC_RELAXED, __HIP_MEMORY_SCOPE_AGENT); }
__device__ __forceinline__ unsigned xb_add(unsigned* p, unsigned v) { return __hip_atomic_fetch_add(p, v, __ATOMIC_RELAXED, __HIP_MEMORY_SCOPE_AGENT); }
__device__ __forceinline__ unsigned xb_xcc_id() { return (unsigned)__builtin_amdgcn_s_getreg((3 << 11) | 20) & 0xFu; }
#define XB_SPIN(cond, bar) do { unsigned _sp = 0; while (cond) { __builtin_amdgcn_s_sleep(1); \
    if ((++_sp & 255u) == 0u) { if (xb_ld(&(bar)[XB_TMO])) break; if (_sp > XB_SPIN_CAP) { atomicAdd(&(bar)[XB_TMO], 1u); break; } } } } while (0)

__device__ __forceinline__ unsigned xb_lane() { unsigned m = ~0u; asm volatile("" : "+s"(m)); return __builtin_amdgcn_mbcnt_hi(m, __builtin_amdgcn_mbcnt_lo(m, 0u)); }
struct XcdBarrier {
    unsigned wv;
    unsigned* bar; unsigned x;
    volatile LAS unsigned* st;
};

__device__ __forceinline__ XcdBarrier xcd_barrier_post(unsigned* bar, volatile LAS unsigned* st, unsigned wv) {
    XcdBarrier b; b.wv = wv; b.bar = bar; b.x = xb_xcc_id(); b.st = st;
    if (wv == 0u && xb_lane() == 0u) (void)xb_add(&bar[XB_XCNT(b.x)], 1u);
    return b;
}
__device__ __forceinline__ void xcd_barrier_complete(unsigned* bar, unsigned x, unsigned& nloc, unsigned& nx) {
    const unsigned G = gridDim.x * gridDim.y * gridDim.z;
    unsigned sum, cnt, mine, sp = 0u;
    for (;;) {
        sum = 0u; cnt = 0u; mine = 0u;
#pragma unroll
        for (unsigned j = 0; j < 16; ++j) { const unsigned c = xb_ld(&bar[XB_XCNT(j)]); sum += c; cnt += (c > 0u) ? 1u : 0u; mine = (j == x) ? c : mine; }
        if (sum == G) break;
        __builtin_amdgcn_s_sleep(1);
        if ((++sp & 255u) == 0u) { if (xb_ld(&bar[XB_TMO])) break; if (sp > XB_SPIN_CAP) { atomicAdd(&bar[XB_TMO], 1u); break; } }
    }
    nloc = mine > 0u ? mine : 1u; nx = cnt > 0u ? cnt : 1u;
}

__device__ __forceinline__ void xcd_barrier(const XcdBarrier& b) {
    asm volatile("s_waitcnt vmcnt(0)" ::: "memory");
    __syncthreads();
    if (b.wv == 0u && xb_lane() == 0u) {
        unsigned* bar = b.bar;
        __builtin_amdgcn_s_waitcnt(0);
        unsigned nloc = b.st[0], nx = b.st[1];
        if (nloc == 0u) { xcd_barrier_complete(bar, b.x, nloc, nx); b.st[0] = nloc; b.st[1] = nx; }
        const unsigned old = xb_add(&bar[XB_XSUB(b.x)], 1u);
        const unsigned gen = old / nloc;
        if (old + 1u == (gen + 1u) * nloc) {
            __builtin_amdgcn_fence(__ATOMIC_RELEASE, "agent");
            asm volatile("s_waitcnt vmcnt(0)" ::: "memory");
            const unsigned og = xb_add(&bar[XB_TOP], 1u);
            const unsigned tg = og / nx;
            if (og + 1u == (tg + 1u) * nx) xb_add(&bar[XB_TOPGEN], 1u);
            else XB_SPIN(xb_ld(&bar[XB_TOPGEN]) == tg, bar);
            __builtin_amdgcn_fence(__ATOMIC_ACQUIRE, "agent");
            xb_add(&bar[XB_XGEN(b.x)], 1u);
            asm volatile("s_waitcnt vmcnt(0)" ::: "memory");
        } else {
            XB_SPIN(xb_ld(&bar[XB_XGEN(b.x)]) == gen, bar);
            __builtin_amdgcn_fence(__ATOMIC_ACQUIRE, "agent");
            asm volatile("s_waitcnt vmcnt(0)" ::: "memory");
        }
    }
    __syncthreads();
}

constexpr int D_MODEL = 2048, SEQ = 4096, BATCH = 8, DEPTH = 2, M_ALL = BATCH * SEQ, D_IN = 16384;
constexpr int BG = 4, TG = BG * SEQ, NGROUP = BATCH / BG;
constexpr int PNBC = 320, PBROW = PNBC * 512;
__device__ __forceinline__ size_t pidx(int row, int col) { return pg8::blk_idx(row, col, PNBC); }
constexpr int C_XA = 0, C_GA = 1024, C_QR = 2048, C_KR = 3072, C_VR = 4096, C_GR = 5120, C_QD = 6144, C_KD = 7168, C_VD = 8192, C_GD = 9216;
constexpr float EPS = 1e-6f;
constexpr int NWAVES = 8;
constexpr size_t MiB = 1u << 20;
constexpr size_t WS_CTL = 0, CTL_ZERO_BYTES = 1 * MiB;
constexpr size_t WS_COSR = 1 * MiB, WS_SINR = 2 * MiB, WS_COSD = 3 * MiB, WS_SIND = 3 * MiB + 128 * 1024, WS_LAMS = 3 * MiB + 512 * 1024;
constexpr size_t WS_WIN = 4 * MiB;
constexpr size_t WS_WBR = 132 * MiB;
constexpr size_t WS_WOUT = 156 * MiB;
constexpr size_t WS_H = 172 * MiB;
constexpr size_t WS_Y = 300 * MiB;
constexpr size_t WS_GM = 396 * MiB;
constexpr size_t WS_PROJ = 588 * MiB;
constexpr size_t WS_O = 588 * MiB;
constexpr size_t WS_M = 716 * MiB;
constexpr size_t WS_X1 = 908 * MiB;
constexpr size_t WS_END = 972 * MiB;
static_assert(WS_M + (size_t)TG * 2048 * 2 <= WS_END && WS_O + (size_t)TG * 2048 * 4 <= WS_M && WS_PROJ + (size_t)TG * 10240 * 2 == WS_X1 && WS_X1 + (size_t)TG * 2048 * 2 == WS_END, "d_ws map");
constexpr int CW_TMO = 0;
constexpr int CW_BAR = 4096;
constexpr int CW_Q = 65536;
constexpr int RING_BYTES = 131072, LDSCTL_OFF = RING_BYTES, MISC_OFF = LDSCTL_OFF + 320, LDS_BYTES = 147456;

#define LAUNDER_V(x) asm volatile("" : "+v"(x))
#define LAUNDER_S(x) asm volatile("" : "+s"(x))
typedef float f32x16 __attribute__((ext_vector_type(16)));
typedef short s16x4 __attribute__((ext_vector_type(4)));
typedef short v4i16_t __attribute__((ext_vector_type(4)));
typedef unsigned u32x2 __attribute__((ext_vector_type(2)));
typedef LAS unsigned char* ldsp;
using pg8::blk_idx; using pg8::cvt_pk_bf16; using pg8::bf_lo; using pg8::bf_hi; using pg8::fast_sigmoid; using pg8::lg2_gamma;

using pg8::swz_xor; using pg8::half_sum; using pg8::half_max;
__device__ __forceinline__ float wave_sum(float v) {
    v += swz_xor<1>(v); v += swz_xor<2>(v); v += swz_xor<4>(v); v += swz_xor<8>(v); v += swz_xor<16>(v);
    return half_sum(v);
}
__device__ __forceinline__ unsigned offb(unsigned row, unsigned ch) { return 256u * row + 16u * (ch ^ (((row & 3u) << 2) | ((row >> 2) & 3u))); }
__device__ __forceinline__ unsigned tr_nat(int lane, int k0, int t, int c) { const int h = lane >> 5, blk = (lane >> 4) & 1, q = (lane & 15) >> 2, p = lane & 3; return offb(k0 + 8 * h + 4 * t + q, 4 * c + 2 * blk + (p >> 1)) + 8 * (p & 1); }
__device__ __forceinline__ unsigned tr_perm(int lane, int k0, int t, int c) { const int h = lane >> 5, blk = (lane >> 4) & 1, q = (lane & 15) >> 2, p = lane & 3; return offb(k0 + 8 * t + 4 * h + q, 4 * c + 2 * blk + (p >> 1)) + 8 * (p & 1); }
__device__ __forceinline__ f32x16 mfma32(bf16x8 a, bf16x8 b, f32x16 c) { return __builtin_amdgcn_mfma_f32_32x32x16_bf16(a, b, c, 0, 0, 0); }
__device__ __forceinline__ s16x4 trr(ldsp p) { return __builtin_bit_cast(s16x4, __builtin_amdgcn_ds_read_tr16_b64_v4i16((LAS v4i16_t*)p)); }
__device__ __forceinline__ bf16x8 cat8(s16x4 lo, s16x4 hi) { return (bf16x8){lo[0], lo[1], lo[2], lo[3], hi[0], hi[1], hi[2], hi[3]}; }
template <int B> __device__ __forceinline__ bf16x8 pack8(const f32x16& x) {
    v4u w = {cvt_pk_bf16(x[B], x[B + 1]), cvt_pk_bf16(x[B + 2], x[B + 3]), cvt_pk_bf16(x[B + 4], x[B + 5]), cvt_pk_bf16(x[B + 6], x[B + 7])};
    return __builtin_bit_cast(bf16x8, w);
}
__device__ __forceinline__ f32x16 zero16() { f32x16 z;
#pragma unroll
    for (int i = 0; i < 16; ++i) z[i] = 0.f; return z; }

struct P0Item { const float* W; bf16* WT; int K, N, item; };
__device__ __forceinline__ void p0_tr_load(const P0Item& I, int lane, f32x4 (&v)[8]) {
    const int nblk = I.N / 32, kb = I.item / nblk, nb = I.item % nblk, k0 = 64 * kb, n0 = 32 * nb;
    const int cg = lane & 7, rs = lane >> 3;
#pragma unroll
    for (int i = 0; i < 8; ++i) v[i] = *(const f32x4*)(I.W + (size_t)(k0 + 8 * i + rs) * I.N + n0 + 4 * cg);
}
__device__ __forceinline__ void p0_tr_finish(const P0Item& I, int lane, LAS float* scr, const f32x4 (&v)[8]) {
    const int nblk = I.N / 32, kb = I.item / nblk, nb = I.item % nblk, k0 = 64 * kb, n0 = 32 * nb;
    { const int cg = lane & 7, rs = lane >> 3;
#pragma unroll
      for (int i = 0; i < 8; ++i) { LAS float* d = scr + (8 * i + rs) * 33 + 4 * cg; d[0] = v[i].x; d[1] = v[i].y; d[2] = v[i].z; d[3] = v[i].w; } }
    LDS_WAIT(); asm volatile("" ::: "memory");
    const int c = lane & 7;
#pragma unroll
    for (int j = 0; j < 4; ++j) { const int n = (lane >> 3) + 8 * j; const LAS float* s = scr + (8 * c) * 33 + n;
        v4u o; o.x = pk2(s[0 * 33], s[1 * 33]); o.y = pk2(s[2 * 33], s[3 * 33]); o.z = pk2(s[4 * 33], s[5 * 33]); o.w = pk2(s[6 * 33], s[7 * 33]);
        *(GAS v4u*)(I.WT + (size_t)(n0 + n) * I.K + k0 + 8 * c) = o; }
    LDS_WAIT(); asm volatile("" ::: "memory");
}
__device__ __forceinline__ void rms_row_load(const float* xrow, int lane, f32x4 (&v)[8]) {
    const float* xr = xrow + 8 * lane;
#pragma unroll
    for (int j = 0; j < 4; ++j) { v[2 * j] = *(const f32x4*)(xr + 512 * j); v[2 * j + 1] = *(const f32x4*)(xr + 512 * j + 4); }
}
__device__ __forceinline__ void rms_row_finish(const f32x4 (&v)[8], const f32x4 (&gv)[8], bf16* orow, int lane) {
    float s = 0.f;
#pragma unroll
    for (int j = 0; j < 8; ++j) s += (v[j].x * v[j].x + v[j].y * v[j].y) + (v[j].z * v[j].z + v[j].w * v[j].w);
    const float rs = rsqrtf(wave_sum(s) * (1.f / D_MODEL) + EPS);
    v4u* o16 = (v4u*)orow + lane;
#pragma unroll
    for (int j = 0; j < 4; ++j) { const f32x4 ga = gv[2 * j], gb = gv[2 * j + 1]; const f32x4 a = v[2 * j] * rs * ga, bq = v[2 * j + 1] * rs * gb;
        v4u w; w.x = cvt_pk_bf16(a.x, a.y); w.y = cvt_pk_bf16(a.z, a.w); w.z = cvt_pk_bf16(bq.x, bq.y); w.w = cvt_pk_bf16(bq.z, bq.w); o16[64 * j] = w; }
}

__device__ __forceinline__ void ret_unit(const int tid, ldsp lds, int b, int h, const bf16* proj, bf16* yb) {
    const int lane = tid & 63, w = __builtin_amdgcn_readfirstlane(tid >> 6), r32 = lane & 31, hi = lane >> 5;
    const int it = w >> 1, eh = w & 1;
    constexpr int O_ST = 0, O_KD = 32768, O_VV = 65536, O_Q = 98304;
    LAS float* STAT = (LAS float*)(lds + RING_BYTES + 1024);
    { unsigned z0 = 0u; LAUNDER_V(z0); for (int i = tid; i < 2048; i += 512) ((LAS v4u*)(lds + O_ST))[i] = (v4u){z0, z0, z0, z0}; }
    ldsp rb[8];
#pragma unroll
    for (int s = 0; s < 8; ++s) rb[s] = lds + offb(r32, 2 * s + hi);
    ldsp tnk0 = lds + O_KD + tr_perm(lane, 0, 0, it), tnk1 = lds + O_KD + tr_perm(lane, 0, 1, it);
    ldsp tpv00 = lds + O_VV + tr_perm(lane, 0, 0, 2 * eh), tpv01 = lds + O_VV + tr_perm(lane, 0, 1, 2 * eh), tpv10 = lds + O_VV + tr_perm(lane, 0, 0, 2 * eh + 1), tpv11 = lds + O_VV + tr_perm(lane, 0, 1, 2 * eh + 1);
    const int row00 = b * SEQ, hcol = h * 128;
    bf16* Yp = yb + (size_t)b * SEQ * 1024 + h * 128;
    const float lg = lg2_gamma(h), cd = __builtin_amdgcn_exp2f(128.f * lg), cout = __builtin_amdgcn_exp2f(lg * (float)(32 * it + r32 - 127));
    f32x16 Dacc0 = zero16(), Dacc1 = zero16();
#define RET_DMA(src_, n_, lane_, off_) do { _Pragma("unroll") for (int k_ = 0; k_ < 4; ++k_) { const int row_ = 16 * w + 4 * k_ + ((lane_) >> 4); \
        const int ch_ = ((lane_) & 15) ^ (((row_ & 3) << 2) | ((row_ >> 2) & 3)); \
        __builtin_amdgcn_global_load_lds((const unsigned*)(proj + pidx(row00 + (n_) * 128 + row_, (src_) + hcol + 8 * ch_)), (LAS unsigned*)(lds + (off_) + 4096 * w + 1024 * k_), 16, 0, 0); } } while (0)
#define RET_BAR() do { asm volatile("s_waitcnt lgkmcnt(0)" ::: "memory"); __builtin_amdgcn_s_barrier(); asm volatile("" ::: "memory"); } while (0)
    RET_DMA(C_KR, 0, lane, O_KD); RET_DMA(C_VR, 0, lane, O_VV); RET_DMA(C_QR, 0, lane, O_Q);
    for (int n = 0; n < 32; ++n) {
        int tid_c = tid; LAUNDER_V(tid_c);
        const int lane_c = tid_c & 63, r32c = lane_c & 31, hic = lane_c >> 5;
        const int rowi = n * 128 + 32 * it + r32c;
        const int nn = n + 1 < 32 ? n + 1 : 31;
        asm volatile("s_waitcnt vmcnt(0) lgkmcnt(0)" ::: "memory"); __builtin_amdgcn_s_barrier(); asm volatile("" ::: "memory");
        bf16x8 qf[8];
        { ldsp qb_ = lds + O_Q + 8192 * it;
#pragma unroll
          for (int s = 0; s < 8; ++s) qf[s] = *(const LAS bf16x8*)(qb_ + (unsigned)(rb[s] - lds)); }
#pragma unroll
        for (int ks = 0; ks < 8; ++ks) {
            const bf16x8 a = cat8(trr(tnk0 + 4096 * ks), trr(tnk1 + 4096 * ks));
            Dacc0 = mfma32(a, cat8(trr(tpv00 + 4096 * ks), trr(tpv01 + 4096 * ks)), Dacc0);
            Dacc1 = mfma32(a, cat8(trr(tpv10 + 4096 * ks), trr(tpv11 + 4096 * ks)), Dacc1);
            if (ks & 1) __builtin_amdgcn_sched_barrier(0);
        }
        f32x16 acc0 = zero16(), acc1 = zero16();
#pragma unroll
        for (int jt = 0; jt < 4; ++jt) if (jt <= it) {
            f32x16 X = zero16();
#pragma unroll
            for (int s = 0; s < 8; ++s) X = mfma32(*(const LAS bf16x8*)(rb[s] + O_KD + 8192 * jt), qf[s], X);
            __builtin_amdgcn_sched_barrier(0);
            if (jt == it) {
#pragma unroll
                for (int r = 0; r < 16; ++r) { const int j = (r & 3) + 8 * (r >> 2) + 4 * hic; if (j > r32c) X[r] = 0.f; }
            }
            const bf16x8 pf0 = pack8<0>(X), pf1 = pack8<8>(X);
            acc0 = mfma32(cat8(trr(tpv00 + 8192 * jt), trr(tpv01 + 8192 * jt)), pf0, acc0);
            acc1 = mfma32(cat8(trr(tpv10 + 8192 * jt), trr(tpv11 + 8192 * jt)), pf0, acc1);
            acc0 = mfma32(cat8(trr(tpv00 + 8192 * jt + 4096), trr(tpv01 + 8192 * jt + 4096)), pf1, acc0);
            acc1 = mfma32(cat8(trr(tpv10 + 8192 * jt + 4096), trr(tpv11 + 8192 * jt + 4096)), pf1, acc1);
            __builtin_amdgcn_sched_barrier(0);
        }
        RET_BAR();
        RET_DMA(C_KR, nn, lane_c, O_KD); RET_DMA(C_VR, nn, lane_c, O_VV); RET_DMA(C_QR, nn, lane_c, O_Q);
        u32x2 gg[8];
        { const bf16* grow = proj + pidx(row00 + rowi, C_GR + hcol + 64 * eh + 4 * hic);
#pragma unroll
          for (int e2 = 0; e2 < 2; ++e2)
#pragma unroll
              for (int q4 = 0; q4 < 4; ++q4) gg[4 * e2 + q4] = *(const u32x2*)(grow + 512 * e2 + 8 * q4); }
        {
            ldsp st0 = lds + 16384 * eh;
#pragma unroll
            for (int s = 0; s < 8; ++s) {
                const unsigned o_ = (unsigned)(rb[s] - lds);
                acc0 = mfma32(*(const LAS bf16x8*)(st0 + o_ + O_ST), qf[s], acc0);
                acc1 = mfma32(*(const LAS bf16x8*)(st0 + o_ + O_ST + 8192), qf[s], acc1);
                if ((s & 3) == 3) __builtin_amdgcn_sched_barrier(0);
            }
        }
        float s1 = 0.f, s2 = 0.f;
#pragma unroll
        for (int r = 0; r < 16; ++r) { s1 += acc0[r] + acc1[r]; s2 += acc0[r] * acc0[r] + acc1[r] * acc1[r]; }
        s1 = half_sum(s1); s2 = half_sum(s2);
        if (hic == 0) { STAT[(32 * it + r32c) * 4 + eh * 2] = s1; STAT[(32 * it + r32c) * 4 + eh * 2 + 1] = s2; }
        RET_BAR();
        {
            const LAS float* st = STAT + (32 * it + r32c) * 4;
            const float mean = (st[0] + st[2]) * (1.f / 128.f); float var = (st[1] + st[3]) * (1.f / 128.f) - mean * mean; var = fmaxf(var, 0.f);
            const float rs = cout * rsqrtf(cout * cout * var + EPS);
            bf16* yrow = Yp + (size_t)rowi * 1024 + 64 * eh + 4 * hic;
#pragma unroll
            for (int e2 = 0; e2 < 2; ++e2)
#pragma unroll
                for (int q4 = 0; q4 < 4; ++q4) {
                    const f32x16& A = e2 ? acc1 : acc0; const u32x2 g = gg[4 * e2 + q4];
                    u32x2 o; o.x = cvt_pk_bf16((A[4 * q4] - mean) * rs * bf_lo(g.x), (A[4 * q4 + 1] - mean) * rs * bf_hi(g.x));
                    o.y = cvt_pk_bf16((A[4 * q4 + 2] - mean) * rs * bf_lo(g.y), (A[4 * q4 + 3] - mean) * rs * bf_hi(g.y));
                    *(u32x2*)(yrow + 32 * e2 + 8 * q4) = o;
                }
        }
#pragma unroll
        for (int r = 0; r < 16; ++r) { Dacc0[r] *= cd; Dacc1[r] *= cd; }
        {
            ldsp sw0 = lds + O_ST + 16384 * eh + 256 * r32c + 8 * hic; const unsigned swr = ((r32c & 3) << 2) | ((r32c >> 2) & 3);
#pragma unroll
            for (int q4 = 0; q4 < 4; ++q4) {
                u32x2 o0, o1; o0.x = cvt_pk_bf16(Dacc0[4 * q4], Dacc0[4 * q4 + 1]); o0.y = cvt_pk_bf16(Dacc0[4 * q4 + 2], Dacc0[4 * q4 + 3]);
                o1.x = cvt_pk_bf16(Dacc1[4 * q4], Dacc1[4 * q4 + 1]); o1.y = cvt_pk_bf16(Dacc1[4 * q4 + 2], Dacc1[4 * q4 + 3]);
                const unsigned co = 16u * ((unsigned)(4 * it + q4) ^ swr);
                *(LAS u32x2*)(sw0 + co) = o0; *(LAS u32x2*)(sw0 + co + 8192) = o1;
            }
        }
    }
    asm volatile("s_waitcnt vmcnt(0)" ::: "memory");
#undef RET_DMA
#undef RET_BAR
}

__device__ __forceinline__ void lru_unit(const int tid, ldsp lds, int b, int nb, const bf16* proj, bf16* ya, const float* convw, const float* convb,
                                         const float* wa, const float* ba, const float* wx, const float* bx, const float* lam) {
    const int lane = tid & 63, w = __builtin_amdgcn_readfirstlane(tid >> 6), r32 = lane & 31, hi = lane >> 5;
    const int c0 = nb * 64;
    LAS bf16* XA = (LAS bf16*)lds; ldsp XC = lds + 17408; LAS float* XF = (LAS float*)(lds + 35840); LAS float* AF = (LAS float*)(lds + 68608);
    ldsp WT = lds + 101376; LAS float* SEG = (LAS float*)(lds + 119808); LAS float* PAR = (LAS float*)(lds + 123904);
    if (tid < 64) { const int c = c0 + tid;
        PAR[tid] = convw[c]; PAR[64 + tid] = convw[1024 + c]; PAR[128 + tid] = convw[2048 + c]; PAR[192 + tid] = convw[3072 + c];
        PAR[256 + tid] = convb[c]; PAR[320 + tid] = ba[c]; PAR[384 + tid] = bx[c];
        const float z = __expf(-lam[c]); PAR[448 + tid] = log1pf(z); }
    for (int idx = tid; idx < 4096; idx += 512) { const int d = idx >> 6, e = idx & 63;
        ((LAS bf16*)WT)[e * 72 + d] = (bf16)f2bf(wa[nb * 4096 + idx]); ((LAS bf16*)(WT + 9216))[e * 72 + d] = (bf16)f2bf(wx[nb * 4096 + idx]); }
    const int row00 = b * SEQ;
    bf16* yp = ya + (size_t)b * SEQ * 1024 + c0;
    const int e = tid & 63;
    float hcarry = 0.f;
    v4u xs0, xs1, xs2;
#define LRU_ISSUE(t0_) do { { const int r = tid >> 3, ch = tid & 7, t = (t0_) - 3 + r; { unsigned z0 = 0u; LAUNDER_V(z0); xs0 = (v4u){z0, z0, z0, z0}; } if (t >= 0) xs0 = *(const v4u*)(proj + pidx(row00 + t, C_XA + c0 + ch * 8)); } \
        { const int r = (tid + 512) >> 3, ch = tid & 7, t = (t0_) - 3 + r; xs1 = *(const v4u*)(proj + pidx(row00 + t, C_XA + c0 + ch * 8)); } \
        if (tid < 24) { const int r = (tid + 1024) >> 3, ch = tid & 7, t = (t0_) - 3 + r; xs2 = *(const v4u*)(proj + pidx(row00 + t, C_XA + c0 + ch * 8)); } } while (0)
    LRU_ISSUE(0);
    for (int n = 0; n < 32; ++n) {
        const int t0 = n * 128;
        __syncthreads();
        *(LAS v4u*)((ldsp)XA + tid * 16) = xs0; *(LAS v4u*)((ldsp)XA + (tid + 512) * 16) = xs1; if (tid < 24) *(LAS v4u*)((ldsp)XA + (tid + 1024) * 16) = xs2;
        __syncthreads();
        { const int c = tid & 63; const float w0 = PAR[c], w1 = PAR[64 + c], w2 = PAR[128 + c], w3 = PAR[192 + c], cb = PAR[256 + c];
#pragma unroll 4
          for (int k = 0; k < 16; ++k) { const int t = (tid >> 6) + 8 * k;
              const float x0 = __uint_as_float((unsigned)XA[t * 64 + c] << 16), x1 = __uint_as_float((unsigned)XA[(t + 1) * 64 + c] << 16),
                          x2 = __uint_as_float((unsigned)XA[(t + 2) * 64 + c] << 16), x3 = __uint_as_float((unsigned)XA[(t + 3) * 64 + c] << 16);
              const float xc = cb + w0 * x0 + w1 * x1 + w2 * x2 + w3 * x3;
              XF[t * 64 + c] = xc; ((LAS bf16*)XC)[t * 72 + c] = (bf16)f2bf(xc); } }
        __syncthreads();
        if (n + 1 < 32) LRU_ISSUE(t0 + 128);
        bf16 gt[16];
#pragma unroll
        for (int k = 0; k < 16; ++k) gt[k] = proj[pidx(row00 + t0 + 16 * w + k, C_GA + c0 + e)];
        { const int tt = w >> 1, et = w & 1;
          f32x16 gr = zero16(), gi = zero16();
#pragma unroll
          for (int s = 0; s < 4; ++s) {
              const bf16x8 a = *(const LAS bf16x8*)(XC + (32 * tt + r32) * 144 + (16 * s + 8 * hi) * 2);
              const bf16x8 br = *(const LAS bf16x8*)(WT + (32 * et + r32) * 144 + (16 * s + 8 * hi) * 2);
              const bf16x8 bi = *(const LAS bf16x8*)(WT + 9216 + (32 * et + r32) * 144 + (16 * s + 8 * hi) * 2);
              gr = mfma32(a, br, gr); gi = mfma32(a, bi, gi); }
          const int ee = 32 * et + r32; const float bar_ = PAR[320 + ee], bxr = PAR[384 + ee], sp = PAR[448 + ee];
#pragma unroll
          for (int r = 0; r < 16; ++r) { const int t = 32 * tt + (r & 3) + 8 * (r >> 2) + 4 * hi;
              const float xc = XF[t * 64 + ee];
              const float rg = fast_sigmoid(gr[r] + bar_), ig = fast_sigmoid(gi[r] + bxr);
              const float la = -8.0f * rg * sp, a = __expf(la), x2 = 2.0f * la;
              const float em_series = -x2 * (1.0f + x2 * (0.5f + x2 * (0.16666667f + x2 * (0.041666668f + x2 * (0.008333334f + x2 * 0.0013888889f)))));
              const float em = x2 < -0.25f ? 1.0f - a * a : em_series;
              AF[t * 64 + ee] = a; XF[t * 64 + ee] = sqrtf(em) * ig * xc; } }
        __syncthreads();
        { float A = 1.f, H = 0.f;
#pragma unroll
          for (int k = 0; k < 16; ++k) { const int t = 16 * w + k; const float a = AF[t * 64 + e], u = XF[t * 64 + e]; H = a * H + u; A *= a; }
          SEG[(w * 64 + e) * 2] = A; SEG[(w * 64 + e) * 2 + 1] = H; }
        __syncthreads();
        float hs = hcarry, hst = 0.f;
#pragma unroll
        for (int s = 0; s < 8; ++s) { const float A = SEG[(s * 64 + e) * 2], H = SEG[(s * 64 + e) * 2 + 1]; if (s == w) hst = hs; hs = A * hs + H; }
        hcarry = hs;
        float hh = hst;
#pragma unroll
        for (int k = 0; k < 16; ++k) { const int t = 16 * w + k; hh = AF[t * 64 + e] * hh + XF[t * 64 + e];
            yp[(size_t)(t0 + t) * 1024 + e] = (bf16)f2bf(hh * __uint_as_float((unsigned)gt[k] << 16)); }
    }
#undef LRU_ISSUE
}

typedef float f32x2 __attribute__((ext_vector_type(2)));
struct AttS { f32x16 O0, O1, O2, O3, p0, p1; bf16x8 pf0, pf1, pf2, pf3; bf16x8 k0, k1, k2, k3, k4, k5, k6, k7; float mref, l, alpha; int rp; };
#define ATT_THR 8.0f
constexpr int ATT_V0 = 0, ATT_K0 = 49152, ATT_SLOT = 16384;
#define ATT_PIN(X_) asm volatile("" : "+v"(X_))
#define ATT_SB() __builtin_amdgcn_sched_barrier(0)
__device__ __forceinline__ float attn_rowmax(const f32x16& a, const f32x16& b) {
    float d = fmaxf(a[0], b[0]);
#pragma unroll
    for (int r = 1; r < 16; ++r) d = fmaxf(d, fmaxf(a[r], b[r]));
    return half_max(d);
}
__device__ __forceinline__ int attn_rowmax_bits(const f32x16& a, const f32x16& b) {
    int d = max(__float_as_int(a[0]), __float_as_int(b[0]));
#pragma unroll
    for (int r = 1; r < 16; ++r) d = max(d, max(__float_as_int(a[r]), __float_as_int(b[r])));
    unsigned x = (unsigned)d, y = x; pg8::half_swap(x, y);
    return max((int)x, (int)y);
}
template <int B> __device__ __forceinline__ f32x2 attn_sum8(const f32x16& a, f32x2 s) {
#pragma unroll
    for (int r = B; r < B + 8; r += 2) s += (f32x2){a[r], a[r + 1]};
    return s;
}
#define ATT_EXP4(P_, B_) do { _Pragma("unroll") for (int r_ = 0; r_ < 4; ++r_) P_[(B_) + r_] = __builtin_amdgcn_exp2f(P_[(B_) + r_]); } while (0)
#define ATT_SUB4(P_, B_) do { _Pragma("unroll") for (int r_ = 0; r_ < 4; ++r_) P_[(B_) + r_] -= st.mref; } while (0)
#define ATT_VF(TV_, KS, ET) cat8(trr((TV_) + 4096 * (ET) + 1024 * (KS)), trr((TV_) + 4096 * (ET) + 1024 * (KS) + 512))
#define ATT_KF(RK_, O_) (*(const LAS bf16x8*)((RK_) + (O_)))
#define ATT_MASK(Q0_, Q1_, t_) do { const int kb_ = 64 * (t_); \
        if (kb_ + 63 > qw) { const int dq_ = qw + r32 - kb_ - 4 * hi; const float NEG_ = -__builtin_inff(); \
            _Pragma("unroll") for (int r_ = 0; r_ < 16; ++r_) { const int cr_ = (r_ & 3) + 8 * (r_ >> 2); if (cr_ > dq_) Q0_[r_] = NEG_; if (cr_ + 32 > dq_) Q1_[r_] = NEG_; } } } while (0)
#define ATT_OSCALE() do { if (st.rp) { _Pragma("unroll") for (int r_ = 0; r_ < 16; ++r_) { st.O0[r_] *= st.alpha; st.O1[r_] *= st.alpha; st.O2[r_] *= st.alpha; st.O3[r_] *= st.alpha; } } } while (0)
#define ATT_EXP1(Q0_, Q1_, I_) do { if ((I_) < 16) Q0_[(I_) & 15] = __builtin_amdgcn_exp2f(Q0_[(I_) & 15]); else Q1_[(I_) & 15] = __builtin_amdgcn_exp2f(Q1_[(I_) & 15]); } while (0)
#define ATT_EXP3(Q0_, Q1_, I_) do { ATT_EXP1(Q0_, Q1_, (I_)); ATT_EXP1(Q0_, Q1_, (I_) + 1); ATT_EXP1(Q0_, Q1_, (I_) + 2); } while (0)
__device__ __forceinline__ f32x16 attn_splat(const float v) { f32x16 z;
#pragma unroll
    for (int i = 0; i < 16; ++i) z[i] = v; return z; }
__device__ __forceinline__ void attn_step(AttS& st, const int t, const int qw, const int r32, const int hi, const bf16x8 (&qf)[4], ldsp tv, ldsp rn0, ldsp rn1, ldsp rn2, ldsp rn3) {
    ATT_OSCALE();
    const f32x16 negm = attn_splat(-st.mref);
    f32x16 q0 = mfma32(st.k0, qf[0], negm); bf16x8 va0 = ATT_VF(tv, 0, 0);
    f32x16 q1 = mfma32(st.k1, qf[0], negm); bf16x8 va1 = ATT_VF(tv, 0, 1);
    ATT_SB();
    q0 = mfma32(st.k2, qf[1], q0); bf16x8 va2 = ATT_VF(tv, 0, 2);
    q1 = mfma32(st.k3, qf[1], q1); bf16x8 va3 = ATT_VF(tv, 0, 3);
    ATT_SB();
    q0 = mfma32(st.k4, qf[2], q0); bf16x8 vb0 = ATT_VF(tv, 1, 0);
    q1 = mfma32(st.k5, qf[2], q1); bf16x8 vb1 = ATT_VF(tv, 1, 1);
    st.pf2 = pack8<0>(st.p1); ATT_PIN(st.pf2);
    ATT_SB();
    q0 = mfma32(st.k6, qf[3], q0); bf16x8 vb2 = ATT_VF(tv, 1, 2);
    q1 = mfma32(st.k7, qf[3], q1); bf16x8 vb3 = ATT_VF(tv, 1, 3);
    st.pf3 = pack8<8>(st.p1); ATT_PIN(st.pf3);
    ATT_SB();
    ATT_MASK(q0, q1, t);
    st.O0 = mfma32(va0, st.pf0, st.O0); va0 = ATT_VF(tv, 2, 0); ATT_EXP3(q0, q1, 0);
    ATT_SB();
    st.O1 = mfma32(va1, st.pf0, st.O1); va1 = ATT_VF(tv, 2, 1); ATT_EXP3(q0, q1, 3);
    ATT_SB();
    st.O2 = mfma32(va2, st.pf0, st.O2); va2 = ATT_VF(tv, 2, 2); ATT_EXP3(q0, q1, 6);
    ATT_SB();
    st.O3 = mfma32(va3, st.pf0, st.O3); va3 = ATT_VF(tv, 2, 3); ATT_EXP3(q0, q1, 9);
    ATT_SB();
    st.O0 = mfma32(vb0, st.pf1, st.O0); vb0 = ATT_VF(tv, 3, 0); ATT_EXP3(q0, q1, 12);
    ATT_SB();
    st.O1 = mfma32(vb1, st.pf1, st.O1); vb1 = ATT_VF(tv, 3, 1); ATT_EXP3(q0, q1, 15);
    ATT_PIN(q0);
    ATT_SB();
    st.O2 = mfma32(vb2, st.pf1, st.O2); vb2 = ATT_VF(tv, 3, 2); ATT_EXP3(q0, q1, 18);
    ATT_SB();
    st.O3 = mfma32(vb3, st.pf1, st.O3); vb3 = ATT_VF(tv, 3, 3); ATT_EXP3(q0, q1, 21);
    ATT_SB();
    st.O0 = mfma32(va0, st.pf2, st.O0); ATT_EXP3(q0, q1, 24); ATT_EXP1(q0, q1, 27);
    ATT_SB();
    st.O1 = mfma32(va1, st.pf2, st.O1); ATT_EXP3(q0, q1, 28); ATT_EXP1(q0, q1, 31);
    ATT_PIN(q1);
    ATT_SB();
    st.O2 = mfma32(va2, st.pf2, st.O2);
    f32x2 ps = attn_sum8<0>(q0, (f32x2){0.f, 0.f}); ps = attn_sum8<8>(q0, ps); ATT_PIN(ps);
    ATT_SB();
    st.O3 = mfma32(va3, st.pf2, st.O3);
    ps = attn_sum8<0>(q1, ps); ps = attn_sum8<8>(q1, ps);
    float psum = ps.x + ps.y; ATT_PIN(psum);
    ATT_SB();
    const bool resc = __any(psum > 256.0f);
    st.rp = resc; st.alpha = 1.f;
    if (resc) {
        const f32x16 nm2 = attn_splat(-st.mref);
        q0 = mfma32(st.k0, qf[0], nm2); q1 = mfma32(st.k1, qf[0], nm2);
        q0 = mfma32(st.k2, qf[1], q0); q1 = mfma32(st.k3, qf[1], q1);
        q0 = mfma32(st.k4, qf[2], q0); q1 = mfma32(st.k5, qf[2], q1);
        q0 = mfma32(st.k6, qf[3], q0); q1 = mfma32(st.k7, qf[3], q1);
        ATT_MASK(q0, q1, t);
        const float d = attn_rowmax(q0, q1);
        const float dl = fmaxf(d, 0.f); st.mref += dl; st.alpha = __builtin_amdgcn_exp2f(-dl); st.l *= st.alpha;
#pragma unroll
        for (int r = 0; r < 16; ++r) { q0[r] = __builtin_amdgcn_exp2f(q0[r] - dl); q1[r] = __builtin_amdgcn_exp2f(q1[r] - dl); }
        f32x2 p2 = attn_sum8<0>(q0, (f32x2){0.f, 0.f}); p2 = attn_sum8<8>(q0, p2); p2 = attn_sum8<0>(q1, p2); p2 = attn_sum8<8>(q1, p2); psum = p2.x + p2.y;
    }
    st.l += psum;
    st.O0 = mfma32(vb0, st.pf3, st.O0); st.k0 = ATT_KF(rn0, 0); st.k1 = ATT_KF(rn0, 8192);
    ATT_PIN(st.l);
    ATT_SB();
    st.O1 = mfma32(vb1, st.pf3, st.O1); st.k2 = ATT_KF(rn1, 0); st.k3 = ATT_KF(rn1, 8192);
    ATT_SB();
    st.O2 = mfma32(vb2, st.pf3, st.O2); st.k4 = ATT_KF(rn2, 0); st.k5 = ATT_KF(rn2, 8192);
    st.pf0 = pack8<0>(q0); ATT_PIN(st.pf0);
    ATT_SB();
    st.O3 = mfma32(vb3, st.pf3, st.O3); st.k6 = ATT_KF(rn3, 0); st.k7 = ATT_KF(rn3, 8192);
    st.pf1 = pack8<8>(q0); ATT_PIN(st.pf1);
    ATT_SB();
    st.p1 = q1;
}
__device__ __forceinline__ void attn_unit(const int tid, ldsp lds, int b, int h, int qb, const bf16* proj, bf16* yc, const float* lamp, const float* subg) {
    const int lane = tid & 63, w = __builtin_amdgcn_readfirstlane(tid >> 6), r32 = lane & 31, hi = lane >> 5;
    const int c = w >> 2, it = w & 3;
    const int qw = qb * 128 + 32 * it, NT = 2 * qb + 2;
    const int row00 = b * SEQ, hcol = h * 128;
    bf16x8 qf[4];
#pragma unroll
    for (int s = 0; s < 4; ++s) qf[s] = *(const bf16x8*)(proj + pidx(row00 + qw + r32, C_QD + hcol + 64 * c + 16 * s + 8 * hi));
    ldsp rk0 = lds + ATT_K0 + offb(r32, 8 * c + 0 + hi), rk1 = lds + ATT_K0 + offb(r32, 8 * c + 2 + hi), rk2 = lds + ATT_K0 + offb(r32, 8 * c + 4 + hi), rk3 = lds + ATT_K0 + offb(r32, 8 * c + 6 + hi);
    ldsp tvb = lds + ATT_V0 + (4 * hi + ((lane & 15) >> 2)) * 64 + 32 * ((lane >> 4) & 1) + 8 * (lane & 3);
    const int kr0 = 8 * w + (lane >> 4), kc0 = (lane & 15) ^ (((kr0 & 3) << 2) | ((kr0 >> 2) & 3)), kr1 = kr0 + 4, kc1 = (lane & 15) ^ (((kr1 & 3) << 2) | ((kr1 >> 2) & 3));
    const unsigned oK0 = 2u * (unsigned)pidx(kr0, C_KD + hcol + 8 * kc0), oK1 = 2u * (unsigned)pidx(kr1, C_KD + hcol + 8 * kc1);
    const unsigned oV0 = 2u * (unsigned)pidx(32 * (w & 1) + (lane >> 2), C_VD + hcol + 32 * (w >> 1) + 8 * (lane & 3));
    const unsigned char* gb = (const unsigned char*)(proj + (size_t)(row00 >> 4) * PBROW);
    const int dK = 2048 * w, dV = 4096 * (w >> 1) + 2048 * (w & 1);
    const unsigned ldsb = (unsigned)__builtin_amdgcn_readfirstlane((int)(unsigned)(unsigned long long)lds);
#define ATT_GLDS(g_, d_) do { unsigned keep_; asm volatile("s_mov_b32 %0, m0\n\ts_mov_b32 m0, %2\n\ts_nop 0\n\tglobal_load_lds_dwordx4 %1, off\n\ts_mov_b32 m0, %0" : "=&s"(keep_) : "v"(g_), "s"(d_) : "memory"); } while (0)
#define ATT_DMA_K(tk_, so_) do { const unsigned char* p_ = gb + (size_t)(4 * (tk_)) * (2 * PBROW); const unsigned d_ = ldsb + ATT_K0 + (so_) + dK; \
        ATT_GLDS(p_ + oK0, d_); ATT_GLDS(p_ + oK1, d_ + 1024u); } while (0)
#define ATT_DMA_V(tv_, so_) do { const unsigned char* p_ = gb + (size_t)(4 * (tv_)) * (2 * PBROW); const unsigned d_ = ldsb + ATT_V0 + (so_) + dV; \
        ATT_GLDS(p_ + oV0, d_); ATT_GLDS(p_ + oV0 + 2 * PBROW, d_ + 1024u); } while (0)
#define ATT_WAITBAR() do { asm volatile("s_waitcnt vmcnt(4) lgkmcnt(0)" ::: "memory"); __builtin_amdgcn_s_barrier(); asm volatile("" ::: "memory"); } while (0)
    const int TL = NT - 1;
    ATT_DMA_K(0, 0);
    ATT_DMA_K(1, ATT_SLOT);
    { const int t2 = 2 < TL ? 2 : TL; ATT_DMA_K(t2, 2 * ATT_SLOT); }
    ATT_DMA_V(0, 0);
    AttS st; st.O0 = zero16(); st.O1 = zero16(); st.O2 = zero16(); st.O3 = zero16();
    st.mref = 0.f; st.l = 0.f; st.alpha = 1.f; st.rp = 0;
    asm volatile("s_waitcnt vmcnt(6)" ::: "memory"); __builtin_amdgcn_s_barrier(); asm volatile("" ::: "memory");
    st.k0 = ATT_KF(rk0, 0); st.k1 = ATT_KF(rk0, 8192); st.k2 = ATT_KF(rk1, 0); st.k3 = ATT_KF(rk1, 8192);
    st.k4 = ATT_KF(rk2, 0); st.k5 = ATT_KF(rk2, 8192); st.k6 = ATT_KF(rk3, 0); st.k7 = ATT_KF(rk3, 8192);
    ATT_WAITBAR();
    { const int t3 = 3 < TL ? 3 : TL, t1 = 1 < TL ? 1 : TL; ATT_DMA_K(t3, 0); ATT_DMA_V(t1, ATT_SLOT); }
    st.p0 = mfma32(st.k0, qf[0], zero16()); st.p1 = mfma32(st.k1, qf[0], zero16());
    st.p0 = mfma32(st.k2, qf[1], st.p0); st.p1 = mfma32(st.k3, qf[1], st.p1);
    st.p0 = mfma32(st.k4, qf[2], st.p0); st.p1 = mfma32(st.k5, qf[2], st.p1);
    st.p0 = mfma32(st.k6, qf[3], st.p0); st.p1 = mfma32(st.k7, qf[3], st.p1);
    ATT_SB();
    st.k0 = ATT_KF(rk0, ATT_SLOT); st.k1 = ATT_KF(rk0, ATT_SLOT + 8192); st.k2 = ATT_KF(rk1, ATT_SLOT); st.k3 = ATT_KF(rk1, ATT_SLOT + 8192);
    st.k4 = ATT_KF(rk2, ATT_SLOT); st.k5 = ATT_KF(rk2, ATT_SLOT + 8192); st.k6 = ATT_KF(rk3, ATT_SLOT); st.k7 = ATT_KF(rk3, ATT_SLOT + 8192);
    ATT_MASK(st.p0, st.p1, 0);
    st.mref = attn_rowmax(st.p0, st.p1);
#pragma unroll
    for (int r = 0; r < 16; ++r) { st.p0[r] = __builtin_amdgcn_exp2f(st.p0[r] - st.mref); st.p1[r] = __builtin_amdgcn_exp2f(st.p1[r] - st.mref); }
    { f32x2 ps = attn_sum8<0>(st.p0, (f32x2){0.f, 0.f}); ps = attn_sum8<8>(st.p0, ps); ps = attn_sum8<0>(st.p1, ps); ps = attn_sum8<8>(st.p1, ps); st.l += ps.x + ps.y; }
    st.pf0 = pack8<0>(st.p0); st.pf1 = pack8<8>(st.p0);
    ATT_PIN(st.pf0); ATT_PIN(st.pf1); ATT_PIN(st.p1);
    int sa = ATT_SLOT, sb = 2 * ATT_SLOT, sc = 0;
    for (int t = 1; t <= TL; ++t) {
        ATT_WAITBAR();
        { const int tk = t + 3 < TL ? t + 3 : TL, tv = t + 1 < TL ? t + 1 : TL; ATT_DMA_K(tk, sa); ATT_DMA_V(tv, sb); }
        attn_step(st, t, qw, r32, hi, qf, tvb + sc, rk0 + sb, rk1 + sb, rk2 + sb, rk3 + sb);
        const int s0 = sa; sa = sb; sb = sc; sc = s0;
    }
    ATT_WAITBAR();
    ATT_OSCALE();
    st.pf2 = pack8<0>(st.p1); st.pf3 = pack8<8>(st.p1);
    { ldsp tv = tvb + sc;
      { const bf16x8 v0 = ATT_VF(tv, 0, 0), v1 = ATT_VF(tv, 0, 1), v2 = ATT_VF(tv, 0, 2), v3 = ATT_VF(tv, 0, 3);
        st.O0 = mfma32(v0, st.pf0, st.O0); st.O1 = mfma32(v1, st.pf0, st.O1); st.O2 = mfma32(v2, st.pf0, st.O2); st.O3 = mfma32(v3, st.pf0, st.O3); }
      { const bf16x8 v0 = ATT_VF(tv, 1, 0), v1 = ATT_VF(tv, 1, 1), v2 = ATT_VF(tv, 1, 2), v3 = ATT_VF(tv, 1, 3);
        st.O0 = mfma32(v0, st.pf1, st.O0); st.O1 = mfma32(v1, st.pf1, st.O1); st.O2 = mfma32(v2, st.pf1, st.O2); st.O3 = mfma32(v3, st.pf1, st.O3); }
      { const bf16x8 v0 = ATT_VF(tv, 2, 0), v1 = ATT_VF(tv, 2, 1), v2 = ATT_VF(tv, 2, 2), v3 = ATT_VF(tv, 2, 3);
        st.O0 = mfma32(v0, st.pf2, st.O0); st.O1 = mfma32(v1, st.pf2, st.O1); st.O2 = mfma32(v2, st.pf2, st.O2); st.O3 = mfma32(v3, st.pf2, st.O3); }
      { const bf16x8 v0 = ATT_VF(tv, 3, 0), v1 = ATT_VF(tv, 3, 1), v2 = ATT_VF(tv, 3, 2), v3 = ATT_VF(tv, 3, 3);
        st.O0 = mfma32(v0, st.pf3, st.O0); st.O1 = mfma32(v1, st.pf3, st.O1); st.O2 = mfma32(v2, st.pf3, st.O2); st.O3 = mfma32(v3, st.pf3, st.O3); } }
#undef ATT_GLDS
#undef ATT_DMA_K
#undef ATT_DMA_V
#undef ATT_WAITBAR
    const float l = half_sum(st.l);
    const float inv = 1.0f / l;
    int tid_e = tid; LAUNDER_V(tid_e);
    const int lane_e = tid_e & 63, r32e = lane_e & 31, hie = lane_e >> 5;
    u32x2 gpre[16]; f32x4 spre[16];
    if (c == 0) { const bf16* grow = proj + pidx(row00 + qw + r32e, C_GD + hcol + 4 * hie); const float* sgp = subg + 4 * hie;
#pragma unroll
        for (int et = 0; et < 4; ++et)
#pragma unroll
            for (int q4 = 0; q4 < 4; ++q4) { gpre[4 * et + q4] = *(const u32x2*)(grow + 512 * et + 8 * q4); spre[4 * et + q4] = *(const f32x4*)(sgp + 32 * et + 8 * q4); }
        asm volatile("s_waitcnt vmcnt(32) lgkmcnt(0)" ::: "memory"); }
    else asm volatile("s_waitcnt vmcnt(0) lgkmcnt(0)" ::: "memory");
    __builtin_amdgcn_s_barrier(); asm volatile("" ::: "memory");
#define ATT_BAR() do { asm volatile("s_waitcnt lgkmcnt(0)" ::: "memory"); __builtin_amdgcn_s_barrier(); asm volatile("" ::: "memory"); } while (0)
    LAS float* XB = (LAS float*)lds + it * 4096 + lane_e;
    const float lam = lamp[0], oml = lamp[1];
    if (c == 1) { const float f = lam * inv;
#pragma unroll
        for (int r = 0; r < 16; ++r) { XB[(0 * 16 + r) * 64] = st.O0[r] * f; XB[(1 * 16 + r) * 64] = st.O1[r] * f; XB[(2 * 16 + r) * 64] = st.O2[r] * f; XB[(3 * 16 + r) * 64] = st.O3[r] * f; } }
    ATT_BAR();
    if (c == 0) {
        float ss = 0.f;
#pragma unroll
        for (int r = 0; r < 16; ++r) {
            st.O0[r] = st.O0[r] * inv - XB[(0 * 16 + r) * 64]; st.O1[r] = st.O1[r] * inv - XB[(1 * 16 + r) * 64];
            st.O2[r] = st.O2[r] * inv - XB[(2 * 16 + r) * 64]; st.O3[r] = st.O3[r] * inv - XB[(3 * 16 + r) * 64];
            ss += st.O0[r] * st.O0[r] + st.O1[r] * st.O1[r] + st.O2[r] * st.O2[r] + st.O3[r] * st.O3[r]; }
        ss = half_sum(ss);
        const float rs = rsqrtf(ss * (1.f / 128.f) + EPS) * oml;
        const size_t rowl = (size_t)(qw + r32e);
        bf16* yrow = yc + ((size_t)b * SEQ + rowl) * 1024 + h * 128 + 4 * hie;
#pragma unroll
        for (int et = 0; et < 4; ++et)
#pragma unroll
            for (int q4 = 0; q4 < 4; ++q4) {
                const f32x16& A = et == 0 ? st.O0 : et == 1 ? st.O1 : et == 2 ? st.O2 : st.O3;
                const int e0 = 32 * et + 8 * q4;
                const f32x4 sg4 = spre[4 * et + q4]; const u32x2 g = gpre[4 * et + q4];
                u32x2 o; o.x = cvt_pk_bf16(A[4 * q4] * rs * sg4.x * bf_lo(g.x), A[4 * q4 + 1] * rs * sg4.y * bf_hi(g.x));
                o.y = cvt_pk_bf16(A[4 * q4 + 2] * rs * sg4.z * bf_lo(g.y), A[4 * q4 + 3] * rs * sg4.w * bf_hi(g.y));
                *(u32x2*)(yrow + e0) = o;
            }
    }
#undef ATT_BAR
#undef ATT_PIN
#undef ATT_SB
#undef ATT_EXP4
#undef ATT_SUB4
#undef ATT_EXP1
#undef ATT_EXP3
#undef ATT_VF
#undef ATT_KF
#undef ATT_MASK
#undef ATT_OSCALE
}

__device__ __forceinline__ int fetch_item(const int tid, gu32* ctr, volatile LAS unsigned* slot) {
    __syncthreads();
    if (tid == 0) *slot = __hip_atomic_fetch_add(ctr, 1u, RLX_AGENT);
    __syncthreads();
    return __builtin_amdgcn_readfirstlane((int)*slot);
}

#ifndef G1_ALIGN
#define G1_ALIGN true
#endif
#ifndef G1_SP2
#define G1_SP2 true
#endif
#ifndef G3_ALIGN
#define G3_ALIGN true
#endif
#ifndef G3_SP2
#define G3_SP2 true
#endif
#ifndef G4_ALIGN
#define G4_ALIGN true
#endif
#ifndef G4_SP2
#define G4_SP2 true
#endif
#ifndef PROBE_DUP
#define PROBE_DUP 0
#endif
#ifndef PROBE_EMODE
#define PROBE_EMODE 0
#endif
#ifndef PROBE_AMODE
#define PROBE_AMODE 0
#endif
#ifndef PROBE_P2SEL
#define PROBE_P2SEL 0
#endif
#ifndef MK_N_LAUNCHES
#define MK_N_LAUNCHES 1
#endif
constexpr int N_PHASES = 1 + NGROUP * DEPTH * 5;
struct Args { const float* in[17]; float* out; unsigned char* ws; int ph_lo, ph_hi, li, pad; };
constexpr int P0_I_IN = (2048 / 64) * (16384 / 32), P0_I_BR = (1024 / 64) * (2048 / 32), P0_I_OUT = (2048 / 64) * (2048 / 32);
constexpr int P0_NITEMS = 2 * P0_I_IN + 6 * P0_I_BR + 2 * P0_I_OUT;
__device__ __forceinline__ P0Item p0_decode(const Args& args, unsigned char* ws, int it) {
    bf16* WIN = (bf16*)(ws + WS_WIN); bf16* WBR = (bf16*)(ws + WS_WBR); bf16* WOUT = (bf16*)(ws + WS_WOUT);
    int r = it; P0Item I;
    if (r < 2 * P0_I_IN) { const int l = r / P0_I_IN; r -= l * P0_I_IN; I.W = args.in[3] + (size_t)l * 2048 * 16384; I.WT = WIN + (size_t)l * 16384 * 2048; I.K = 2048; I.N = 16384; I.item = r; return I; }
    r -= 2 * P0_I_IN;
    if (r < 6 * P0_I_BR) { const int lj = r / P0_I_BR; r -= lj * P0_I_BR; const int l = lj / 3, j = lj - 3 * l;
        const float* src = j == 0 ? args.in[13] : j == 1 ? args.in[14] : args.in[15];
        I.W = src + (size_t)l * 1024 * 2048; I.WT = WBR + (size_t)lj * 2048 * 1024; I.K = 1024; I.N = 2048; I.item = r; return I; }
    r -= 6 * P0_I_BR;
    { const int l = r / P0_I_OUT; r -= l * P0_I_OUT; I.W = args.in[16] + (size_t)l * 2048 * 2048; I.WT = WOUT + (size_t)l * 2048 * 2048; I.K = 2048; I.N = 2048; I.item = r; return I; }
}
constexpr int DEF_TR = P0_NITEMS - P0_I_IN, DEF_ROWS = M_ALL - TG, DEF_UNITS = DEF_TR + DEF_ROWS, DEF_WGITEMS = DEF_UNITS / 64;
static_assert(DEF_TR % 64 == 0 && DEF_ROWS % 64 == 0, "deferred set-up units come in workgroup items of 64");
__global__ void __launch_bounds__(NWAVES * 64, 2) hyb_fwd(Args args) {
    extern __shared__ __attribute__((aligned(16))) unsigned char lds_raw[];
    ldsp lds = (ldsp)lds_raw;
    volatile LAS unsigned* MISC = (volatile LAS unsigned*)(lds + MISC_OFF);
    for (int u = threadIdx.x; u < (LDS_BYTES - LDSCTL_OFF) / 4; u += NWAVES * 64) ((LAS unsigned*)(lds + LDSCTL_OFF))[u] = 0u;
    __syncthreads();
    XcdBarrier bar = xcd_barrier_post((unsigned*)((gu32*)(args.ws + WS_CTL) + CW_BAR) + args.li * XCD_BAR_WORDS, MISC + 8, (unsigned)__builtin_amdgcn_readfirstlane((int)threadIdx.x >> 6));
    int tidc = threadIdx.x;
    const int lo = args.ph_lo, hi_ = args.ph_hi;
#define IN(k) (lo <= (k) && (k) < hi_)
#define BOTH(k) (IN(k) && IN((k) + 1))
#define PHASE_ENTRY() LAUNDER_V(tidc); const int tid = tidc; unsigned long long z_ = 0ull; LAUNDER_S(z_); unsigned char* ws = args.ws + z_; const int G = gridDim.x; \
    const int lane = tid & 63, wave = __builtin_amdgcn_readfirstlane(tid >> 6); (void)lane; (void)wave; (void)G

    if (IN(0)) {
        PHASE_ENTRY();
        const int gw = blockIdx.x * NWAVES + wave, NGW = G * NWAVES;
        float* lams = (float*)(ws + WS_LAMS);
        bf16* HB = (bf16*)(ws + WS_H);
        LAS float* scr = (LAS float*)(lds + wave * 16384);
        for (int it = gw; it < P0_I_IN; it += 2 * NGW) {
            const P0Item A = p0_decode(args, ws, it); f32x4 va[8], vb[8]; p0_tr_load(A, lane, va);
            const bool hasB = it + NGW < P0_I_IN; P0Item B = A;
            if (hasB) { B = p0_decode(args, ws, it + NGW); p0_tr_load(B, lane, vb); }
            p0_tr_finish(A, lane, scr, va);
            if (hasB) p0_tr_finish(B, lane, scr, vb);
        }
        if (blockIdx.x == 0 && wave == 0) {
            for (int l = 0; l < DEPTH; ++l) { const float* dl = args.in[11] + l * 256;
                const float s01 = wave_sum(dl[lane] * dl[64 + lane]), s23 = wave_sum(dl[128 + lane] * dl[192 + lane]);
                const float lam_init = 0.8f - 0.6f * __expf(-0.3f * (float)l);
                if (lane == 0) { lams[2 * l] = __expf(s01) - __expf(s23) + lam_init; lams[2 * l + 1] = 1.0f - lam_init; } }
        }
        { f32x4 gv[8];
#pragma unroll
          for (int j = 0; j < 4; ++j) { gv[2 * j] = *(const f32x4*)(args.in[1] + 512 * j + 8 * lane); gv[2 * j + 1] = *(const f32x4*)(args.in[1] + 512 * j + 8 * lane + 4); }
          for (int m = gw; m < TG; m += 2 * NGW) {
              f32x4 va[8], vb[8]; const bool hasB = m + NGW < TG; rms_row_load(args.in[0] + (size_t)m * D_MODEL, lane, va); if (hasB) rms_row_load(args.in[0] + (size_t)(m + NGW) * D_MODEL, lane, vb);
              rms_row_finish(va, gv, HB + (size_t)m * D_MODEL, lane); if (hasB) rms_row_finish(vb, gv, HB + (size_t)(m + NGW) * D_MODEL, lane); } }
        if (BOTH(0)) xcd_barrier(bar);
    }

    for (int g = 0; g < NGROUP; ++g)
        for (int l = 0; l < DEPTH; ++l) {
            const int pb = 1 + (g * DEPTH + l) * 5;
            if (IN(pb)) {
                PHASE_ENTRY();
                pg8::SchedPlain S; S.so.init(TG, D_IN, G, (int)blockIdx.x); S.A = (const char*)(ws + WS_H) + (size_t)g * TG * D_MODEL * 2; S.Bt = (const char*)(ws + WS_WIN) + (size_t)l * D_IN * D_MODEL * 2;
                pg8::EpiProj E{(bf16*)(ws + WS_PROJ), (bf16*)(ws + WS_GM), (PROBE_DUP == 1 && args.li > 0 && pb == lo) ? PROBE_EMODE : 0};
#ifndef SKIP_P1
                pg8::gemm_phase<pg8::EpiProj, pg8::SchedPlain, G1_ALIGN, G1_SP2>(lds, D_MODEL, S, E, tid);
#endif
                if (BOTH(pb)) xcd_barrier(bar);
            }
            if (IN(pb + 1)) {
                const bool only = PROBE_DUP == 2 && PROBE_P2SEL != 0 && args.li > 0 && (pb + 1) == lo;
#ifndef SKIP_RET
                if (!only || PROBE_P2SEL == 1) { PHASE_ENTRY(); gu32* q = (gu32*)(ws + WS_CTL) + CW_Q + 64 * 3 * (g * DEPTH + l) + args.li * 1024;
                  const bf16* PROJ = (const bf16*)(ws + WS_PROJ); bf16* YB = (bf16*)(ws + WS_Y);
                  for (;;) { LAUNDER_V(tidc); const int t2 = tidc; const int it = fetch_item(t2, q, MISC + 16); if (it >= BG * 8) break; ret_unit(t2, lds, it >> 3, it & 7, PROJ, YB + (size_t)TG * 1024); } }
#endif
#ifndef SKIP_LRU
                if (!only || PROBE_P2SEL == 2) { PHASE_ENTRY(); gu32* q = (gu32*)(ws + WS_CTL) + CW_Q + 64 * 3 * (g * DEPTH + l) + args.li * 1024;
                  const bf16* PROJ = (const bf16*)(ws + WS_PROJ); bf16* YB = (bf16*)(ws + WS_Y);
                  for (;;) { LAUNDER_V(tidc); const int t2 = tidc; const int it = fetch_item(t2, q + 64, MISC + 16); if (it >= BG * 16) break;
                    lru_unit(t2, lds, it >> 4, it & 15, PROJ, YB, args.in[4] + l * 4096, args.in[5] + l * 1024, args.in[6] + (size_t)l * 65536, args.in[7] + l * 1024,
                             args.in[8] + (size_t)l * 65536, args.in[9] + l * 1024, args.in[10] + l * 1024); } }
#endif
#ifndef SKIP_ATT
                if (!only || PROBE_P2SEL == 3) { PHASE_ENTRY(); gu32* q = (gu32*)(ws + WS_CTL) + CW_Q + 64 * 3 * (g * DEPTH + l) + args.li * 1024;
                  const bf16* PROJ = (const bf16*)(ws + WS_PROJ); bf16* YB = (bf16*)(ws + WS_Y); const float* lams = (const float*)(ws + WS_LAMS);
                  int it; { LAUNDER_V(tidc); const int t2 = tidc; it = fetch_item(t2, q + 128, MISC + 16); }
                  while (it < BG * 8 * 32) { LAUNDER_V(tidc); const int t2 = tidc; const int qb = 31 - (it >> 5), bh = it & 31;
                    unsigned pend = 0u; if (t2 == 0) pend = __hip_atomic_fetch_add(q + 128, 1u, RLX_AGENT);
                    attn_unit(t2, lds, bh >> 3, bh & 7, qb, PROJ, YB + (size_t)2 * TG * 1024, lams + 2 * l, args.in[12] + l * 128);
                    LAUNDER_V(tidc); const int t3 = tidc; volatile LAS unsigned* slot = MISC + 16;
                    __syncthreads(); if (t3 == 0) *slot = pend; __syncthreads(); it = __builtin_amdgcn_readfirstlane((int)*slot); } }
#endif
                if (g == 0 && l == 0) { PHASE_ENTRY();
                  gu32* qd = (gu32*)(ws + WS_CTL) + CW_Q + 60000 + args.li * 64;
                  bf16* HB = (bf16*)(ws + WS_H); LAS float* scr = (LAS float*)(lds + wave * 16384);
                  f32x4 gv[8];
#pragma unroll
                  for (int j = 0; j < 4; ++j) { gv[2 * j] = *(const f32x4*)(args.in[1] + 512 * j + 8 * lane); gv[2 * j + 1] = *(const f32x4*)(args.in[1] + 512 * j + 8 * lane + 4); }
                  for (;;) { LAUNDER_V(tidc); const int t2 = tidc; const int it = fetch_item(t2, qd, MISC + 16); if (it >= DEF_WGITEMS) break;
                    const int u0 = it * 64 + 8 * wave;
                    if (u0 < DEF_TR) {
                      for (int k = 0; k < 8; k += 4) { f32x4 va[8], vb[8], vc[8], vd[8];
                        const P0Item A = p0_decode(args, ws, P0_I_IN + u0 + k), B = p0_decode(args, ws, P0_I_IN + u0 + k + 1), C = p0_decode(args, ws, P0_I_IN + u0 + k + 2), D = p0_decode(args, ws, P0_I_IN + u0 + k + 3);
                        p0_tr_load(A, lane, va); p0_tr_load(B, lane, vb); p0_tr_load(C, lane, vc); p0_tr_load(D, lane, vd);
                        p0_tr_finish(A, lane, scr, va); p0_tr_finish(B, lane, scr, vb); p0_tr_finish(C, lane, scr, vc); p0_tr_finish(D, lane, scr, vd); }
                    } else {
                      for (int k = 0; k < 8; k += 4) { const size_t m = (size_t)TG + (u0 - DEF_TR) + k; f32x4 va[8], vb[8], vc[8], vd[8];
                        rms_row_load(args.in[0] + m * D_MODEL, lane, va); rms_row_load(args.in[0] + (m + 1) * D_MODEL, lane, vb); rms_row_load(args.in[0] + (m + 2) * D_MODEL, lane, vc); rms_row_load(args.in[0] + (m + 3) * D_MODEL, lane, vd);
                        rms_row_finish(va, gv, HB + m * D_MODEL, lane); rms_row_finish(vb, gv, HB + (m + 1) * D_MODEL, lane); rms_row_finish(vc, gv, HB + (m + 2) * D_MODEL, lane); rms_row_finish(vd, gv, HB + (m + 3) * D_MODEL, lane); }
                    } } }
                if (BOTH(pb + 1)) xcd_barrier(bar);
            }
            if (IN(pb + 2)) {
                PHASE_ENTRY();
                pg8::SchedBranch S; S.so.init(TG, D_MODEL, G, (int)blockIdx.x); S.A = (const char*)(ws + WS_Y); S.strideA = (size_t)TG * 1024 * 2;
                S.Bt = (const char*)(ws + WS_WBR) + (size_t)l * 3 * 2048 * 1024 * 2; S.strideB = (size_t)2048 * 1024 * 2;
                pg8::EpiMerge E{(const unsigned char*)(ws + WS_GM), (bf16*)(ws + WS_M)};
#ifndef SKIP_P3
                pg8::gemm_phase<pg8::EpiMerge, pg8::SchedBranch, G3_ALIGN, G3_SP2>(lds, 1024, S, E, tid);
#endif
                if (BOTH(pb + 2)) xcd_barrier(bar);
            }
            if (IN(pb + 3)) {
                PHASE_ENTRY();
                pg8::SchedPlain S; S.so.init(TG, D_MODEL, G, (int)blockIdx.x); S.A = (const char*)(ws + WS_M); S.Bt = (const char*)(ws + WS_WOUT) + (size_t)l * D_MODEL * D_MODEL * 2;
                pg8::EpiBf16Plain E{(bf16*)(ws + WS_O), D_MODEL};
#ifndef SKIP_P4
                pg8::gemm_phase<pg8::EpiBf16Plain, pg8::SchedPlain, G4_ALIGN, G4_SP2>(lds, D_MODEL, S, E, tid);
#endif
                if (BOTH(pb + 3)) xcd_barrier(bar);
            }
            if (IN(pb + 4)) {
                PHASE_ENTRY();
                const int gw = blockIdx.x * NWAVES + wave, NGW = G * NWAVES;
                const bool dead = __hip_atomic_load((gu32*)(ws + WS_CTL) + CW_BAR + XB_TMO, RLX_AGENT) != 0u;
                const bf16* OB = (const bf16*)(ws + WS_O); bf16* HB = (bf16*)(ws + WS_H); bf16* X1 = (bf16*)(ws + WS_X1);
                f32x4 pgv[8], ngv[8];
                { const float* pg = args.in[2] + l * D_MODEL + 8 * lane; const float* ng = args.in[1] + D_MODEL + 8 * lane;
#pragma unroll
                  for (int j = 0; j < 4; ++j) { pgv[2 * j] = *(const f32x4*)(pg + 512 * j); pgv[2 * j + 1] = *(const f32x4*)(pg + 512 * j + 4); ngv[2 * j] = *(const f32x4*)(ng + 512 * j); ngv[2 * j + 1] = *(const f32x4*)(ng + 512 * j + 4); } }
                for (int m = gw; m < TG; m += NGW) {
                    const size_t row = (size_t)g * TG + m;
                    const v4u* orow = (const v4u*)(OB + (size_t)m * D_MODEL) + lane;
                    f32x4 v[8]; float s = 0.f;
#pragma unroll
                    for (int j = 0; j < 4; ++j) { const v4u ow = orow[64 * j]; v[2 * j] = (f32x4){bf_lo(ow.x), bf_hi(ow.x), bf_lo(ow.y), bf_hi(ow.y)}; v[2 * j + 1] = (f32x4){bf_lo(ow.z), bf_hi(ow.z), bf_lo(ow.w), bf_hi(ow.w)}; }
#pragma unroll
                    for (int j = 0; j < 8; ++j) s += (v[j].x * v[j].x + v[j].y * v[j].y) + (v[j].z * v[j].z + v[j].w * v[j].w);
                    const float rs = rsqrtf(wave_sum(s) * (1.f / D_MODEL) + EPS);
                    if (l == 0) {
                        const float* xrow = args.in[0] + row * D_MODEL + 8 * lane; float s2 = 0.f;
                        v4u* x8 = (v4u*)(X1 + (size_t)m * D_MODEL) + lane;
#pragma unroll
                        for (int j = 0; j < 4; ++j) {
                            const f32x4 xa = *(const f32x4*)(xrow + 512 * j), xb = *(const f32x4*)(xrow + 512 * j + 4), ga = pgv[2 * j], gb = pgv[2 * j + 1];
                            v[2 * j] = xa + v[2 * j] * rs * ga; v[2 * j + 1] = xb + v[2 * j + 1] * rs * gb;
                            v4u wv; wv.x = cvt_pk_bf16(v[2 * j].x, v[2 * j].y); wv.y = cvt_pk_bf16(v[2 * j].z, v[2 * j].w); wv.z = cvt_pk_bf16(v[2 * j + 1].x, v[2 * j + 1].y); wv.w = cvt_pk_bf16(v[2 * j + 1].z, v[2 * j + 1].w);
                            x8[64 * j] = wv; }
#pragma unroll
                        for (int j = 0; j < 8; ++j) s2 += (v[j].x * v[j].x + v[j].y * v[j].y) + (v[j].z * v[j].z + v[j].w * v[j].w);
                        const float rs2 = rsqrtf(wave_sum(s2) * (1.f / D_MODEL) + EPS);
                        v4u* o8 = (v4u*)(HB + row * D_MODEL) + lane;
#pragma unroll
                        for (int j = 0; j < 4; ++j) { const f32x4 ga = ngv[2 * j], gb = ngv[2 * j + 1]; const f32x4 a = v[2 * j] * rs2 * ga, bq = v[2 * j + 1] * rs2 * gb;
                            v4u wv; wv.x = cvt_pk_bf16(a.x, a.y); wv.y = cvt_pk_bf16(a.z, a.w); wv.z = cvt_pk_bf16(bq.x, bq.y); wv.w = cvt_pk_bf16(bq.z, bq.w); o8[64 * j] = wv; }
                    } else {
                        const v4u* x8 = (const v4u*)(X1 + (size_t)m * D_MODEL) + lane;
                        float* drow = args.out + row * D_MODEL + 8 * lane;
#pragma unroll
                        for (int j = 0; j < 4; ++j) { const v4u xw = x8[64 * j]; const f32x4 ga = pgv[2 * j], gb = pgv[2 * j + 1];
                            f32x4 a = (f32x4){bf_lo(xw.x), bf_hi(xw.x), bf_lo(xw.y), bf_hi(xw.y)} + v[2 * j] * rs * ga, bq = (f32x4){bf_lo(xw.z), bf_hi(xw.z), bf_lo(xw.w), bf_hi(xw.w)} + v[2 * j + 1] * rs * gb;
                            if (dead) { const float qn = __builtin_nanf(""); a = (f32x4){qn, qn, qn, qn}; bq = a; }
                            *(f32x4*)(drow + 512 * j) = a; *(f32x4*)(drow + 512 * j + 4) = bq; }
                    }
                }
                if (BOTH(pb + 4)) xcd_barrier(bar);
            }
        }
#undef IN
#undef BOTH
#undef PHASE_ENTRY
}

extern "C" void kernel_launch(void* const* d_in, const int* in_sizes, int n_in, void* d_out, int out_size, void* d_ws, size_t ws_size, hipStream_t stream) {
    static int grid = 0;
    if (grid == 0) {
        if (n_in != 17 || in_sizes[0] != M_ALL * D_MODEL || out_size != M_ALL * D_MODEL || ws_size < WS_END) {
            fprintf(stderr, "kernel_launch: unexpected shapes (n_in %d, in0 %d, out %d, ws %zu < %zu); nothing launched\n", n_in, n_in > 0 ? in_sizes[0] : -1, out_size, ws_size, (size_t)WS_END); grid = -1; return; }
        int dev = 0, cus = 0, per_cu = 0;
        if (hipGetDevice(&dev) != hipSuccess || hipDeviceGetAttribute(&cus, hipDeviceAttributeMultiprocessorCount, dev) != hipSuccess) { grid = -1; return; }
        if (hipFuncSetAttribute((const void*)hyb_fwd, hipFuncAttributeMaxDynamicSharedMemorySize, LDS_BYTES) != hipSuccess) { fprintf(stderr, "kernel_launch: hipFuncSetAttribute failed\n"); grid = -1; return; }
        if (hipOccupancyMaxActiveBlocksPerMultiprocessor(&per_cu, (const void*)hyb_fwd, NWAVES * 64, LDS_BYTES) != hipSuccess || per_cu < 1)
            fprintf(stderr, "kernel_launch: note: occupancy query reports %d workgroups per CU\n", per_cu);
        (void)hipGetLastError();
        grid = cus;
    }
    if (grid < 0) return;
    if (hipMemsetAsync((char*)d_ws + WS_CTL, 0, CTL_ZERO_BYTES, stream) != hipSuccess) return;
    Args a{};
    for (int i = 0; i < 17; ++i) a.in[i] = (const float*)d_in[i];
    a.out = (float*)d_out; a.ws = (unsigned char*)d_ws;
#if PROBE_DUP > 0
    { int lo = 0; for (int k = 0; k <= NGROUP * DEPTH; ++k) { const int p = 1 + k * 5 + (PROBE_DUP - 1); const int hi = k < NGROUP * DEPTH ? p + 1 : N_PHASES;
        a.ph_lo = lo; a.ph_hi = hi; a.li = k; a.pad = 0; hipLaunchKernelGGL(hyb_fwd, dim3(grid), dim3(NWAVES * 64), LDS_BYTES, stream, a); lo = p; } }
#elif MK_N_LAUNCHES == 1
    a.ph_lo = 0; a.ph_hi = N_PHASES; a.li = 0; a.pad = 0;
    hipLaunchKernelGGL(hyb_fwd, dim3(grid), dim3(NWAVES * 64), LDS_BYTES, stream, a);
#else
    for (int p = 0; p < N_PHASES; ++p) { a.ph_lo = p; a.ph_hi = p + 1; a.li = 0; a.pad = 0;
        hipLaunchKernelGGL(hyb_fwd, dim3(grid), dim3(NWAVES * 64), LDS_BYTES, stream, a); }
#endif
}
```

```cpp
#include <hip/hip_runtime.h>
#include <cstdio>
#include <cstdint>

namespace pg8 {
#define PG8_LAS __attribute__((address_space(3)))
typedef unsigned short bf16_t;
typedef short bf16x8 __attribute__((ext_vector_type(8)));
typedef float f32x4 __attribute__((ext_vector_type(4)));
typedef unsigned u32x4 __attribute__((ext_vector_type(4)));
constexpr int BM = 256, BK = 64, HALF = 128, HTB = HALF * BK * 2  , STAGE_BYTES = 8 * HTB, NXCD = 8, WGM = 8;

__host__ __device__ __forceinline__ int lds_byte(int r, int c) { const int st = (r >> 4) * 2 + (c >> 5), rr = r & 15, cc = c & 31, ob = rr * 64 + cc * 2; return st * 1024 + (ob ^ (((ob >> 9) & 1) << 5)); }
__host__ __device__ __forceinline__ void stage_rc(int b, int& R, int& C) { const int st = b / 1024, sb = b % 1024, swz = sb ^ (((sb >> 9) & 1) << 5); R = (st >> 1) * 16 + swz / 64; C = (st & 1) * 32 + (swz % 64) / 2; }
__host__ __device__ __forceinline__ int perm32(int rho) { const int n = rho >> 4, i = rho & 15; return 8 * (i >> 2) + 4 * n + (i & 3); }

struct Unit { int pm, pn, sel; };

struct StaticOrder {
    int nM, nN, nwg, G, c;
    __host__ __device__ void init(int M, int N, int G_, int c_) { nM = M / BM; nN = N / BM; nwg = nM * nN; G = G_; c = c_; }
    __host__ __device__ bool next(int i, Unit& u) const {
        const long L = (long)i * G + c; if (L >= nwg) return false;
        int wgid = (int)L; { const int q = nwg / NXCD, r = nwg % NXCD, xcd = wgid % NXCD, off = wgid / NXCD; wgid = (xcd < r ? xcd * (q + 1) : r * (q + 1) + (xcd - r) * q) + off; }
        const int nig = WGM * nN, gid = wgid / nig, fm = gid * WGM, gsz = (nM - fm) < WGM ? (nM - fm) : WGM;
        u.pm = fm + ((wgid % nig) % gsz); u.pn = (wgid % nig) / gsz; u.sel = 0; return true;
    }
};
struct SchedPlain {
    StaticOrder so; const char* A; const char* Bt;
    __device__ __forceinline__ bool next(int i, Unit& u) const { return so.next(i, u); }
    __device__ __forceinline__ const char* a_base(const Unit& u, size_t tstep) const { return A + (size_t)u.pm * tstep; }
    __device__ __forceinline__ const char* b_base(const Unit& u, size_t tstep) const { return Bt + (size_t)u.pn * tstep; }
    __device__ __forceinline__ bool keep(const Unit&) const { return false; }
    __device__ __forceinline__ void a_ready(const Unit&) const {}
    __device__ __forceinline__ void done(const Unit&) const {}
};
struct SchedBranch {
    StaticOrder so; const char* A; const char* Bt; size_t strideA, strideB;
    __device__ __forceinline__ bool next(int i, Unit& u) const { const int t = i / 3; if (!so.next(t, u)) return false; u.sel = i - 3 * t; return true; }
    __device__ __forceinline__ const char* a_base(const Unit& u, size_t tstep) const { return A + (size_t)u.sel * strideA + (size_t)u.pm * tstep; }
    __device__ __forceinline__ const char* b_base(const Unit& u, size_t tstep) const { return Bt + (size_t)u.sel * strideB + (size_t)u.pn * tstep; }
    __device__ __forceinline__ bool keep(const Unit& u) const { return u.sel < 2; }
    __device__ __forceinline__ void a_ready(const Unit&) const {}
    __device__ __forceinline__ void done(const Unit&) const {}
};

typedef float f32x2_cv __attribute__((ext_vector_type(2))); typedef __bf16 bf16x2_cv __attribute__((ext_vector_type(2)));
__device__ __forceinline__ unsigned cvt_pk_bf16(float lo, float hi) { const f32x2_cv v = {lo, hi}; const bf16x2_cv b = __builtin_convertvector(v, bf16x2_cv); return __builtin_bit_cast(unsigned, b); }
__device__ __forceinline__ float bf_lo(unsigned w) { return __uint_as_float(w << 16); }
__device__ __forceinline__ float bf_hi(unsigned w) { return __uint_as_float(w & 0xffff0000u); }
__device__ __forceinline__ float fast_sigmoid(float x) { return __builtin_amdgcn_rcpf(1.0f + __expf(-x)); }
__device__ __forceinline__ float fast_silu(float x) { return x * fast_sigmoid(x); }
__device__ __forceinline__ float lg2_gamma(int h) {
    const float x = __builtin_amdgcn_exp2f((float)(-5 - h));
    const float s = x * (1.0f + x * (0.5f + x * (0.33333334f + x * (0.25f + x * 0.2f))));
    return -s * 1.4426950408889634f;
}

template <int MASK> __device__ __forceinline__ float swz_xor(float v) { return __builtin_bit_cast(float, __builtin_amdgcn_ds_swizzle(__builtin_bit_cast(int, v), (MASK << 10) | 0x1f)); }
__device__ __forceinline__ float swz_xor16(float v) { return swz_xor<16>(v); }
__device__ __forceinline__ void half_swap(unsigned& a, unsigned& b) { asm volatile("s_nop 1\n\tv_permlane32_swap_b32 %0, %1" : "+v"(a), "+v"(b)); }
__device__ __forceinline__ float half_sum(float v) { unsigned a = __builtin_bit_cast(unsigned, v), b = a; half_swap(a, b); return __builtin_bit_cast(float, a) + __builtin_bit_cast(float, b); }
__device__ __forceinline__ float half_max(float v) { unsigned a = __builtin_bit_cast(unsigned, v), b = a; half_swap(a, b); return fmaxf(__builtin_bit_cast(float, a), __builtin_bit_cast(float, b)); }

__host__ __device__ __forceinline__ size_t blk_idx(int row, int col, int nbc  ) { return ((size_t)(row >> 4) * nbc + (col >> 5)) * 512 + (size_t)((row & 15) * 32 + (col & 31)); }

struct EpiF32 {
    static constexpr bool PERM = false, AFTER_DRAIN = false;
    float* C; int ldc;
    __device__ __forceinline__ void operator()(f32x4 (&acc)[2][2][4][2], const Unit& u, int wr, int wc, int fr, int fq) const {
        const int row0 = u.pm * BM + wr * 64 + fr, col0 = u.pn * BM + wc * 32 + 4 * fq;
#pragma unroll
        for (int ai = 0; ai < 2; ++ai)
#pragma unroll
            for (int m = 0; m < 4; ++m) { float* rowp = C + (size_t)(row0 + ai * HALF + m * 16) * ldc + col0;
#pragma unroll
                for (int bj = 0; bj < 2; ++bj)
#pragma unroll
                    for (int n = 0; n < 2; ++n) *(f32x4*)(rowp + bj * HALF + n * 16) = acc[ai][bj][m][n]; }
    }
};

__host__ __device__ __forceinline__ size_t gm8_idx(int row, int bc) { return ((size_t)(row >> 4) * 96 + (bc >> 6)) * 1024 + (size_t)((row & 15) * 64 + (bc & 63)); }
__device__ __forceinline__ unsigned gate_q8x4(const f32x4& g) {
    const unsigned q0 = max((unsigned)(g[0] * 255.f + 0.5f), 1u), q1 = max((unsigned)(g[1] * 255.f + 0.5f), 1u), q2 = max((unsigned)(g[2] * 255.f + 0.5f), 1u), q3 = max((unsigned)(g[3] * 255.f + 0.5f), 1u);
    return q0 | (q1 << 8) | (q2 << 16) | (q3 << 24); }
__device__ __forceinline__ f32x4 gate_unq4(unsigned w) { return (f32x4){(float)(w & 0xffu), (float)((w >> 8) & 0xffu), (float)((w >> 16) & 0xffu), (float)(w >> 24)}; }
struct EpiProj {
    static constexpr bool PERM = true, AFTER_DRAIN = false;
    bf16_t* proj; bf16_t* gm; int mode;
    template <int KIND> __device__ __forceinline__ void run(f32x4 (&acc)[2][2][4][2], const Unit& u, int wr, int wc, int fr, int fq) const {
        const int row0 = u.pm * BM + wr * 64 + fr, colt = u.pn * BM, cl = wc * 32 + 8 * fq;
        constexpr double FRD[8] = {0.15915494309189535, 0.030863763158420102, 0.00598518567638293, 0.001160663620968869, 0.00022507907904105155, 4.3647954811733995e-05, 8.464331128654902e-06, 1.6414263867044143e-06};
#pragma unroll
        for (int ai = 0; ai < 2; ++ai)
#pragma unroll
            for (int m = 0; m < 4; ++m) {
                const int row = row0 + ai * HALF + m * 16, pos = row & 4095;
                float cs[8], sn[8];
                if constexpr (KIND == 2 || KIND == 3) {
                    int fqo = fq; asm volatile("" : "+v"(fqo));
#pragma unroll
                    for (int k = 0; k < 4; ++k) { const double fv = (double)__builtin_amdgcn_exp2f(-(float)(16 * wc + 4 * fqo + k) * (13.287712379549449f / 63.0f)) * 0.15915494309189535;
                        const double ph = (double)pos * fv; const float r = (float)(ph - __builtin_floor(ph)); cs[k] = __builtin_amdgcn_cosf(r); sn[k] = __builtin_amdgcn_sinf(r); }
                }
                if constexpr (KIND == 4 || KIND == 5) {
                    if ((wc & 1) == 0) {
#pragma unroll
                        for (int k = 0; k < 8; ++k) { const double ph = (double)pos * FRD[k]; const float r = (float)(ph - __builtin_floor(ph)); cs[k] = __builtin_amdgcn_cosf(r); sn[k] = __builtin_amdgcn_sinf(r); if (fq == 0) sn[k] = -sn[k]; }
                    }
                }
                u32x4 w8 = {0u, 0u, 0u, 0u};
#pragma unroll
                for (int bj = 0; bj < 2; ++bj) {
                    const int col = colt + bj * HALF + cl;
                    f32x4 v0 = acc[ai][bj][m][0], v1 = acc[ai][bj][m][1];
                    if constexpr (KIND == 0) {
#pragma unroll
                        for (int k = 0; k < 4; ++k) { v0[k] = fast_sigmoid(v0[k]); v1[k] = fast_sigmoid(v1[k]); }
                        if (bj == 0) { w8.x = gate_q8x4(v0); w8.y = gate_q8x4(v1); } else { w8.z = gate_q8x4(v0); w8.w = gate_q8x4(v1); }
                    } else if constexpr (KIND == 1) {
#pragma unroll
                        for (int k = 0; k < 4; ++k) { v0[k] = fast_silu(v0[k]); v1[k] = fast_silu(v1[k]); }
                    } else if constexpr (KIND == 2 || KIND == 3) {
                        float sc = 1.0f;
                        if constexpr (KIND == 3) { int hh = ((colt - 3072) >> 7) + bj; asm volatile("" : "+s"(hh));
                            sc = 0.08838834764831845f * __builtin_amdgcn_exp2f(lg2_gamma(hh) * (float)(127 - (pos & 127))); }
                        const f32x4 ca = {cs[0] * sc, cs[0] * sc, cs[1] * sc, cs[1] * sc}, sa = {sn[0] * sc, sn[0] * sc, sn[1] * sc, sn[1] * sc};
                        const f32x4 cb = {cs[2] * sc, cs[2] * sc, cs[3] * sc, cs[3] * sc}, sb = {sn[2] * sc, sn[2] * sc, sn[3] * sc, sn[3] * sc};
                        const f32x4 w0 = {-v0[1], v0[0], -v0[3], v0[2]}, w1 = {-v1[1], v1[0], -v1[3], v1[2]};
                        v0 = v0 * ca + w0 * sa; v1 = v1 * cb + w1 * sb;
                    } else if constexpr (KIND == 4 || KIND == 5) {
                        if ((wc & 1) == 0) {
                            f32x4 p0, p1;
#pragma unroll
                            for (int k = 0; k < 4; ++k) { p0[k] = swz_xor16(v0[k]); p1[k] = swz_xor16(v1[k]); }
                            if (fq < 2) {
#pragma unroll
                                for (int k = 0; k < 4; ++k) { v0[k] = v0[k] * cs[k] + p0[k] * sn[k]; v1[k] = v1[k] * cs[4 + k] + p1[k] * sn[4 + k]; }
                            }
                        }
                        if constexpr (KIND == 4) { v0 = v0 * 0.18033688011112042f; v1 = v1 * 0.18033688011112042f; }
                    }
                    if constexpr (KIND != 0) {
                        u32x4 w; w.x = cvt_pk_bf16(v0[0], v0[1]); w.y = cvt_pk_bf16(v0[2], v0[3]); w.z = cvt_pk_bf16(v1[0], v1[1]); w.w = cvt_pk_bf16(v1[2], v1[3]);
                        if constexpr (KIND == 7) *(u32x4*)(gm + blk_idx(row, col - 10240, 192)) = w;
                        else *(u32x4*)(proj + blk_idx(row, col, 320)) = w;
                    }
                }
                if constexpr (KIND == 0) *(u32x4*)((unsigned char*)gm + gm8_idx(row, colt - 10240 + 2 * cl)) = w8;
            }
    }
    __device__ __forceinline__ void operator()(f32x4 (&acc)[2][2][4][2], const Unit& u, int wr, int wc, int fr, int fq) const {
        const int seg = (u.pn * BM) >> 10;
        if (mode == 1) return;
        if (mode == 2) { if (seg >= 10) run<7>(acc, u, wr, wc, fr, fq); else run<6>(acc, u, wr, wc, fr, fq); return; }
        if (seg >= 10) run<0>(acc, u, wr, wc, fr, fq);
        else if (seg == 1 || seg == 5 || seg == 9) run<1>(acc, u, wr, wc, fr, fq);
        else if (seg == 2) run<2>(acc, u, wr, wc, fr, fq);
        else if (seg == 3) run<3>(acc, u, wr, wc, fr, fq);
        else if (seg == 6) run<4>(acc, u, wr, wc, fr, fq);
        else if (seg == 7) run<5>(acc, u, wr, wc, fr, fq);
        else run<6>(acc, u, wr, wc, fr, fq);
    }
};

struct EpiBf16Plain {
    static constexpr bool PERM = true, AFTER_DRAIN = false;
    bf16_t* O; int ldc;
    __device__ __forceinline__ void operator()(f32x4 (&acc)[2][2][4][2], const Unit& u, int wr, int wc, int fr, int fq) const {
        const int row0 = u.pm * BM + wr * 64 + fr, col0 = u.pn * BM + wc * 32 + 8 * fq;
#pragma unroll
        for (int ai = 0; ai < 2; ++ai)
#pragma unroll
            for (int m = 0; m < 4; ++m) { bf16_t* rowp = O + (size_t)(row0 + ai * HALF + m * 16) * ldc + col0;
#pragma unroll
                for (int bj = 0; bj < 2; ++bj) { const f32x4 v0 = acc[ai][bj][m][0], v1 = acc[ai][bj][m][1];
                    u32x4 w; w.x = cvt_pk_bf16(v0[0], v0[1]); w.y = cvt_pk_bf16(v0[2], v0[3]); w.z = cvt_pk_bf16(v1[0], v1[1]); w.w = cvt_pk_bf16(v1[2], v1[3]);
                    *(u32x4*)(rowp + bj * HALF) = w; } }
    }
};

struct EpiMerge {
    static constexpr bool PERM = true, AFTER_DRAIN = false;
    const unsigned char* gm; bf16_t* mo;
    __device__ __forceinline__ void load_batch(const int bt, const int row0, const int gbc, const int j, u32x4 (&gc)[2], u32x4 (&gn)[2]) const {
        const int ai = bt >> 1, mh = bt & 1;
#pragma unroll
        for (int mm = 0; mm < 2; ++mm) { const unsigned char* p = gm + gm8_idx(row0 + ai * HALF + (2 * mh + mm) * 16, gbc);
            gc[mm] = *(const u32x4*)p; if (j < 2) gn[mm] = *(const u32x4*)(p + (size_t)32 * 1024); else gn[mm] = gc[mm]; }
    }
    __device__ __forceinline__ void apply_batch(const int bt, f32x4 (&acc)[2][2][4][2], const int row0, const int col0, const int j, const u32x4 (&gc)[2], const u32x4 (&gn)[2]) const {
        const int ai = bt >> 1, mh = bt & 1;
#pragma unroll
        for (int mm = 0; mm < 2; ++mm)
#pragma unroll
            for (int bj = 0; bj < 2; ++bj) {
                const int m = 2 * mh + mm; const u32x4 c = gc[mm];
                f32x4 g0 = gate_unq4(bj == 0 ? c.x : c.z), g1 = gate_unq4(bj == 0 ? c.y : c.w);
                if (j < 2) {
                    const u32x4 n = gn[mm];
                    const f32x4 n0 = gate_unq4(bj == 0 ? n.x : n.z), n1 = gate_unq4(bj == 0 ? n.y : n.w);
#pragma unroll
                    for (int k = 0; k < 4; ++k) { g0[k] = g0[k] * __builtin_amdgcn_rcpf(n0[k]); g1[k] = g1[k] * __builtin_amdgcn_rcpf(n1[k]); }
                    acc[ai][bj][m][0] = acc[ai][bj][m][0] * g0; acc[ai][bj][m][1] = acc[ai][bj][m][1] * g1;
                } else {
                    const f32x4 v0 = acc[ai][bj][m][0] * (g0 * (1.0f / 255.0f)), v1 = acc[ai][bj][m][1] * (g1 * (1.0f / 255.0f));
                    u32x4 w; w.x = cvt_pk_bf16(v0[0], v0[1]); w.y = cvt_pk_bf16(v0[2], v0[3]); w.z = cvt_pk_bf16(v1[0], v1[1]); w.w = cvt_pk_bf16(v1[2], v1[3]);
                    *(u32x4*)(mo + (size_t)(row0 + ai * HALF + m * 16) * 2048 + col0 + bj * HALF) = w;
                }
            }
    }
    __device__ __forceinline__ void operator()(f32x4 (&acc)[2][2][4][2], const Unit& u, int wr, int wc, int fr, int fq) const {
        const int row0 = u.pm * BM + wr * 64 + fr, col0 = u.pn * BM + wc * 32 + 8 * fq, j = u.sel;
        const int gbc = j * 2048 + u.pn * 256 + 64 * wc + 16 * fq;
        u32x4 gcA[2], gnA[2], gcB[2], gnB[2], gcC[2], gnC[2], gcD[2], gnD[2];
        load_batch(0, row0, gbc, j, gcA, gnA);
        load_batch(1, row0, gbc, j, gcB, gnB);
        load_batch(2, row0, gbc, j, gcC, gnC);
        load_batch(3, row0, gbc, j, gcD, gnD);
        __builtin_amdgcn_sched_barrier(0);
        apply_batch(0, acc, row0, col0, j, gcA, gnA);
        __builtin_amdgcn_sched_barrier(0);
        apply_batch(1, acc, row0, col0, j, gcB, gnB);
        __builtin_amdgcn_sched_barrier(0);
        apply_batch(2, acc, row0, col0, j, gcC, gnC);
        __builtin_amdgcn_sched_barrier(0);
        apply_batch(3, acc, row0, col0, j, gcD, gnD);
    }
};

template <class Epi, class Sched, bool ALIGN_EPI = false, bool SP2 = false>
__device__ __forceinline__ void gemm_phase(PG8_LAS unsigned char* lds, const int K_, const Sched& S, const Epi& E, const int tid) {
    const int wid = __builtin_amdgcn_readfirstlane(tid >> 6), lane = tid & 63, wr = wid >> 2, wc = wid & 3, fr = lane & 15, fq = lane >> 4;
    const int K = K_, nt = K / BK;
    unsigned voffA[2], voffB[2];
#pragma unroll
    for (int i = 0; i < 2; ++i) { int R, C; stage_rc(tid * 16 + i * 8192, R, C); const int Rb = Epi::PERM ? ((R & ~31) + perm32(R & 31)) : R;
        voffA[i] = (unsigned)(R * K + C) * 2u; voffB[i] = (unsigned)(Rb * K + C) * 2u; }
    const size_t kstep = (size_t)(BK * 2);
    const size_t hstep = (size_t)HALF * K * 2;
    const size_t tstep = 2 * hstep;
    const unsigned ldsw = (unsigned)wid * 1024u;
    const int aoff = lds_byte(wr * 64 + fr, fq * 8), boff = lds_byte(wc * 32 + fr, fq * 8);
#define PG8_SA(b, h) (((b) * 2 + (h)) * HTB)
#define PG8_SB(b, h) ((4 + (b) * 2 + (h)) * HTB)
#define PG8_STAGE(bufoff, gbase, voff) do { _Pragma("unroll") for (int _i = 0; _i < 2; ++_i) \
        __builtin_amdgcn_global_load_lds((const unsigned*)((const char*)(gbase) + (voff)[_i]), (PG8_LAS unsigned*)(lds + (bufoff) + ldsw + _i * 8192), 16, 0, 0); } while (0)
#define PG8_LDA(dst, b, h) do { _Pragma("unroll") for (int m = 0; m < 4; ++m) _Pragma("unroll") for (int k = 0; k < 2; ++k) dst[m][k] = *(const PG8_LAS bf16x8*)(lds + PG8_SA(b, h) + aoff + m * 2048 + k * 1024); } while (0)
#define PG8_LDB(dst, b, h) do { _Pragma("unroll") for (int n = 0; n < 2; ++n) _Pragma("unroll") for (int k = 0; k < 2; ++k) dst[n][k] = *(const PG8_LAS bf16x8*)(lds + PG8_SB(b, h) + boff + n * 2048 + k * 1024); } while (0)
#define PG8_MMA(ai, bj, At, Bt) do { __builtin_amdgcn_s_setprio(1); _Pragma("unroll") for (int m = 0; m < 4; ++m) _Pragma("unroll") for (int n = 0; n < 2; ++n) _Pragma("unroll") for (int k = 0; k < 2; ++k) \
        acc[ai][bj][m][n] = __builtin_amdgcn_mfma_f32_16x16x32_bf16(Bt[n][k], At[m][k], acc[ai][bj][m][n], 0, 0, 0); __builtin_amdgcn_s_setprio(0); } while (0)
#define PG8_WAIT_V(n) asm volatile("s_waitcnt vmcnt(" #n ")" ::: "memory")
#define PG8_WAIT_L(n) asm volatile("s_waitcnt lgkmcnt(" #n ")" ::: "memory")
#define PG8_BAR __builtin_amdgcn_s_barrier()
#define PG8_SCHED __builtin_amdgcn_sched_barrier(0)
    Unit cur, nxt; int ui = 0;
    if (!S.next(0, cur)) return;
    f32x4 acc[2][2][4][2];
#pragma unroll
    for (int a = 0; a < 2; ++a)
#pragma unroll
        for (int b = 0; b < 2; ++b)
#pragma unroll
            for (int m = 0; m < 4; ++m)
#pragma unroll
                for (int n = 0; n < 2; ++n) acc[a][b][m][n] = (f32x4){0.f, 0.f, 0.f, 0.f};
    bf16x8 At[4][2], B0[2][2], B1[2][2];
    const char* cA = S.a_base(cur, tstep); const char* cB = S.b_base(cur, tstep);
    S.a_ready(cur);
    if constexpr (SP2) {
        PG8_STAGE(PG8_SB(0, 0), cB, voffB); PG8_STAGE(PG8_SB(0, 1), cB + hstep, voffB); PG8_STAGE(PG8_SA(0, 0), cA, voffA); PG8_STAGE(PG8_SA(0, 1), cA + hstep, voffA);
        if (wr == 1) PG8_BAR;
        PG8_WAIT_V(2); PG8_BAR;
        PG8_STAGE(PG8_SB(1, 0), cB + kstep, voffB); PG8_STAGE(PG8_SA(1, 0), cA + kstep, voffA); PG8_STAGE(PG8_SB(1, 1), cB + hstep + kstep, voffB);
        PG8_WAIT_V(6); PG8_BAR;
    } else {
        PG8_STAGE(PG8_SB(0, 0), cB, voffB); PG8_STAGE(PG8_SA(0, 0), cA, voffA); PG8_STAGE(PG8_SB(0, 1), cB + hstep, voffB); PG8_STAGE(PG8_SA(0, 1), cA + hstep, voffA);
        if (wr == 1) PG8_BAR;
        PG8_WAIT_V(4); PG8_BAR;
        PG8_STAGE(PG8_SB(1, 0), cB + kstep, voffB); PG8_STAGE(PG8_SA(1, 0), cA + kstep, voffA); PG8_STAGE(PG8_SB(1, 1), cB + hstep + kstep, voffB);
        PG8_WAIT_V(6); PG8_BAR;
    }
    for (;;) {
        const bool has_next = S.next(ui + 1, nxt);
        const char* nA = has_next ? S.a_base(nxt, tstep) : cA; const char* nB = has_next ? S.b_base(nxt, tstep) : cB;
        for (int t = 0; t < nt; t += 2) {
            const bool last = (t == nt - 2);
            const char* a1 = cA + (size_t)(t + 1) * kstep;
            const char* a2 = last ? nA : cA + (size_t)(t + 2) * kstep; const char* b2 = last ? nB : cB + (size_t)(t + 2) * kstep;
            const char* a3 = a2 + kstep; const char* b3 = b2 + kstep;
            if (last && has_next) S.a_ready(nxt);
            if constexpr (SP2) {
            PG8_LDB(B0, 0, 0); PG8_LDB(B1, 0, 1); PG8_SCHED; PG8_LDA(At, 0, 0); PG8_STAGE(PG8_SA(1, 1), a1 + hstep, voffA);
            PG8_WAIT_V(8); PG8_WAIT_L(0); PG8_BAR; PG8_MMA(0, 0, At, B0); PG8_MMA(0, 1, At, B1); PG8_BAR; PG8_SCHED;
            PG8_LDA(At, 0, 1); PG8_STAGE(PG8_SB(0, 0), b2, voffB); PG8_STAGE(PG8_SB(0, 1), b2 + hstep, voffB); PG8_STAGE(PG8_SA(0, 0), a2, voffA);
            PG8_WAIT_V(8); PG8_WAIT_L(0); PG8_BAR; PG8_MMA(1, 0, At, B0); PG8_MMA(1, 1, At, B1); PG8_BAR; PG8_SCHED;
            PG8_LDB(B0, 1, 0); PG8_LDB(B1, 1, 1); PG8_SCHED; PG8_LDA(At, 1, 0); PG8_STAGE(PG8_SA(0, 1), a2 + hstep, voffA);
            PG8_WAIT_V(8); PG8_WAIT_L(0); PG8_BAR; PG8_MMA(0, 0, At, B0); PG8_MMA(0, 1, At, B1); PG8_BAR; PG8_SCHED;
            PG8_LDA(At, 1, 1); PG8_STAGE(PG8_SB(1, 0), b3, voffB); PG8_STAGE(PG8_SB(1, 1), b3 + hstep, voffB); PG8_STAGE(PG8_SA(1, 0), a3, voffA);
            PG8_WAIT_V(8); PG8_WAIT_L(0); PG8_BAR; PG8_MMA(1, 0, At, B0); PG8_MMA(1, 1, At, B1); PG8_BAR; PG8_SCHED;
            } else {
            PG8_LDB(B0, 0, 0); PG8_SCHED; PG8_LDA(At, 0, 0); PG8_STAGE(PG8_SA(1, 1), a1 + hstep, voffA);
            PG8_WAIT_L(8); PG8_BAR; PG8_WAIT_L(0); PG8_MMA(0, 0, At, B0); PG8_BAR; PG8_SCHED;
            PG8_LDB(B1, 0, 1); PG8_STAGE(PG8_SB(0, 0), b2, voffB);
            PG8_BAR; PG8_WAIT_L(0); PG8_MMA(0, 1, At, B1); PG8_BAR;
            PG8_LDA(At, 0, 1); PG8_STAGE(PG8_SA(0, 0), a2, voffA);
            PG8_BAR; PG8_WAIT_L(0); PG8_MMA(1, 0, At, B0); PG8_BAR; PG8_SCHED;
            PG8_STAGE(PG8_SB(0, 1), b2 + hstep, voffB);
            PG8_WAIT_V(6); PG8_BAR; PG8_MMA(1, 1, At, B1); PG8_BAR;
            PG8_LDB(B0, 1, 0); PG8_SCHED; PG8_LDA(At, 1, 0); PG8_STAGE(PG8_SA(0, 1), a2 + hstep, voffA);
            PG8_WAIT_L(8); PG8_BAR; PG8_WAIT_L(0); PG8_MMA(0, 0, At, B0); PG8_BAR; PG8_SCHED;
            PG8_LDB(B1, 1, 1); PG8_STAGE(PG8_SB(1, 0), b3, voffB);
            PG8_BAR; PG8_WAIT_L(0); PG8_MMA(0, 1, At, B1); PG8_BAR;
            PG8_LDA(At, 1, 1); PG8_STAGE(PG8_SA(1, 0), a3, voffA);
            PG8_BAR; PG8_WAIT_L(0); PG8_MMA(1, 0, At, B0); PG8_BAR; PG8_SCHED;
            PG8_STAGE(PG8_SB(1, 1), b3 + hstep, voffB);
            PG8_WAIT_V(6); PG8_BAR; PG8_MMA(1, 1, At, B1); PG8_BAR;
            }
        }
        if constexpr (ALIGN_EPI) { if (wr == 0) PG8_BAR; }
        if constexpr (!Epi::AFTER_DRAIN) { E(acc, cur, wr, wc, fr, fq); S.done(cur); }
        if (!has_next) break;
        if (!S.keep(cur)) {
#pragma unroll
        for (int a = 0; a < 2; ++a)
#pragma unroll
            for (int b = 0; b < 2; ++b)
#pragma unroll
                for (int m = 0; m < 4; ++m)
#pragma unroll
                    for (int n = 0; n < 2; ++n) acc[a][b][m][n] = (f32x4){0.f, 0.f, 0.f, 0.f};
        }
        cur = nxt; cA = nA; cB = nB; ++ui;
        if constexpr (ALIGN_EPI) { if (wr == 1) PG8_BAR; }
    }
    PG8_WAIT_V(0);
    if constexpr (!ALIGN_EPI) { if (wr == 0) PG8_BAR; }
    PG8_BAR;
    if constexpr (Epi::AFTER_DRAIN) { E.fused(acc, cur, wr, wc, fr, fq, lds, wid, lane); S.done(cur); }
#undef PG8_SA
#undef PG8_SB
#undef PG8_STAGE
#undef PG8_LDA
#undef PG8_LDB
#undef PG8_MMA
#undef PG8_WAIT_V
#undef PG8_WAIT_L
#undef PG8_BAR
#undef PG8_SCHED
}
}
#define GAS __attribute__((address_space(1)))
#define LAS __attribute__((address_space(3)))
typedef unsigned short bf16;
typedef unsigned v4u __attribute__((ext_vector_type(4)));
typedef float f32x4 __attribute__((ext_vector_type(4)));
typedef short bf16x8 __attribute__((ext_vector_type(8)));
typedef GAS unsigned gu32;
typedef GAS unsigned long long gu64;
#define RLX_AGENT __ATOMIC_RELAXED, __HIP_MEMORY_SCOPE_AGENT
#define LDS_WAIT() asm volatile("s_waitcnt lgkmcnt(0)" ::: "memory")
#define VM_WAIT() asm volatile("s_waitcnt vmcnt(0)" ::: "memory")
__device__ __forceinline__ unsigned long long rt() { return __builtin_amdgcn_s_memrealtime(); }
__device__ __forceinline__ unsigned f2bf(float f) { unsigned u = __builtin_bit_cast(unsigned, f); return (u + 0x7fffu + ((u >> 16) & 1u)) >> 16; }
__device__ __forceinline__ unsigned pk2(float lo, float hi) { return f2bf(lo) | (f2bf(hi) << 16); }

#define XB_TMO      128
#define XB_XCNT(j)  (256  + 64 * (j))
#define XB_XSUB(j)  (1280 + 64 * (j))
#define XB_XGEN(j)  (2304 + 64 * (j))
#define XB_TOP      3328
#define XB_TOPGEN   3392
#define XCD_BAR_WORDS 3456
#define XB_SPIN_CAP (1u << 18)

__device__ __forceinline__ unsigned xb_ld(unsigned* p)              { return __hip_atomic_load(p, __ATOMIC_RELAXED, __HIP_MEMORY_SCOPE_AGENT); }
__device__ __forceinline__ unsigned xb_add(unsigned* p, unsigned v) { return __hip_atomic_fetch_add(p, v, __ATOMIC_RELAXED, __HIP_MEMORY_SCOPE_AGENT); }
__device__ __forceinline__ unsigned xb_xcc_id() { return (unsigned)__builtin_amdgcn_s_getreg((3 << 11) | 20) & 0xFu; }
#define XB_SPIN(cond, bar) do { unsigned _sp = 0; while (cond) { __builtin_amdgcn_s_sleep(1); \
    if ((++_sp & 255u) == 0u) { if (xb_ld(&(bar)[XB_TMO])) break; if (_sp > XB_SPIN_CAP) { atomicAdd(&(bar)[XB_TMO], 1u); break; } } } } while (0)

__device__ __forceinline__ unsigned xb_lane() { unsigned m = ~0u; asm volatile("" : "+s"(m)); return __builtin_amdgcn_mbcnt_hi(m, __builtin_amdgcn_mbcnt_lo(m, 0u)); }
struct XcdBarrier {
    unsigned wv;
    unsigned* bar; unsigned x;
    volatile LAS unsigned* st;
};

__device__ __forceinline__ XcdBarrier xcd_barrier_post(unsigned* bar, volatile LAS unsigned* st, unsigned wv) {
    XcdBarrier b; b.wv = wv; b.bar = bar; b.x = xb_xcc_id(); b.st = st;
    if (wv == 0u && xb_lane() == 0u) (void)xb_add(&bar[XB_XCNT(b.x)], 1u);
    return b;
}
__device__ __forceinline__ void xcd_barrier_complete(unsigned* bar, unsigned x, unsigned& nloc, unsigned& nx) {
    const unsigned G = gridDim.x * gridDim.y * gridDim.z;
    unsigned sum, cnt, mine, sp = 0u;
    for (;;) {
        sum = 0u; cnt = 0u; mine = 0u;
#pragma unroll
        for (unsigned j = 0; j < 16; ++j) { const unsigned c = xb_ld(&bar[XB_XCNT(j)]); sum += c; cnt += (c > 0u) ? 1u : 0u; mine = (j == x) ? c : mine; }
        if (sum == G) break;
        __builtin_amdgcn_s_sleep(1);
        if ((++sp & 255u) == 0u) { if (xb_ld(&bar[XB_TMO])) break; if (sp > XB_SPIN_CAP) { atomicAdd(&bar[XB_TMO], 1u); break; } }
    }
    nloc = mine > 0u ? mine : 1u; nx = cnt > 0u ? cnt : 1u;
}

__device__ __forceinline__ void xcd_barrier(const XcdBarrier& b) {
    asm volatile("s_waitcnt vmcnt(0)" ::: "memory");
    __syncthreads();
    if (b.wv == 0u && xb_lane() == 0u) {
        unsigned* bar = b.bar;
        __builtin_amdgcn_s_waitcnt(0);
        unsigned nloc = b.st[0], nx = b.st[1];
        if (nloc == 0u) { xcd_barrier_complete(bar, b.x, nloc, nx); b.st[0] = nloc; b.st[1] = nx; }
        const unsigned old = xb_add(&bar[XB_XSUB(b.x)], 1u);
        const unsigned gen = old / nloc;
        if (old + 1u == (gen + 1u) * nloc) {
            __builtin_amdgcn_fence(__ATOMIC_RELEASE, "agent");
            asm volatile("s_waitcnt vmcnt(0)" ::: "memory");
            const unsigned og = xb_add(&bar[XB_TOP], 1u);
            const unsigned tg = og / nx;
            if (og + 1u == (tg + 1u) * nx) xb_add(&bar[XB_TOPGEN], 1u);
            else XB_SPIN(xb_ld(&bar[XB_TOPGEN]) == tg, bar);
            __builtin_amdgcn_fence(__ATOMIC_ACQUIRE, "agent");
            xb_add(&bar[XB_XGEN(b.x)], 1u);
            asm volatile("s_waitcnt vmcnt(0)" ::: "memory");
        } else {
            XB_SPIN(xb_ld(&bar[XB_XGEN(b.x)]) == gen, bar);
            __builtin_amdgcn_fence(__ATOMIC_ACQUIRE, "agent");
            asm volatile("s_waitcnt vmcnt(0)" ::: "memory");
        }
    }
    __syncthreads();
}

constexpr int D_MODEL = 2048, SEQ = 4096, BATCH = 8, DEPTH = 2, M_ALL = BATCH * SEQ, D_IN = 16384;
constexpr int BG = 4, TG = BG * SEQ, NGROUP = BATCH / BG;
constexpr int PNBC = 320, PBROW = PNBC * 512;
__device__ __forceinline__ size_t pidx(int row, int col) { return pg8::blk_idx(row, col, PNBC); }
constexpr int C_XA = 0, C_GA = 1024, C_QR = 2048, C_KR = 3072, C_VR = 4096, C_GR = 5120, C_QD = 6144, C_KD = 7168, C_VD = 8192, C_GD = 9216;
constexpr float EPS = 1e-6f;
constexpr int NWAVES = 8;
constexpr size_t MiB = 1u << 20;
constexpr size_t WS_CTL = 0, CTL_ZERO_BYTES = 1 * MiB;
constexpr size_t WS_COSR = 1 * MiB, WS_SINR = 2 * MiB, WS_COSD = 3 * MiB, WS_SIND = 3 * MiB + 128 * 1024, WS_LAMS = 3 * MiB + 512 * 1024;
constexpr size_t WS_WIN = 4 * MiB;
constexpr size_t WS_WBR = 132 * MiB;
constexpr size_t WS_WOUT = 156 * MiB;
constexpr size_t WS_H = 172 * MiB;
constexpr size_t WS_Y = 300 * MiB;
constexpr size_t WS_GM = 396 * MiB;
constexpr size_t WS_PROJ = 588 * MiB;
constexpr size_t WS_O = 588 * MiB;
constexpr size_t WS_M = 716 * MiB;
constexpr size_t WS_X1 = 908 * MiB;
constexpr size_t WS_END = 972 * MiB;
static_assert(WS_M + (size_t)TG * 2048 * 2 <= WS_END && WS_O + (size_t)TG * 2048 * 4 <= WS_M && WS_PROJ + (size_t)TG * 10240 * 2 == WS_X1 && WS_X1 + (size_t)TG * 2048 * 2 == WS_END, "d_ws map");
constexpr int CW_TMO = 0;
constexpr int CW_BAR = 4096;
constexpr int CW_Q = 65536;
constexpr int RING_BYTES = 131072, LDSCTL_OFF = RING_BYTES, MISC_OFF = LDSCTL_OFF + 320, LDS_BYTES = 147456;

#define LAUNDER_V(x) asm volatile("" : "+v"(x))
#define LAUNDER_S(x) asm volatile("" : "+s"(x))
typedef float f32x16 __attribute__((ext_vector_type(16)));
typedef short s16x4 __attribute__((ext_vector_type(4)));
typedef short v4i16_t __attribute__((ext_vector_type(4)));
typedef unsigned u32x2 __attribute__((ext_vector_type(2)));
typedef LAS unsigned char* ldsp;
using pg8::blk_idx; using pg8::cvt_pk_bf16; using pg8::bf_lo; using pg8::bf_hi; using pg8::fast_sigmoid; using pg8::lg2_gamma;

using pg8::swz_xor; using pg8::half_sum; using pg8::half_max;
__device__ __forceinline__ float wave_sum(float v) {
    v += swz_xor<1>(v); v += swz_xor<2>(v); v += swz_xor<4>(v); v += swz_xor<8>(v); v += swz_xor<16>(v);
    return half_sum(v);
}
__device__ __forceinline__ unsigned offb(unsigned row, unsigned ch) { return 256u * row + 16u * (ch ^ (((row & 3u) << 2) | ((row >> 2) & 3u))); }
__device__ __forceinline__ unsigned tr_nat(int lane, int k0, int t, int c) { const int h = lane >> 5, blk = (lane >> 4) & 1, q = (lane & 15) >> 2, p = lane & 3; return offb(k0 + 8 * h + 4 * t + q, 4 * c + 2 * blk + (p >> 1)) + 8 * (p & 1); }
__device__ __forceinline__ unsigned tr_perm(int lane, int k0, int t, int c) { const int h = lane >> 5, blk = (lane >> 4) & 1, q = (lane & 15) >> 2, p = lane & 3; return offb(k0 + 8 * t + 4 * h + q, 4 * c + 2 * blk + (p >> 1)) + 8 * (p & 1); }
__device__ __forceinline__ f32x16 mfma32(bf16x8 a, bf16x8 b, f32x16 c) { return __builtin_amdgcn_mfma_f32_32x32x16_bf16(a, b, c, 0, 0, 0); }
__device__ __forceinline__ s16x4 trr(ldsp p) { return __builtin_bit_cast(s16x4, __builtin_amdgcn_ds_read_tr16_b64_v4i16((LAS v4i16_t*)p)); }
__device__ __forceinline__ bf16x8 cat8(s16x4 lo, s16x4 hi) { return (bf16x8){lo[0], lo[1], lo[2], lo[3], hi[0], hi[1], hi[2], hi[3]}; }
template <int B> __device__ __forceinline__ bf16x8 pack8(const f32x16& x) {
    v4u w = {cvt_pk_bf16(x[B], x[B + 1]), cvt_pk_bf16(x[B + 2], x[B + 3]), cvt_pk_bf16(x[B + 4], x[B + 5]), cvt_pk_bf16(x[B + 6], x[B + 7])};
    return __builtin_bit_cast(bf16x8, w);
}
__device__ __forceinline__ f32x16 zero16() { f32x16 z;
#pragma unroll
    for (int i = 0; i < 16; ++i) z[i] = 0.f; return z; }

__device__ __forceinline__ void p0_transpose_item(const float* W, int K, int N, bf16* WT, LAS float* scr, int item, int lane) {
    const int nkb = K / 64, grp = item / (nkb * 64), rem = item - grp * (nkb * 64), kb = rem >> 6, nb = 64 * grp + (rem & 63), k0 = 64 * kb, n0 = 32 * nb;
    { const int cg = lane & 7, rs = lane >> 3;
      f32x4 v[8];
#pragma unroll
      for (int i = 0; i < 8; ++i) v[i] = *(const f32x4*)(W + (size_t)(k0 + 8 * i + rs) * N + n0 + 4 * cg);
#pragma unroll
      for (int i = 0; i < 8; ++i) { LAS float* d = scr + (8 * i + rs) * 33 + 4 * cg; d[0] = v[i].x; d[1] = v[i].y; d[2] = v[i].z; d[3] = v[i].w; } }
    LDS_WAIT(); asm volatile("" ::: "memory");
    const int c = lane & 7;
#pragma unroll
    for (int j = 0; j < 4; ++j) { const int n = (lane >> 3) + 8 * j; const LAS float* s = scr + (8 * c) * 33 + n;
        v4u o; o.x = pk2(s[0 * 33], s[1 * 33]); o.y = pk2(s[2 * 33], s[3 * 33]); o.z = pk2(s[4 * 33], s[5 * 33]); o.w = pk2(s[6 * 33], s[7 * 33]);
        *(GAS v4u*)(WT + (size_t)(n0 + n) * K + k0 + 8 * c) = o; }
    LDS_WAIT(); asm volatile("" ::: "memory");
}
__device__ __forceinline__ void rms_row_to_bf16(const float* xrow, const f32x4 (&gv)[8], bf16* orow, int lane) {
    const float* xr = xrow + 8 * lane;
    f32x4 v[8]; float s = 0.f;
#pragma unroll
    for (int j = 0; j < 4; ++j) { v[2 * j] = *(const f32x4*)(xr + 512 * j); v[2 * j + 1] = *(const f32x4*)(xr + 512 * j + 4); }
#pragma unroll
    for (int j = 0; j < 8; ++j) s += (v[j].x * v[j].x + v[j].y * v[j].y) + (v[j].z * v[j].z + v[j].w * v[j].w);
    const float rs = rsqrtf(wave_sum(s) * (1.f / D_MODEL) + EPS);
    v4u* o16 = (v4u*)orow + lane;
#pragma unroll
    for (int j = 0; j < 4; ++j) { const f32x4 ga = gv[2 * j], gb = gv[2 * j + 1]; const f32x4 a = v[2 * j] * rs * ga, bq = v[2 * j + 1] * rs * gb;
        v4u w; w.x = cvt_pk_bf16(a.x, a.y); w.y = cvt_pk_bf16(a.z, a.w); w.z = cvt_pk_bf16(bq.x, bq.y); w.w = cvt_pk_bf16(bq.z, bq.w); o16[64 * j] = w; }
}

__device__ __forceinline__ void ret_unit(const int tid, ldsp lds, int b, int h, const bf16* proj, bf16* yb) {
    const int lane = tid & 63, w = __builtin_amdgcn_readfirstlane(tid >> 6), r32 = lane & 31, hi = lane >> 5;
    const int it = w >> 1, eh = w & 1;
    constexpr int O_ST = 0, O_KD = 32768, O_VV = 65536, O_Q = 98304;
    LAS float* STAT = (LAS float*)(lds + RING_BYTES + 1024);
    { unsigned z0 = 0u; LAUNDER_V(z0); for (int i = tid; i < 2048; i += 512) ((LAS v4u*)(lds + O_ST))[i] = (v4u){z0, z0, z0, z0}; }
    ldsp rb[8];
#pragma unroll
    for (int s = 0; s < 8; ++s) rb[s] = lds + offb(r32, 2 * s + hi);
    ldsp tnk0 = lds + O_KD + tr_perm(lane, 0, 0, it), tnk1 = lds + O_KD + tr_perm(lane, 0, 1, it);
    ldsp tpv00 = lds + O_VV + tr_perm(lane, 0, 0, 2 * eh), tpv01 = lds + O_VV + tr_perm(lane, 0, 1, 2 * eh), tpv10 = lds + O_VV + tr_perm(lane, 0, 0, 2 * eh + 1), tpv11 = lds + O_VV + tr_perm(lane, 0, 1, 2 * eh + 1);
    const int row00 = b * SEQ, hcol = h * 128;
    bf16* Yp = yb + (size_t)b * SEQ * 1024 + h * 128;
    const float lg = lg2_gamma(h), cd = __builtin_amdgcn_exp2f(128.f * lg), cout = __builtin_amdgcn_exp2f(lg * (float)(32 * it + r32 - 127));
    f32x16 Dacc0 = zero16(), Dacc1 = zero16();
#define RET_DMA(src_, n_, lane_, off_) do { _Pragma("unroll") for (int k_ = 0; k_ < 4; ++k_) { const int row_ = 16 * w + 4 * k_ + ((lane_) >> 4); \
        const int ch_ = ((lane_) & 15) ^ (((row_ & 3) << 2) | ((row_ >> 2) & 3)); \
        __builtin_amdgcn_global_load_lds((const unsigned*)(proj + pidx(row00 + (n_) * 128 + row_, (src_) + hcol + 8 * ch_)), (LAS unsigned*)(lds + (off_) + 4096 * w + 1024 * k_), 16, 0, 0); } } while (0)
#define RET_BAR() do { asm volatile("s_waitcnt lgkmcnt(0)" ::: "memory"); __builtin_amdgcn_s_barrier(); asm volatile("" ::: "memory"); } while (0)
    RET_DMA(C_KR, 0, lane, O_KD); RET_DMA(C_VR, 0, lane, O_VV); RET_DMA(C_QR, 0, lane, O_Q);
    for (int n = 0; n < 32; ++n) {
        int tid_c = tid; LAUNDER_V(tid_c);
        const int lane_c = tid_c & 63, r32c = lane_c & 31, hic = lane_c >> 5;
        const int rowi = n * 128 + 32 * it + r32c;
        const int nn = n + 1 < 32 ? n + 1 : 31;
        asm volatile("s_waitcnt vmcnt(0) lgkmcnt(0)" ::: "memory"); __builtin_amdgcn_s_barrier(); asm volatile("" ::: "memory");
        bf16x8 qf[8];
        { ldsp qb_ = lds + O_Q + 8192 * it;
#pragma unroll
          for (int s = 0; s < 8; ++s) qf[s] = *(const LAS bf16x8*)(qb_ + (unsigned)(rb[s] - lds)); }
#pragma unroll
        for (int ks = 0; ks < 8; ++ks) {
            const bf16x8 a = cat8(trr(tnk0 + 4096 * ks), trr(tnk1 + 4096 * ks));
            Dacc0 = mfma32(a, cat8(trr(tpv00 + 4096 * ks), trr(tpv01 + 4096 * ks)), Dacc0);
            Dacc1 = mfma32(a, cat8(trr(tpv10 + 4096 * ks), trr(tpv11 + 4096 * ks)), Dacc1);
            if (ks & 1) __builtin_amdgcn_sched_barrier(0);
        }
        f32x16 acc0 = zero16(), acc1 = zero16();
#pragma unroll
        for (int jt = 0; jt < 4; ++jt) if (jt <= it) {
            f32x16 X = zero16();
#pragma unroll
            for (int s = 0; s < 8; ++s) X = mfma32(*(const LAS bf16x8*)(rb[s] + O_KD + 8192 * jt), qf[s], X);
            __builtin_amdgcn_sched_barrier(0);
            if (jt == it) {
#pragma unroll
                for (int r = 0; r < 16; ++r) { const int j = (r & 3) + 8 * (r >> 2) + 4 * hic; if (j > r32c) X[r] = 0.f; }
            }
            const bf16x8 pf0 = pack8<0>(X), pf1 = pack8<8>(X);
            acc0 = mfma32(cat8(trr(tpv00 + 8192 * jt), trr(tpv01 + 8192 * jt)), pf0, acc0);
            acc1 = mfma32(cat8(trr(tpv10 + 8192 * jt), trr(tpv11 + 8192 * jt)), pf0, acc1);
            acc0 = mfma32(cat8(trr(tpv00 + 8192 * jt + 4096), trr(tpv01 + 8192 * jt + 4096)), pf1, acc0);
            acc1 = mfma32(cat8(trr(tpv10 + 8192 * jt + 4096), trr(tpv11 + 8192 * jt + 4096)), pf1, acc1);
            __builtin_amdgcn_sched_barrier(0);
        }
        RET_BAR();
        RET_DMA(C_KR, nn, lane_c, O_KD); RET_DMA(C_VR, nn, lane_c, O_VV); RET_DMA(C_QR, nn, lane_c, O_Q);
        u32x2 gg[8];
        { const bf16* grow = proj + pidx(row00 + rowi, C_GR + hcol + 64 * eh + 4 * hic);
#pragma unroll
          for (int e2 = 0; e2 < 2; ++e2)
#pragma unroll
              for (int q4 = 0; q4 < 4; ++q4) gg[4 * e2 + q4] = *(const u32x2*)(grow + 512 * e2 + 8 * q4); }
        {
            ldsp st0 = lds + 16384 * eh;
#pragma unroll
            for (int s = 0; s < 8; ++s) {
                const unsigned o_ = (unsigned)(rb[s] - lds);
                acc0 = mfma32(*(const LAS bf16x8*)(st0 + o_ + O_ST), qf[s], acc0);
                acc1 = mfma32(*(const LAS bf16x8*)(st0 + o_ + O_ST + 8192), qf[s], acc1);
                if ((s & 3) == 3) __builtin_amdgcn_sched_barrier(0);
            }
        }
        float s1 = 0.f, s2 = 0.f;
#pragma unroll
        for (int r = 0; r < 16; ++r) { s1 += acc0[r] + acc1[r]; s2 += acc0[r] * acc0[r] + acc1[r] * acc1[r]; }
        s1 = half_sum(s1); s2 = half_sum(s2);
        if (hic == 0) { STAT[(32 * it + r32c) * 4 + eh * 2] = s1; STAT[(32 * it + r32c) * 4 + eh * 2 + 1] = s2; }
        RET_BAR();
        {
            const LAS float* st = STAT + (32 * it + r32c) * 4;
            const float mean = (st[0] + st[2]) * (1.f / 128.f); float var = (st[1] + st[3]) * (1.f / 128.f) - mean * mean; var = fmaxf(var, 0.f);
            const float rs = cout * rsqrtf(cout * cout * var + EPS);
            bf16* yrow = Yp + (size_t)rowi * 1024 + 64 * eh + 4 * hic;
#pragma unroll
            for (int e2 = 0; e2 < 2; ++e2)
#pragma unroll
                for (int q4 = 0; q4 < 4; ++q4) {
                    const f32x16& A = e2 ? acc1 : acc0; const u32x2 g = gg[4 * e2 + q4];
                    u32x2 o; o.x = cvt_pk_bf16((A[4 * q4] - mean) * rs * bf_lo(g.x), (A[4 * q4 + 1] - mean) * rs * bf_hi(g.x));
                    o.y = cvt_pk_bf16((A[4 * q4 + 2] - mean) * rs * bf_lo(g.y), (A[4 * q4 + 3] - mean) * rs * bf_hi(g.y));
                    *(u32x2*)(yrow + 32 * e2 + 8 * q4) = o;
                }
        }
#pragma unroll
        for (int r = 0; r < 16; ++r) { Dacc0[r] *= cd; Dacc1[r] *= cd; }
        {
            ldsp sw0 = lds + O_ST + 16384 * eh + 256 * r32c + 8 * hic; const unsigned swr = ((r32c & 3) << 2) | ((r32c >> 2) & 3);
#pragma unroll
            for (int q4 = 0; q4 < 4; ++q4) {
                u32x2 o0, o1; o0.x = cvt_pk_bf16(Dacc0[4 * q4], Dacc0[4 * q4 + 1]); o0.y = cvt_pk_bf16(Dacc0[4 * q4 + 2], Dacc0[4 * q4 + 3]);
                o1.x = cvt_pk_bf16(Dacc1[4 * q4], Dacc1[4 * q4 + 1]); o1.y = cvt_pk_bf16(Dacc1[4 * q4 + 2], Dacc1[4 * q4 + 3]);
                const unsigned co = 16u * ((unsigned)(4 * it + q4) ^ swr);
                *(LAS u32x2*)(sw0 + co) = o0; *(LAS u32x2*)(sw0 + co + 8192) = o1;
            }
        }
    }
    asm volatile("s_waitcnt vmcnt(0)" ::: "memory");
#undef RET_DMA
#undef RET_BAR
}

__device__ __forceinline__ void lru_unit(const int tid, ldsp lds, int b, int nb, const bf16* proj, bf16* ya, const float* convw, const float* convb,
                                         const float* wa, const float* ba, const float* wx, const float* bx, const float* lam) {
    const int lane = tid & 63, w = __builtin_amdgcn_readfirstlane(tid >> 6), r32 = lane & 31, hi = lane >> 5;
    const int c0 = nb * 64;
    LAS bf16* XA = (LAS bf16*)lds; ldsp XC = lds + 17408; LAS float* XF = (LAS float*)(lds + 35840); LAS float* AF = (LAS float*)(lds + 68608);
    ldsp WT = lds + 101376; LAS float* SEG = (LAS float*)(lds + 119808); LAS float* PAR = (LAS float*)(lds + 123904);
    if (tid < 64) { const int c = c0 + tid;
        PAR[tid] = convw[c]; PAR[64 + tid] = convw[1024 + c]; PAR[128 + tid] = convw[2048 + c]; PAR[192 + tid] = convw[3072 + c];
        PAR[256 + tid] = convb[c]; PAR[320 + tid] = ba[c]; PAR[384 + tid] = bx[c];
        const float z = __expf(-lam[c]); PAR[448 + tid] = log1pf(z); }
    for (int idx = tid; idx < 4096; idx += 512) { const int d = idx >> 6, e = idx & 63;
        ((LAS bf16*)WT)[e * 72 + d] = (bf16)f2bf(wa[nb * 4096 + idx]); ((LAS bf16*)(WT + 9216))[e * 72 + d] = (bf16)f2bf(wx[nb * 4096 + idx]); }
    const int row00 = b * SEQ;
    bf16* yp = ya + (size_t)b * SEQ * 1024 + c0;
    const int e = tid & 63;
    float hcarry = 0.f;
    v4u xs0, xs1, xs2;
#define LRU_ISSUE(t0_) do { { const int r = tid >> 3, ch = tid & 7, t = (t0_) - 3 + r; { unsigned z0 = 0u; LAUNDER_V(z0); xs0 = (v4u){z0, z0, z0, z0}; } if (t >= 0) xs0 = *(const v4u*)(proj + pidx(row00 + t, C_XA + c0 + ch * 8)); } \
        { const int r = (tid + 512) >> 3, ch = tid & 7, t = (t0_) - 3 + r; xs1 = *(const v4u*)(proj + pidx(row00 + t, C_XA + c0 + ch * 8)); } \
        if (tid < 24) { const int r = (tid + 1024) >> 3, ch = tid & 7, t = (t0_) - 3 + r; xs2 = *(const v4u*)(proj + pidx(row00 + t, C_XA + c0 + ch * 8)); } } while (0)
    LRU_ISSUE(0);
    for (int n = 0; n < 32; ++n) {
        const int t0 = n * 128;
        __syncthreads();
        *(LAS v4u*)((ldsp)XA + tid * 16) = xs0; *(LAS v4u*)((ldsp)XA + (tid + 512) * 16) = xs1; if (tid < 24) *(LAS v4u*)((ldsp)XA + (tid + 1024) * 16) = xs2;
        __syncthreads();
        { const int c = tid & 63; const float w0 = PAR[c], w1 = PAR[64 + c], w2 = PAR[128 + c], w3 = PAR[192 + c], cb = PAR[256 + c];
#pragma unroll 4
          for (int k = 0; k < 16; ++k) { const int t = (tid >> 6) + 8 * k;
              const float x0 = __uint_as_float((unsigned)XA[t * 64 + c] << 16), x1 = __uint_as_float((unsigned)XA[(t + 1) * 64 + c] << 16),
                          x2 = __uint_as_float((unsigned)XA[(t + 2) * 64 + c] << 16), x3 = __uint_as_float((unsigned)XA[(t + 3) * 64 + c] << 16);
              const float xc = cb + w0 * x0 + w1 * x1 + w2 * x2 + w3 * x3;
              XF[t * 64 + c] = xc; ((LAS bf16*)XC)[t * 72 + c] = (bf16)f2bf(xc); } }
        __syncthreads();
        if (n + 1 < 32) LRU_ISSUE(t0 + 128);
        bf16 gt[16];
#pragma unroll
        for (int k = 0; k < 16; ++k) gt[k] = proj[pidx(row00 + t0 + 16 * w + k, C_GA + c0 + e)];
        { const int tt = w >> 1, et = w & 1;
          f32x16 gr = zero16(), gi = zero16();
#pragma unroll
          for (int s = 0; s < 4; ++s) {
              const bf16x8 a = *(const LAS bf16x8*)(XC + (32 * tt + r32) * 144 + (16 * s + 8 * hi) * 2);
              const bf16x8 br = *(const LAS bf16x8*)(WT + (32 * et + r32) * 144 + (16 * s + 8 * hi) * 2);
              const bf16x8 bi = *(const LAS bf16x8*)(WT + 9216 + (32 * et + r32) * 144 + (16 * s + 8 * hi) * 2);
              gr = mfma32(a, br, gr); gi = mfma32(a, bi, gi); }
          const int ee = 32 * et + r32; const float bar_ = PAR[320 + ee], bxr = PAR[384 + ee], sp = PAR[448 + ee];
#pragma unroll
          for (int r = 0; r < 16; ++r) { const int t = 32 * tt + (r & 3) + 8 * (r >> 2) + 4 * hi;
              const float xc = XF[t * 64 + ee];
              const float rg = fast_sigmoid(gr[r] + bar_), ig = fast_sigmoid(gi[r] + bxr);
              const float la = -8.0f * rg * sp, a = __expf(la), x2 = 2.0f * la;
              const float em_series = -x2 * (1.0f + x2 * (0.5f + x2 * (0.16666667f + x2 * (0.041666668f + x2 * (0.008333334f + x2 * 0.0013888889f)))));
              const float em = x2 < -0.25f ? 1.0f - a * a : em_series;
              AF[t * 64 + ee] = a; XF[t * 64 + ee] = sqrtf(em) * ig * xc; } }
        __syncthreads();
        { float A = 1.f, H = 0.f;
#pragma unroll
          for (int k = 0; k < 16; ++k) { const int t = 16 * w + k; const float a = AF[t * 64 + e], u = XF[t * 64 + e]; H = a * H + u; A *= a; }
          SEG[(w * 64 + e) * 2] = A; SEG[(w * 64 + e) * 2 + 1] = H; }
        __syncthreads();
        float hs = hcarry, hst = 0.f;
#pragma unroll
        for (int s = 0; s < 8; ++s) { const float A = SEG[(s * 64 + e) * 2], H = SEG[(s * 64 + e) * 2 + 1]; if (s == w) hst = hs; hs = A * hs + H; }
        hcarry = hs;
        float hh = hst;
#pragma unroll
        for (int k = 0; k < 16; ++k) { const int t = 16 * w + k; hh = AF[t * 64 + e] * hh + XF[t * 64 + e];
            yp[(size_t)(t0 + t) * 1024 + e] = (bf16)f2bf(hh * __uint_as_float((unsigned)gt[k] << 16)); }
    }
#undef LRU_ISSUE
}

typedef float f32x2 __attribute__((ext_vector_type(2)));
struct AttS { f32x16 O0, O1, O2, O3, p0, p1; bf16x8 pf0, pf1, pf2, pf3; bf16x8 k0, k1, k2, k3, k4, k5, k6, k7; float mref, l, alpha; int rp; };
#define ATT_THR 8.0f
constexpr int ATT_V0 = 0, ATT_K0 = 49152, ATT_SLOT = 16384;
#define ATT_PIN(X_) asm volatile("" : "+v"(X_))
#define ATT_SB() __builtin_amdgcn_sched_barrier(0)
__device__ __forceinline__ float attn_rowmax(const f32x16& a, const f32x16& b) {
    float d = fmaxf(a[0], b[0]);
#pragma unroll
    for (int r = 1; r < 16; ++r) d = fmaxf(d, fmaxf(a[r], b[r]));
    return half_max(d);
}
__device__ __forceinline__ int attn_rowmax_bits(const f32x16& a, const f32x16& b) {
    int d = max(__float_as_int(a[0]), __float_as_int(b[0]));
#pragma unroll
    for (int r = 1; r < 16; ++r) d = max(d, max(__float_as_int(a[r]), __float_as_int(b[r])));
    unsigned x = (unsigned)d, y = x; pg8::half_swap(x, y);
    return max((int)x, (int)y);
}
template <int B> __device__ __forceinline__ f32x2 attn_sum8(const f32x16& a, f32x2 s) {
#pragma unroll
    for (int r = B; r < B + 8; r += 2) s += (f32x2){a[r], a[r + 1]};
    return s;
}
#define ATT_EXP4(P_, B_) do { _Pragma("unroll") for (int r_ = 0; r_ < 4; ++r_) P_[(B_) + r_] = __builtin_amdgcn_exp2f(P_[(B_) + r_]); } while (0)
#define ATT_SUB4(P_, B_) do { _Pragma("unroll") for (int r_ = 0; r_ < 4; ++r_) P_[(B_) + r_] -= st.mref; } while (0)
#define ATT_VF(TV_, KS, ET) cat8(trr((TV_) + 4096 * (ET) + 1024 * (KS)), trr((TV_) + 4096 * (ET) + 1024 * (KS) + 512))
#define ATT_KF(RK_, O_) (*(const LAS bf16x8*)((RK_) + (O_)))
#define ATT_MASK(Q0_, Q1_, t_) do { const int kb_ = 64 * (t_); \
        if (kb_ + 63 > qw) { const int dq_ = qw + r32 - kb_ - 4 * hi; const float NEG_ = -__builtin_inff(); \
            _Pragma("unroll") for (int r_ = 0; r_ < 16; ++r_) { const int cr_ = (r_ & 3) + 8 * (r_ >> 2); if (cr_ > dq_) Q0_[r_] = NEG_; if (cr_ + 32 > dq_) Q1_[r_] = NEG_; } } } while (0)
#define ATT_OSCALE() do { if (st.rp) { _Pragma("unroll") for (int r_ = 0; r_ < 16; ++r_) { st.O0[r_] *= st.alpha; st.O1[r_] *= st.alpha; st.O2[r_] *= st.alpha; st.O3[r_] *= st.alpha; } } } while (0)
#define ATT_EXP1(Q0_, Q1_, I_) do { if ((I_) < 16) Q0_[(I_) & 15] = __builtin_amdgcn_exp2f(Q0_[(I_) & 15]); else Q1_[(I_) & 15] = __builtin_amdgcn_exp2f(Q1_[(I_) & 15]); } while (0)
#define ATT_EXP3(Q0_, Q1_, I_) do { ATT_EXP1(Q0_, Q1_, (I_)); ATT_EXP1(Q0_, Q1_, (I_) + 1); ATT_EXP1(Q0_, Q1_, (I_) + 2); } while (0)
__device__ __forceinline__ f32x16 attn_splat(const float v) { f32x16 z;
#pragma unroll
    for (int i = 0; i < 16; ++i) z[i] = v; return z; }
__device__ __forceinline__ void attn_step(AttS& st, const int t, const int qw, const int r32, const int hi, const bf16x8 (&qf)[4], ldsp tv, ldsp rn0, ldsp rn1, ldsp rn2, ldsp rn3) {
    ATT_OSCALE();
    const f32x16 negm = attn_splat(-st.mref);
    f32x16 q0 = mfma32(st.k0, qf[0], negm); bf16x8 va0 = ATT_VF(tv, 0, 0);
    f32x16 q1 = mfma32(st.k1, qf[0], negm); bf16x8 va1 = ATT_VF(tv, 0, 1);
    ATT_SB();
    q0 = mfma32(st.k2, qf[1], q0); bf16x8 va2 = ATT_VF(tv, 0, 2);
    q1 = mfma32(st.k3, qf[1], q1); bf16x8 va3 = ATT_VF(tv, 0, 3);
    ATT_SB();
    q0 = mfma32(st.k4, qf[2], q0); bf16x8 vb0 = ATT_VF(tv, 1, 0);
    q1 = mfma32(st.k5, qf[2], q1); bf16x8 vb1 = ATT_VF(tv, 1, 1);
    st.pf2 = pack8<0>(st.p1); ATT_PIN(st.pf2);
    ATT_SB();
    q0 = mfma32(st.k6, qf[3], q0); bf16x8 vb2 = ATT_VF(tv, 1, 2);
    q1 = mfma32(st.k7, qf[3], q1); bf16x8 vb3 = ATT_VF(tv, 1, 3);
    st.pf3 = pack8<8>(st.p1); ATT_PIN(st.pf3);
    ATT_SB();
    ATT_MASK(q0, q1, t);
    st.O0 = mfma32(va0, st.pf0, st.O0); va0 = ATT_VF(tv, 2, 0); ATT_EXP3(q0, q1, 0);
    ATT_SB();
    st.O1 = mfma32(va1, st.pf0, st.O1); va1 = ATT_VF(tv, 2, 1); ATT_EXP3(q0, q1, 3);
    ATT_SB();
    st.O2 = mfma32(va2, st.pf0, st.O2); va2 = ATT_VF(tv, 2, 2); ATT_EXP3(q0, q1, 6);
    ATT_SB();
    st.O3 = mfma32(va3, st.pf0, st.O3); va3 = ATT_VF(tv, 2, 3); ATT_EXP3(q0, q1, 9);
    ATT_SB();
    st.O0 = mfma32(vb0, st.pf1, st.O0); vb0 = ATT_VF(tv, 3, 0); ATT_EXP3(q0, q1, 12);
    ATT_SB();
    st.O1 = mfma32(vb1, st.pf1, st.O1); vb1 = ATT_VF(tv, 3, 1); ATT_EXP3(q0, q1, 15);
    ATT_PIN(q0);
    ATT_SB();
    st.O2 = mfma32(vb2, st.pf1, st.O2); vb2 = ATT_VF(tv, 3, 2); ATT_EXP3(q0, q1, 18);
    ATT_SB();
    st.O3 = mfma32(vb3, st.pf1, st.O3); vb3 = ATT_VF(tv, 3, 3); ATT_EXP3(q0, q1, 21);
    ATT_SB();
    st.O0 = mfma32(va0, st.pf2, st.O0); ATT_EXP3(q0, q1, 24); ATT_EXP1(q0, q1, 27);
    ATT_SB();
    st.O1 = mfma32(va1, st.pf2, st.O1); ATT_EXP3(q0, q1, 28); ATT_EXP1(q0, q1, 31);
    ATT_PIN(q1);
    ATT_SB();
    st.O2 = mfma32(va2, st.pf2, st.O2);
    f32x2 ps = attn_sum8<0>(q0, (f32x2){0.f, 0.f}); ps = attn_sum8<8>(q0, ps); ATT_PIN(ps);
    ATT_SB();
    st.O3 = mfma32(va3, st.pf2, st.O3);
    ps = attn_sum8<0>(q1, ps); ps = attn_sum8<8>(q1, ps);
    float psum = ps.x + ps.y; ATT_PIN(psum);
    ATT_SB();
    const bool resc = __any(psum > 256.0f);
    st.rp = resc; st.alpha = 1.f;
    if (resc) {
        const f32x16 nm2 = attn_splat(-st.mref);
        q0 = mfma32(st.k0, qf[0], nm2); q1 = mfma32(st.k1, qf[0], nm2);
        q0 = mfma32(st.k2, qf[1], q0); q1 = mfma32(st.k3, qf[1], q1);
        q0 = mfma32(st.k4, qf[2], q0); q1 = mfma32(st.k5, qf[2], q1);
        q0 = mfma32(st.k6, qf[3], q0); q1 = mfma32(st.k7, qf[3], q1);
        ATT_MASK(q0, q1, t);
        const float d = attn_rowmax(q0, q1);
        const float dl = fmaxf(d, 0.f); st.mref += dl; st.alpha = __builtin_amdgcn_exp2f(-dl); st.l *= st.alpha;
#pragma unroll
        for (int r = 0; r < 16; ++r) { q0[r] = __builtin_amdgcn_exp2f(q0[r] - dl); q1[r] = __builtin_amdgcn_exp2f(q1[r] - dl); }
        f32x2 p2 = attn_sum8<0>(q0, (f32x2){0.f, 0.f}); p2 = attn_sum8<8>(q0, p2); p2 = attn_sum8<0>(q1, p2); p2 = attn_sum8<8>(q1, p2); psum = p2.x + p2.y;
    }
    st.l += psum;
    st.O0 = mfma32(vb0, st.pf3, st.O0); st.k0 = ATT_KF(rn0, 0); st.k1 = ATT_KF(rn0, 8192);
    ATT_PIN(st.l);
    ATT_SB();
    st.O1 = mfma32(vb1, st.pf3, st.O1); st.k2 = ATT_KF(rn1, 0); st.k3 = ATT_KF(rn1, 8192);
    ATT_SB();
    st.O2 = mfma32(vb2, st.pf3, st.O2); st.k4 = ATT_KF(rn2, 0); st.k5 = ATT_KF(rn2, 8192);
    st.pf0 = pack8<0>(q0); ATT_PIN(st.pf0);
    ATT_SB();
    st.O3 = mfma32(vb3, st.pf3, st.O3); st.k6 = ATT_KF(rn3, 0); st.k7 = ATT_KF(rn3, 8192);
    st.pf1 = pack8<8>(q0); ATT_PIN(st.pf1);
    ATT_SB();
    st.p1 = q1;
}
__device__ __forceinline__ void attn_unit(const int tid, ldsp lds, int b, int h, int qb, const bf16* proj, bf16* yc, const float* lamp, const float* subg) {
    const int lane = tid & 63, w = __builtin_amdgcn_readfirstlane(tid >> 6), r32 = lane & 31, hi = lane >> 5;
    const int c = w >> 2, it = w & 3;
    const int qw = qb * 128 + 32 * it, NT = 2 * qb + 2;
    const int row00 = b * SEQ, hcol = h * 128;
    bf16x8 qf[4];
#pragma unroll
    for (int s = 0; s < 4; ++s) qf[s] = *(const bf16x8*)(proj + pidx(row00 + qw + r32, C_QD + hcol + 64 * c + 16 * s + 8 * hi));
    ldsp rk0 = lds + ATT_K0 + offb(r32, 8 * c + 0 + hi), rk1 = lds + ATT_K0 + offb(r32, 8 * c + 2 + hi), rk2 = lds + ATT_K0 + offb(r32, 8 * c + 4 + hi), rk3 = lds + ATT_K0 + offb(r32, 8 * c + 6 + hi);
    ldsp tvb = lds + ATT_V0 + (4 * hi + ((lane & 15) >> 2)) * 64 + 32 * ((lane >> 4) & 1) + 8 * (lane & 3);
    const int kr0 = 8 * w + (lane >> 4), kc0 = (lane & 15) ^ (((kr0 & 3) << 2) | ((kr0 >> 2) & 3)), kr1 = kr0 + 4, kc1 = (lane & 15) ^ (((kr1 & 3) << 2) | ((kr1 >> 2) & 3));
    const unsigned oK0 = 2u * (unsigned)pidx(kr0, C_KD + hcol + 8 * kc0), oK1 = 2u * (unsigned)pidx(kr1, C_KD + hcol + 8 * kc1);
    const unsigned oV0 = 2u * (unsigned)pidx(32 * (w & 1) + (lane >> 2), C_VD + hcol + 32 * (w >> 1) + 8 * (lane & 3));
    const unsigned char* gb = (const unsigned char*)(proj + (size_t)(row00 >> 4) * PBROW);
    const int dK = 2048 * w, dV = 4096 * (w >> 1) + 2048 * (w & 1);
    const unsigned ldsb = (unsigned)__builtin_amdgcn_readfirstlane((int)(unsigned)(unsigned long long)lds);
#define ATT_GLDS(g_, d_) do { unsigned keep_; asm volatile("s_mov_b32 %0, m0\n\ts_mov_b32 m0, %2\n\ts_nop 0\n\tglobal_load_lds_dwordx4 %1, off\n\ts_mov_b32 m0, %0" : "=&s"(keep_) : "v"(g_), "s"(d_) : "memory"); } while (0)
#define ATT_DMA_K(tk_, so_) do { const unsigned char* p_ = gb + (size_t)(4 * (tk_)) * (2 * PBROW); const unsigned d_ = ldsb + ATT_K0 + (so_) + dK; \
        ATT_GLDS(p_ + oK0, d_); ATT_GLDS(p_ + oK1, d_ + 1024u); } while (0)
#define ATT_DMA_V(tv_, so_) do { const unsigned char* p_ = gb + (size_t)(4 * (tv_)) * (2 * PBROW); const unsigned d_ = ldsb + ATT_V0 + (so_) + dV; \
        ATT_GLDS(p_ + oV0, d_); ATT_GLDS(p_ + oV0 + 2 * PBROW, d_ + 1024u); } while (0)
#define ATT_WAITBAR() do { asm volatile("s_waitcnt vmcnt(4) lgkmcnt(0)" ::: "memory"); __builtin_amdgcn_s_barrier(); asm volatile("" ::: "memory"); } while (0)
    const int TL = NT - 1;
    ATT_DMA_K(0, 0);
    ATT_DMA_K(1, ATT_SLOT);
    { const int t2 = 2 < TL ? 2 : TL; ATT_DMA_K(t2, 2 * ATT_SLOT); }
    ATT_DMA_V(0, 0);
    AttS st; st.O0 = zero16(); st.O1 = zero16(); st.O2 = zero16(); st.O3 = zero16();
    st.mref = 0.f; st.l = 0.f; st.alpha = 1.f; st.rp = 0;
    asm volatile("s_waitcnt vmcnt(6)" ::: "memory"); __builtin_amdgcn_s_barrier(); asm volatile("" ::: "memory");
    st.k0 = ATT_KF(rk0, 0); st.k1 = ATT_KF(rk0, 8192); st.k2 = ATT_KF(rk1, 0); st.k3 = ATT_KF(rk1, 8192);
    st.k4 = ATT_KF(rk2, 0); st.k5 = ATT_KF(rk2, 8192); st.k6 = ATT_KF(rk3, 0); st.k7 = ATT_KF(rk3, 8192);
    ATT_WAITBAR();
    { const int t3 = 3 < TL ? 3 : TL, t1 = 1 < TL ? 1 : TL; ATT_DMA_K(t3, 0); ATT_DMA_V(t1, ATT_SLOT); }
    st.p0 = mfma32(st.k0, qf[0], zero16()); st.p1 = mfma32(st.k1, qf[0], zero16());
    st.p0 = mfma32(st.k2, qf[1], st.p0); st.p1 = mfma32(st.k3, qf[1], st.p1);
    st.p0 = mfma32(st.k4, qf[2], st.p0); st.p1 = mfma32(st.k5, qf[2], st.p1);
    st.p0 = mfma32(st.k6, qf[3], st.p0); st.p1 = mfma32(st.k7, qf[3], st.p1);
    ATT_SB();
    st.k0 = ATT_KF(rk0, ATT_SLOT); st.k1 = ATT_KF(rk0, ATT_SLOT + 8192); st.k2 = ATT_KF(rk1, ATT_SLOT); st.k3 = ATT_KF(rk1, ATT_SLOT + 8192);
    st.k4 = ATT_KF(rk2, ATT_SLOT); st.k5 = ATT_KF(rk2, ATT_SLOT + 8192); st.k6 = ATT_KF(rk3, ATT_SLOT); st.k7 = ATT_KF(rk3, ATT_SLOT + 8192);
    ATT_MASK(st.p0, st.p1, 0);
    st.mref = attn_rowmax(st.p0, st.p1);
#pragma unroll
    for (int r = 0; r < 16; ++r) { st.p0[r] = __builtin_amdgcn_exp2f(st.p0[r] - st.mref); st.p1[r] = __builtin_amdgcn_exp2f(st.p1[r] - st.mref); }
    { f32x2 ps = attn_sum8<0>(st.p0, (f32x2){0.f, 0.f}); ps = attn_sum8<8>(st.p0, ps); ps = attn_sum8<0>(st.p1, ps); ps = attn_sum8<8>(st.p1, ps); st.l += ps.x + ps.y; }
    st.pf0 = pack8<0>(st.p0); st.pf1 = pack8<8>(st.p0);
    ATT_PIN(st.pf0); ATT_PIN(st.pf1); ATT_PIN(st.p1);
    int sa = ATT_SLOT, sb = 2 * ATT_SLOT, sc = 0;
    for (int t = 1; t <= TL; ++t) {
        ATT_WAITBAR();
        { const int tk = t + 3 < TL ? t + 3 : TL, tv = t + 1 < TL ? t + 1 : TL; ATT_DMA_K(tk, sa); ATT_DMA_V(tv, sb); }
        attn_step(st, t, qw, r32, hi, qf, tvb + sc, rk0 + sb, rk1 + sb, rk2 + sb, rk3 + sb);
        const int s0 = sa; sa = sb; sb = sc; sc = s0;
    }
    ATT_WAITBAR();
    ATT_OSCALE();
    st.pf2 = pack8<0>(st.p1); st.pf3 = pack8<8>(st.p1);
    { ldsp tv = tvb + sc;
      { const bf16x8 v0 = ATT_VF(tv, 0, 0), v1 = ATT_VF(tv, 0, 1), v2 = ATT_VF(tv, 0, 2), v3 = ATT_VF(tv, 0, 3);
        st.O0 = mfma32(v0, st.pf0, st.O0); st.O1 = mfma32(v1, st.pf0, st.O1); st.O2 = mfma32(v2, st.pf0, st.O2); st.O3 = mfma32(v3, st.pf0, st.O3); }
      { const bf16x8 v0 = ATT_VF(tv, 1, 0), v1 = ATT_VF(tv, 1, 1), v2 = ATT_VF(tv, 1, 2), v3 = ATT_VF(tv, 1, 3);
        st.O0 = mfma32(v0, st.pf1, st.O0); st.O1 = mfma32(v1, st.pf1, st.O1); st.O2 = mfma32(v2, st.pf1, st.O2); st.O3 = mfma32(v3, st.pf1, st.O3); }
      { const bf16x8 v0 = ATT_VF(tv, 2, 0), v1 = ATT_VF(tv, 2, 1), v2 = ATT_VF(tv, 2, 2), v3 = ATT_VF(tv, 2, 3);
        st.O0 = mfma32(v0, st.pf2, st.O0); st.O1 = mfma32(v1, st.pf2, st.O1); st.O2 = mfma32(v2, st.pf2, st.O2); st.O3 = mfma32(v3, st.pf2, st.O3); }
      { const bf16x8 v0 = ATT_VF(tv, 3, 0), v1 = ATT_VF(tv, 3, 1), v2 = ATT_VF(tv, 3, 2), v3 = ATT_VF(tv, 3, 3);
        st.O0 = mfma32(v0, st.pf3, st.O0); st.O1 = mfma32(v1, st.pf3, st.O1); st.O2 = mfma32(v2, st.pf3, st.O2); st.O3 = mfma32(v3, st.pf3, st.O3); } }
#undef ATT_GLDS
#undef ATT_DMA_K
#undef ATT_DMA_V
#undef ATT_WAITBAR
    const float l = half_sum(st.l);
    const float inv = 1.0f / l;
    int tid_e = tid; LAUNDER_V(tid_e);
    const int lane_e = tid_e & 63, r32e = lane_e & 31, hie = lane_e >> 5;
    u32x2 gpre[16]; f32x4 spre[16];
    if (c == 0) { const bf16* grow = proj + pidx(row00 + qw + r32e, C_GD + hcol + 4 * hie); const float* sgp = subg + 4 * hie;
#pragma unroll
        for (int et = 0; et < 4; ++et)
#pragma unroll
            for (int q4 = 0; q4 < 4; ++q4) { gpre[4 * et + q4] = *(const u32x2*)(grow + 512 * et + 8 * q4); spre[4 * et + q4] = *(const f32x4*)(sgp + 32 * et + 8 * q4); }
        asm volatile("s_waitcnt vmcnt(32) lgkmcnt(0)" ::: "memory"); }
    else asm volatile("s_waitcnt vmcnt(0) lgkmcnt(0)" ::: "memory");
    __builtin_amdgcn_s_barrier(); asm volatile("" ::: "memory");
#define ATT_BAR() do { asm volatile("s_waitcnt lgkmcnt(0)" ::: "memory"); __builtin_amdgcn_s_barrier(); asm volatile("" ::: "memory"); } while (0)
    LAS float* XB = (LAS float*)lds + it * 4096 + lane_e;
    const float lam = lamp[0], oml = lamp[1];
    if (c == 1) { const float f = lam * inv;
#pragma unroll
        for (int r = 0; r < 16; ++r) { XB[(0 * 16 + r) * 64] = st.O0[r] * f; XB[(1 * 16 + r) * 64] = st.O1[r] * f; XB[(2 * 16 + r) * 64] = st.O2[r] * f; XB[(3 * 16 + r) * 64] = st.O3[r] * f; } }
    ATT_BAR();
    if (c == 0) {
        float ss = 0.f;
#pragma unroll
        for (int r = 0; r < 16; ++r) {
            st.O0[r] = st.O0[r] * inv - XB[(0 * 16 + r) * 64]; st.O1[r] = st.O1[r] * inv - XB[(1 * 16 + r) * 64];
            st.O2[r] = st.O2[r] * inv - XB[(2 * 16 + r) * 64]; st.O3[r] = st.O3[r] * inv - XB[(3 * 16 + r) * 64];
            ss += st.O0[r] * st.O0[r] + st.O1[r] * st.O1[r] + st.O2[r] * st.O2[r] + st.O3[r] * st.O3[r]; }
        ss = half_sum(ss);
        const float rs = rsqrtf(ss * (1.f / 128.f) + EPS) * oml;
        const size_t rowl = (size_t)(qw + r32e);
        bf16* yrow = yc + ((size_t)b * SEQ + rowl) * 1024 + h * 128 + 4 * hie;
#pragma unroll
        for (int et = 0; et < 4; ++et)
#pragma unroll
            for (int q4 = 0; q4 < 4; ++q4) {
                const f32x16& A = et == 0 ? st.O0 : et == 1 ? st.O1 : et == 2 ? st.O2 : st.O3;
                const int e0 = 32 * et + 8 * q4;
                const f32x4 sg4 = spre[4 * et + q4]; const u32x2 g = gpre[4 * et + q4];
                u32x2 o; o.x = cvt_pk_bf16(A[4 * q4] * rs * sg4.x * bf_lo(g.x), A[4 * q4 + 1] * rs * sg4.y * bf_hi(g.x));
                o.y = cvt_pk_bf16(A[4 * q4 + 2] * rs * sg4.z * bf_lo(g.y), A[4 * q4 + 3] * rs * sg4.w * bf_hi(g.y));
                *(u32x2*)(yrow + e0) = o;
            }
    }
#undef ATT_BAR
#undef ATT_PIN
#undef ATT_SB
#undef ATT_EXP4
#undef ATT_SUB4
#undef ATT_EXP1
#undef ATT_EXP3
#undef ATT_VF
#undef ATT_KF
#undef ATT_MASK
#undef ATT_OSCALE
}

__device__ __forceinline__ int fetch_item(const int tid, gu32* ctr, volatile LAS unsigned* slot) {
    __syncthreads();
    if (tid == 0) *slot = __hip_atomic_fetch_add(ctr, 1u, RLX_AGENT);
    __syncthreads();
    return __builtin_amdgcn_readfirstlane((int)*slot);
}

#ifndef G1_ALIGN
#define G1_ALIGN true
#endif
#ifndef G1_SP2
#define G1_SP2 true
#endif
#ifndef G3_ALIGN
#define G3_ALIGN true
#endif
#ifndef G3_SP2
#define G3_SP2 true
#endif
#ifndef G4_ALIGN
#define G4_ALIGN true
#endif
#ifndef G4_SP2
#define G4_SP2 true
#endif
#ifndef PROBE_DUP
#define PROBE_DUP 0
#endif
#ifndef PROBE_EMODE
#define PROBE_EMODE 0
#endif
#ifndef PROBE_AMODE
#define PROBE_AMODE 0
#endif
#ifndef PROBE_P2SEL
#define PROBE_P2SEL 0
#endif
#ifndef MK_N_LAUNCHES
#define MK_N_LAUNCHES 1
#endif
constexpr int N_PHASES = 1 + NGROUP * DEPTH * 5;
struct Args { const float* in[17]; float* out; unsigned char* ws; int ph_lo, ph_hi, li, pad; };
__global__ void __launch_bounds__(NWAVES * 64, 2) hyb_fwd(Args args) {
    extern __shared__ __attribute__((aligned(16))) unsigned char lds_raw[];
    ldsp lds = (ldsp)lds_raw;
    volatile LAS unsigned* MISC = (volatile LAS unsigned*)(lds + MISC_OFF);
    for (int u = threadIdx.x; u < (LDS_BYTES - LDSCTL_OFF) / 4; u += NWAVES * 64) ((LAS unsigned*)(lds + LDSCTL_OFF))[u] = 0u;
    __syncthreads();
    XcdBarrier bar = xcd_barrier_post((unsigned*)((gu32*)(args.ws + WS_CTL) + CW_BAR) + args.li * XCD_BAR_WORDS, MISC + 8, (unsigned)__builtin_amdgcn_readfirstlane((int)threadIdx.x >> 6));
    int tidc = threadIdx.x;
    const int lo = args.ph_lo, hi_ = args.ph_hi;
#define IN(k) (lo <= (k) && (k) < hi_)
#define BOTH(k) (IN(k) && IN((k) + 1))
#define PHASE_ENTRY() LAUNDER_V(tidc); const int tid = tidc; unsigned long long z_ = 0ull; LAUNDER_S(z_); unsigned char* ws = args.ws + z_; const int G = gridDim.x; \
    const int lane = tid & 63, wave = __builtin_amdgcn_readfirstlane(tid >> 6); (void)lane; (void)wave; (void)G

    if (IN(0)) {
        PHASE_ENTRY();
        const int gw = blockIdx.x * NWAVES + wave, NGW = G * NWAVES;
        float* lams = (float*)(ws + WS_LAMS);
        bf16* WIN = (bf16*)(ws + WS_WIN); bf16* WBR = (bf16*)(ws + WS_WBR); bf16* WOUT = (bf16*)(ws + WS_WOUT); bf16* HB = (bf16*)(ws + WS_H);
        LAS float* scr = (LAS float*)(lds + wave * 16384);
        constexpr int I_IN = (2048 / 64) * (16384 / 32), I_BR = (1024 / 64) * (2048 / 32), I_OUT = (2048 / 64) * (2048 / 32);
        constexpr int NITEMS = 2 * I_IN + 6 * I_BR + 2 * I_OUT;
        for (int it = gw; it < NITEMS; it += NGW) {
            int r = it;
            if (r < 2 * I_IN) { const int l = r / I_IN; r -= l * I_IN; p0_transpose_item(args.in[3] + (size_t)l * 2048 * 16384, 2048, 16384, WIN + (size_t)l * 16384 * 2048, scr, r, lane); continue; }
            r -= 2 * I_IN;
            if (r < 6 * I_BR) { const int lj = r / I_BR; r -= lj * I_BR; const int l = lj / 3, j = lj - 3 * l;
                const float* src = j == 0 ? args.in[13] : j == 1 ? args.in[14] : args.in[15];
                p0_transpose_item(src + (size_t)l * 1024 * 2048, 1024, 2048, WBR + (size_t)lj * 2048 * 1024, scr, r, lane); continue; }
            r -= 6 * I_BR;
            { const int l = r / I_OUT; r -= l * I_OUT; p0_transpose_item(args.in[16] + (size_t)l * 2048 * 2048, 2048, 2048, WOUT + (size_t)l * 2048 * 2048, scr, r, lane); }
        }
        if (blockIdx.x == 0 && wave == 0) {
            for (int l = 0; l < DEPTH; ++l) { const float* dl = args.in[11] + l * 256;
                const float s01 = wave_sum(dl[lane] * dl[64 + lane]), s23 = wave_sum(dl[128 + lane] * dl[192 + lane]);
                const float lam_init = 0.8f - 0.6f * __expf(-0.3f * (float)l);
                if (lane == 0) { lams[2 * l] = __expf(s01) - __expf(s23) + lam_init; lams[2 * l + 1] = 1.0f - lam_init; } }
        }
        { f32x4 gv[8];
#pragma unroll
          for (int j = 0; j < 4; ++j) { gv[2 * j] = *(const f32x4*)(args.in[1] + 512 * j + 8 * lane); gv[2 * j + 1] = *(const f32x4*)(args.in[1] + 512 * j + 8 * lane + 4); }
          for (int m = gw; m < M_ALL; m += NGW) rms_row_to_bf16(args.in[0] + (size_t)m * D_MODEL, gv, HB + (size_t)m * D_MODEL, lane); }
        if (BOTH(0)) xcd_barrier(bar);
    }

    for (int g = 0; g < NGROUP; ++g)
        for (int l = 0; l < DEPTH; ++l) {
            const int pb = 1 + (g * DEPTH + l) * 5;
            if (IN(pb)) {
                PHASE_ENTRY();
                pg8::SchedPlain S; S.so.init(TG, D_IN, G, (int)blockIdx.x); S.A = (const char*)(ws + WS_H) + (size_t)g * TG * D_MODEL * 2; S.Bt = (const char*)(ws + WS_WIN) + (size_t)l * D_IN * D_MODEL * 2;
                pg8::EpiProj E{(bf16*)(ws + WS_PROJ), (bf16*)(ws + WS_GM), (PROBE_DUP == 1 && args.li > 0 && pb == lo) ? PROBE_EMODE : 0};
#ifndef SKIP_P1
                pg8::gemm_phase<pg8::EpiProj, pg8::SchedPlain, G1_ALIGN, G1_SP2>(lds, D_MODEL, S, E, tid);
#endif
                if (BOTH(pb)) xcd_barrier(bar);
            }
            if (IN(pb + 1)) {
                const bool only = PROBE_DUP == 2 && PROBE_P2SEL != 0 && args.li > 0 && (pb + 1) == lo;
#ifndef SKIP_RET
                if (!only || PROBE_P2SEL == 1) { PHASE_ENTRY(); gu32* q = (gu32*)(ws + WS_CTL) + CW_Q + 64 * 3 * (g * DEPTH + l) + args.li * 1024;
                  const bf16* PROJ = (const bf16*)(ws + WS_PROJ); bf16* YB = (bf16*)(ws + WS_Y);
                  for (;;) { LAUNDER_V(tidc); const int t2 = tidc; const int it = fetch_item(t2, q, MISC + 16); if (it >= BG * 8) break; ret_unit(t2, lds, it >> 3, it & 7, PROJ, YB + (size_t)TG * 1024); } }
#endif
#ifndef SKIP_LRU
                if (!only || PROBE_P2SEL == 2) { PHASE_ENTRY(); gu32* q = (gu32*)(ws + WS_CTL) + CW_Q + 64 * 3 * (g * DEPTH + l) + args.li * 1024;
                  const bf16* PROJ = (const bf16*)(ws + WS_PROJ); bf16* YB = (bf16*)(ws + WS_Y);
                  for (;;) { LAUNDER_V(tidc); const int t2 = tidc; const int it = fetch_item(t2, q + 64, MISC + 16); if (it >= BG * 16) break;
                    lru_unit(t2, lds, it >> 4, it & 15, PROJ, YB, args.in[4] + l * 4096, args.in[5] + l * 1024, args.in[6] + (size_t)l * 65536, args.in[7] + l * 1024,
                             args.in[8] + (size_t)l * 65536, args.in[9] + l * 1024, args.in[10] + l * 1024); } }
#endif
#ifndef SKIP_ATT
                if (!only || PROBE_P2SEL == 3) { PHASE_ENTRY(); gu32* q = (gu32*)(ws + WS_CTL) + CW_Q + 64 * 3 * (g * DEPTH + l) + args.li * 1024;
                  const bf16* PROJ = (const bf16*)(ws + WS_PROJ); bf16* YB = (bf16*)(ws + WS_Y); const float* lams = (const float*)(ws + WS_LAMS);
                  int it; { LAUNDER_V(tidc); const int t2 = tidc; it = fetch_item(t2, q + 128, MISC + 16); }
                  while (it < BG * 8 * 32) { LAUNDER_V(tidc); const int t2 = tidc; const int qb = 31 - (it >> 5), bh = it & 31;
                    unsigned pend = 0u; if (t2 == 0) pend = __hip_atomic_fetch_add(q + 128, 1u, RLX_AGENT);
                    attn_unit(t2, lds, bh >> 3, bh & 7, qb, PROJ, YB + (size_t)2 * TG * 1024, lams + 2 * l, args.in[12] + l * 128);
                    LAUNDER_V(tidc); const int t3 = tidc; volatile LAS unsigned* slot = MISC + 16;
                    __syncthreads(); if (t3 == 0) *slot = pend; __syncthreads(); it = __builtin_amdgcn_readfirstlane((int)*slot); } }
#endif
                if (BOTH(pb + 1)) xcd_barrier(bar);
            }
            if (IN(pb + 2)) {
                PHASE_ENTRY();
                pg8::SchedBranch S; S.so.init(TG, D_MODEL, G, (int)blockIdx.x); S.A = (const char*)(ws + WS_Y); S.strideA = (size_t)TG * 1024 * 2;
                S.Bt = (const char*)(ws + WS_WBR) + (size_t)l * 3 * 2048 * 1024 * 2; S.strideB = (size_t)2048 * 1024 * 2;
                pg8::EpiMerge E{(const unsigned char*)(ws + WS_GM), (bf16*)(ws + WS_M)};
#ifndef SKIP_P3
                pg8::gemm_phase<pg8::EpiMerge, pg8::SchedBranch, G3_ALIGN, G3_SP2>(lds, 1024, S, E, tid);
#endif
                if (BOTH(pb + 2)) xcd_barrier(bar);
            }
            if (IN(pb + 3)) {
                PHASE_ENTRY();
                pg8::SchedPlain S; S.so.init(TG, D_MODEL, G, (int)blockIdx.x); S.A = (const char*)(ws + WS_M); S.Bt = (const char*)(ws + WS_WOUT) + (size_t)l * D_MODEL * D_MODEL * 2;
                pg8::EpiBf16Plain E{(bf16*)(ws + WS_O), D_MODEL};
#ifndef SKIP_P4
                pg8::gemm_phase<pg8::EpiBf16Plain, pg8::SchedPlain, G4_ALIGN, G4_SP2>(lds, D_MODEL, S, E, tid);
#endif
                if (BOTH(pb + 3)) xcd_barrier(bar);
            }
            if (IN(pb + 4)) {
                PHASE_ENTRY();
                const int gw = blockIdx.x * NWAVES + wave, NGW = G * NWAVES;
                const bool dead = __hip_atomic_load((gu32*)(ws + WS_CTL) + CW_BAR + XB_TMO, RLX_AGENT) != 0u;
                const bf16* OB = (const bf16*)(ws + WS_O); bf16* HB = (bf16*)(ws + WS_H); bf16* X1 = (bf16*)(ws + WS_X1);
                f32x4 pgv[8], ngv[8];
                { const float* pg = args.in[2] + l * D_MODEL + 8 * lane; const float* ng = args.in[1] + D_MODEL + 8 * lane;
#pragma unroll
                  for (int j = 0; j < 4; ++j) { pgv[2 * j] = *(const f32x4*)(pg + 512 * j); pgv[2 * j + 1] = *(const f32x4*)(pg + 512 * j + 4); ngv[2 * j] = *(const f32x4*)(ng + 512 * j); ngv[2 * j + 1] = *(const f32x4*)(ng + 512 * j + 4); } }
                for (int m = gw; m < TG; m += NGW) {
                    const size_t row = (size_t)g * TG + m;
                    const v4u* orow = (const v4u*)(OB + (size_t)m * D_MODEL) + lane;
                    f32x4 v[8]; float s = 0.f;
#pragma unroll
                    for (int j = 0; j < 4; ++j) { const v4u ow = orow[64 * j]; v[2 * j] = (f32x4){bf_lo(ow.x), bf_hi(ow.x), bf_lo(ow.y), bf_hi(ow.y)}; v[2 * j + 1] = (f32x4){bf_lo(ow.z), bf_hi(ow.z), bf_lo(ow.w), bf_hi(ow.w)}; }
#pragma unroll
                    for (int j = 0; j < 8; ++j) s += (v[j].x * v[j].x + v[j].y * v[j].y) + (v[j].z * v[j].z + v[j].w * v[j].w);
                    const float rs = rsqrtf(wave_sum(s) * (1.f / D_MODEL) + EPS);
                    if (l == 0) {
                        const float* xrow = args.in[0] + row * D_MODEL + 8 * lane; float s2 = 0.f;
                        v4u* x8 = (v4u*)(X1 + (size_t)m * D_MODEL) + lane;
#pragma unroll
                        for (int j = 0; j < 4; ++j) {
                            const f32x4 xa = *(const f32x4*)(xrow + 512 * j), xb = *(const f32x4*)(xrow + 512 * j + 4), ga = pgv[2 * j], gb = pgv[2 * j + 1];
                            v[2 * j] = xa + v[2 * j] * rs * ga; v[2 * j + 1] = xb + v[2 * j + 1] * rs * gb;
                            v4u wv; wv.x = cvt_pk_bf16(v[2 * j].x, v[2 * j].y); wv.y = cvt_pk_bf16(v[2 * j].z, v[2 * j].w); wv.z = cvt_pk_bf16(v[2 * j + 1].x, v[2 * j + 1].y); wv.w = cvt_pk_bf16(v[2 * j + 1].z, v[2 * j + 1].w);
                            x8[64 * j] = wv; }
#pragma unroll
                        for (int j = 0; j < 8; ++j) s2 += (v[j].x * v[j].x + v[j].y * v[j].y) + (v[j].z * v[j].z + v[j].w * v[j].w);
                        const float rs2 = rsqrtf(wave_sum(s2) * (1.f / D_MODEL) + EPS);
                        v4u* o8 = (v4u*)(HB + row * D_MODEL) + lane;
#pragma unroll
                        for (int j = 0; j < 4; ++j) { const f32x4 ga = ngv[2 * j], gb = ngv[2 * j + 1]; const f32x4 a = v[2 * j] * rs2 * ga, bq = v[2 * j + 1] * rs2 * gb;
                            v4u wv; wv.x = cvt_pk_bf16(a.x, a.y); wv.y = cvt_pk_bf16(a.z, a.w); wv.z = cvt_pk_bf16(bq.x, bq.y); wv.w = cvt_pk_bf16(bq.z, bq.w); o8[64 * j] = wv; }
                    } else {
                        const v4u* x8 = (const v4u*)(X1 + (size_t)m * D_MODEL) + lane;
                        float* drow = args.out + row * D_MODEL + 8 * lane;
#pragma unroll
                        for (int j = 0; j < 4; ++j) { const v4u xw = x8[64 * j]; const f32x4 ga = pgv[2 * j], gb = pgv[2 * j + 1];
                            f32x4 a = (f32x4){bf_lo(xw.x), bf_hi(xw.x), bf_lo(xw.y), bf_hi(xw.y)} + v[2 * j] * rs * ga, bq = (f32x4){bf_lo(xw.z), bf_hi(xw.z), bf_lo(xw.w), bf_hi(xw.w)} + v[2 * j + 1] * rs * gb;
                            if (dead) { const float qn = __builtin_nanf(""); a = (f32x4){qn, qn, qn, qn}; bq = a; }
                            *(f32x4*)(drow + 512 * j) = a; *(f32x4*)(drow + 512 * j + 4) = bq; }
                    }
                }
                if (BOTH(pb + 4)) xcd_barrier(bar);
            }
        }
#undef IN
#undef BOTH
#undef PHASE_ENTRY
}

extern "C" void kernel_launch(void* const* d_in, const int* in_sizes, int n_in, void* d_out, int out_size, void* d_ws, size_t ws_size, hipStream_t stream) {
    static int grid = 0;
    if (grid == 0) {
        if (n_in != 17 || in_sizes[0] != M_ALL * D_MODEL || out_size != M_ALL * D_MODEL || ws_size < WS_END) {
            fprintf(stderr, "kernel_launch: unexpected shapes (n_in %d, in0 %d, out %d, ws %zu < %zu); nothing launched\n", n_in, n_in > 0 ? in_sizes[0] : -1, out_size, ws_size, (size_t)WS_END); grid = -1; return; }
        int dev = 0, cus = 0, per_cu = 0;
        if (hipGetDevice(&dev) != hipSuccess || hipDeviceGetAttribute(&cus, hipDeviceAttributeMultiprocessorCount, dev) != hipSuccess) { grid = -1; return; }
        if (hipFuncSetAttribute((const void*)hyb_fwd, hipFuncAttributeMaxDynamicSharedMemorySize, LDS_BYTES) != hipSuccess) { fprintf(stderr, "kernel_launch: hipFuncSetAttribute failed\n"); grid = -1; return; }
        if (hipOccupancyMaxActiveBlocksPerMultiprocessor(&per_cu, (const void*)hyb_fwd, NWAVES * 64, LDS_BYTES) != hipSuccess || per_cu < 1)
            fprintf(stderr, "kernel_launch: note: occupancy query reports %d workgroups per CU\n", per_cu);
        (void)hipGetLastError();
        grid = cus;
    }
    if (grid < 0) return;
    if (hipMemsetAsync((char*)d_ws + WS_CTL, 0, CTL_ZERO_BYTES, stream) != hipSuccess) return;
    Args a{};
    for (int i = 0; i < 17; ++i) a.in[i] = (const float*)d_in[i];
    a.out = (float*)d_out; a.ws = (unsigned char*)d_ws;
#if PROBE_DUP > 0
    { int lo = 0; for (int k = 0; k <= NGROUP * DEPTH; ++k) { const int p = 1 + k * 5 + (PROBE_DUP - 1); const int hi = k < NGROUP * DEPTH ? p + 1 : N_PHASES;
        a.ph_lo = lo; a.ph_hi = hi; a.li = k; a.pad = 0; hipLaunchKernelGGL(hyb_fwd, dim3(grid), dim3(NWAVES * 64), LDS_BYTES, stream, a); lo = p; } }
#elif MK_N_LAUNCHES == 1
    a.ph_lo = 0; a.ph_hi = N_PHASES; a.li = 0; a.pad = 0;
    hipLaunchKernelGGL(hyb_fwd, dim3(grid), dim3(NWAVES * 64), LDS_BYTES, stream, a);
#else
    for (int p = 0; p < N_PHASES; ++p) { a.ph_lo = p; a.ph_hi = p + 1; a.li = 0; a.pad = 0;
        hipLaunchKernelGGL(hyb_fwd, dim3(grid), dim3(NWAVES * 64), LDS_BYTES, stream, a); }
#endif
}
```

```cpp
#include <hip/hip_runtime.h>
#include <cstdio>
#include <cstdint>

namespace pg8 {
#define PG8_LAS __attribute__((address_space(3)))
typedef unsigned short bf16_t;
typedef short bf16x8 __attribute__((ext_vector_type(8)));
typedef float f32x4 __attribute__((ext_vector_type(4)));
typedef unsigned u32x4 __attribute__((ext_vector_type(4)));
constexpr int BM = 256, BK = 64, HALF = 128, HTB = HALF * BK * 2  , STAGE_BYTES = 8 * HTB, NXCD = 8, WGM = 8;

__host__ __device__ __forceinline__ int lds_byte(int r, int c) { const int st = (r >> 4) * 2 + (c >> 5), rr = r & 15, cc = c & 31, ob = rr * 64 + cc * 2; return st * 1024 + (ob ^ (((ob >> 9) & 1) << 5)); }
__host__ __device__ __forceinline__ void stage_rc(int b, int& R, int& C) { const int st = b / 1024, sb = b % 1024, swz = sb ^ (((sb >> 9) & 1) << 5); R = (st >> 1) * 16 + swz / 64; C = (st & 1) * 32 + (swz % 64) / 2; }
__host__ __device__ __forceinline__ int perm32(int rho) { const int n = rho >> 4, i = rho & 15; return 8 * (i >> 2) + 4 * n + (i & 3); }

struct Unit { int pm, pn, sel; };

struct StaticOrder {
    int nM, nN, nwg, G, c;
    __host__ __device__ void init(int M, int N, int G_, int c_) { nM = M / BM; nN = N / BM; nwg = nM * nN; G = G_; c = c_; }
    __host__ __device__ bool next(int i, Unit& u) const {
        const long L = (long)i * G + c; if (L >= nwg) return false;
        int wgid = (int)L; { const int q = nwg / NXCD, r = nwg % NXCD, xcd = wgid % NXCD, off = wgid / NXCD; wgid = (xcd < r ? xcd * (q + 1) : r * (q + 1) + (xcd - r) * q) + off; }
        const int nig = WGM * nN, gid = wgid / nig, fm = gid * WGM, gsz = (nM - fm) < WGM ? (nM - fm) : WGM;
        u.pm = fm + ((wgid % nig) % gsz); u.pn = (wgid % nig) / gsz; u.sel = 0; return true;
    }
};
struct SchedPlain {
    StaticOrder so; const char* A; const char* Bt;
    __device__ __forceinline__ bool next(int i, Unit& u) const { return so.next(i, u); }
    __device__ __forceinline__ const char* a_base(const Unit& u, size_t tstep) const { return A + (size_t)u.pm * tstep; }
    __device__ __forceinline__ const char* b_base(const Unit& u, size_t tstep) const { return Bt + (size_t)u.pn * tstep; }
    __device__ __forceinline__ bool keep(const Unit&) const { return false; }
    __device__ __forceinline__ void a_ready(const Unit&) const {}
    __device__ __forceinline__ void done(const Unit&) const {}
};
struct SchedBranch {
    StaticOrder so; const char* A; const char* Bt; size_t strideA, strideB;
    __device__ __forceinline__ bool next(int i, Unit& u) const { const int t = i / 3; if (!so.next(t, u)) return false; u.sel = i - 3 * t; return true; }
    __device__ __forceinline__ const char* a_base(const Unit& u, size_t tstep) const { return A + (size_t)u.sel * strideA + (size_t)u.pm * tstep; }
    __device__ __forceinline__ const char* b_base(const Unit& u, size_t tstep) const { return Bt + (size_t)u.sel * strideB + (size_t)u.pn * tstep; }
    __device__ __forceinline__ bool keep(const Unit& u) const { return u.sel < 2; }
    __device__ __forceinline__ void a_ready(const Unit&) const {}
    __device__ __forceinline__ void done(const Unit&) const {}
};

typedef float f32x2_cv __attribute__((ext_vector_type(2))); typedef __bf16 bf16x2_cv __attribute__((ext_vector_type(2)));
__device__ __forceinline__ unsigned cvt_pk_bf16(float lo, float hi) { const f32x2_cv v = {lo, hi}; const bf16x2_cv b = __builtin_convertvector(v, bf16x2_cv); return __builtin_bit_cast(unsigned, b); }
__device__ __forceinline__ float bf_lo(unsigned w) { return __uint_as_float(w << 16); }
__device__ __forceinline__ float bf_hi(unsigned w) { return __uint_as_float(w & 0xffff0000u); }
__device__ __forceinline__ float fast_sigmoid(float x) { return __builtin_amdgcn_rcpf(1.0f + __expf(-x)); }
__device__ __forceinline__ float fast_silu(float x) { return x * fast_sigmoid(x); }
__device__ __forceinline__ float lg2_gamma(int h) {
    const float x = __builtin_amdgcn_exp2f((float)(-5 - h));
    const float s = x * (1.0f + x * (0.5f + x * (0.33333334f + x * (0.25f + x * 0.2f))));
    return -s * 1.4426950408889634f;
}

template <int MASK> __device__ __forceinline__ float swz_xor(float v) { return __builtin_bit_cast(float, __builtin_amdgcn_ds_swizzle(__builtin_bit_cast(int, v), (MASK << 10) | 0x1f)); }
__device__ __forceinline__ float swz_xor16(float v) { return swz_xor<16>(v); }
__device__ __forceinline__ void half_swap(unsigned& a, unsigned& b) { asm volatile("s_nop 1\n\tv_permlane32_swap_b32 %0, %1" : "+v"(a), "+v"(b)); }
__device__ __forceinline__ float half_sum(float v) { unsigned a = __builtin_bit_cast(unsigned, v), b = a; half_swap(a, b); return __builtin_bit_cast(float, a) + __builtin_bit_cast(float, b); }
__device__ __forceinline__ float half_max(float v) { unsigned a = __builtin_bit_cast(unsigned, v), b = a; half_swap(a, b); return fmaxf(__builtin_bit_cast(float, a), __builtin_bit_cast(float, b)); }

__host__ __device__ __forceinline__ size_t blk_idx(int row, int col, int nbc  ) { return ((size_t)(row >> 4) * nbc + (col >> 5)) * 512 + (size_t)((row & 15) * 32 + (col & 31)); }

struct EpiF32 {
    static constexpr bool PERM = false, AFTER_DRAIN = false;
    float* C; int ldc;
    __device__ __forceinline__ void operator()(f32x4 (&acc)[2][2][4][2], const Unit& u, int wr, int wc, int fr, int fq) const {
        const int row0 = u.pm * BM + wr * 64 + fr, col0 = u.pn * BM + wc * 32 + 4 * fq;
#pragma unroll
        for (int ai = 0; ai < 2; ++ai)
#pragma unroll
            for (int m = 0; m < 4; ++m) { float* rowp = C + (size_t)(row0 + ai * HALF + m * 16) * ldc + col0;
#pragma unroll
                for (int bj = 0; bj < 2; ++bj)
#pragma unroll
                    for (int n = 0; n < 2; ++n) *(f32x4*)(rowp + bj * HALF + n * 16) = acc[ai][bj][m][n]; }
    }
};

__host__ __device__ __forceinline__ size_t gm8_idx(int row, int bc) { return ((size_t)(row >> 4) * 96 + (bc >> 6)) * 1024 + (size_t)((row & 15) * 64 + (bc & 63)); }
__device__ __forceinline__ unsigned gate_q8x4(const f32x4& g) {
    const unsigned q0 = max((unsigned)(g[0] * 255.f + 0.5f), 1u), q1 = max((unsigned)(g[1] * 255.f + 0.5f), 1u), q2 = max((unsigned)(g[2] * 255.f + 0.5f), 1u), q3 = max((unsigned)(g[3] * 255.f + 0.5f), 1u);
    return q0 | (q1 << 8) | (q2 << 16) | (q3 << 24); }
__device__ __forceinline__ f32x4 gate_unq4(unsigned w) { return (f32x4){(float)(w & 0xffu), (float)((w >> 8) & 0xffu), (float)((w >> 16) & 0xffu), (float)(w >> 24)}; }
struct EpiProj {
    static constexpr bool PERM = true, AFTER_DRAIN = false;
    bf16_t* proj; bf16_t* gm; int mode;
    template <int KIND> __device__ __forceinline__ void run(f32x4 (&acc)[2][2][4][2], const Unit& u, int wr, int wc, int fr, int fq) const {
        const int row0 = u.pm * BM + wr * 64 + fr, colt = u.pn * BM, cl = wc * 32 + 8 * fq;
        constexpr double FRD[8] = {0.15915494309189535, 0.030863763158420102, 0.00598518567638293, 0.001160663620968869, 0.00022507907904105155, 4.3647954811733995e-05, 8.464331128654902e-06, 1.6414263867044143e-06};
#pragma unroll
        for (int ai = 0; ai < 2; ++ai)
#pragma unroll
            for (int m = 0; m < 4; ++m) {
                const int row = row0 + ai * HALF + m * 16, pos = row & 4095;
                float cs[8], sn[8];
                if constexpr (KIND == 2 || KIND == 3) {
                    int fqo = fq; asm volatile("" : "+v"(fqo));
#pragma unroll
                    for (int k = 0; k < 4; ++k) { const double fv = (double)__builtin_amdgcn_exp2f(-(float)(16 * wc + 4 * fqo + k) * (13.287712379549449f / 63.0f)) * 0.15915494309189535;
                        const double ph = (double)pos * fv; const float r = (float)(ph - __builtin_floor(ph)); cs[k] = __builtin_amdgcn_cosf(r); sn[k] = __builtin_amdgcn_sinf(r); }
                }
                if constexpr (KIND == 4 || KIND == 5) {
                    if ((wc & 1) == 0) {
#pragma unroll
                        for (int k = 0; k < 8; ++k) { const double ph = (double)pos * FRD[k]; const float r = (float)(ph - __builtin_floor(ph)); cs[k] = __builtin_amdgcn_cosf(r); sn[k] = __builtin_amdgcn_sinf(r); if (fq == 0) sn[k] = -sn[k]; }
                    }
                }
                u32x4 w8 = {0u, 0u, 0u, 0u};
#pragma unroll
                for (int bj = 0; bj < 2; ++bj) {
                    const int col = colt + bj * HALF + cl;
                    f32x4 v0 = acc[ai][bj][m][0], v1 = acc[ai][bj][m][1];
                    if constexpr (KIND == 0) {
#pragma unroll
                        for (int k = 0; k < 4; ++k) { v0[k] = fast_sigmoid(v0[k]); v1[k] = fast_sigmoid(v1[k]); }
                        if (bj == 0) { w8.x = gate_q8x4(v0); w8.y = gate_q8x4(v1); } else { w8.z = gate_q8x4(v0); w8.w = gate_q8x4(v1); }
                    } else if constexpr (KIND == 1) {
#pragma unroll
                        for (int k = 0; k < 4; ++k) { v0[k] = fast_silu(v0[k]); v1[k] = fast_silu(v1[k]); }
                    } else if constexpr (KIND == 2 || KIND == 3) {
                        float sc = 1.0f;
                        if constexpr (KIND == 3) { int hh = ((colt - 3072) >> 7) + bj; asm volatile("" : "+s"(hh));
                            sc = 0.08838834764831845f * __builtin_amdgcn_exp2f(lg2_gamma(hh) * (float)(127 - (pos & 127))); }
                        const f32x4 ca = {cs[0] * sc, cs[0] * sc, cs[1] * sc, cs[1] * sc}, sa = {sn[0] * sc, sn[0] * sc, sn[1] * sc, sn[1] * sc};
                        const f32x4 cb = {cs[2] * sc, cs[2] * sc, cs[3] * sc, cs[3] * sc}, sb = {sn[2] * sc, sn[2] * sc, sn[3] * sc, sn[3] * sc};
                        const f32x4 w0 = {-v0[1], v0[0], -v0[3], v0[2]}, w1 = {-v1[1], v1[0], -v1[3], v1[2]};
                        v0 = v0 * ca + w0 * sa; v1 = v1 * cb + w1 * sb;
                    } else if constexpr (KIND == 4 || KIND == 5) {
                        if ((wc & 1) == 0) {
                            f32x4 p0, p1;
#pragma unroll
                            for (int k = 0; k < 4; ++k) { p0[k] = swz_xor16(v0[k]); p1[k] = swz_xor16(v1[k]); }
                            if (fq < 2) {
#pragma unroll
                                for (int k = 0; k < 4; ++k) { v0[k] = v0[k] * cs[k] + p0[k] * sn[k]; v1[k] = v1[k] * cs[4 + k] + p1[k] * sn[4 + k]; }
                            }
                        }
                        if constexpr (KIND == 4) { v0 = v0 * 0.18033688011112042f; v1 = v1 * 0.18033688011112042f; }
                    }
                    if constexpr (KIND != 0) {
                        u32x4 w; w.x = cvt_pk_bf16(v0[0], v0[1]); w.y = cvt_pk_bf16(v0[2], v0[3]); w.z = cvt_pk_bf16(v1[0], v1[1]); w.w = cvt_pk_bf16(v1[2], v1[3]);
                        if constexpr (KIND == 7) *(u32x4*)(gm + blk_idx(row, col - 10240, 192)) = w;
                        else *(u32x4*)(proj + blk_idx(row, col, 320)) = w;
                    }
                }
                if constexpr (KIND == 0) *(u32x4*)((unsigned char*)gm + gm8_idx(row, colt - 10240 + 2 * cl)) = w8;
            }
    }
    __device__ __forceinline__ void operator()(f32x4 (&acc)[2][2][4][2], const Unit& u, int wr, int wc, int fr, int fq) const {
        const int seg = (u.pn * BM) >> 10;
        if (mode == 1) return;
        if (mode == 2) { if (seg >= 10) run<7>(acc, u, wr, wc, fr, fq); else run<6>(acc, u, wr, wc, fr, fq); return; }
        if (seg >= 10) run<0>(acc, u, wr, wc, fr, fq);
        else if (seg == 1 || seg == 5 || seg == 9) run<1>(acc, u, wr, wc, fr, fq);
        else if (seg == 2) run<2>(acc, u, wr, wc, fr, fq);
        else if (seg == 3) run<3>(acc, u, wr, wc, fr, fq);
        else if (seg == 6) run<4>(acc, u, wr, wc, fr, fq);
        else if (seg == 7) run<5>(acc, u, wr, wc, fr, fq);
        else run<6>(acc, u, wr, wc, fr, fq);
    }
};

struct EpiBf16Plain {
    static constexpr bool PERM = true, AFTER_DRAIN = false;
    bf16_t* O; int ldc;
    __device__ __forceinline__ void operator()(f32x4 (&acc)[2][2][4][2], const Unit& u, int wr, int wc, int fr, int fq) const {
        const int row0 = u.pm * BM + wr * 64 + fr, col0 = u.pn * BM + wc * 32 + 8 * fq;
#pragma unroll
        for (int ai = 0; ai < 2; ++ai)
#pragma unroll
            for (int m = 0; m < 4; ++m) { bf16_t* rowp = O + (size_t)(row0 + ai * HALF + m * 16) * ldc + col0;
#pragma unroll
                for (int bj = 0; bj < 2; ++bj) { const f32x4 v0 = acc[ai][bj][m][0], v1 = acc[ai][bj][m][1];
                    u32x4 w; w.x = cvt_pk_bf16(v0[0], v0[1]); w.y = cvt_pk_bf16(v0[2], v0[3]); w.z = cvt_pk_bf16(v1[0], v1[1]); w.w = cvt_pk_bf16(v1[2], v1[3]);
                    *(u32x4*)(rowp + bj * HALF) = w; } }
    }
};

struct EpiMerge {
    static constexpr bool PERM = true, AFTER_DRAIN = false;
    const unsigned char* gm; bf16_t* mo;
    __device__ __forceinline__ void load_batch(const int bt, const int row0, const int gbc, const int j, u32x4 (&gc)[2], u32x4 (&gn)[2]) const {
        const int ai = bt >> 1, mh = bt & 1;
#pragma unroll
        for (int mm = 0; mm < 2; ++mm) { const unsigned char* p = gm + gm8_idx(row0 + ai * HALF + (2 * mh + mm) * 16, gbc);
            gc[mm] = *(const u32x4*)p; if (j < 2) gn[mm] = *(const u32x4*)(p + (size_t)32 * 1024); else gn[mm] = gc[mm]; }
    }
    __device__ __forceinline__ void apply_batch(const int bt, f32x4 (&acc)[2][2][4][2], const int row0, const int col0, const int j, const u32x4 (&gc)[2], const u32x4 (&gn)[2]) const {
        const int ai = bt >> 1, mh = bt & 1;
#pragma unroll
        for (int mm = 0; mm < 2; ++mm)
#pragma unroll
            for (int bj = 0; bj < 2; ++bj) {
                const int m = 2 * mh + mm; const u32x4 c = gc[mm];
                f32x4 g0 = gate_unq4(bj == 0 ? c.x : c.z), g1 = gate_unq4(bj == 0 ? c.y : c.w);
                if (j < 2) {
                    const u32x4 n = gn[mm];
                    const f32x4 n0 = gate_unq4(bj == 0 ? n.x : n.z), n1 = gate_unq4(bj == 0 ? n.y : n.w);
#pragma unroll
                    for (int k = 0; k < 4; ++k) { g0[k] = g0[k] * __builtin_amdgcn_rcpf(n0[k]); g1[k] = g1[k] * __builtin_amdgcn_rcpf(n1[k]); }
                    acc[ai][bj][m][0] = acc[ai][bj][m][0] * g0; acc[ai][bj][m][1] = acc[ai][bj][m][1] * g1;
                } else {
                    const f32x4 v0 = acc[ai][bj][m][0] * (g0 * (1.0f / 255.0f)), v1 = acc[ai][bj][m][1] * (g1 * (1.0f / 255.0f));
                    u32x4 w; w.x = cvt_pk_bf16(v0[0], v0[1]); w.y = cvt_pk_bf16(v0[2], v0[3]); w.z = cvt_pk_bf16(v1[0], v1[1]); w.w = cvt_pk_bf16(v1[2], v1[3]);
                    *(u32x4*)(mo + (size_t)(row0 + ai * HALF + m * 16) * 2048 + col0 + bj * HALF) = w;
                }
            }
    }
    __device__ __forceinline__ void operator()(f32x4 (&acc)[2][2][4][2], const Unit& u, int wr, int wc, int fr, int fq) const {
        const int row0 = u.pm * BM + wr * 64 + fr, col0 = u.pn * BM + wc * 32 + 8 * fq, j = u.sel;
        const int gbc = j * 2048 + u.pn * 256 + 64 * wc + 16 * fq;
        u32x4 gcA[2], gnA[2], gcB[2], gnB[2], gcC[2], gnC[2], gcD[2], gnD[2];
        load_batch(0, row0, gbc, j, gcA, gnA);
        load_batch(1, row0, gbc, j, gcB, gnB);
        load_batch(2, row0, gbc, j, gcC, gnC);
        load_batch(3, row0, gbc, j, gcD, gnD);
        __builtin_amdgcn_sched_barrier(0);
        apply_batch(0, acc, row0, col0, j, gcA, gnA);
        __builtin_amdgcn_sched_barrier(0);
        apply_batch(1, acc, row0, col0, j, gcB, gnB);
        __builtin_amdgcn_sched_barrier(0);
        apply_batch(2, acc, row0, col0, j, gcC, gnC);
        __builtin_amdgcn_sched_barrier(0);
        apply_batch(3, acc, row0, col0, j, gcD, gnD);
    }
};

template <class Epi, class Sched, bool ALIGN_EPI = false, bool SP2 = false>
__device__ __forceinline__ void gemm_phase(PG8_LAS unsigned char* lds, const int K_, const Sched& S, const Epi& E, const int tid) {
    const int wid = __builtin_amdgcn_readfirstlane(tid >> 6), lane = tid & 63, wr = wid >> 2, wc = wid & 3, fr = lane & 15, fq = lane >> 4;
    const int K = K_, nt = K / BK;
    unsigned voffA[2], voffB[2];
#pragma unroll
    for (int i = 0; i < 2; ++i) { int R, C; stage_rc(tid * 16 + i * 8192, R, C); const int Rb = Epi::PERM ? ((R & ~31) + perm32(R & 31)) : R;
        voffA[i] = (unsigned)(R * K + C) * 2u; voffB[i] = (unsigned)(Rb * K + C) * 2u; }
    const size_t kstep = (size_t)(BK * 2);
    const size_t hstep = (size_t)HALF * K * 2;
    const size_t tstep = 2 * hstep;
    const unsigned ldsw = (unsigned)wid * 1024u;
    const int aoff = lds_byte(wr * 64 + fr, fq * 8), boff = lds_byte(wc * 32 + fr, fq * 8);
#define PG8_SA(b, h) (((b) * 2 + (h)) * HTB)
#define PG8_SB(b, h) ((4 + (b) * 2 + (h)) * HTB)
#define PG8_STAGE(bufoff, gbase, voff) do { _Pragma("unroll") for (int _i = 0; _i < 2; ++_i) \
        __builtin_amdgcn_global_load_lds((const unsigned*)((const char*)(gbase) + (voff)[_i]), (PG8_LAS unsigned*)(lds + (bufoff) + ldsw + _i * 8192), 16, 0, 0); } while (0)
#define PG8_LDA(dst, b, h) do { _Pragma("unroll") for (int m = 0; m < 4; ++m) _Pragma("unroll") for (int k = 0; k < 2; ++k) dst[m][k] = *(const PG8_LAS bf16x8*)(lds + PG8_SA(b, h) + aoff + m * 2048 + k * 1024); } while (0)
#define PG8_LDB(dst, b, h) do { _Pragma("unroll") for (int n = 0; n < 2; ++n) _Pragma("unroll") for (int k = 0; k < 2; ++k) dst[n][k] = *(const PG8_LAS bf16x8*)(lds + PG8_SB(b, h) + boff + n * 2048 + k * 1024); } while (0)
#define PG8_MMA(ai, bj, At, Bt) do { __builtin_amdgcn_s_setprio(1); _Pragma("unroll") for (int m = 0; m < 4; ++m) _Pragma("unroll") for (int n = 0; n < 2; ++n) _Pragma("unroll") for (int k = 0; k < 2; ++k) \
        acc[ai][bj][m][n] = __builtin_amdgcn_mfma_f32_16x16x32_bf16(Bt[n][k], At[m][k], acc[ai][bj][m][n], 0, 0, 0); __builtin_amdgcn_s_setprio(0); } while (0)
#define PG8_WAIT_V(n) asm volatile("s_waitcnt vmcnt(" #n ")" ::: "memory")
#define PG8_WAIT_L(n) asm volatile("s_waitcnt lgkmcnt(" #n ")" ::: "memory")
#define PG8_BAR __builtin_amdgcn_s_barrier()
#define PG8_SCHED __builtin_amdgcn_sched_barrier(0)
    Unit cur, nxt; int ui = 0;
    if (!S.next(0, cur)) return;
    f32x4 acc[2][2][4][2];
#pragma unroll
    for (int a = 0; a < 2; ++a)
#pragma unroll
        for (int b = 0; b < 2; ++b)
#pragma unroll
            for (int m = 0; m < 4; ++m)
#pragma unroll
                for (int n = 0; n < 2; ++n) acc[a][b][m][n] = (f32x4){0.f, 0.f, 0.f, 0.f};
    bf16x8 At[4][2], B0[2][2], B1[2][2];
    const char* cA = S.a_base(cur, tstep); const char* cB = S.b_base(cur, tstep);
    S.a_ready(cur);
    if constexpr (SP2) {
        PG8_STAGE(PG8_SB(0, 0), cB, voffB); PG8_STAGE(PG8_SB(0, 1), cB + hstep, voffB); PG8_STAGE(PG8_SA(0, 0), cA, voffA); PG8_STAGE(PG8_SA(0, 1), cA + hstep, voffA);
        if (wr == 1) PG8_BAR;
        PG8_WAIT_V(2); PG8_BAR;
        PG8_STAGE(PG8_SB(1, 0), cB + kstep, voffB); PG8_STAGE(PG8_SA(1, 0), cA + kstep, voffA); PG8_STAGE(PG8_SB(1, 1), cB + hstep + kstep, voffB);
        PG8_WAIT_V(6); PG8_BAR;
    } else {
        PG8_STAGE(PG8_SB(0, 0), cB, voffB); PG8_STAGE(PG8_SA(0, 0), cA, voffA); PG8_STAGE(PG8_SB(0, 1), cB + hstep, voffB); PG8_STAGE(PG8_SA(0, 1), cA + hstep, voffA);
        if (wr == 1) PG8_BAR;
        PG8_WAIT_V(4); PG8_BAR;
        PG8_STAGE(PG8_SB(1, 0), cB + kstep, voffB); PG8_STAGE(PG8_SA(1, 0), cA + kstep, voffA); PG8_STAGE(PG8_SB(1, 1), cB + hstep + kstep, voffB);
        PG8_WAIT_V(6); PG8_BAR;
    }
    for (;;) {
        const bool has_next = S.next(ui + 1, nxt);
        const char* nA = has_next ? S.a_base(nxt, tstep) : cA; const char* nB = has_next ? S.b_base(nxt, tstep) : cB;
        for (int t = 0; t < nt; t += 2) {
            const bool last = (t == nt - 2);
            const char* a1 = cA + (size_t)(t + 1) * kstep;
            const char* a2 = last ? nA : cA + (size_t)(t + 2) * kstep; const char* b2 = last ? nB : cB + (size_t)(t + 2) * kstep;
            const char* a3 = a2 + kstep; const char* b3 = b2 + kstep;
            if (last && has_next) S.a_ready(nxt);
            if constexpr (SP2) {
            PG8_LDB(B0, 0, 0); PG8_LDB(B1, 0, 1); PG8_SCHED; PG8_LDA(At, 0, 0); PG8_STAGE(PG8_SA(1, 1), a1 + hstep, voffA);
            PG8_WAIT_V(8); PG8_WAIT_L(0); PG8_BAR; PG8_MMA(0, 0, At, B0); PG8_MMA(0, 1, At, B1); PG8_BAR; PG8_SCHED;
            PG8_LDA(At, 0, 1); PG8_STAGE(PG8_SB(0, 0), b2, voffB); PG8_STAGE(PG8_SB(0, 1), b2 + hstep, voffB); PG8_STAGE(PG8_SA(0, 0), a2, voffA);
            PG8_WAIT_V(8); PG8_WAIT_L(0); PG8_BAR; PG8_MMA(1, 0, At, B0); PG8_MMA(1, 1, At, B1); PG8_BAR; PG8_SCHED;
            PG8_LDB(B0, 1, 0); PG8_LDB(B1, 1, 1); PG8_SCHED; PG8_LDA(At, 1, 0); PG8_STAGE(PG8_SA(0, 1), a2 + hstep, voffA);
            PG8_WAIT_V(8); PG8_WAIT_L(0); PG8_BAR; PG8_MMA(0, 0, At, B0); PG8_MMA(0, 1, At, B1); PG8_BAR; PG8_SCHED;
            PG8_LDA(At, 1, 1); PG8_STAGE(PG8_SB(1, 0), b3, voffB); PG8_STAGE(PG8_SB(1, 1), b3 + hstep, voffB); PG8_STAGE(PG8_SA(1, 0), a3, voffA);
            PG8_WAIT_V(8); PG8_WAIT_L(0); PG8_BAR; PG8_MMA(1, 0, At, B0); PG8_MMA(1, 1, At, B1); PG8_BAR; PG8_SCHED;
            } else {
            PG8_LDB(B0, 0, 0); PG8_SCHED; PG8_LDA(At, 0, 0); PG8_STAGE(PG8_SA(1, 1), a1 + hstep, voffA);
            PG8_WAIT_L(8); PG8_BAR; PG8_WAIT_L(0); PG8_MMA(0, 0, At, B0); PG8_BAR; PG8_SCHED;
            PG8_LDB(B1, 0, 1); PG8_STAGE(PG8_SB(0, 0), b2, voffB);
            PG8_BAR; PG8_WAIT_L(0); PG8_MMA(0, 1, At, B1); PG8_BAR;
            PG8_LDA(At, 0, 1); PG8_STAGE(PG8_SA(0, 0), a2, voffA);
            PG8_BAR; PG8_WAIT_L(0); PG8_MMA(1, 0, At, B0); PG8_BAR; PG8_SCHED;
            PG8_STAGE(PG8_SB(0, 1), b2 + hstep, voffB);
            PG8_WAIT_V(6); PG8_BAR; PG8_MMA(1, 1, At, B1); PG8_BAR;
            PG8_LDB(B0, 1, 0); PG8_SCHED; PG8_LDA(At, 1, 0); PG8_STAGE(PG8_SA(0, 1), a2 + hstep, voffA);
            PG8_WAIT_L(8); PG8_BAR; PG8_WAIT_L(0); PG8_MMA(0, 0, At, B0); PG8_BAR; PG8_SCHED;
            PG8_LDB(B1, 1, 1); PG8_STAGE(PG8_SB(1, 0), b3, voffB);
            PG8_BAR; PG8_WAIT_L(0); PG8_MMA(0, 1, At, B1); PG8_BAR;
            PG8_LDA(At, 1, 1); PG8_STAGE(PG8_SA(1, 0), a3, voffA);
            PG8_BAR; PG8_WAIT_L(0); PG8_MMA(1, 0, At, B0); PG8_BAR; PG8_SCHED;
            PG8_STAGE(PG8_SB(1, 1), b3 + hstep, voffB);
            PG8_WAIT_V(6); PG8_BAR; PG8_MMA(1, 1, At, B1); PG8_BAR;
            }
        }
        if constexpr (ALIGN_EPI) { if (wr == 0) PG8_BAR; }
        if constexpr (!Epi::AFTER_DRAIN) { E(acc, cur, wr, wc, fr, fq); S.done(cur); }
        if (!has_next) break;
        if (!S.keep(cur)) {
#pragma unroll
        for (int a = 0; a < 2; ++a)
#pragma unroll
            for (int b = 0; b < 2; ++b)
#pragma unroll
                for (int m = 0; m < 4; ++m)
#pragma unroll
                    for (int n = 0; n < 2; ++n) acc[a][b][m][n] = (f32x4){0.f, 0.f, 0.f, 0.f};
        }
        cur = nxt; cA = nA; cB = nB; ++ui;
        if constexpr (ALIGN_EPI) { if (wr == 1) PG8_BAR; }
    }
    PG8_WAIT_V(0);
    if constexpr (!ALIGN_EPI) { if (wr == 0) PG8_BAR; }
    PG8_BAR;
    if constexpr (Epi::AFTER_DRAIN) { E.fused(acc, cur, wr, wc, fr, fq, lds, wid, lane); S.done(cur); }
#undef PG8_SA
#undef PG8_SB
#undef PG8_STAGE
#undef PG8_LDA
#undef PG8_LDB
#undef PG8_MMA
#undef PG8_WAIT_V
#undef PG8_WAIT_L
#undef PG8_BAR
#undef PG8_SCHED
}
}
#define GAS __attribute__((address_space(1)))
#define LAS __attribute__((address_space(3)))
typedef unsigned short bf16;
typedef unsigned v4u __attribute__((ext_vector_type(4)));
typedef float f32x4 __attribute__((ext_vector_type(4)));
typedef short bf16x8 __attribute__((ext_vector_type(8)));
typedef GAS unsigned gu32;
typedef GAS unsigned long long gu64;
#define RLX_AGENT __ATOMIC_RELAXED, __HIP_MEMORY_SCOPE_AGENT
#define LDS_WAIT() asm volatile("s_waitcnt lgkmcnt(0)" ::: "memory")
#define VM_WAIT() asm volatile("s_waitcnt vmcnt(0)" ::: "memory")
__device__ __forceinline__ unsigned long long rt() { return __builtin_amdgcn_s_memrealtime(); }
__device__ __forceinline__ unsigned f2bf(float f) { unsigned u = __builtin_bit_cast(unsigned, f); return (u + 0x7fffu + ((u >> 16) & 1u)) >> 16; }
__device__ __forceinline__ unsigned pk2(float lo, float hi) { return f2bf(lo) | (f2bf(hi) << 16); }

#define XB_TMO      128
#define XB_XCNT(j)  (256  + 64 * (j))
#define XB_XSUB(j)  (1280 + 64 * (j))
#define XB_XGEN(j)  (2304 + 64 * (j))
#define XB_TOP      3328
#define XB_TOPGEN   3392
#define XCD_BAR_WORDS 3456
#define XB_SPIN_CAP (1u << 18)

__device__ __forceinline__ unsigned xb_ld(unsigned* p)              { return __hip_atomic_load(p, __ATOMIC_RELAXED, __HIP_MEMORY_SCOPE_AGENT); }
__device__ __forceinline__ unsigned xb_add(unsigned* p, unsigned v) { return __hip_atomic_fetch_add(p, v, __ATOMIC_RELAXED, __HIP_MEMORY_SCOPE_AGENT); }
__device__ __forceinline__ unsigned xb_xcc_id() { return (unsigned)__builtin_amdgcn_s_getreg((3 << 11) | 20) & 0xFu; }
#define XB_SPIN(cond, bar) do { unsigned _sp = 0; while (cond) { __builtin_amdgcn_s_sleep(1); \
    if ((++_sp & 255u) == 0u) { if (xb_ld(&(bar)[XB_TMO])) break; if (_sp > XB_SPIN_CAP) { atomicAdd(&(bar)[XB_TMO], 1u); break; } } } } while (0)

__device__ __forceinline__ unsigned xb_lane() { unsigned m = ~0u; asm volatile("" : "+s"(m)); return __builtin_amdgcn_mbcnt_hi(m, __builtin_amdgcn_mbcnt_lo(m, 0u)); }
struct XcdBarrier {
    unsigned wv;
    unsigned* bar; unsigned x;
    volatile LAS unsigned* st;
};

__device__ __forceinline__ XcdBarrier xcd_barrier_post(unsigned* bar, volatile LAS unsigned* st, unsigned wv) {
    XcdBarrier b; b.wv = wv; b.bar = bar; b.x = xb_xcc_id(); b.st = st;
    if (wv == 0u && xb_lane() == 0u) (void)xb_add(&bar[XB_XCNT(b.x)], 1u);
    return b;
}
__device__ __forceinline__ void xcd_barrier_complete(unsigned* bar, unsigned x, unsigned& nloc, unsigned& nx) {
    const unsigned G = gridDim.x * gridDim.y * gridDim.z;
    unsigned sum, cnt, mine, sp = 0u;
    for (;;) {
        sum = 0u; cnt = 0u; mine = 0u;
#pragma unroll
        for (unsigned j = 0; j < 16; ++j) { const unsigned c = xb_ld(&bar[XB_XCNT(j)]); sum += c; cnt += (c > 0u) ? 1u : 0u; mine = (j == x) ? c : mine; }
        if (sum == G) break;
        __builtin_amdgcn_s_sleep(1);
        if ((++sp & 255u) == 0u) { if (xb_ld(&bar[XB_TMO])) break; if (sp > XB_SPIN_CAP) { atomicAdd(&bar[XB_TMO], 1u); break; } }
    }
    nloc = mine > 0u ? mine : 1u; nx = cnt > 0u ? cnt : 1u;
}

__device__ __forceinline__ void xcd_barrier(const XcdBarrier& b) {
    asm volatile("s_waitcnt vmcnt(0)" ::: "memory");
    __syncthreads();
    if (b.wv == 0u && xb_lane() == 0u) {
        unsigned* bar = b.bar;
        __builtin_amdgcn_s_waitcnt(0);
        unsigned nloc = b.st[0], nx = b.st[1];
        if (nloc == 0u) { xcd_barrier_complete(bar, b.x, nloc, nx); b.st[0] = nloc; b.st[1] = nx; }
        const unsigned old = xb_add(&bar[XB_XSUB(b.x)], 1u);
        const unsigned gen = old / nloc;
        if (old + 1u == (gen + 1u) * nloc) {
            __builtin_amdgcn_fence(__ATOMIC_RELEASE, "agent");
            asm volatile("s_waitcnt vmcnt(0)" ::: "memory");
            const unsigned og = xb_add(&bar[XB_TOP], 1u);
            const unsigned tg = og / nx;
            if (og + 1u == (tg + 1u) * nx) xb_add(&bar[XB_TOPGEN], 1u);
            else XB_SPIN(xb_ld(&bar[XB_TOPGEN]) == tg, bar);
            __builtin_amdgcn_fence(__ATOMIC_ACQUIRE, "agent");
            xb_add(&bar[XB_XGEN(b.x)], 1u);
            asm volatile("s_waitcnt vmcnt(0)" ::: "memory");
        } else {
            XB_SPIN(xb_ld(&bar[XB_XGEN(b.x)]) == gen, bar);
            __builtin_amdgcn_fence(__ATOMIC_ACQUIRE, "agent");
            asm volatile("s_waitcnt vmcnt(0)" ::: "memory");
        }
    }
    __syncthreads();
}

constexpr int D_MODEL = 2048, SEQ = 4096, BATCH = 8, DEPTH = 2, M_ALL = BATCH * SEQ, D_IN = 16384;
constexpr int BG = 4, TG = BG * SEQ, NGROUP = BATCH / BG;
constexpr int PNBC = 320, PBROW = PNBC * 512;
__device__ __forceinline__ size_t pidx(int row, int col) { return pg8::blk_idx(row, col, PNBC); }
constexpr int C_XA = 0, C_GA = 1024, C_QR = 2048, C_KR = 3072, C_VR = 4096, C_GR = 5120, C_QD = 6144, C_KD = 7168, C_VD = 8192, C_GD = 9216;
constexpr float EPS = 1e-6f;
constexpr int NWAVES = 8;
constexpr size_t MiB = 1u << 20;
constexpr size_t WS_CTL = 0, CTL_ZERO_BYTES = 1 * MiB;
constexpr size_t WS_COSR = 1 * MiB, WS_SINR = 2 * MiB, WS_COSD = 3 * MiB, WS_SIND = 3 * MiB + 128 * 1024, WS_LAMS = 3 * MiB + 512 * 1024;
constexpr size_t WS_WIN = 4 * MiB;
constexpr size_t WS_WBR = 132 * MiB;
constexpr size_t WS_WOUT = 156 * MiB;
constexpr size_t WS_H = 172 * MiB;
constexpr size_t WS_Y = 300 * MiB;
constexpr size_t WS_GM = 396 * MiB;
constexpr size_t WS_PROJ = 588 * MiB;
constexpr size_t WS_O = 588 * MiB;
constexpr size_t WS_M = 716 * MiB;
constexpr size_t WS_X1 = 908 * MiB;
constexpr size_t WS_END = 972 * MiB;
static_assert(WS_M + (size_t)TG * 2048 * 2 <= WS_END && WS_O + (size_t)TG * 2048 * 4 <= WS_M && WS_PROJ + (size_t)TG * 10240 * 2 == WS_X1 && WS_X1 + (size_t)TG * 2048 * 2 == WS_END, "d_ws map");
constexpr int CW_TMO = 0;
constexpr int CW_BAR = 4096;
constexpr int CW_Q = 65536;
constexpr int RING_BYTES = 131072, LDSCTL_OFF = RING_BYTES, MISC_OFF = LDSCTL_OFF + 320, LDS_BYTES = 147456;

#define LAUNDER_V(x) asm volatile("" : "+v"(x))
#define LAUNDER_S(x) asm volatile("" : "+s"(x))
typedef float f32x16 __attribute__((ext_vector_type(16)));
typedef short s16x4 __attribute__((ext_vector_type(4)));
typedef short v4i16_t __attribute__((ext_vector_type(4)));
typedef unsigned u32x2 __attribute__((ext_vector_type(2)));
typedef LAS unsigned char* ldsp;
using pg8::blk_idx; using pg8::cvt_pk_bf16; using pg8::bf_lo; using pg8::bf_hi; using pg8::fast_sigmoid; using pg8::lg2_gamma;

using pg8::swz_xor; using pg8::half_sum; using pg8::half_max;
__device__ __forceinline__ float wave_sum(float v) {
    v += swz_xor<1>(v); v += swz_xor<2>(v); v += swz_xor<4>(v); v += swz_xor<8>(v); v += swz_xor<16>(v);
    return half_sum(v);
}
__device__ __forceinline__ unsigned offb(unsigned row, unsigned ch) { return 256u * row + 16u * (ch ^ (((row & 3u) << 2) | ((row >> 2) & 3u))); }
__device__ __forceinline__ unsigned tr_nat(int lane, int k0, int t, int c) { const int h = lane >> 5, blk = (lane >> 4) & 1, q = (lane & 15) >> 2, p = lane & 3; return offb(k0 + 8 * h + 4 * t + q, 4 * c + 2 * blk + (p >> 1)) + 8 * (p & 1); }
__device__ __forceinline__ unsigned tr_perm(int lane, int k0, int t, int c) { const int h = lane >> 5, blk = (lane >> 4) & 1, q = (lane & 15) >> 2, p = lane & 3; return offb(k0 + 8 * t + 4 * h + q, 4 * c + 2 * blk + (p >> 1)) + 8 * (p & 1); }
__device__ __forceinline__ f32x16 mfma32(bf16x8 a, bf16x8 b, f32x16 c) { return __builtin_amdgcn_mfma_f32_32x32x16_bf16(a, b, c, 0, 0, 0); }
__device__ __forceinline__ s16x4 trr(ldsp p) { return __builtin_bit_cast(s16x4, __builtin_amdgcn_ds_read_tr16_b64_v4i16((LAS v4i16_t*)p)); }
__device__ __forceinline__ bf16x8 cat8(s16x4 lo, s16x4 hi) { return (bf16x8){lo[0], lo[1], lo[2], lo[3], hi[0], hi[1], hi[2], hi[3]}; }
template <int B> __device__ __forceinline__ bf16x8 pack8(const f32x16& x) {
    v4u w = {cvt_pk_bf16(x[B], x[B + 1]), cvt_pk_bf16(x[B + 2], x[B + 3]), cvt_pk_bf16(x[B + 4], x[B + 5]), cvt_pk_bf16(x[B + 6], x[B + 7])};
    return __builtin_bit_cast(bf16x8, w);
}
__device__ __forceinline__ f32x16 zero16() { f32x16 z;
#pragma unroll
    for (int i = 0; i < 16; ++i) z[i] = 0.f; return z; }

__device__ __forceinline__ void p0_transpose_item(const float* W, int K, int N, bf16* WT, LAS float* scr, int item, int lane) {
    const int nblk = N / 32, kb = item / nblk, nb = item % nblk, k0 = 64 * kb, n0 = 32 * nb;
    { const int cg = lane & 7, rs = lane >> 3;
      f32x4 v[8];
#pragma unroll
      for (int i = 0; i < 8; ++i) v[i] = *(const f32x4*)(W + (size_t)(k0 + 8 * i + rs) * N + n0 + 4 * cg);
#pragma unroll
      for (int i = 0; i < 8; ++i) { LAS float* d = scr + (8 * i + rs) * 33 + 4 * cg; d[0] = v[i].x; d[1] = v[i].y; d[2] = v[i].z; d[3] = v[i].w; } }
    LDS_WAIT(); asm volatile("" ::: "memory");
    const int c = lane & 7;
#pragma unroll
    for (int j = 0; j < 4; ++j) { const int n = (lane >> 3) + 8 * j; const LAS float* s = scr + (8 * c) * 33 + n;
        v4u o; o.x = pk2(s[0 * 33], s[1 * 33]); o.y = pk2(s[2 * 33], s[3 * 33]); o.z = pk2(s[4 * 33], s[5 * 33]); o.w = pk2(s[6 * 33], s[7 * 33]);
        *(GAS v4u*)(WT + (size_t)(n0 + n) * K + k0 + 8 * c) = o; }
    LDS_WAIT(); asm volatile("" ::: "memory");
}
__device__ __forceinline__ void rms_row_to_bf16(const float* xrow, const f32x4 (&gv)[8], bf16* orow, int lane) {
    const float* xr = xrow + 8 * lane;
    f32x4 v[8]; float s = 0.f;
#pragma unroll
    for (int j = 0; j < 4; ++j) { v[2 * j] = *(const f32x4*)(xr + 512 * j); v[2 * j + 1] = *(const f32x4*)(xr + 512 * j + 4); }
#pragma unroll
    for (int j = 0; j < 8; ++j) s += (v[j].x * v[j].x + v[j].y * v[j].y) + (v[j].z * v[j].z + v[j].w * v[j].w);
    const float rs = rsqrtf(wave_sum(s) * (1.f / D_MODEL) + EPS);
    v4u* o16 = (v4u*)orow + lane;
#pragma unroll
    for (int j = 0; j < 4; ++j) { const f32x4 ga = gv[2 * j], gb = gv[2 * j + 1]; const f32x4 a = v[2 * j] * rs * ga, bq = v[2 * j + 1] * rs * gb;
        v4u w; w.x = cvt_pk_bf16(a.x, a.y); w.y = cvt_pk_bf16(a.z, a.w); w.z = cvt_pk_bf16(bq.x, bq.y); w.w = cvt_pk_bf16(bq.z, bq.w); o16[64 * j] = w; }
}

__device__ __forceinline__ void ret_unit(const int tid, ldsp lds, int b, int h, const bf16* proj, bf16* yb) {
    const int lane = tid & 63, w = __builtin_amdgcn_readfirstlane(tid >> 6), r32 = lane & 31, hi = lane >> 5;
    const int it = w >> 1, eh = w & 1;
    constexpr int O_ST = 0, O_KD = 32768, O_VV = 65536, O_Q = 98304;
    LAS float* STAT = (LAS float*)(lds + RING_BYTES + 1024);
    { unsigned z0 = 0u; LAUNDER_V(z0); for (int i = tid; i < 2048; i += 512) ((LAS v4u*)(lds + O_ST))[i] = (v4u){z0, z0, z0, z0}; }
    ldsp rb[8];
#pragma unroll
    for (int s = 0; s < 8; ++s) rb[s] = lds + offb(r32, 2 * s + hi);
    ldsp tnk0 = lds + O_KD + tr_perm(lane, 0, 0, it), tnk1 = lds + O_KD + tr_perm(lane, 0, 1, it);
    ldsp tpv00 = lds + O_VV + tr_perm(lane, 0, 0, 2 * eh), tpv01 = lds + O_VV + tr_perm(lane, 0, 1, 2 * eh), tpv10 = lds + O_VV + tr_perm(lane, 0, 0, 2 * eh + 1), tpv11 = lds + O_VV + tr_perm(lane, 0, 1, 2 * eh + 1);
    const int row00 = b * SEQ, hcol = h * 128;
    bf16* Yp = yb + (size_t)b * SEQ * 1024 + h * 128;
    const float lg = lg2_gamma(h), cd = __builtin_amdgcn_exp2f(128.f * lg), cout = __builtin_amdgcn_exp2f(lg * (float)(32 * it + r32 - 127));
    f32x16 Dacc0 = zero16(), Dacc1 = zero16();
#define RET_DMA(src_, n_, lane_, off_) do { _Pragma("unroll") for (int k_ = 0; k_ < 4; ++k_) { const int row_ = 16 * w + 4 * k_ + ((lane_) >> 4); \
        const int ch_ = ((lane_) & 15) ^ (((row_ & 3) << 2) | ((row_ >> 2) & 3)); \
        __builtin_amdgcn_global_load_lds((const unsigned*)(proj + pidx(row00 + (n_) * 128 + row_, (src_) + hcol + 8 * ch_)), (LAS unsigned*)(lds + (off_) + 4096 * w + 1024 * k_), 16, 0, 0); } } while (0)
#define RET_BAR() do { asm volatile("s_waitcnt lgkmcnt(0)" ::: "memory"); __builtin_amdgcn_s_barrier(); asm volatile("" ::: "memory"); } while (0)
    RET_DMA(C_KR, 0, lane, O_KD); RET_DMA(C_VR, 0, lane, O_VV); RET_DMA(C_QR, 0, lane, O_Q);
    for (int n = 0; n < 32; ++n) {
        int tid_c = tid; LAUNDER_V(tid_c);
        const int lane_c = tid_c & 63, r32c = lane_c & 31, hic = lane_c >> 5;
        const int rowi = n * 128 + 32 * it + r32c;
        const int nn = n + 1 < 32 ? n + 1 : 31;
        asm volatile("s_waitcnt vmcnt(0) lgkmcnt(0)" ::: "memory"); __builtin_amdgcn_s_barrier(); asm volatile("" ::: "memory");
        bf16x8 qf[8];
        { ldsp qb_ = lds + O_Q + 8192 * it;
#pragma unroll
          for (int s = 0; s < 8; ++s) qf[s] = *(const LAS bf16x8*)(qb_ + (unsigned)(rb[s] - lds)); }
#pragma unroll
        for (int ks = 0; ks < 8; ++ks) {
            const bf16x8 a = cat8(trr(tnk0 + 4096 * ks), trr(tnk1 + 4096 * ks));
            Dacc0 = mfma32(a, cat8(trr(tpv00 + 4096 * ks), trr(tpv01 + 4096 * ks)), Dacc0);
            Dacc1 = mfma32(a, cat8(trr(tpv10 + 4096 * ks), trr(tpv11 + 4096 * ks)), Dacc1);
            if (ks & 1) __builtin_amdgcn_sched_barrier(0);
        }
        f32x16 acc0 = zero16(), acc1 = zero16();
#pragma unroll
        for (int jt = 0; jt < 4; ++jt) if (jt <= it) {
            f32x16 X = zero16();
#pragma unroll
            for (int s = 0; s < 8; ++s) X = mfma32(*(const LAS bf16x8*)(rb[s] + O_KD + 8192 * jt), qf[s], X);
            __builtin_amdgcn_sched_barrier(0);
            if (jt == it) {
#pragma unroll
                for (int r = 0; r < 16; ++r) { const int j = (r & 3) + 8 * (r >> 2) + 4 * hic; if (j > r32c) X[r] = 0.f; }
            }
            const bf16x8 pf0 = pack8<0>(X), pf1 = pack8<8>(X);
            acc0 = mfma32(cat8(trr(tpv00 + 8192 * jt), trr(tpv01 + 8192 * jt)), pf0, acc0);
            acc1 = mfma32(cat8(trr(tpv10 + 8192 * jt), trr(tpv11 + 8192 * jt)), pf0, acc1);
            acc0 = mfma32(cat8(trr(tpv00 + 8192 * jt + 4096), trr(tpv01 + 8192 * jt + 4096)), pf1, acc0);
            acc1 = mfma32(cat8(trr(tpv10 + 8192 * jt + 4096), trr(tpv11 + 8192 * jt + 4096)), pf1, acc1);
            __builtin_amdgcn_sched_barrier(0);
        }
        RET_BAR();
        RET_DMA(C_KR, nn, lane_c, O_KD); RET_DMA(C_VR, nn, lane_c, O_VV); RET_DMA(C_QR, nn, lane_c, O_Q);
        u32x2 gg[8];
        { const bf16* grow = proj + pidx(row00 + rowi, C_GR + hcol + 64 * eh + 4 * hic);
#pragma unroll
          for (int e2 = 0; e2 < 2; ++e2)
#pragma unroll
              for (int q4 = 0; q4 < 4; ++q4) gg[4 * e2 + q4] = *(const u32x2*)(grow + 512 * e2 + 8 * q4); }
        {
            ldsp st0 = lds + 16384 * eh;
#pragma unroll
            for (int s = 0; s < 8; ++s) {
                const unsigned o_ = (unsigned)(rb[s] - lds);
                acc0 = mfma32(*(const LAS bf16x8*)(st0 + o_ + O_ST), qf[s], acc0);
                acc1 = mfma32(*(const LAS bf16x8*)(st0 + o_ + O_ST + 8192), qf[s], acc1);
                if ((s & 3) == 3) __builtin_amdgcn_sched_barrier(0);
            }
        }
        float s1 = 0.f, s2 = 0.f;
#pragma unroll
        for (int r = 0; r < 16; ++r) { s1 += acc0[r] + acc1[r]; s2 += acc0[r] * acc0[r] + acc1[r] * acc1[r]; }
        s1 = half_sum(s1); s2 = half_sum(s2);
        if (hic == 0) { STAT[(32 * it + r32c) * 4 + eh * 2] = s1; STAT[(32 * it + r32c) * 4 + eh * 2 + 1] = s2; }
        RET_BAR();
        {
            const LAS float* st = STAT + (32 * it + r32c) * 4;
            const float mean = (st[0] + st[2]) * (1.f / 128.f); float var = (st[1] + st[3]) * (1.f / 128.f) - mean * mean; var = fmaxf(var, 0.f);
            const float rs = cout * rsqrtf(cout * cout * var + EPS);
            bf16* yrow = Yp + (size_t)rowi * 1024 + 64 * eh + 4 * hic;
#pragma unroll
            for (int e2 = 0; e2 < 2; ++e2)
#pragma unroll
                for (int q4 = 0; q4 < 4; ++q4) {
                    const f32x16& A = e2 ? acc1 : acc0; const u32x2 g = gg[4 * e2 + q4];
                    u32x2 o; o.x = cvt_pk_bf16((A[4 * q4] - mean) * rs * bf_lo(g.x), (A[4 * q4 + 1] - mean) * rs * bf_hi(g.x));
                    o.y = cvt_pk_bf16((A[4 * q4 + 2] - mean) * rs * bf_lo(g.y), (A[4 * q4 + 3] - mean) * rs * bf_hi(g.y));
                    *(u32x2*)(yrow + 32 * e2 + 8 * q4) = o;
                }
        }
#pragma unroll
        for (int r = 0; r < 16; ++r) { Dacc0[r] *= cd; Dacc1[r] *= cd; }
        {
            ldsp sw0 = lds + O_ST + 16384 * eh + 256 * r32c + 8 * hic; const unsigned swr = ((r32c & 3) << 2) | ((r32c >> 2) & 3);
#pragma unroll
            for (int q4 = 0; q4 < 4; ++q4) {
                u32x2 o0, o1; o0.x = cvt_pk_bf16(Dacc0[4 * q4], Dacc0[4 * q4 + 1]); o0.y = cvt_pk_bf16(Dacc0[4 * q4 + 2], Dacc0[4 * q4 + 3]);
                o1.x = cvt_pk_bf16(Dacc1[4 * q4], Dacc1[4 * q4 + 1]); o1.y = cvt_pk_bf16(Dacc1[4 * q4 + 2], Dacc1[4 * q4 + 3]);
                const unsigned co = 16u * ((unsigned)(4 * it + q4) ^ swr);
                *(LAS u32x2*)(sw0 + co) = o0; *(LAS u32x2*)(sw0 + co + 8192) = o1;
            }
        }
    }
    asm volatile("s_waitcnt vmcnt(0)" ::: "memory");
#undef RET_DMA
#undef RET_BAR
}

__device__ __forceinline__ void lru_unit(const int tid, ldsp lds, int b, int nb, const bf16* proj, bf16* ya, const float* convw, const float* convb,
                                         const float* wa, const float* ba, const float* wx, const float* bx, const float* lam) {
    const int lane = tid & 63, w = __builtin_amdgcn_readfirstlane(tid >> 6), r32 = lane & 31, hi = lane >> 5;
    const int c0 = nb * 64;
    LAS bf16* XA = (LAS bf16*)lds; ldsp XC = lds + 17408; LAS float* XF = (LAS float*)(lds + 35840); LAS float* AF = (LAS float*)(lds + 68608);
    ldsp WT = lds + 101376; LAS float* SEG = (LAS float*)(lds + 119808); LAS float* PAR = (LAS float*)(lds + 123904);
    if (tid < 64) { const int c = c0 + tid;
        PAR[tid] = convw[c]; PAR[64 + tid] = convw[1024 + c]; PAR[128 + tid] = convw[2048 + c]; PAR[192 + tid] = convw[3072 + c];
        PAR[256 + tid] = convb[c]; PAR[320 + tid] = ba[c]; PAR[384 + tid] = bx[c];
        const float z = __expf(-lam[c]); PAR[448 + tid] = log1pf(z); }
    for (int idx = tid; idx < 4096; idx += 512) { const int d = idx >> 6, e = idx & 63;
        ((LAS bf16*)WT)[e * 72 + d] = (bf16)f2bf(wa[nb * 4096 + idx]); ((LAS bf16*)(WT + 9216))[e * 72 + d] = (bf16)f2bf(wx[nb * 4096 + idx]); }
    const int row00 = b * SEQ;
    bf16* yp = ya + (size_t)b * SEQ * 1024 + c0;
    const int e = tid & 63;
    float hcarry = 0.f;
    v4u xs[2][3];
#define LRU_ISSUE(S_, t0_) do { { const int r = tid >> 3, ch = tid & 7, t = (t0_) - 3 + r; { unsigned z0 = 0u; LAUNDER_V(z0); xs[S_][0] = (v4u){z0, z0, z0, z0}; } if (t >= 0) xs[S_][0] = *(const v4u*)(proj + pidx(row00 + t, C_XA + c0 + ch * 8)); } \
        { const int r = (tid + 512) >> 3, ch = tid & 7, t = (t0_) - 3 + r; xs[S_][1] = *(const v4u*)(proj + pidx(row00 + t, C_XA + c0 + ch * 8)); } \
        if (tid < 24) { const int r = (tid + 1024) >> 3, ch = tid & 7, t = (t0_) - 3 + r; xs[S_][2] = *(const v4u*)(proj + pidx(row00 + t, C_XA + c0 + ch * 8)); } } while (0)
    LRU_ISSUE(0, 0); LRU_ISSUE(1, 128);
    for (int n2 = 0; n2 < 32; n2 += 2)
#pragma unroll
      for (int sx = 0; sx < 2; ++sx) {
        const int n = n2 + sx;
        const int t0 = n * 128;
        __syncthreads();
        *(LAS v4u*)((ldsp)XA + tid * 16) = xs[sx][0]; *(LAS v4u*)((ldsp)XA + (tid + 512) * 16) = xs[sx][1]; if (tid < 24) *(LAS v4u*)((ldsp)XA + (tid + 1024) * 16) = xs[sx][2];
        if (n + 2 < 32) LRU_ISSUE(sx, t0 + 256);
        __syncthreads();
        { const int c = tid & 63; const float w0 = PAR[c], w1 = PAR[64 + c], w2 = PAR[128 + c], w3 = PAR[192 + c], cb = PAR[256 + c];
#pragma unroll 4
          for (int k = 0; k < 16; ++k) { const int t = (tid >> 6) + 8 * k;
              const float x0 = __uint_as_float((unsigned)XA[t * 64 + c] << 16), x1 = __uint_as_float((unsigned)XA[(t + 1) * 64 + c] << 16),
                          x2 = __uint_as_float((unsigned)XA[(t + 2) * 64 + c] << 16), x3 = __uint_as_float((unsigned)XA[(t + 3) * 64 + c] << 16);
              const float xc = cb + w0 * x0 + w1 * x1 + w2 * x2 + w3 * x3;
              XF[t * 64 + c] = xc; ((LAS bf16*)XC)[t * 72 + c] = (bf16)f2bf(xc); } }
        __syncthreads();
        bf16 gt[16];
#pragma unroll
        for (int k = 0; k < 16; ++k) gt[k] = proj[pidx(row00 + t0 + 16 * w + k, C_GA + c0 + e)];
        { const int tt = w >> 1, et = w & 1;
          f32x16 gr = zero16(), gi = zero16();
#pragma unroll
          for (int s = 0; s < 4; ++s) {
              const bf16x8 a = *(const LAS bf16x8*)(XC + (32 * tt + r32) * 144 + (16 * s + 8 * hi) * 2);
              const bf16x8 br = *(const LAS bf16x8*)(WT + (32 * et + r32) * 144 + (16 * s + 8 * hi) * 2);
              const bf16x8 bi = *(const LAS bf16x8*)(WT + 9216 + (32 * et + r32) * 144 + (16 * s + 8 * hi) * 2);
              gr = mfma32(a, br, gr); gi = mfma32(a, bi, gi); }
          const int ee = 32 * et + r32; const float bar_ = PAR[320 + ee], bxr = PAR[384 + ee], sp = PAR[448 + ee];
#pragma unroll
          for (int r = 0; r < 16; ++r) { const int t = 32 * tt + (r & 3) + 8 * (r >> 2) + 4 * hi;
              const float xc = XF[t * 64 + ee];
              const float rg = fast_sigmoid(gr[r] + bar_), ig = fast_sigmoid(gi[r] + bxr);
              const float la = -8.0f * rg * sp, a = __expf(la), x2 = 2.0f * la;
              const float em_series = -x2 * (1.0f + x2 * (0.5f + x2 * (0.16666667f + x2 * (0.041666668f + x2 * (0.008333334f + x2 * 0.0013888889f)))));
              const float em = x2 < -0.25f ? 1.0f - a * a : em_series;
              AF[t * 64 + ee] = a; XF[t * 64 + ee] = __builtin_amdgcn_sqrtf(em) * ig * xc; } }
        __syncthreads();
        { float A = 1.f, H = 0.f;
#pragma unroll
          for (int k = 0; k < 16; ++k) { const int t = 16 * w + k; const float a = AF[t * 64 + e], u = XF[t * 64 + e]; H = a * H + u; A *= a; }
          SEG[(w * 64 + e) * 2] = A; SEG[(w * 64 + e) * 2 + 1] = H; }
        __syncthreads();
        float hs = hcarry, hst = 0.f;
#pragma unroll
        for (int s = 0; s < 8; ++s) { const float A = SEG[(s * 64 + e) * 2], H = SEG[(s * 64 + e) * 2 + 1]; if (s == w) hst = hs; hs = A * hs + H; }
        hcarry = hs;
        float hh = hst;
#pragma unroll
        for (int k = 0; k < 16; ++k) { const int t = 16 * w + k; hh = AF[t * 64 + e] * hh + XF[t * 64 + e];
            yp[(size_t)(t0 + t) * 1024 + e] = (bf16)f2bf(hh * __uint_as_float((unsigned)gt[k] << 16)); }
    }
#undef LRU_ISSUE
}

typedef float f32x2 __attribute__((ext_vector_type(2)));
struct AttS { f32x16 O0, O1, O2, O3, p0, p1; bf16x8 pf0, pf1, pf2, pf3; bf16x8 k0, k1, k2, k3, k4, k5, k6, k7; float mref, l, alpha; int rp; };
#define ATT_THR 8.0f
constexpr int ATT_V0 = 0, ATT_K0 = 49152, ATT_SLOT = 16384;
#define ATT_PIN(X_) asm volatile("" : "+v"(X_))
#define ATT_SB() __builtin_amdgcn_sched_barrier(0)
__device__ __forceinline__ float attn_rowmax(const f32x16& a, const f32x16& b) {
    float d = fmaxf(a[0], b[0]);
#pragma unroll
    for (int r = 1; r < 16; ++r) d = fmaxf(d, fmaxf(a[r], b[r]));
    return half_max(d);
}
__device__ __forceinline__ int attn_rowmax_bits(const f32x16& a, const f32x16& b) {
    int d = max(__float_as_int(a[0]), __float_as_int(b[0]));
#pragma unroll
    for (int r = 1; r < 16; ++r) d = max(d, max(__float_as_int(a[r]), __float_as_int(b[r])));
    unsigned x = (unsigned)d, y = x; pg8::half_swap(x, y);
    return max((int)x, (int)y);
}
template <int B> __device__ __forceinline__ f32x2 attn_sum8(const f32x16& a, f32x2 s) {
#pragma unroll
    for (int r = B; r < B + 8; r += 2) s += (f32x2){a[r], a[r + 1]};
    return s;
}
#define ATT_EXP4(P_, B_) do { _Pragma("unroll") for (int r_ = 0; r_ < 4; ++r_) P_[(B_) + r_] = __builtin_amdgcn_exp2f(P_[(B_) + r_]); } while (0)
#define ATT_SUB4(P_, B_) do { _Pragma("unroll") for (int r_ = 0; r_ < 4; ++r_) P_[(B_) + r_] -= st.mref; } while (0)
#define ATT_VF(TV_, KS, ET) cat8(trr((TV_) + 4096 * (ET) + 1024 * (KS)), trr((TV_) + 4096 * (ET) + 1024 * (KS) + 512))
#define ATT_KF(RK_, O_) (*(const LAS bf16x8*)((RK_) + (O_)))
#define ATT_MASK(Q0_, Q1_, t_) do { const int kb_ = 64 * (t_); \
        if (kb_ + 63 > qw) { const int dq_ = qw + r32 - kb_ - 4 * hi; const float NEG_ = -__builtin_inff(); \
            _Pragma("unroll") for (int r_ = 0; r_ < 16; ++r_) { const int cr_ = (r_ & 3) + 8 * (r_ >> 2); if (cr_ > dq_) Q0_[r_] = NEG_; if (cr_ + 32 > dq_) Q1_[r_] = NEG_; } } } while (0)
#define ATT_OSCALE() do { if (st.rp) { _Pragma("unroll") for (int r_ = 0; r_ < 16; ++r_) { st.O0[r_] *= st.alpha; st.O1[r_] *= st.alpha; st.O2[r_] *= st.alpha; st.O3[r_] *= st.alpha; } } } while (0)
#define ATT_EXP1(Q0_, Q1_, I_) do { if ((I_) < 16) Q0_[(I_) & 15] = __builtin_amdgcn_exp2f(Q0_[(I_) & 15]); else Q1_[(I_) & 15] = __builtin_amdgcn_exp2f(Q1_[(I_) & 15]); } while (0)
#define ATT_EXP3(Q0_, Q1_, I_) do { ATT_EXP1(Q0_, Q1_, (I_)); ATT_EXP1(Q0_, Q1_, (I_) + 1); ATT_EXP1(Q0_, Q1_, (I_) + 2); } while (0)
__device__ __forceinline__ f32x16 attn_splat(const float v) { f32x16 z;
#pragma unroll
    for (int i = 0; i < 16; ++i) z[i] = v; return z; }
__device__ __forceinline__ void attn_step(AttS& st, const int t, const int qw, const int r32, const int hi, const bf16x8 (&qf)[4], ldsp tv, ldsp rn0, ldsp rn1, ldsp rn2, ldsp rn3) {
    ATT_OSCALE();
    const f32x16 negm = attn_splat(-st.mref);
    f32x16 q0 = mfma32(st.k0, qf[0], negm); bf16x8 va0 = ATT_VF(tv, 0, 0);
    f32x16 q1 = mfma32(st.k1, qf[0], negm); bf16x8 va1 = ATT_VF(tv, 0, 1);
    ATT_SB();
    q0 = mfma32(st.k2, qf[1], q0); bf16x8 va2 = ATT_VF(tv, 0, 2);
    q1 = mfma32(st.k3, qf[1], q1); bf16x8 va3 = ATT_VF(tv, 0, 3);
    ATT_SB();
    q0 = mfma32(st.k4, qf[2], q0); bf16x8 vb0 = ATT_VF(tv, 1, 0);
    q1 = mfma32(st.k5, qf[2], q1); bf16x8 vb1 = ATT_VF(tv, 1, 1);
    st.pf2 = pack8<0>(st.p1); ATT_PIN(st.pf2);
    ATT_SB();
    q0 = mfma32(st.k6, qf[3], q0); bf16x8 vb2 = ATT_VF(tv, 1, 2);
    q1 = mfma32(st.k7, qf[3], q1); bf16x8 vb3 = ATT_VF(tv, 1, 3);
    st.pf3 = pack8<8>(st.p1); ATT_PIN(st.pf3);
    ATT_SB();
    ATT_MASK(q0, q1, t);
    st.O0 = mfma32(va0, st.pf0, st.O0); va0 = ATT_VF(tv, 2, 0); ATT_EXP3(q0, q1, 0);
    ATT_SB();
    st.O1 = mfma32(va1, st.pf0, st.O1); va1 = ATT_VF(tv, 2, 1); ATT_EXP3(q0, q1, 3);
    ATT_SB();
    st.O2 = mfma32(va2, st.pf0, st.O2); va2 = ATT_VF(tv, 2, 2); ATT_EXP3(q0, q1, 6);
    ATT_SB();
    st.O3 = mfma32(va3, st.pf0, st.O3); va3 = ATT_VF(tv, 2, 3); ATT_EXP3(q0, q1, 9);
    ATT_SB();
    st.O0 = mfma32(vb0, st.pf1, st.O0); vb0 = ATT_VF(tv, 3, 0); ATT_EXP3(q0, q1, 12);
    ATT_SB();
    st.O1 = mfma32(vb1, st.pf1, st.O1); vb1 = ATT_VF(tv, 3, 1); ATT_EXP3(q0, q1, 15);
    ATT_PIN(q0);
    ATT_SB();
    st.O2 = mfma32(vb2, st.pf1, st.O2); vb2 = ATT_VF(tv, 3, 2); ATT_EXP3(q0, q1, 18);
    ATT_SB();
    st.O3 = mfma32(vb3, st.pf1, st.O3); vb3 = ATT_VF(tv, 3, 3); ATT_EXP3(q0, q1, 21);
    ATT_SB();
    st.O0 = mfma32(va0, st.pf2, st.O0); ATT_EXP3(q0, q1, 24); ATT_EXP1(q0, q1, 27);
    ATT_SB();
    st.O1 = mfma32(va1, st.pf2, st.O1); ATT_EXP3(q0, q1, 28); ATT_EXP1(q0, q1, 31);
    ATT_PIN(q1);
    ATT_SB();
    st.O2 = mfma32(va2, st.pf2, st.O2);
    f32x2 ps = attn_sum8<0>(q0, (f32x2){0.f, 0.f}); ps = attn_sum8<8>(q0, ps); ATT_PIN(ps);
    ATT_SB();
    st.O3 = mfma32(va3, st.pf2, st.O3);
    ps = attn_sum8<0>(q1, ps); ps = attn_sum8<8>(q1, ps);
    float psum = ps.x + ps.y; ATT_PIN(psum);
    ATT_SB();
    const bool resc = __any(psum > 256.0f);
    st.rp = resc; st.alpha = 1.f;
    if (resc) {
        const f32x16 nm2 = attn_splat(-st.mref);
        q0 = mfma32(st.k0, qf[0], nm2); q1 = mfma32(st.k1, qf[0], nm2);
        q0 = mfma32(st.k2, qf[1], q0); q1 = mfma32(st.k3, qf[1], q1);
        q0 = mfma32(st.k4, qf[2], q0); q1 = mfma32(st.k5, qf[2], q1);
        q0 = mfma32(st.k6, qf[3], q0); q1 = mfma32(st.k7, qf[3], q1);
        ATT_MASK(q0, q1, t);
        const float d = attn_rowmax(q0, q1);
        const float dl = fmaxf(d, 0.f); st.mref += dl; st.alpha = __builtin_amdgcn_exp2f(-dl); st.l *= st.alpha;
#pragma unroll
        for (int r = 0; r < 16; ++r) { q0[r] = __builtin_amdgcn_exp2f(q0[r] - dl); q1[r] = __builtin_amdgcn_exp2f(q1[r] - dl); }
        f32x2 p2 = attn_sum8<0>(q0, (f32x2){0.f, 0.f}); p2 = attn_sum8<8>(q0, p2); p2 = attn_sum8<0>(q1, p2); p2 = attn_sum8<8>(q1, p2); psum = p2.x + p2.y;
    }
    st.l += psum;
    st.O0 = mfma32(vb0, st.pf3, st.O0); st.k0 = ATT_KF(rn0, 0); st.k1 = ATT_KF(rn0, 8192);
    ATT_PIN(st.l);
    ATT_SB();
    st.O1 = mfma32(vb1, st.pf3, st.O1); st.k2 = ATT_KF(rn1, 0); st.k3 = ATT_KF(rn1, 8192);
    ATT_SB();
    st.O2 = mfma32(vb2, st.pf3, st.O2); st.k4 = ATT_KF(rn2, 0); st.k5 = ATT_KF(rn2, 8192);
    st.pf0 = pack8<0>(q0); ATT_PIN(st.pf0);
    ATT_SB();
    st.O3 = mfma32(vb3, st.pf3, st.O3); st.k6 = ATT_KF(rn3, 0); st.k7 = ATT_KF(rn3, 8192);
    st.pf1 = pack8<8>(q0); ATT_PIN(st.pf1);
    ATT_SB();
    st.p1 = q1;
}
__device__ __forceinline__ void attn_unit(const int tid, ldsp lds, int b, int h, int qb, const bf16* proj, bf16* yc, const float* lamp, const float* subg) {
    const int lane = tid & 63, w = __builtin_amdgcn_readfirstlane(tid >> 6), r32 = lane & 31, hi = lane >> 5;
    const int c = w >> 2, it = w & 3;
    const int qw = qb * 128 + 32 * it, NT = 2 * qb + 2;
    const int row00 = b * SEQ, hcol = h * 128;
    bf16x8 qf[4];
#pragma unroll
    for (int s = 0; s < 4; ++s) qf[s] = *(const bf16x8*)(proj + pidx(row00 + qw + r32, C_QD + hcol + 64 * c + 16 * s + 8 * hi));
    ldsp rk0 = lds + ATT_K0 + offb(r32, 8 * c + 0 + hi), rk1 = lds + ATT_K0 + offb(r32, 8 * c + 2 + hi), rk2 = lds + ATT_K0 + offb(r32, 8 * c + 4 + hi), rk3 = lds + ATT_K0 + offb(r32, 8 * c + 6 + hi);
    ldsp tvb = lds + ATT_V0 + (4 * hi + ((lane & 15) >> 2)) * 64 + 32 * ((lane >> 4) & 1) + 8 * (lane & 3);
    const int kr0 = 8 * w + (lane >> 4), kc0 = (lane & 15) ^ (((kr0 & 3) << 2) | ((kr0 >> 2) & 3)), kr1 = kr0 + 4, kc1 = (lane & 15) ^ (((kr1 & 3) << 2) | ((kr1 >> 2) & 3));
    const unsigned oK0 = 2u * (unsigned)pidx(kr0, C_KD + hcol + 8 * kc0), oK1 = 2u * (unsigned)pidx(kr1, C_KD + hcol + 8 * kc1);
    const unsigned oV0 = 2u * (unsigned)pidx(32 * (w & 1) + (lane >> 2), C_VD + hcol + 32 * (w >> 1) + 8 * (lane & 3));
    const unsigned char* gb = (const unsigned char*)(proj + (size_t)(row00 >> 4) * PBROW);
    const int dK = 2048 * w, dV = 4096 * (w >> 1) + 2048 * (w & 1);
    const unsigned ldsb = (unsigned)__builtin_amdgcn_readfirstlane((int)(unsigned)(unsigned long long)lds);
#define ATT_GLDS(g_, d_) do { unsigned keep_; asm volatile("s_mov_b32 %0, m0\n\ts_mov_b32 m0, %2\n\ts_nop 0\n\tglobal_load_lds_dwordx4 %1, off\n\ts_mov_b32 m0, %0" : "=&s"(keep_) : "v"(g_), "s"(d_) : "memory"); } while (0)
#define ATT_DMA_K(tk_, so_) do { const unsigned char* p_ = gb + (size_t)(4 * (tk_)) * (2 * PBROW); const unsigned d_ = ldsb + ATT_K0 + (so_) + dK; \
        ATT_GLDS(p_ + oK0, d_); ATT_GLDS(p_ + oK1, d_ + 1024u); } while (0)
#define ATT_DMA_V(tv_, so_) do { const unsigned char* p_ = gb + (size_t)(4 * (tv_)) * (2 * PBROW); const unsigned d_ = ldsb + ATT_V0 + (so_) + dV; \
        ATT_GLDS(p_ + oV0, d_); ATT_GLDS(p_ + oV0 + 2 * PBROW, d_ + 1024u); } while (0)
#define ATT_WAITBAR() do { asm volatile("s_waitcnt vmcnt(4) lgkmcnt(0)" ::: "memory"); __builtin_amdgcn_s_barrier(); asm volatile("" ::: "memory"); } while (0)
    const int TL = NT - 1;
    ATT_DMA_K(0, 0);
    ATT_DMA_K(1, ATT_SLOT);
    { const int t2 = 2 < TL ? 2 : TL; ATT_DMA_K(t2, 2 * ATT_SLOT); }
    ATT_DMA_V(0, 0);
    AttS st; st.O0 = zero16(); st.O1 = zero16(); st.O2 = zero16(); st.O3 = zero16();
    st.mref = 0.f; st.l = 0.f; st.alpha = 1.f; st.rp = 0;
    asm volatile("s_waitcnt vmcnt(6)" ::: "memory"); __builtin_amdgcn_s_barrier(); asm volatile("" ::: "memory");
    st.k0 = ATT_KF(rk0, 0); st.k1 = ATT_KF(rk0, 8192); st.k2 = ATT_KF(rk1, 0); st.k3 = ATT_KF(rk1, 8192);
    st.k4 = ATT_KF(rk2, 0); st.k5 = ATT_KF(rk2, 8192); st.k6 = ATT_KF(rk3, 0); st.k7 = ATT_KF(rk3, 8192);
    ATT_WAITBAR();
    { const int t3 = 3 < TL ? 3 : TL, t1 = 1 < TL ? 1 : TL; ATT_DMA_K(t3, 0); ATT_DMA_V(t1, ATT_SLOT); }
    st.p0 = mfma32(st.k0, qf[0], zero16()); st.p1 = mfma32(st.k1, qf[0], zero16());
    st.p0 = mfma32(st.k2, qf[1], st.p0); st.p1 = mfma32(st.k3, qf[1], st.p1);
    st.p0 = mfma32(st.k4, qf[2], st.p0); st.p1 = mfma32(st.k5, qf[2], st.p1);
    st.p0 = mfma32(st.k6, qf[3], st.p0); st.p1 = mfma32(st.k7, qf[3], st.p1);
    ATT_SB();
    st.k0 = ATT_KF(rk0, ATT_SLOT); st.k1 = ATT_KF(rk0, ATT_SLOT + 8192); st.k2 = ATT_KF(rk1, ATT_SLOT); st.k3 = ATT_KF(rk1, ATT_SLOT + 8192);
    st.k4 = ATT_KF(rk2, ATT_SLOT); st.k5 = ATT_KF(rk2, ATT_SLOT + 8192); st.k6 = ATT_KF(rk3, ATT_SLOT); st.k7 = ATT_KF(rk3, ATT_SLOT + 8192);
    ATT_MASK(st.p0, st.p1, 0);
    st.mref = attn_rowmax(st.p0, st.p1);
#pragma unroll
    for (int r = 0; r < 16; ++r) { st.p0[r] = __builtin_amdgcn_exp2f(st.p0[r] - st.mref); st.p1[r] = __builtin_amdgcn_exp2f(st.p1[r] - st.mref); }
    { f32x2 ps = attn_sum8<0>(st.p0, (f32x2){0.f, 0.f}); ps = attn_sum8<8>(st.p0, ps); ps = attn_sum8<0>(st.p1, ps); ps = attn_sum8<8>(st.p1, ps); st.l += ps.x + ps.y; }
    st.pf0 = pack8<0>(st.p0); st.pf1 = pack8<8>(st.p0);
    ATT_PIN(st.pf0); ATT_PIN(st.pf1); ATT_PIN(st.p1);
    int sa = ATT_SLOT, sb = 2 * ATT_SLOT, sc = 0;
    for (int t = 1; t <= TL; ++t) {
        ATT_WAITBAR();
        { const int tk = t + 3 < TL ? t + 3 : TL, tv = t + 1 < TL ? t + 1 : TL; ATT_DMA_K(tk, sa); ATT_DMA_V(tv, sb); }
        attn_step(st, t, qw, r32, hi, qf, tvb + sc, rk0 + sb, rk1 + sb, rk2 + sb, rk3 + sb);
        const int s0 = sa; sa = sb; sb = sc; sc = s0;
    }
    ATT_WAITBAR();
    ATT_OSCALE();
    st.pf2 = pack8<0>(st.p1); st.pf3 = pack8<8>(st.p1);
    { ldsp tv = tvb + sc;
      { const bf16x8 v0 = ATT_VF(tv, 0, 0), v1 = ATT_VF(tv, 0, 1), v2 = ATT_VF(tv, 0, 2), v3 = ATT_VF(tv, 0, 3);
        st.O0 = mfma32(v0, st.pf0, st.O0); st.O1 = mfma32(v1, st.pf0, st.O1); st.O2 = mfma32(v2, st.pf0, st.O2); st.O3 = mfma32(v3, st.pf0, st.O3); }
      { const bf16x8 v0 = ATT_VF(tv, 1, 0), v1 = ATT_VF(tv, 1, 1), v2 = ATT_VF(tv, 1, 2), v3 = ATT_VF(tv, 1, 3);
        st.O0 = mfma32(v0, st.pf1, st.O0); st.O1 = mfma32(v1, st.pf1, st.O1); st.O2 = mfma32(v2, st.pf1, st.O2); st.O3 = mfma32(v3, st.pf1, st.O3); }
      { const bf16x8 v0 = ATT_VF(tv, 2, 0), v1 = ATT_VF(tv, 2, 1), v2 = ATT_VF(tv, 2, 2), v3 = ATT_VF(tv, 2, 3);
        st.O0 = mfma32(v0, st.pf2, st.O0); st.O1 = mfma32(v1, st.pf2, st.O1); st.O2 = mfma32(v2, st.pf2, st.O2); st.O3 = mfma32(v3, st.pf2, st.O3); }
      { const bf16x8 v0 = ATT_VF(tv, 3, 0), v1 = ATT_VF(tv, 3, 1), v2 = ATT_VF(tv, 3, 2), v3 = ATT_VF(tv, 3, 3);
        st.O0 = mfma32(v0, st.pf3, st.O0); st.O1 = mfma32(v1, st.pf3, st.O1); st.O2 = mfma32(v2, st.pf3, st.O2); st.O3 = mfma32(v3, st.pf3, st.O3); } }
#undef ATT_GLDS
#undef ATT_DMA_K
#undef ATT_DMA_V
#undef ATT_WAITBAR
    const float l = half_sum(st.l);
    const float inv = 1.0f / l;
    int tid_e = tid; LAUNDER_V(tid_e);
    const int lane_e = tid_e & 63, r32e = lane_e & 31, hie = lane_e >> 5;
    u32x2 gpre[16]; f32x4 spre[16];
    if (c == 0) { const bf16* grow = proj + pidx(row00 + qw + r32e, C_GD + hcol + 4 * hie); const float* sgp = subg + 4 * hie;
#pragma unroll
        for (int et = 0; et < 4; ++et)
#pragma unroll
            for (int q4 = 0; q4 < 4; ++q4) { gpre[4 * et + q4] = *(const u32x2*)(grow + 512 * et + 8 * q4); spre[4 * et + q4] = *(const f32x4*)(sgp + 32 * et + 8 * q4); }
        asm volatile("s_waitcnt vmcnt(32) lgkmcnt(0)" ::: "memory"); }
    else asm volatile("s_waitcnt vmcnt(0) lgkmcnt(0)" ::: "memory");
    __builtin_amdgcn_s_barrier(); asm volatile("" ::: "memory");
#define ATT_BAR() do { asm volatile("s_waitcnt lgkmcnt(0)" ::: "memory"); __builtin_amdgcn_s_barrier(); asm volatile("" ::: "memory"); } while (0)
    LAS float* XB = (LAS float*)lds + it * 4096 + lane_e;
    const float lam = lamp[0], oml = lamp[1];
    if (c == 1) { const float f = lam * inv;
#pragma unroll
        for (int r = 0; r < 16; ++r) { XB[(0 * 16 + r) * 64] = st.O0[r] * f; XB[(1 * 16 + r) * 64] = st.O1[r] * f; XB[(2 * 16 + r) * 64] = st.O2[r] * f; XB[(3 * 16 + r) * 64] = st.O3[r] * f; } }
    ATT_BAR();
    if (c == 0) {
        float ss = 0.f;
#pragma unroll
        for (int r = 0; r < 16; ++r) {
            st.O0[r] = st.O0[r] * inv - XB[(0 * 16 + r) * 64]; st.O1[r] = st.O1[r] * inv - XB[(1 * 16 + r) * 64];
            st.O2[r] = st.O2[r] * inv - XB[(2 * 16 + r) * 64]; st.O3[r] = st.O3[r] * inv - XB[(3 * 16 + r) * 64];
            ss += st.O0[r] * st.O0[r] + st.O1[r] * st.O1[r] + st.O2[r] * st.O2[r] + st.O3[r] * st.O3[r]; }
        ss = half_sum(ss);
        const float rs = rsqrtf(ss * (1.f / 128.f) + EPS) * oml;
        const size_t rowl = (size_t)(qw + r32e);
        bf16* yrow = yc + ((size_t)b * SEQ + rowl) * 1024 + h * 128 + 4 * hie;
#pragma unroll
        for (int et = 0; et < 4; ++et)
#pragma unroll
            for (int q4 = 0; q4 < 4; ++q4) {
                const f32x16& A = et == 0 ? st.O0 : et == 1 ? st.O1 : et == 2 ? st.O2 : st.O3;
                const int e0 = 32 * et + 8 * q4;
                const f32x4 sg4 = spre[4 * et + q4]; const u32x2 g = gpre[4 * et + q4];
                u32x2 o; o.x = cvt_pk_bf16(A[4 * q4] * rs * sg4.x * bf_lo(g.x), A[4 * q4 + 1] * rs * sg4.y * bf_hi(g.x));
                o.y = cvt_pk_bf16(A[4 * q4 + 2] * rs * sg4.z * bf_lo(g.y), A[4 * q4 + 3] * rs * sg4.w * bf_hi(g.y));
                *(u32x2*)(yrow + e0) = o;
            }
    }
#undef ATT_BAR
#undef ATT_PIN
#undef ATT_SB
#undef ATT_EXP4
#undef ATT_SUB4
#undef ATT_EXP1
#undef ATT_EXP3
#undef ATT_VF
#undef ATT_KF
#undef ATT_MASK
#undef ATT_OSCALE
}

__device__ __forceinline__ int fetch_item(const int tid, gu32* ctr, volatile LAS unsigned* slot) {
    __syncthreads();
    if (tid == 0) *slot = __hip_atomic_fetch_add(ctr, 1u, RLX_AGENT);
    __syncthreads();
    return __builtin_amdgcn_readfirstlane((int)*slot);
}

#ifndef G1_ALIGN
#define G1_ALIGN true
#endif
#ifndef G1_SP2
#define G1_SP2 true
#endif
#ifndef G3_ALIGN
#define G3_ALIGN true
#endif
#ifndef G3_SP2
#define G3_SP2 true
#endif
#ifndef G4_ALIGN
#define G4_ALIGN true
#endif
#ifndef G4_SP2
#define G4_SP2 true
#endif
#ifndef PROBE_DUP
#define PROBE_DUP 0
#endif
#ifndef PROBE_EMODE
#define PROBE_EMODE 0
#endif
#ifndef PROBE_AMODE
#define PROBE_AMODE 0
#endif
#ifndef PROBE_P2SEL
#define PROBE_P2SEL 0
#endif
#ifndef MK_N_LAUNCHES
#define MK_N_LAUNCHES 1
#endif
constexpr int N_PHASES = 1 + NGROUP * DEPTH * 5;
struct Args { const float* in[17]; float* out; unsigned char* ws; int ph_lo, ph_hi, li, pad; };
__global__ void __launch_bounds__(NWAVES * 64, 2) hyb_fwd(Args args) {
    extern __shared__ __attribute__((aligned(16))) unsigned char lds_raw[];
    ldsp lds = (ldsp)lds_raw;
    volatile LAS unsigned* MISC = (volatile LAS unsigned*)(lds + MISC_OFF);
    for (int u = threadIdx.x; u < (LDS_BYTES - LDSCTL_OFF) / 4; u += NWAVES * 64) ((LAS unsigned*)(lds + LDSCTL_OFF))[u] = 0u;
    __syncthreads();
    XcdBarrier bar = xcd_barrier_post((unsigned*)((gu32*)(args.ws + WS_CTL) + CW_BAR) + args.li * XCD_BAR_WORDS, MISC + 8, (unsigned)__builtin_amdgcn_readfirstlane((int)threadIdx.x >> 6));
    int tidc = threadIdx.x;
    const int lo = args.ph_lo, hi_ = args.ph_hi;
#define IN(k) (lo <= (k) && (k) < hi_)
#define BOTH(k) (IN(k) && IN((k) + 1))
#define PHASE_ENTRY() LAUNDER_V(tidc); const int tid = tidc; unsigned long long z_ = 0ull; LAUNDER_S(z_); unsigned char* ws = args.ws + z_; const int G = gridDim.x; \
    const int lane = tid & 63, wave = __builtin_amdgcn_readfirstlane(tid >> 6); (void)lane; (void)wave; (void)G

    if (IN(0)) {
        PHASE_ENTRY();
        const int gw = blockIdx.x * NWAVES + wave, NGW = G * NWAVES;
        float* lams = (float*)(ws + WS_LAMS);
        bf16* WIN = (bf16*)(ws + WS_WIN); bf16* WBR = (bf16*)(ws + WS_WBR); bf16* WOUT = (bf16*)(ws + WS_WOUT); bf16* HB = (bf16*)(ws + WS_H);
        LAS float* scr = (LAS float*)(lds + wave * 16384);
        constexpr int I_IN = (2048 / 64) * (16384 / 32), I_BR = (1024 / 64) * (2048 / 32), I_OUT = (2048 / 64) * (2048 / 32);
        constexpr int NITEMS = 2 * I_IN + 6 * I_BR + 2 * I_OUT;
        for (int it = gw; it < NITEMS; it += NGW) {
            int r = it;
            if (r < 2 * I_IN) { const int l = r / I_IN; r -= l * I_IN; p0_transpose_item(args.in[3] + (size_t)l * 2048 * 16384, 2048, 16384, WIN + (size_t)l * 16384 * 2048, scr, r, lane); continue; }
            r -= 2 * I_IN;
            if (r < 6 * I_BR) { const int lj = r / I_BR; r -= lj * I_BR; const int l = lj / 3, j = lj - 3 * l;
                const float* src = j == 0 ? args.in[13] : j == 1 ? args.in[14] : args.in[15];
                p0_transpose_item(src + (size_t)l * 1024 * 2048, 1024, 2048, WBR + (size_t)lj * 2048 * 1024, scr, r, lane); continue; }
            r -= 6 * I_BR;
            { const int l = r / I_OUT; r -= l * I_OUT; p0_transpose_item(args.in[16] + (size_t)l * 2048 * 2048, 2048, 2048, WOUT + (size_t)l * 2048 * 2048, scr, r, lane); }
        }
        if (blockIdx.x == 0 && wave == 0) {
            for (int l = 0; l < DEPTH; ++l) { const float* dl = args.in[11] + l * 256;
                const float s01 = wave_sum(dl[lane] * dl[64 + lane]), s23 = wave_sum(dl[128 + lane] * dl[192 + lane]);
                const float lam_init = 0.8f - 0.6f * __expf(-0.3f * (float)l);
                if (lane == 0) { lams[2 * l] = __expf(s01) - __expf(s23) + lam_init; lams[2 * l + 1] = 1.0f - lam_init; } }
        }
        { f32x4 gv[8];
#pragma unroll
          for (int j = 0; j < 4; ++j) { gv[2 * j] = *(const f32x4*)(args.in[1] + 512 * j + 8 * lane); gv[2 * j + 1] = *(const f32x4*)(args.in[1] + 512 * j + 8 * lane + 4); }
          for (int m = gw; m < M_ALL; m += NGW) rms_row_to_bf16(args.in[0] + (size_t)m * D_MODEL, gv, HB + (size_t)m * D_MODEL, lane); }
        if (BOTH(0)) xcd_barrier(bar);
    }

    for (int g = 0; g < NGROUP; ++g)
        for (int l = 0; l < DEPTH; ++l) {
            const int pb = 1 + (g * DEPTH + l) * 5;
            if (IN(pb)) {
                PHASE_ENTRY();
                pg8::SchedPlain S; S.so.init(TG, D_IN, G, (int)blockIdx.x); S.A = (const char*)(ws + WS_H) + (size_t)g * TG * D_MODEL * 2; S.Bt = (const char*)(ws + WS_WIN) + (size_t)l * D_IN * D_MODEL * 2;
                pg8::EpiProj E{(bf16*)(ws + WS_PROJ), (bf16*)(ws + WS_GM), (PROBE_DUP == 1 && args.li > 0 && pb == lo) ? PROBE_EMODE : 0};
#ifndef SKIP_P1
                pg8::gemm_phase<pg8::EpiProj, pg8::SchedPlain, G1_ALIGN, G1_SP2>(lds, D_MODEL, S, E, tid);
#endif
                if (BOTH(pb)) xcd_barrier(bar);
            }
            if (IN(pb + 1)) {
                const bool only = PROBE_DUP == 2 && PROBE_P2SEL != 0 && args.li > 0 && (pb + 1) == lo;
#ifndef SKIP_RET
                if (!only || PROBE_P2SEL == 1) { PHASE_ENTRY(); gu32* q = (gu32*)(ws + WS_CTL) + CW_Q + 64 * 3 * (g * DEPTH + l) + args.li * 1024;
                  const bf16* PROJ = (const bf16*)(ws + WS_PROJ); bf16* YB = (bf16*)(ws + WS_Y);
                  for (;;) { LAUNDER_V(tidc); const int t2 = tidc; const int it = fetch_item(t2, q, MISC + 16); if (it >= BG * 8) break; ret_unit(t2, lds, it >> 3, it & 7, PROJ, YB + (size_t)TG * 1024); } }
#endif
#ifndef SKIP_LRU
                if (!only || PROBE_P2SEL == 2) { PHASE_ENTRY(); gu32* q = (gu32*)(ws + WS_CTL) + CW_Q + 64 * 3 * (g * DEPTH + l) + args.li * 1024;
                  const bf16* PROJ = (const bf16*)(ws + WS_PROJ); bf16* YB = (bf16*)(ws + WS_Y);
                  for (;;) { LAUNDER_V(tidc); const int t2 = tidc; const int it = fetch_item(t2, q + 64, MISC + 16); if (it >= BG * 16) break;
                    lru_unit(t2, lds, it >> 4, it & 15, PROJ, YB, args.in[4] + l * 4096, args.in[5] + l * 1024, args.in[6] + (size_t)l * 65536, args.in[7] + l * 1024,
                             args.in[8] + (size_t)l * 65536, args.in[9] + l * 1024, args.in[10] + l * 1024); } }
#endif
#ifndef SKIP_ATT
                if (!only || PROBE_P2SEL == 3) { PHASE_ENTRY(); gu32* q = (gu32*)(ws + WS_CTL) + CW_Q + 64 * 3 * (g * DEPTH + l) + args.li * 1024;
                  const bf16* PROJ = (const bf16*)(ws + WS_PROJ); bf16* YB = (bf16*)(ws + WS_Y); const float* lams = (const float*)(ws + WS_LAMS);
                  int it; { LAUNDER_V(tidc); const int t2 = tidc; it = fetch_item(t2, q + 128, MISC + 16); }
                  while (it < BG * 8 * 32) { LAUNDER_V(tidc); const int t2 = tidc; const int qb = 31 - (it >> 5), bh = it & 31;
                    unsigned pend = 0u; if (t2 == 0) pend = __hip_atomic_fetch_add(q + 128, 1u, RLX_AGENT);
                    attn_unit(t2, lds, bh >> 3, bh & 7, qb, PROJ, YB + (size_t)2 * TG * 1024, lams + 2 * l, args.in[12] + l * 128);
                    LAUNDER_V(tidc); const int t3 = tidc; volatile LAS unsigned* slot = MISC + 16;
                    __syncthreads(); if (t3 == 0) *slot = pend; __syncthreads(); it = __builtin_amdgcn_readfirstlane((int)*slot); } }
#endif
                if (BOTH(pb + 1)) xcd_barrier(bar);
            }
            if (IN(pb + 2)) {
                PHASE_ENTRY();
                pg8::SchedBranch S; S.so.init(TG, D_MODEL, G, (int)blockIdx.x); S.A = (const char*)(ws + WS_Y); S.strideA = (size_t)TG * 1024 * 2;
                S.Bt = (const char*)(ws + WS_WBR) + (size_t)l * 3 * 2048 * 1024 * 2; S.strideB = (size_t)2048 * 1024 * 2;
                pg8::EpiMerge E{(const unsigned char*)(ws + WS_GM), (bf16*)(ws + WS_M)};
#ifndef SKIP_P3
                pg8::gemm_phase<pg8::EpiMerge, pg8::SchedBranch, G3_ALIGN, G3_SP2>(lds, 1024, S, E, tid);
#endif
                if (BOTH(pb + 2)) xcd_barrier(bar);
            }
            if (IN(pb + 3)) {
                PHASE_ENTRY();
                pg8::SchedPlain S; S.so.init(TG, D_MODEL, G, (int)blockIdx.x); S.A = (const char*)(ws + WS_M); S.Bt = (const char*)(ws + WS_WOUT) + (size_t)l * D_MODEL * D_MODEL * 2;
                pg8::EpiBf16Plain E{(bf16*)(ws + WS_O), D_MODEL};
#ifndef SKIP_P4
                pg8::gemm_phase<pg8::EpiBf16Plain, pg8::SchedPlain, G4_ALIGN, G4_SP2>(lds, D_MODEL, S, E, tid);
#endif
                if (BOTH(pb + 3)) xcd_barrier(bar);
            }
            if (IN(pb + 4)) {
                PHASE_ENTRY();
                const int gw = blockIdx.x * NWAVES + wave, NGW = G * NWAVES;
                const bool dead = __hip_atomic_load((gu32*)(ws + WS_CTL) + CW_BAR + XB_TMO, RLX_AGENT) != 0u;
                const bf16* OB = (const bf16*)(ws + WS_O); bf16* HB = (bf16*)(ws + WS_H); bf16* X1 = (bf16*)(ws + WS_X1);
                f32x4 pgv[8], ngv[8];
                { const float* pg = args.in[2] + l * D_MODEL + 8 * lane; const float* ng = args.in[1] + D_MODEL + 8 * lane;
#pragma unroll
                  for (int j = 0; j < 4; ++j) { pgv[2 * j] = *(const f32x4*)(pg + 512 * j); pgv[2 * j + 1] = *(const f32x4*)(pg + 512 * j + 4); ngv[2 * j] = *(const f32x4*)(ng + 512 * j); ngv[2 * j + 1] = *(const f32x4*)(ng + 512 * j + 4); } }
                for (int m = gw; m < TG; m += NGW) {
                    const size_t row = (size_t)g * TG + m;
                    const v4u* orow = (const v4u*)(OB + (size_t)m * D_MODEL) + lane;
                    f32x4 v[8]; float s = 0.f;
#pragma unroll
                    for (int j = 0; j < 4; ++j) { const v4u ow = orow[64 * j]; v[2 * j] = (f32x4){bf_lo(ow.x), bf_hi(ow.x), bf_lo(ow.y), bf_hi(ow.y)}; v[2 * j + 1] = (f32x4){bf_lo(ow.z), bf_hi(ow.z), bf_lo(ow.w), bf_hi(ow.w)}; }
#pragma unroll
                    for (int j = 0; j < 8; ++j) s += (v[j].x * v[j].x + v[j].y * v[j].y) + (v[j].z * v[j].z + v[j].w * v[j].w);
                    const float rs = rsqrtf(wave_sum(s) * (1.f / D_MODEL) + EPS);
                    if (l == 0) {
                        const float* xrow = args.in[0] + row * D_MODEL + 8 * lane; float s2 = 0.f;
                        v4u* x8 = (v4u*)(X1 + (size_t)m * D_MODEL) + lane;
#pragma unroll
                        for (int j = 0; j < 4; ++j) {
                            const f32x4 xa = *(const f32x4*)(xrow + 512 * j), xb = *(const f32x4*)(xrow + 512 * j + 4), ga = pgv[2 * j], gb = pgv[2 * j + 1];
                            v[2 * j] = xa + v[2 * j] * rs * ga; v[2 * j + 1] = xb + v[2 * j + 1] * rs * gb;
                            v4u wv; wv.x = cvt_pk_bf16(v[2 * j].x, v[2 * j].y); wv.y = cvt_pk_bf16(v[2 * j].z, v[2 * j].w); wv.z = cvt_pk_bf16(v[2 * j + 1].x, v[2 * j + 1].y); wv.w = cvt_pk_bf16(v[2 * j + 1].z, v[2 * j + 1].w);
                            x8[64 * j] = wv; }
#pragma unroll
                        for (int j = 0; j < 8; ++j) s2 += (v[j].x * v[j].x + v[j].y * v[j].y) + (v[j].z * v[j].z + v[j].w * v[j].w);
                        const float rs2 = rsqrtf(wave_sum(s2) * (1.f / D_MODEL) + EPS);
                        v4u* o8 = (v4u*)(HB + row * D_MODEL) + lane;
#pragma unroll
                        for (int j = 0; j < 4; ++j) { const f32x4 ga = ngv[2 * j], gb = ngv[2 * j + 1]; const f32x4 a = v[2 * j] * rs2 * ga, bq = v[2 * j + 1] * rs2 * gb;
                            v4u wv; wv.x = cvt_pk_bf16(a.x, a.y); wv.y = cvt_pk_bf16(a.z, a.w); wv.z = cvt_pk_bf16(bq.x, bq.y); wv.w = cvt_pk_bf16(bq.z, bq.w); o8[64 * j] = wv; }
                    } else {
                        const v4u* x8 = (const v4u*)(X1 + (size_t)m * D_MODEL) + lane;
                        float* drow = args.out + row * D_MODEL + 8 * lane;
#pragma unroll
                        for (int j = 0; j < 4; ++j) { const v4u xw = x8[64 * j]; const f32x4 ga = pgv[2 * j], gb = pgv[2 * j + 1];
                            f32x4 a = (f32x4){bf_lo(xw.x), bf_hi(xw.x), bf_lo(xw.y), bf_hi(xw.y)} + v[2 * j] * rs * ga, bq = (f32x4){bf_lo(xw.z), bf_hi(xw.z), bf_lo(xw.w), bf_hi(xw.w)} + v[2 * j + 1] * rs * gb;
                            if (dead) { const float qn = __builtin_nanf(""); a = (f32x4){qn, qn, qn, qn}; bq = a; }
                            *(f32x4*)(drow + 512 * j) = a; *(f32x4*)(drow + 512 * j + 4) = bq; }
                    }
                }
                if (BOTH(pb + 4)) xcd_barrier(bar);
            }
        }
#undef IN
#undef BOTH
#undef PHASE_ENTRY
}

extern "C" void kernel_launch(void* const* d_in, const int* in_sizes, int n_in, void* d_out, int out_size, void* d_ws, size_t ws_size, hipStream_t stream) {
    static int grid = 0;
    if (grid == 0) {
        if (n_in != 17 || in_sizes[0] != M_ALL * D_MODEL || out_size != M_ALL * D_MODEL || ws_size < WS_END) {
            fprintf(stderr, "kernel_launch: unexpected shapes (n_in %d, in0 %d, out %d, ws %zu < %zu); nothing launched\n", n_in, n_in > 0 ? in_sizes[0] : -1, out_size, ws_size, (size_t)WS_END); grid = -1; return; }
        int dev = 0, cus = 0, per_cu = 0;
        if (hipGetDevice(&dev) != hipSuccess || hipDeviceGetAttribute(&cus, hipDeviceAttributeMultiprocessorCount, dev) != hipSuccess) { grid = -1; return; }
        if (hipFuncSetAttribute((const void*)hyb_fwd, hipFuncAttributeMaxDynamicSharedMemorySize, LDS_BYTES) != hipSuccess) { fprintf(stderr, "kernel_launch: hipFuncSetAttribute failed\n"); grid = -1; return; }
        if (hipOccupancyMaxActiveBlocksPerMultiprocessor(&per_cu, (const void*)hyb_fwd, NWAVES * 64, LDS_BYTES) != hipSuccess || per_cu < 1)
            fprintf(stderr, "kernel_launch: note: occupancy query reports %d workgroups per CU\n", per_cu);
        (void)hipGetLastError();
        grid = cus;
    }
    if (grid < 0) return;
    if (hipMemsetAsync((char*)d_ws + WS_CTL, 0, CTL_ZERO_BYTES, stream) != hipSuccess) return;
    Args a{};
    for (int i = 0; i < 17; ++i) a.in[i] = (const float*)d_in[i];
    a.out = (float*)d_out; a.ws = (unsigned char*)d_ws;
#if PROBE_DUP > 0
    { int lo = 0; for (int k = 0; k <= NGROUP * DEPTH; ++k) { const int p = 1 + k * 5 + (PROBE_DUP - 1); const int hi = k < NGROUP * DEPTH ? p + 1 : N_PHASES;
        a.ph_lo = lo; a.ph_hi = hi; a.li = k; a.pad = 0; hipLaunchKernelGGL(hyb_fwd, dim3(grid), dim3(NWAVES * 64), LDS_BYTES, stream, a); lo = p; } }
#elif MK_N_LAUNCHES == 1
    a.ph_lo = 0; a.ph_hi = N_PHASES; a.li = 0; a.pad = 0;
    hipLaunchKernelGGL(hyb_fwd, dim3(grid), dim3(NWAVES * 64), LDS_BYTES, stream, a);
#else
    for (int p = 0; p < N_PHASES; ++p) { a.ph_lo = p; a.ph_hi = p + 1; a.li = 0; a.pad = 0;
        hipLaunchKernelGGL(hyb_fwd, dim3(grid), dim3(NWAVES * 64), LDS_BYTES, stream, a); }
#endif
}
```

```cpp
#include <hip/hip_runtime.h>
#include <cstdio>
#include <cstdint>

namespace pg8 {
#define PG8_LAS __attribute__((address_space(3)))
typedef unsigned short bf16_t;
typedef short bf16x8 __attribute__((ext_vector_type(8)));
typedef float f32x4 __attribute__((ext_vector_type(4)));
typedef unsigned u32x4 __attribute__((ext_vector_type(4)));
constexpr int BM = 256, BK = 64, HALF = 128, HTB = HALF * BK * 2  , STAGE_BYTES = 8 * HTB, NXCD = 8, WGM = 8;

__host__ __device__ __forceinline__ int lds_byte(int r, int c) { const int st = (r >> 4) * 2 + (c >> 5), rr = r & 15, cc = c & 31, ob = rr * 64 + cc * 2; return st * 1024 + (ob ^ (((ob >> 9) & 1) << 5)); }
__host__ __device__ __forceinline__ void stage_rc(int b, int& R, int& C) { const int st = b / 1024, sb = b % 1024, swz = sb ^ (((sb >> 9) & 1) << 5); R = (st >> 1) * 16 + swz / 64; C = (st & 1) * 32 + (swz % 64) / 2; }
__host__ __device__ __forceinline__ int perm32(int rho) { const int n = rho >> 4, i = rho & 15; return 8 * (i >> 2) + 4 * n + (i & 3); }

struct Unit { int pm, pn, sel; };

struct StaticOrder {
    int nM, nN, nwg, G, c;
    __host__ __device__ void init(int M, int N, int G_, int c_) { nM = M / BM; nN = N / BM; nwg = nM * nN; G = G_; c = c_; }
    __host__ __device__ bool next(int i, Unit& u) const {
        const long L = (long)i * G + c; if (L >= nwg) return false;
        int wgid = (int)L; { const int q = nwg / NXCD, r = nwg % NXCD, xcd = wgid % NXCD, off = wgid / NXCD; wgid = (xcd < r ? xcd * (q + 1) : r * (q + 1) + (xcd - r) * q) + off; }
        const int nig = WGM * nN, gid = wgid / nig, fm = gid * WGM, gsz = (nM - fm) < WGM ? (nM - fm) : WGM;
        u.pm = fm + ((wgid % nig) % gsz); u.pn = (wgid % nig) / gsz; u.sel = 0; return true;
    }
};
struct SchedPlain {
    StaticOrder so; const char* A; const char* Bt;
    __device__ __forceinline__ bool next(int i, Unit& u) const { return so.next(i, u); }
    __device__ __forceinline__ const char* a_base(const Unit& u, size_t tstep) const { return A + (size_t)u.pm * tstep; }
    __device__ __forceinline__ const char* b_base(const Unit& u, size_t tstep) const { return Bt + (size_t)u.pn * tstep; }
    __device__ __forceinline__ bool keep(const Unit&) const { return false; }
    __device__ __forceinline__ void a_ready(const Unit&) const {}
    __device__ __forceinline__ void done(const Unit&) const {}
};
struct SchedBranch {
    StaticOrder so; const char* A; const char* Bt; size_t strideA, strideB;
    __device__ __forceinline__ bool next(int i, Unit& u) const { const int t = i / 3; if (!so.next(t, u)) return false; u.sel = i - 3 * t; return true; }
    __device__ __forceinline__ const char* a_base(const Unit& u, size_t tstep) const { return A + (size_t)u.sel * strideA + (size_t)u.pm * tstep; }
    __device__ __forceinline__ const char* b_base(const Unit& u, size_t tstep) const { return Bt + (size_t)u.sel * strideB + (size_t)u.pn * tstep; }
    __device__ __forceinline__ bool keep(const Unit& u) const { return u.sel < 2; }
    __device__ __forceinline__ void a_ready(const Unit&) const {}
    __device__ __forceinline__ void done(const Unit&) const {}
};

typedef float f32x2_cv __attribute__((ext_vector_type(2))); typedef __bf16 bf16x2_cv __attribute__((ext_vector_type(2)));
__device__ __forceinline__ unsigned cvt_pk_bf16(float lo, float hi) { const f32x2_cv v = {lo, hi}; const bf16x2_cv b = __builtin_convertvector(v, bf16x2_cv); return __builtin_bit_cast(unsigned, b); }
__device__ __forceinline__ float bf_lo(unsigned w) { return __uint_as_float(w << 16); }
__device__ __forceinline__ float bf_hi(unsigned w) { return __uint_as_float(w & 0xffff0000u); }
__device__ __forceinline__ float fast_sigmoid(float x) { return __builtin_amdgcn_rcpf(1.0f + __expf(-x)); }
__device__ __forceinline__ float fast_silu(float x) { return x * fast_sigmoid(x); }
__device__ __forceinline__ float lg2_gamma(int h) {
    const float x = __builtin_amdgcn_exp2f((float)(-5 - h));
    const float s = x * (1.0f + x * (0.5f + x * (0.33333334f + x * (0.25f + x * 0.2f))));
    return -s * 1.4426950408889634f;
}

template <int MASK> __device__ __forceinline__ float swz_xor(float v) { return __builtin_bit_cast(float, __builtin_amdgcn_ds_swizzle(__builtin_bit_cast(int, v), (MASK << 10) | 0x1f)); }
__device__ __forceinline__ float swz_xor16(float v) { return swz_xor<16>(v); }
__device__ __forceinline__ void half_swap(unsigned& a, unsigned& b) { asm volatile("s_nop 1\n\tv_permlane32_swap_b32 %0, %1" : "+v"(a), "+v"(b)); }
__device__ __forceinline__ float half_sum(float v) { unsigned a = __builtin_bit_cast(unsigned, v), b = a; half_swap(a, b); return __builtin_bit_cast(float, a) + __builtin_bit_cast(float, b); }
__device__ __forceinline__ float half_max(float v) { unsigned a = __builtin_bit_cast(unsigned, v), b = a; half_swap(a, b); return fmaxf(__builtin_bit_cast(float, a), __builtin_bit_cast(float, b)); }

__host__ __device__ __forceinline__ size_t blk_idx(int row, int col, int nbc  ) { return ((size_t)(row >> 4) * nbc + (col >> 5)) * 512 + (size_t)((row & 15) * 32 + (col & 31)); }

struct EpiF32 {
    static constexpr bool PERM = false, AFTER_DRAIN = false;
    float* C; int ldc;
    __device__ __forceinline__ void operator()(f32x4 (&acc)[2][2][4][2], const Unit& u, int wr, int wc, int fr, int fq) const {
        const int row0 = u.pm * BM + wr * 64 + fr, col0 = u.pn * BM + wc * 32 + 4 * fq;
#pragma unroll
        for (int ai = 0; ai < 2; ++ai)
#pragma unroll
            for (int m = 0; m < 4; ++m) { float* rowp = C + (size_t)(row0 + ai * HALF + m * 16) * ldc + col0;
#pragma unroll
                for (int bj = 0; bj < 2; ++bj)
#pragma unroll
                    for (int n = 0; n < 2; ++n) *(f32x4*)(rowp + bj * HALF + n * 16) = acc[ai][bj][m][n]; }
    }
};

__host__ __device__ __forceinline__ size_t gm8_idx(int row, int bc) { return ((size_t)(row >> 4) * 96 + (bc >> 6)) * 1024 + (size_t)((row & 15) * 64 + (bc & 63)); }
__device__ __forceinline__ unsigned gate_q8x4(const f32x4& g) {
    const unsigned q0 = max((unsigned)(g[0] * 255.f + 0.5f), 1u), q1 = max((unsigned)(g[1] * 255.f + 0.5f), 1u), q2 = max((unsigned)(g[2] * 255.f + 0.5f), 1u), q3 = max((unsigned)(g[3] * 255.f + 0.5f), 1u);
    return q0 | (q1 << 8) | (q2 << 16) | (q3 << 24); }
__device__ __forceinline__ f32x4 gate_unq4(unsigned w) { return (f32x4){(float)(w & 0xffu), (float)((w >> 8) & 0xffu), (float)((w >> 16) & 0xffu), (float)(w >> 24)}; }
struct EpiProj {
    static constexpr bool PERM = true, AFTER_DRAIN = false;
    bf16_t* proj; bf16_t* gm; int mode;
    template <int KIND> __device__ __forceinline__ void run(f32x4 (&acc)[2][2][4][2], const Unit& u, int wr, int wc, int fr, int fq) const {
        const int row0 = u.pm * BM + wr * 64 + fr, colt = u.pn * BM, cl = wc * 32 + 8 * fq;
        constexpr double FRD[8] = {0.15915494309189535, 0.030863763158420102, 0.00598518567638293, 0.001160663620968869, 0.00022507907904105155, 4.3647954811733995e-05, 8.464331128654902e-06, 1.6414263867044143e-06};
#pragma unroll
        for (int ai = 0; ai < 2; ++ai)
#pragma unroll
            for (int m = 0; m < 4; ++m) {
                const int row = row0 + ai * HALF + m * 16, pos = row & 4095;
                float cs[8], sn[8];
                if constexpr (KIND == 2 || KIND == 3) {
                    int fqo = fq; asm volatile("" : "+v"(fqo));
#pragma unroll
                    for (int k = 0; k < 4; ++k) { const double fv = (double)__builtin_amdgcn_exp2f(-(float)(16 * wc + 4 * fqo + k) * (13.287712379549449f / 63.0f)) * 0.15915494309189535;
                        const double ph = (double)pos * fv; const float r = (float)(ph - __builtin_floor(ph)); cs[k] = __builtin_amdgcn_cosf(r); sn[k] = __builtin_amdgcn_sinf(r); }
                }
                if constexpr (KIND == 4 || KIND == 5) {
                    if ((wc & 1) == 0) {
#pragma unroll
                        for (int k = 0; k < 8; ++k) { const double ph = (double)pos * FRD[k]; const float r = (float)(ph - __builtin_floor(ph)); cs[k] = __builtin_amdgcn_cosf(r); sn[k] = __builtin_amdgcn_sinf(r); if (fq == 0) sn[k] = -sn[k]; }
                    }
                }
                u32x4 w8 = {0u, 0u, 0u, 0u};
#pragma unroll
                for (int bj = 0; bj < 2; ++bj) {
                    const int col = colt + bj * HALF + cl;
                    f32x4 v0 = acc[ai][bj][m][0], v1 = acc[ai][bj][m][1];
                    if constexpr (KIND == 0) {
#pragma unroll
                        for (int k = 0; k < 4; ++k) { v0[k] = fast_sigmoid(v0[k]); v1[k] = fast_sigmoid(v1[k]); }
                        if (bj == 0) { w8.x = gate_q8x4(v0); w8.y = gate_q8x4(v1); } else { w8.z = gate_q8x4(v0); w8.w = gate_q8x4(v1); }
                    } else if constexpr (KIND == 1) {
#pragma unroll
                        for (int k = 0; k < 4; ++k) { v0[k] = fast_silu(v0[k]); v1[k] = fast_silu(v1[k]); }
                    } else if constexpr (KIND == 2 || KIND == 3) {
                        float sc = 1.0f;
                        if constexpr (KIND == 3) { int hh = ((colt - 3072) >> 7) + bj; asm volatile("" : "+s"(hh));
                            sc = 0.08838834764831845f * __builtin_amdgcn_exp2f(lg2_gamma(hh) * (float)(127 - (pos & 127))); }
                        const f32x4 ca = {cs[0] * sc, cs[0] * sc, cs[1] * sc, cs[1] * sc}, sa = {sn[0] * sc, sn[0] * sc, sn[1] * sc, sn[1] * sc};
                        const f32x4 cb = {cs[2] * sc, cs[2] * sc, cs[3] * sc, cs[3] * sc}, sb = {sn[2] * sc, sn[2] * sc, sn[3] * sc, sn[3] * sc};
                        const f32x4 w0 = {-v0[1], v0[0], -v0[3], v0[2]}, w1 = {-v1[1], v1[0], -v1[3], v1[2]};
                        v0 = v0 * ca + w0 * sa; v1 = v1 * cb + w1 * sb;
                    } else if constexpr (KIND == 4 || KIND == 5) {
                        if ((wc & 1) == 0) {
                            f32x4 p0, p1;
#pragma unroll
                            for (int k = 0; k < 4; ++k) { p0[k] = swz_xor16(v0[k]); p1[k] = swz_xor16(v1[k]); }
                            if (fq < 2) {
#pragma unroll
                                for (int k = 0; k < 4; ++k) { v0[k] = v0[k] * cs[k] + p0[k] * sn[k]; v1[k] = v1[k] * cs[4 + k] + p1[k] * sn[4 + k]; }
                            }
                        }
                        if constexpr (KIND == 4) { v0 = v0 * 0.18033688011112042f; v1 = v1 * 0.18033688011112042f; }
                    }
                    if constexpr (KIND != 0) {
                        u32x4 w; w.x = cvt_pk_bf16(v0[0], v0[1]); w.y = cvt_pk_bf16(v0[2], v0[3]); w.z = cvt_pk_bf16(v1[0], v1[1]); w.w = cvt_pk_bf16(v1[2], v1[3]);
                        if constexpr (KIND == 7) *(u32x4*)(gm + blk_idx(row, col - 10240, 192)) = w;
                        else *(u32x4*)(proj + blk_idx(row, col, 320)) = w;
                    }
                }
                if constexpr (KIND == 0) *(u32x4*)((unsigned char*)gm + gm8_idx(row, colt - 10240 + 2 * cl)) = w8;
            }
    }
    __device__ __forceinline__ void operator()(f32x4 (&acc)[2][2][4][2], const Unit& u, int wr, int wc, int fr, int fq) const {
        const int seg = (u.pn * BM) >> 10;
        if (mode == 1) return;
        if (mode == 2) { if (seg >= 10) run<7>(acc, u, wr, wc, fr, fq); else run<6>(acc, u, wr, wc, fr, fq); return; }
        if (seg >= 10) run<0>(acc, u, wr, wc, fr, fq);
        else if (seg == 1 || seg == 5 || seg == 9) run<1>(acc, u, wr, wc, fr, fq);
        else if (seg == 2) run<2>(acc, u, wr, wc, fr, fq);
        else if (seg == 3) run<3>(acc, u, wr, wc, fr, fq);
        else if (seg == 6) run<4>(acc, u, wr, wc, fr, fq);
        else if (seg == 7) run<5>(acc, u, wr, wc, fr, fq);
        else run<6>(acc, u, wr, wc, fr, fq);
    }
};

struct EpiBf16Plain {
    static constexpr bool PERM = true, AFTER_DRAIN = false;
    bf16_t* O; int ldc;
    __device__ __forceinline__ void operator()(f32x4 (&acc)[2][2][4][2], const Unit& u, int wr, int wc, int fr, int fq) const {
        const int row0 = u.pm * BM + wr * 64 + fr, col0 = u.pn * BM + wc * 32 + 8 * fq;
#pragma unroll
        for (int ai = 0; ai < 2; ++ai)
#pragma unroll
            for (int m = 0; m < 4; ++m) { bf16_t* rowp = O + (size_t)(row0 + ai * HALF + m * 16) * ldc + col0;
#pragma unroll
                for (int bj = 0; bj < 2; ++bj) { const f32x4 v0 = acc[ai][bj][m][0], v1 = acc[ai][bj][m][1];
                    u32x4 w; w.x = cvt_pk_bf16(v0[0], v0[1]); w.y = cvt_pk_bf16(v0[2], v0[3]); w.z = cvt_pk_bf16(v1[0], v1[1]); w.w = cvt_pk_bf16(v1[2], v1[3]);
                    *(u32x4*)(rowp + bj * HALF) = w; } }
    }
};

struct EpiMerge {
    static constexpr bool PERM = true, AFTER_DRAIN = false;
    const unsigned char* gm; bf16_t* mo;
    __device__ __forceinline__ void load_batch(const int bt, const int row0, const int gbc, const int j, u32x4 (&gc)[2], u32x4 (&gn)[2]) const {
        const int ai = bt >> 1, mh = bt & 1;
#pragma unroll
        for (int mm = 0; mm < 2; ++mm) { const unsigned char* p = gm + gm8_idx(row0 + ai * HALF + (2 * mh + mm) * 16, gbc);
            gc[mm] = *(const u32x4*)p; if (j < 2) gn[mm] = *(const u32x4*)(p + (size_t)32 * 1024); else gn[mm] = gc[mm]; }
    }
    __device__ __forceinline__ void apply_batch(const int bt, f32x4 (&acc)[2][2][4][2], const int row0, const int col0, const int j, const u32x4 (&gc)[2], const u32x4 (&gn)[2]) const {
        const int ai = bt >> 1, mh = bt & 1;
#pragma unroll
        for (int mm = 0; mm < 2; ++mm)
#pragma unroll
            for (int bj = 0; bj < 2; ++bj) {
                const int m = 2 * mh + mm; const u32x4 c = gc[mm];
                f32x4 g0 = gate_unq4(bj == 0 ? c.x : c.z), g1 = gate_unq4(bj == 0 ? c.y : c.w);
                if (j < 2) {
                    const u32x4 n = gn[mm];
                    const f32x4 n0 = gate_unq4(bj == 0 ? n.x : n.z), n1 = gate_unq4(bj == 0 ? n.y : n.w);
#pragma unroll
                    for (int k = 0; k < 4; ++k) { g0[k] = g0[k] * __builtin_amdgcn_rcpf(n0[k]); g1[k] = g1[k] * __builtin_amdgcn_rcpf(n1[k]); }
                    acc[ai][bj][m][0] = acc[ai][bj][m][0] * g0; acc[ai][bj][m][1] = acc[ai][bj][m][1] * g1;
                } else {
                    const f32x4 v0 = acc[ai][bj][m][0] * (g0 * (1.0f / 255.0f)), v1 = acc[ai][bj][m][1] * (g1 * (1.0f / 255.0f));
                    u32x4 w; w.x = cvt_pk_bf16(v0[0], v0[1]); w.y = cvt_pk_bf16(v0[2], v0[3]); w.z = cvt_pk_bf16(v1[0], v1[1]); w.w = cvt_pk_bf16(v1[2], v1[3]);
                    *(u32x4*)(mo + (size_t)(row0 + ai * HALF + m * 16) * 2048 + col0 + bj * HALF) = w;
                }
            }
    }
    __device__ __forceinline__ void operator()(f32x4 (&acc)[2][2][4][2], const Unit& u, int wr, int wc, int fr, int fq) const {
        const int row0 = u.pm * BM + wr * 64 + fr, col0 = u.pn * BM + wc * 32 + 8 * fq, j = u.sel;
        const int gbc = j * 2048 + u.pn * 256 + 64 * wc + 16 * fq;
        u32x4 gcA[2], gnA[2], gcB[2], gnB[2], gcC[2], gnC[2];
        load_batch(0, row0, gbc, j, gcA, gnA);
        load_batch(1, row0, gbc, j, gcB, gnB);
        load_batch(2, row0, gbc, j, gcC, gnC);
        __builtin_amdgcn_sched_barrier(0);
        apply_batch(0, acc, row0, col0, j, gcA, gnA);
        __builtin_amdgcn_sched_barrier(0);
        load_batch(3, row0, gbc, j, gcA, gnA);
        __builtin_amdgcn_sched_barrier(0);
        apply_batch(1, acc, row0, col0, j, gcB, gnB);
        __builtin_amdgcn_sched_barrier(0);
        apply_batch(2, acc, row0, col0, j, gcC, gnC);
        __builtin_amdgcn_sched_barrier(0);
        apply_batch(3, acc, row0, col0, j, gcA, gnA);
    }
};

template <class Epi, class Sched, bool ALIGN_EPI = false, bool SP2 = false>
__device__ __forceinline__ void gemm_phase(PG8_LAS unsigned char* lds, const int K_, const Sched& S, const Epi& E, const int tid) {
    const int wid = __builtin_amdgcn_readfirstlane(tid >> 6), lane = tid & 63, wr = wid >> 2, wc = wid & 3, fr = lane & 15, fq = lane >> 4;
    const int K = K_, nt = K / BK;
    unsigned voffA[2], voffB[2];
#pragma unroll
    for (int i = 0; i < 2; ++i) { int R, C; stage_rc(tid * 16 + i * 8192, R, C); const int Rb = Epi::PERM ? ((R & ~31) + perm32(R & 31)) : R;
        voffA[i] = (unsigned)(R * K + C) * 2u; voffB[i] = (unsigned)(Rb * K + C) * 2u; }
    const size_t kstep = (size_t)(BK * 2);
    const size_t hstep = (size_t)HALF * K * 2;
    const size_t tstep = 2 * hstep;
    const unsigned ldsw = (unsigned)wid * 1024u;
    const int aoff = lds_byte(wr * 64 + fr, fq * 8), boff = lds_byte(wc * 32 + fr, fq * 8);
#define PG8_SA(b, h) (((b) * 2 + (h)) * HTB)
#define PG8_SB(b, h) ((4 + (b) * 2 + (h)) * HTB)
#define PG8_STAGE(bufoff, gbase, voff) do { _Pragma("unroll") for (int _i = 0; _i < 2; ++_i) \
        __builtin_amdgcn_global_load_lds((const unsigned*)((const char*)(gbase) + (voff)[_i]), (PG8_LAS unsigned*)(lds + (bufoff) + ldsw + _i * 8192), 16, 0, 0); } while (0)
#define PG8_LDA(dst, b, h) do { _Pragma("unroll") for (int m = 0; m < 4; ++m) _Pragma("unroll") for (int k = 0; k < 2; ++k) dst[m][k] = *(const PG8_LAS bf16x8*)(lds + PG8_SA(b, h) + aoff + m * 2048 + k * 1024); } while (0)
#define PG8_LDB(dst, b, h) do { _Pragma("unroll") for (int n = 0; n < 2; ++n) _Pragma("unroll") for (int k = 0; k < 2; ++k) dst[n][k] = *(const PG8_LAS bf16x8*)(lds + PG8_SB(b, h) + boff + n * 2048 + k * 1024); } while (0)
#define PG8_MMA(ai, bj, At, Bt) do { __builtin_amdgcn_s_setprio(1); _Pragma("unroll") for (int m = 0; m < 4; ++m) _Pragma("unroll") for (int n = 0; n < 2; ++n) _Pragma("unroll") for (int k = 0; k < 2; ++k) \
        acc[ai][bj][m][n] = __builtin_amdgcn_mfma_f32_16x16x32_bf16(Bt[n][k], At[m][k], acc[ai][bj][m][n], 0, 0, 0); __builtin_amdgcn_s_setprio(0); } while (0)
#define PG8_WAIT_V(n) asm volatile("s_waitcnt vmcnt(" #n ")" ::: "memory")
#define PG8_WAIT_L(n) asm volatile("s_waitcnt lgkmcnt(" #n ")" ::: "memory")
#define PG8_BAR __builtin_amdgcn_s_barrier()
#define PG8_SCHED __builtin_amdgcn_sched_barrier(0)
    Unit cur, nxt; int ui = 0;
    if (!S.next(0, cur)) return;
    f32x4 acc[2][2][4][2];
#pragma unroll
    for (int a = 0; a < 2; ++a)
#pragma unroll
        for (int b = 0; b < 2; ++b)
#pragma unroll
            for (int m = 0; m < 4; ++m)
#pragma unroll
                for (int n = 0; n < 2; ++n) acc[a][b][m][n] = (f32x4){0.f, 0.f, 0.f, 0.f};
    bf16x8 At[4][2], B0[2][2], B1[2][2];
    const char* cA = S.a_base(cur, tstep); const char* cB = S.b_base(cur, tstep);
    S.a_ready(cur);
    if constexpr (SP2) {
        PG8_STAGE(PG8_SB(0, 0), cB, voffB); PG8_STAGE(PG8_SB(0, 1), cB + hstep, voffB); PG8_STAGE(PG8_SA(0, 0), cA, voffA); PG8_STAGE(PG8_SA(0, 1), cA + hstep, voffA);
        if (wr == 1) PG8_BAR;
        PG8_WAIT_V(2); PG8_BAR;
        PG8_STAGE(PG8_SB(1, 0), cB + kstep, voffB); PG8_STAGE(PG8_SA(1, 0), cA + kstep, voffA); PG8_STAGE(PG8_SB(1, 1), cB + hstep + kstep, voffB);
        PG8_WAIT_V(6); PG8_BAR;
    } else {
        PG8_STAGE(PG8_SB(0, 0), cB, voffB); PG8_STAGE(PG8_SA(0, 0), cA, voffA); PG8_STAGE(PG8_SB(0, 1), cB + hstep, voffB); PG8_STAGE(PG8_SA(0, 1), cA + hstep, voffA);
        if (wr == 1) PG8_BAR;
        PG8_WAIT_V(4); PG8_BAR;
        PG8_STAGE(PG8_SB(1, 0), cB + kstep, voffB); PG8_STAGE(PG8_SA(1, 0), cA + kstep, voffA); PG8_STAGE(PG8_SB(1, 1), cB + hstep + kstep, voffB);
        PG8_WAIT_V(6); PG8_BAR;
    }
    for (;;) {
        const bool has_next = S.next(ui + 1, nxt);
        const char* nA = has_next ? S.a_base(nxt, tstep) : cA; const char* nB = has_next ? S.b_base(nxt, tstep) : cB;
        for (int t = 0; t < nt; t += 2) {
            const bool last = (t == nt - 2);
            const char* a1 = cA + (size_t)(t + 1) * kstep;
            const char* a2 = last ? nA : cA + (size_t)(t + 2) * kstep; const char* b2 = last ? nB : cB + (size_t)(t + 2) * kstep;
            const char* a3 = a2 + kstep; const char* b3 = b2 + kstep;
            if (last && has_next) S.a_ready(nxt);
            if constexpr (SP2) {
            PG8_LDB(B0, 0, 0); PG8_LDB(B1, 0, 1); PG8_SCHED; PG8_LDA(At, 0, 0); PG8_STAGE(PG8_SA(1, 1), a1 + hstep, voffA);
            PG8_WAIT_V(8); PG8_WAIT_L(0); PG8_BAR; PG8_MMA(0, 0, At, B0); PG8_MMA(0, 1, At, B1); PG8_BAR; PG8_SCHED;
            PG8_LDA(At, 0, 1); PG8_STAGE(PG8_SB(0, 0), b2, voffB); PG8_STAGE(PG8_SB(0, 1), b2 + hstep, voffB); PG8_STAGE(PG8_SA(0, 0), a2, voffA);
            PG8_WAIT_V(8); PG8_WAIT_L(0); PG8_BAR; PG8_MMA(1, 0, At, B0); PG8_MMA(1, 1, At, B1); PG8_BAR; PG8_SCHED;
            PG8_LDB(B0, 1, 0); PG8_LDB(B1, 1, 1); PG8_SCHED; PG8_LDA(At, 1, 0); PG8_STAGE(PG8_SA(0, 1), a2 + hstep, voffA);
            PG8_WAIT_V(8); PG8_WAIT_L(0); PG8_BAR; PG8_MMA(0, 0, At, B0); PG8_MMA(0, 1, At, B1); PG8_BAR; PG8_SCHED;
            PG8_LDA(At, 1, 1); PG8_STAGE(PG8_SB(1, 0), b3, voffB); PG8_STAGE(PG8_SB(1, 1), b3 + hstep, voffB); PG8_STAGE(PG8_SA(1, 0), a3, voffA);
            PG8_WAIT_V(8); PG8_WAIT_L(0); PG8_BAR; PG8_MMA(1, 0, At, B0); PG8_MMA(1, 1, At, B1); PG8_BAR; PG8_SCHED;
            } else {
            PG8_LDB(B0, 0, 0); PG8_SCHED; PG8_LDA(At, 0, 0); PG8_STAGE(PG8_SA(1, 1), a1 + hstep, voffA);
            PG8_WAIT_L(8); PG8_BAR; PG8_WAIT_L(0); PG8_MMA(0, 0, At, B0); PG8_BAR; PG8_SCHED;
            PG8_LDB(B1, 0, 1); PG8_STAGE(PG8_SB(0, 0), b2, voffB);
            PG8_BAR; PG8_WAIT_L(0); PG8_MMA(0, 1, At, B1); PG8_BAR;
            PG8_LDA(At, 0, 1); PG8_STAGE(PG8_SA(0, 0), a2, voffA);
            PG8_BAR; PG8_WAIT_L(0); PG8_MMA(1, 0, At, B0); PG8_BAR; PG8_SCHED;
            PG8_STAGE(PG8_SB(0, 1), b2 + hstep, voffB);
            PG8_WAIT_V(6); PG8_BAR; PG8_MMA(1, 1, At, B1); PG8_BAR;
            PG8_LDB(B0, 1, 0); PG8_SCHED; PG8_LDA(At, 1, 0); PG8_STAGE(PG8_SA(0, 1), a2 + hstep, voffA);
            PG8_WAIT_L(8); PG8_BAR; PG8_WAIT_L(0); PG8_MMA(0, 0, At, B0); PG8_BAR; PG8_SCHED;
            PG8_LDB(B1, 1, 1); PG8_STAGE(PG8_SB(1, 0), b3, voffB);
            PG8_BAR; PG8_WAIT_L(0); PG8_MMA(0, 1, At, B1); PG8_BAR;
            PG8_LDA(At, 1, 1); PG8_STAGE(PG8_SA(1, 0), a3, voffA);
            PG8_BAR; PG8_WAIT_L(0); PG8_MMA(1, 0, At, B0); PG8_BAR; PG8_SCHED;
            PG8_STAGE(PG8_SB(1, 1), b3 + hstep, voffB);
            PG8_WAIT_V(6); PG8_BAR; PG8_MMA(1, 1, At, B1); PG8_BAR;
            }
        }
        if constexpr (ALIGN_EPI) { if (wr == 0) PG8_BAR; }
        if constexpr (!Epi::AFTER_DRAIN) { E(acc, cur, wr, wc, fr, fq); S.done(cur); }
        if (!has_next) break;
        if (!S.keep(cur)) {
#pragma unroll
        for (int a = 0; a < 2; ++a)
#pragma unroll
            for (int b = 0; b < 2; ++b)
#pragma unroll
                for (int m = 0; m < 4; ++m)
#pragma unroll
                    for (int n = 0; n < 2; ++n) acc[a][b][m][n] = (f32x4){0.f, 0.f, 0.f, 0.f};
        }
        cur = nxt; cA = nA; cB = nB; ++ui;
        if constexpr (ALIGN_EPI) { if (wr == 1) PG8_BAR; }
    }
    PG8_WAIT_V(0);
    if constexpr (!ALIGN_EPI) { if (wr == 0) PG8_BAR; }
    PG8_BAR;
    if constexpr (Epi::AFTER_DRAIN) { E.fused(acc, cur, wr, wc, fr, fq, lds, wid, lane); S.done(cur); }
#undef PG8_SA
#undef PG8_SB
#undef PG8_STAGE
#undef PG8_LDA
#undef PG8_LDB
#undef PG8_MMA
#undef PG8_WAIT_V
#undef PG8_WAIT_L
#undef PG8_BAR
#undef PG8_SCHED
}
}
#define GAS __attribute__((address_space(1)))
#define LAS __attribute__((address_space(3)))
typedef unsigned short bf16;
typedef unsigned v4u __attribute__((ext_vector_type(4)));
typedef float f32x4 __attribute__((ext_vector_type(4)));
typedef short bf16x8 __attribute__((ext_vector_type(8)));
typedef GAS unsigned gu32;
typedef GAS unsigned long long gu64;
#define RLX_AGENT __ATOMIC_RELAXED, __HIP_MEMORY_SCOPE_AGENT
#define LDS_WAIT() asm volatile("s_waitcnt lgkmcnt(0)" ::: "memory")
#define VM_WAIT() asm volatile("s_waitcnt vmcnt(0)" ::: "memory")
__device__ __forceinline__ unsigned long long rt() { return __builtin_amdgcn_s_memrealtime(); }
__device__ __forceinline__ unsigned f2bf(float f) { unsigned u = __builtin_bit_cast(unsigned, f); return (u + 0x7fffu + ((u >> 16) & 1u)) >> 16; }
__device__ __forceinline__ unsigned pk2(float lo, float hi) { return f2bf(lo) | (f2bf(hi) << 16); }

#define XB_TMO      128
#define XB_XCNT(j)  (256  + 64 * (j))
#define XB_XSUB(j)  (1280 + 64 * (j))
#define XB_XGEN(j)  (2304 + 64 * (j))
#define XB_TOP      3328
#define XB_TOPGEN   3392
#define XCD_BAR_WORDS 3456
#define XB_SPIN_CAP (1u << 18)

__device__ __forceinline__ unsigned xb_ld(unsigned* p)              { return __hip_atomic_load(p, __ATOMIC_RELAXED, __HIP_MEMORY_SCOPE_AGENT); }
__device__ __forceinline__ unsigned xb_add(unsigned* p, unsigned v) { return __hip_atomic_fetch_add(p, v, __ATOMIC_RELAXED, __HIP_MEMORY_SCOPE_AGENT); }
__device__ __forceinline__ unsigned xb_xcc_id() { return (unsigned)__builtin_amdgcn_s_getreg((3 << 11) | 20) & 0xFu; }
#define XB_SPIN(cond, bar) do { unsigned _sp = 0; while (cond) { __builtin_amdgcn_s_sleep(1); \
    if ((++_sp & 255u) == 0u) { if (xb_ld(&(bar)[XB_TMO])) break; if (_sp > XB_SPIN_CAP) { atomicAdd(&(bar)[XB_TMO], 1u); break; } } } } while (0)

__device__ __forceinline__ unsigned xb_lane() { unsigned m = ~0u; asm volatile("" : "+s"(m)); return __builtin_amdgcn_mbcnt_hi(m, __builtin_amdgcn_mbcnt_lo(m, 0u)); }
struct XcdBarrier {
    unsigned wv;
    unsigned* bar; unsigned x;
    volatile LAS unsigned* st;
};

__device__ __forceinline__ XcdBarrier xcd_barrier_post(unsigned* bar, volatile LAS unsigned* st, unsigned wv) {
    XcdBarrier b; b.wv = wv; b.bar = bar; b.x = xb_xcc_id(); b.st = st;
    if (wv == 0u && xb_lane() == 0u) (void)xb_add(&bar[XB_XCNT(b.x)], 1u);
    return b;
}
__device__ __forceinline__ void xcd_barrier_complete(unsigned* bar, unsigned x, unsigned& nloc, unsigned& nx) {
    const unsigned G = gridDim.x * gridDim.y * gridDim.z;
    unsigned sum, cnt, mine, sp = 0u;
    for (;;) {
        sum = 0u; cnt = 0u; mine = 0u;
#pragma unroll
        for (unsigned j = 0; j < 16; ++j) { const unsigned c = xb_ld(&bar[XB_XCNT(j)]); sum += c; cnt += (c > 0u) ? 1u : 0u; mine = (j == x) ? c : mine; }
        if (sum == G) break;
        __builtin_amdgcn_s_sleep(1);
        if ((++sp & 255u) == 0u) { if (xb_ld(&bar[XB_TMO])) break; if (sp > XB_SPIN_CAP) { atomicAdd(&bar[XB_TMO], 1u); break; } }
    }
    nloc = mine > 0u ? mine : 1u; nx = cnt > 0u ? cnt : 1u;
}

__device__ __forceinline__ void xcd_barrier(const XcdBarrier& b) {
    asm volatile("s_waitcnt vmcnt(0)" ::: "memory");
    __syncthreads();
    if (b.wv == 0u && xb_lane() == 0u) {
        unsigned* bar = b.bar;
        __builtin_amdgcn_s_waitcnt(0);
        unsigned nloc = b.st[0], nx = b.st[1];
        if (nloc == 0u) { xcd_barrier_complete(bar, b.x, nloc, nx); b.st[0] = nloc; b.st[1] = nx; }
        const unsigned old = xb_add(&bar[XB_XSUB(b.x)], 1u);
        const unsigned gen = old / nloc;
        if (old + 1u == (gen + 1u) * nloc) {
            __builtin_amdgcn_fence(__ATOMIC_RELEASE, "agent");
            asm volatile("s_waitcnt vmcnt(0)" ::: "memory");
            const unsigned og = xb_add(&bar[XB_TOP], 1u);
            const unsigned tg = og / nx;
            if (og + 1u == (tg + 1u) * nx) xb_add(&bar[XB_TOPGEN], 1u);
            else XB_SPIN(xb_ld(&bar[XB_TOPGEN]) == tg, bar);
            __builtin_amdgcn_fence(__ATOMIC_ACQUIRE, "agent");
            xb_add(&bar[XB_XGEN(b.x)], 1u);
            asm volatile("s_waitcnt vmcnt(0)" ::: "memory");
        } else {
            XB_SPIN(xb_ld(&bar[XB_XGEN(b.x)]) == gen, bar);
            __builtin_amdgcn_fence(__ATOMIC_ACQUIRE, "agent");
            asm volatile("s_waitcnt vmcnt(0)" ::: "memory");
        }
    }
    __syncthreads();
}

constexpr int D_MODEL = 2048, SEQ = 4096, BATCH = 8, DEPTH = 2, M_ALL = BATCH * SEQ, D_IN = 16384;
constexpr int BG = 4, TG = BG * SEQ, NGROUP = BATCH / BG;
constexpr int PNBC = 320, PBROW = PNBC * 512;
__device__ __forceinline__ size_t pidx(int row, int col) { return pg8::blk_idx(row, col, PNBC); }
constexpr int C_XA = 0, C_GA = 1024, C_QR = 2048, C_KR = 3072, C_VR = 4096, C_GR = 5120, C_QD = 6144, C_KD = 7168, C_VD = 8192, C_GD = 9216;
constexpr float EPS = 1e-6f;
constexpr int NWAVES = 8;
constexpr size_t MiB = 1u << 20;
constexpr size_t WS_CTL = 0, CTL_ZERO_BYTES = 1 * MiB;
constexpr size_t WS_COSR = 1 * MiB, WS_SINR = 2 * MiB, WS_COSD = 3 * MiB, WS_SIND = 3 * MiB + 128 * 1024, WS_LAMS = 3 * MiB + 512 * 1024;
constexpr size_t WS_WIN = 4 * MiB;
constexpr size_t WS_WBR = 132 * MiB;
constexpr size_t WS_WOUT = 156 * MiB;
constexpr size_t WS_H = 172 * MiB;
constexpr size_t WS_Y = 300 * MiB;
constexpr size_t WS_GM = 396 * MiB;
constexpr size_t WS_PROJ = 588 * MiB;
constexpr size_t WS_O = 588 * MiB;
constexpr size_t WS_M = 716 * MiB;
constexpr size_t WS_X1 = 908 * MiB;
constexpr size_t WS_END = 972 * MiB;
static_assert(WS_M + (size_t)TG * 2048 * 2 <= WS_END && WS_O + (size_t)TG * 2048 * 4 <= WS_M && WS_PROJ + (size_t)TG * 10240 * 2 == WS_X1 && WS_X1 + (size_t)TG * 2048 * 2 == WS_END, "d_ws map");
constexpr int CW_TMO = 0;
constexpr int CW_BAR = 4096;
constexpr int CW_Q = 65536;
constexpr int RING_BYTES = 131072, LDSCTL_OFF = RING_BYTES, MISC_OFF = LDSCTL_OFF + 320, LDS_BYTES = 147456;

#define LAUNDER_V(x) asm volatile("" : "+v"(x))
#define LAUNDER_S(x) asm volatile("" : "+s"(x))
typedef float f32x16 __attribute__((ext_vector_type(16)));
typedef short s16x4 __attribute__((ext_vector_type(4)));
typedef short v4i16_t __attribute__((ext_vector_type(4)));
typedef unsigned u32x2 __attribute__((ext_vector_type(2)));
typedef LAS unsigned char* ldsp;
using pg8::blk_idx; using pg8::cvt_pk_bf16; using pg8::bf_lo; using pg8::bf_hi; using pg8::fast_sigmoid; using pg8::lg2_gamma;

using pg8::swz_xor; using pg8::half_sum; using pg8::half_max;
__device__ __forceinline__ float wave_sum(float v) {
    v += swz_xor<1>(v); v += swz_xor<2>(v); v += swz_xor<4>(v); v += swz_xor<8>(v); v += swz_xor<16>(v);
    return half_sum(v);
}
__device__ __forceinline__ unsigned offb(unsigned row, unsigned ch) { return 256u * row + 16u * (ch ^ (((row & 3u) << 2) | ((row >> 2) & 3u))); }
__device__ __forceinline__ unsigned tr_nat(int lane, int k0, int t, int c) { const int h = lane >> 5, blk = (lane >> 4) & 1, q = (lane & 15) >> 2, p = lane & 3; return offb(k0 + 8 * h + 4 * t + q, 4 * c + 2 * blk + (p >> 1)) + 8 * (p & 1); }
__device__ __forceinline__ unsigned tr_perm(int lane, int k0, int t, int c) { const int h = lane >> 5, blk = (lane >> 4) & 1, q = (lane & 15) >> 2, p = lane & 3; return offb(k0 + 8 * t + 4 * h + q, 4 * c + 2 * blk + (p >> 1)) + 8 * (p & 1); }
__device__ __forceinline__ f32x16 mfma32(bf16x8 a, bf16x8 b, f32x16 c) { return __builtin_amdgcn_mfma_f32_32x32x16_bf16(a, b, c, 0, 0, 0); }
__device__ __forceinline__ s16x4 trr(ldsp p) { return __builtin_bit_cast(s16x4, __builtin_amdgcn_ds_read_tr16_b64_v4i16((LAS v4i16_t*)p)); }
__device__ __forceinline__ bf16x8 cat8(s16x4 lo, s16x4 hi) { return (bf16x8){lo[0], lo[1], lo[2], lo[3], hi[0], hi[1], hi[2], hi[3]}; }
template <int B> __device__ __forceinline__ bf16x8 pack8(const f32x16& x) {
    v4u w = {cvt_pk_bf16(x[B], x[B + 1]), cvt_pk_bf16(x[B + 2], x[B + 3]), cvt_pk_bf16(x[B + 4], x[B + 5]), cvt_pk_bf16(x[B + 6], x[B + 7])};
    return __builtin_bit_cast(bf16x8, w);
}
__device__ __forceinline__ f32x16 zero16() { f32x16 z;
#pragma unroll
    for (int i = 0; i < 16; ++i) z[i] = 0.f; return z; }

__device__ __forceinline__ void p0_transpose_item(const float* W, int K, int N, bf16* WT, LAS float* scr, int item, int lane) {
    const int nblk = N / 32, kb = item / nblk, nb = item % nblk, k0 = 64 * kb, n0 = 32 * nb;
    { const int cg = lane & 7, rs = lane >> 3;
      f32x4 v[8];
#pragma unroll
      for (int i = 0; i < 8; ++i) v[i] = *(const f32x4*)(W + (size_t)(k0 + 8 * i + rs) * N + n0 + 4 * cg);
#pragma unroll
      for (int i = 0; i < 8; ++i) { LAS float* d = scr + (8 * i + rs) * 33 + 4 * cg; d[0] = v[i].x; d[1] = v[i].y; d[2] = v[i].z; d[3] = v[i].w; } }
    LDS_WAIT(); asm volatile("" ::: "memory");
    const int c = lane & 7;
#pragma unroll
    for (int j = 0; j < 4; ++j) { const int n = (lane >> 3) + 8 * j; const LAS float* s = scr + (8 * c) * 33 + n;
        v4u o; o.x = pk2(s[0 * 33], s[1 * 33]); o.y = pk2(s[2 * 33], s[3 * 33]); o.z = pk2(s[4 * 33], s[5 * 33]); o.w = pk2(s[6 * 33], s[7 * 33]);
        *(GAS v4u*)(WT + (size_t)(n0 + n) * K + k0 + 8 * c) = o; }
    LDS_WAIT(); asm volatile("" ::: "memory");
}
__device__ __forceinline__ void rms_row_to_bf16(const float* xrow, const f32x4 (&gv)[8], bf16* orow, int lane) {
    const float* xr = xrow + 8 * lane;
    f32x4 v[8]; float s = 0.f;
#pragma unroll
    for (int j = 0; j < 4; ++j) { v[2 * j] = *(const f32x4*)(xr + 512 * j); v[2 * j + 1] = *(const f32x4*)(xr + 512 * j + 4); }
#pragma unroll
    for (int j = 0; j < 8; ++j) s += (v[j].x * v[j].x + v[j].y * v[j].y) + (v[j].z * v[j].z + v[j].w * v[j].w);
    const float rs = rsqrtf(wave_sum(s) * (1.f / D_MODEL) + EPS);
    v4u* o16 = (v4u*)orow + lane;
#pragma unroll
    for (int j = 0; j < 4; ++j) { const f32x4 ga = gv[2 * j], gb = gv[2 * j + 1]; const f32x4 a = v[2 * j] * rs * ga, bq = v[2 * j + 1] * rs * gb;
        v4u w; w.x = cvt_pk_bf16(a.x, a.y); w.y = cvt_pk_bf16(a.z, a.w); w.z = cvt_pk_bf16(bq.x, bq.y); w.w = cvt_pk_bf16(bq.z, bq.w); o16[64 * j] = w; }
}

__device__ __forceinline__ void ret_unit(const int tid, ldsp lds, int b, int h, const bf16* proj, bf16* yb) {
    const int lane = tid & 63, w = __builtin_amdgcn_readfirstlane(tid >> 6), r32 = lane & 31, hi = lane >> 5;
    const int it = w >> 1, eh = w & 1;
    constexpr int O_ST = 0, O_KD = 32768, O_VV = 65536, O_Q = 98304;
    LAS float* STAT = (LAS float*)(lds + RING_BYTES + 1024);
    { unsigned z0 = 0u; LAUNDER_V(z0); for (int i = tid; i < 2048; i += 512) ((LAS v4u*)(lds + O_ST))[i] = (v4u){z0, z0, z0, z0}; }
    ldsp rb[8];
#pragma unroll
    for (int s = 0; s < 8; ++s) rb[s] = lds + offb(r32, 2 * s + hi);
    ldsp tnk0 = lds + O_KD + tr_perm(lane, 0, 0, it), tnk1 = lds + O_KD + tr_perm(lane, 0, 1, it);
    ldsp tpv00 = lds + O_VV + tr_perm(lane, 0, 0, 2 * eh), tpv01 = lds + O_VV + tr_perm(lane, 0, 1, 2 * eh), tpv10 = lds + O_VV + tr_perm(lane, 0, 0, 2 * eh + 1), tpv11 = lds + O_VV + tr_perm(lane, 0, 1, 2 * eh + 1);
    const int row00 = b * SEQ, hcol = h * 128;
    bf16* Yp = yb + (size_t)b * SEQ * 1024 + h * 128;
    const float lg = lg2_gamma(h), cd = __builtin_amdgcn_exp2f(128.f * lg), cout = __builtin_amdgcn_exp2f(lg * (float)(32 * it + r32 - 127));
    f32x16 Dacc0 = zero16(), Dacc1 = zero16();
#define RET_DMA(src_, n_, lane_, off_) do { _Pragma("unroll") for (int k_ = 0; k_ < 4; ++k_) { const int row_ = 16 * w + 4 * k_ + ((lane_) >> 4); \
        const int ch_ = ((lane_) & 15) ^ (((row_ & 3) << 2) | ((row_ >> 2) & 3)); \
        __builtin_amdgcn_global_load_lds((const unsigned*)(proj + pidx(row00 + (n_) * 128 + row_, (src_) + hcol + 8 * ch_)), (LAS unsigned*)(lds + (off_) + 4096 * w + 1024 * k_), 16, 0, 0); } } while (0)
#define RET_BAR() do { asm volatile("s_waitcnt lgkmcnt(0)" ::: "memory"); __builtin_amdgcn_s_barrier(); asm volatile("" ::: "memory"); } while (0)
    RET_DMA(C_KR, 0, lane, O_KD); RET_DMA(C_VR, 0, lane, O_VV); RET_DMA(C_QR, 0, lane, O_Q);
    for (int n = 0; n < 32; ++n) {
        int tid_c = tid; LAUNDER_V(tid_c);
        const int lane_c = tid_c & 63, r32c = lane_c & 31, hic = lane_c >> 5;
        const int rowi = n * 128 + 32 * it + r32c;
        const int nn = n + 1 < 32 ? n + 1 : 31;
        asm volatile("s_waitcnt vmcnt(0) lgkmcnt(0)" ::: "memory"); __builtin_amdgcn_s_barrier(); asm volatile("" ::: "memory");
        bf16x8 qf[8];
        { ldsp qb_ = lds + O_Q + 8192 * it;
#pragma unroll
          for (int s = 0; s < 8; ++s) qf[s] = *(const LAS bf16x8*)(qb_ + (unsigned)(rb[s] - lds)); }
#pragma unroll
        for (int ks = 0; ks < 8; ++ks) {
            const bf16x8 a = cat8(trr(tnk0 + 4096 * ks), trr(tnk1 + 4096 * ks));
            Dacc0 = mfma32(a, cat8(trr(tpv00 + 4096 * ks), trr(tpv01 + 4096 * ks)), Dacc0);
            Dacc1 = mfma32(a, cat8(trr(tpv10 + 4096 * ks), trr(tpv11 + 4096 * ks)), Dacc1);
            if (ks & 1) __builtin_amdgcn_sched_barrier(0);
        }
        f32x16 acc0 = zero16(), acc1 = zero16();
#pragma unroll
        for (int jt = 0; jt < 4; ++jt) if (jt <= it) {
            f32x16 X = zero16();
#pragma unroll
            for (int s = 0; s < 8; ++s) X = mfma32(*(const LAS bf16x8*)(rb[s] + O_KD + 8192 * jt), qf[s], X);
            __builtin_amdgcn_sched_barrier(0);
            if (jt == it) {
#pragma unroll
                for (int r = 0; r < 16; ++r) { const int j = (r & 3) + 8 * (r >> 2) + 4 * hic; if (j > r32c) X[r] = 0.f; }
            }
            const bf16x8 pf0 = pack8<0>(X), pf1 = pack8<8>(X);
            acc0 = mfma32(cat8(trr(tpv00 + 8192 * jt), trr(tpv01 + 8192 * jt)), pf0, acc0);
            acc1 = mfma32(cat8(trr(tpv10 + 8192 * jt), trr(tpv11 + 8192 * jt)), pf0, acc1);
            acc0 = mfma32(cat8(trr(tpv00 + 8192 * jt + 4096), trr(tpv01 + 8192 * jt + 4096)), pf1, acc0);
            acc1 = mfma32(cat8(trr(tpv10 + 8192 * jt + 4096), trr(tpv11 + 8192 * jt + 4096)), pf1, acc1);
            __builtin_amdgcn_sched_barrier(0);
        }
        RET_BAR();
        RET_DMA(C_KR, nn, lane_c, O_KD); RET_DMA(C_VR, nn, lane_c, O_VV); RET_DMA(C_QR, nn, lane_c, O_Q);
        u32x2 gg[8];
        { const bf16* grow = proj + pidx(row00 + rowi, C_GR + hcol + 64 * eh + 4 * hic);
#pragma unroll
          for (int e2 = 0; e2 < 2; ++e2)
#pragma unroll
              for (int q4 = 0; q4 < 4; ++q4) gg[4 * e2 + q4] = *(const u32x2*)(grow + 512 * e2 + 8 * q4); }
        {
            ldsp st0 = lds + 16384 * eh;
#pragma unroll
            for (int s = 0; s < 8; ++s) {
                const unsigned o_ = (unsigned)(rb[s] - lds);
                acc0 = mfma32(*(const LAS bf16x8*)(st0 + o_ + O_ST), qf[s], acc0);
                acc1 = mfma32(*(const LAS bf16x8*)(st0 + o_ + O_ST + 8192), qf[s], acc1);
                if ((s & 3) == 3) __builtin_amdgcn_sched_barrier(0);
            }
        }
        float s1 = 0.f, s2 = 0.f;
#pragma unroll
        for (int r = 0; r < 16; ++r) { s1 += acc0[r] + acc1[r]; s2 += acc0[r] * acc0[r] + acc1[r] * acc1[r]; }
        s1 = half_sum(s1); s2 = half_sum(s2);
        if (hic == 0) { STAT[(32 * it + r32c) * 4 + eh * 2] = s1; STAT[(32 * it + r32c) * 4 + eh * 2 + 1] = s2; }
        RET_BAR();
        {
            const LAS float* st = STAT + (32 * it + r32c) * 4;
            const float mean = (st[0] + st[2]) * (1.f / 128.f); float var = (st[1] + st[3]) * (1.f / 128.f) - mean * mean; var = fmaxf(var, 0.f);
            const float rs = cout * rsqrtf(cout * cout * var + EPS);
            bf16* yrow = Yp + (size_t)rowi * 1024 + 64 * eh + 4 * hic;
#pragma unroll
            for (int e2 = 0; e2 < 2; ++e2)
#pragma unroll
                for (int q4 = 0; q4 < 4; ++q4) {
                    const f32x16& A = e2 ? acc1 : acc0; const u32x2 g = gg[4 * e2 + q4];
                    u32x2 o; o.x = cvt_pk_bf16((A[4 * q4] - mean) * rs * bf_lo(g.x), (A[4 * q4 + 1] - mean) * rs * bf_hi(g.x));
                    o.y = cvt_pk_bf16((A[4 * q4 + 2] - mean) * rs * bf_lo(g.y), (A[4 * q4 + 3] - mean) * rs * bf_hi(g.y));
                    *(u32x2*)(yrow + 32 * e2 + 8 * q4) = o;
                }
        }
#pragma unroll
        for (int r = 0; r < 16; ++r) { Dacc0[r] *= cd; Dacc1[r] *= cd; }
        {
            ldsp sw0 = lds + O_ST + 16384 * eh + 256 * r32c + 8 * hic; const unsigned swr = ((r32c & 3) << 2) | ((r32c >> 2) & 3);
#pragma unroll
            for (int q4 = 0; q4 < 4; ++q4) {
                u32x2 o0, o1; o0.x = cvt_pk_bf16(Dacc0[4 * q4], Dacc0[4 * q4 + 1]); o0.y = cvt_pk_bf16(Dacc0[4 * q4 + 2], Dacc0[4 * q4 + 3]);
                o1.x = cvt_pk_bf16(Dacc1[4 * q4], Dacc1[4 * q4 + 1]); o1.y = cvt_pk_bf16(Dacc1[4 * q4 + 2], Dacc1[4 * q4 + 3]);
                const unsigned co = 16u * ((unsigned)(4 * it + q4) ^ swr);
                *(LAS u32x2*)(sw0 + co) = o0; *(LAS u32x2*)(sw0 + co + 8192) = o1;
            }
        }
    }
    asm volatile("s_waitcnt vmcnt(0)" ::: "memory");
#undef RET_DMA
#undef RET_BAR
}

__device__ __forceinline__ void lru_unit(const int tid, ldsp lds, int b, int nb, const bf16* proj, bf16* ya, const float* convw, const float* convb,
                                         const float* wa, const float* ba, const float* wx, const float* bx, const float* lam) {
    const int lane = tid & 63, w = __builtin_amdgcn_readfirstlane(tid >> 6), r32 = lane & 31, hi = lane >> 5;
    const int c0 = nb * 64;
    LAS bf16* XA = (LAS bf16*)lds; ldsp XC = lds + 17408; LAS float* XF = (LAS float*)(lds + 35840); LAS float* AF = (LAS float*)(lds + 68608);
    ldsp WT = lds + 101376; LAS float* SEG = (LAS float*)(lds + 119808); LAS float* PAR = (LAS float*)(lds + 123904);
    if (tid < 64) { const int c = c0 + tid;
        PAR[tid] = convw[c]; PAR[64 + tid] = convw[1024 + c]; PAR[128 + tid] = convw[2048 + c]; PAR[192 + tid] = convw[3072 + c];
        PAR[256 + tid] = convb[c]; PAR[320 + tid] = ba[c]; PAR[384 + tid] = bx[c];
        const float z = __expf(-lam[c]); PAR[448 + tid] = log1pf(z); }
    for (int idx = tid; idx < 4096; idx += 512) { const int d = idx >> 6, e = idx & 63;
        ((LAS bf16*)WT)[e * 72 + d] = (bf16)f2bf(wa[nb * 4096 + idx]); ((LAS bf16*)(WT + 9216))[e * 72 + d] = (bf16)f2bf(wx[nb * 4096 + idx]); }
    const int row00 = b * SEQ;
    bf16* yp = ya + (size_t)b * SEQ * 1024 + c0;
    const int e = tid & 63;
    float hcarry = 0.f;
    v4u xs[2][3];
#define LRU_ISSUE(S_, t0_) do { { const int r = tid >> 3, ch = tid & 7, t = (t0_) - 3 + r; { unsigned z0 = 0u; LAUNDER_V(z0); xs[S_][0] = (v4u){z0, z0, z0, z0}; } if (t >= 0) xs[S_][0] = *(const v4u*)(proj + pidx(row00 + t, C_XA + c0 + ch * 8)); } \
        { const int r = (tid + 512) >> 3, ch = tid & 7, t = (t0_) - 3 + r; xs[S_][1] = *(const v4u*)(proj + pidx(row00 + t, C_XA + c0 + ch * 8)); } \
        if (tid < 24) { const int r = (tid + 1024) >> 3, ch = tid & 7, t = (t0_) - 3 + r; xs[S_][2] = *(const v4u*)(proj + pidx(row00 + t, C_XA + c0 + ch * 8)); } } while (0)
    LRU_ISSUE(0, 0); LRU_ISSUE(1, 128);
    for (int n2 = 0; n2 < 32; n2 += 2)
#pragma unroll
      for (int sx = 0; sx < 2; ++sx) {
        const int n = n2 + sx;
        const int t0 = n * 128;
        __syncthreads();
        *(LAS v4u*)((ldsp)XA + tid * 16) = xs[sx][0]; *(LAS v4u*)((ldsp)XA + (tid + 512) * 16) = xs[sx][1]; if (tid < 24) *(LAS v4u*)((ldsp)XA + (tid + 1024) * 16) = xs[sx][2];
        if (n + 2 < 32) LRU_ISSUE(sx, t0 + 256);
        __syncthreads();
        { const int c = tid & 63; const float w0 = PAR[c], w1 = PAR[64 + c], w2 = PAR[128 + c], w3 = PAR[192 + c], cb = PAR[256 + c];
#pragma unroll 4
          for (int k = 0; k < 16; ++k) { const int t = (tid >> 6) + 8 * k;
              const float x0 = __uint_as_float((unsigned)XA[t * 64 + c] << 16), x1 = __uint_as_float((unsigned)XA[(t + 1) * 64 + c] << 16),
                          x2 = __uint_as_float((unsigned)XA[(t + 2) * 64 + c] << 16), x3 = __uint_as_float((unsigned)XA[(t + 3) * 64 + c] << 16);
              const float xc = cb + w0 * x0 + w1 * x1 + w2 * x2 + w3 * x3;
              XF[t * 64 + c] = xc; ((LAS bf16*)XC)[t * 72 + c] = (bf16)f2bf(xc); } }
        __syncthreads();
        bf16 gt[16];
#pragma unroll
        for (int k = 0; k < 16; ++k) gt[k] = proj[pidx(row00 + t0 + 16 * w + k, C_GA + c0 + e)];
        { const int tt = w >> 1, et = w & 1;
          f32x16 gr = zero16(), gi = zero16();
#pragma unroll
          for (int s = 0; s < 4; ++s) {
              const bf16x8 a = *(const LAS bf16x8*)(XC + (32 * tt + r32) * 144 + (16 * s + 8 * hi) * 2);
              const bf16x8 br = *(const LAS bf16x8*)(WT + (32 * et + r32) * 144 + (16 * s + 8 * hi) * 2);
              const bf16x8 bi = *(const LAS bf16x8*)(WT + 9216 + (32 * et + r32) * 144 + (16 * s + 8 * hi) * 2);
              gr = mfma32(a, br, gr); gi = mfma32(a, bi, gi); }
          const int ee = 32 * et + r32; const float bar_ = PAR[320 + ee], bxr = PAR[384 + ee], sp = PAR[448 + ee];
#pragma unroll
          for (int r = 0; r < 16; ++r) { const int t = 32 * tt + (r & 3) + 8 * (r >> 2) + 4 * hi;
              const float xc = XF[t * 64 + ee];
              const float rg = fast_sigmoid(gr[r] + bar_), ig = fast_sigmoid(gi[r] + bxr);
              const float la = -8.0f * rg * sp, a = __expf(la), x2 = 2.0f * la;
              const float em_series = -x2 * (1.0f + x2 * (0.5f + x2 * (0.16666667f + x2 * (0.041666668f + x2 * (0.008333334f + x2 * 0.0013888889f)))));
              const float em = x2 < -0.25f ? 1.0f - a * a : em_series;
              AF[t * 64 + ee] = a; XF[t * 64 + ee] = __builtin_amdgcn_sqrtf(em) * ig * xc; } }
        __syncthreads();
        { float A = 1.f, H = 0.f;
#pragma unroll
          for (int k = 0; k < 16; ++k) { const int t = 16 * w + k; const float a = AF[t * 64 + e], u = XF[t * 64 + e]; H = a * H + u; A *= a; }
          SEG[(w * 64 + e) * 2] = A; SEG[(w * 64 + e) * 2 + 1] = H; }
        __syncthreads();
        float hs = hcarry, hst = 0.f;
#pragma unroll
        for (int s = 0; s < 8; ++s) { const float A = SEG[(s * 64 + e) * 2], H = SEG[(s * 64 + e) * 2 + 1]; if (s == w) hst = hs; hs = A * hs + H; }
        hcarry = hs;
        float hh = hst;
#pragma unroll
        for (int k = 0; k < 16; ++k) { const int t = 16 * w + k; hh = AF[t * 64 + e] * hh + XF[t * 64 + e];
            yp[(size_t)(t0 + t) * 1024 + e] = (bf16)f2bf(hh * __uint_as_float((unsigned)gt[k] << 16)); }
    }
#undef LRU_ISSUE
}

typedef float f32x2 __attribute__((ext_vector_type(2)));
struct AttS { f32x16 O0, O1, O2, O3, p0, p1; bf16x8 pf0, pf1, pf2, pf3; bf16x8 k0, k1, k2, k3, k4, k5, k6, k7; float mref, l, alpha; int rp; };
#define ATT_THR 8.0f
constexpr int ATT_V0 = 0, ATT_K0 = 49152, ATT_SLOT = 16384;
#define ATT_PIN(X_) asm volatile("" : "+v"(X_))
#define ATT_SB() __builtin_amdgcn_sched_barrier(0)
__device__ __forceinline__ float attn_rowmax(const f32x16& a, const f32x16& b) {
    float d = fmaxf(a[0], b[0]);
#pragma unroll
    for (int r = 1; r < 16; ++r) d = fmaxf(d, fmaxf(a[r], b[r]));
    return half_max(d);
}
__device__ __forceinline__ int attn_rowmax_bits(const f32x16& a, const f32x16& b) {
    int d = max(__float_as_int(a[0]), __float_as_int(b[0]));
#pragma unroll
    for (int r = 1; r < 16; ++r) d = max(d, max(__float_as_int(a[r]), __float_as_int(b[r])));
    unsigned x = (unsigned)d, y = x; pg8::half_swap(x, y);
    return max((int)x, (int)y);
}
template <int B> __device__ __forceinline__ f32x2 attn_sum8(const f32x16& a, f32x2 s) {
#pragma unroll
    for (int r = B; r < B + 8; r += 2) s += (f32x2){a[r], a[r + 1]};
    return s;
}
#define ATT_EXP4(P_, B_) do { _Pragma("unroll") for (int r_ = 0; r_ < 4; ++r_) P_[(B_) + r_] = __builtin_amdgcn_exp2f(P_[(B_) + r_]); } while (0)
#define ATT_SUB4(P_, B_) do { _Pragma("unroll") for (int r_ = 0; r_ < 4; ++r_) P_[(B_) + r_] -= st.mref; } while (0)
#define ATT_VF(TV_, KS, ET) cat8(trr((TV_) + 4096 * (ET) + 1024 * (KS)), trr((TV_) + 4096 * (ET) + 1024 * (KS) + 512))
#define ATT_KF(RK_, O_) (*(const LAS bf16x8*)((RK_) + (O_)))
#define ATT_MASK(Q0_, Q1_, t_) do { const int kb_ = 64 * (t_); \
        if (kb_ + 63 > qw) { const int dq_ = qw + r32 - kb_ - 4 * hi; const float NEG_ = -__builtin_inff(); \
            _Pragma("unroll") for (int r_ = 0; r_ < 16; ++r_) { const int cr_ = (r_ & 3) + 8 * (r_ >> 2); if (cr_ > dq_) Q0_[r_] = NEG_; if (cr_ + 32 > dq_) Q1_[r_] = NEG_; } } } while (0)
#define ATT_OSCALE() do { if (st.rp) { _Pragma("unroll") for (int r_ = 0; r_ < 16; ++r_) { st.O0[r_] *= st.alpha; st.O1[r_] *= st.alpha; st.O2[r_] *= st.alpha; st.O3[r_] *= st.alpha; } } } while (0)
#define ATT_EXP1(Q0_, Q1_, I_) do { if ((I_) < 16) Q0_[(I_) & 15] = __builtin_amdgcn_exp2f(Q0_[(I_) & 15]); else Q1_[(I_) & 15] = __builtin_amdgcn_exp2f(Q1_[(I_) & 15]); } while (0)
#define ATT_EXP3(Q0_, Q1_, I_) do { ATT_EXP1(Q0_, Q1_, (I_)); ATT_EXP1(Q0_, Q1_, (I_) + 1); ATT_EXP1(Q0_, Q1_, (I_) + 2); } while (0)
__device__ __forceinline__ f32x16 attn_splat(const float v) { f32x16 z;
#pragma unroll
    for (int i = 0; i < 16; ++i) z[i] = v; return z; }
__device__ __forceinline__ void attn_step(AttS& st, const int t, const int qw, const int r32, const int hi, const bf16x8 (&qf)[4], ldsp tv, ldsp rn0, ldsp rn1, ldsp rn2, ldsp rn3) {
    ATT_OSCALE();
    const f32x16 negm = attn_splat(-st.mref);
    f32x16 q0 = mfma32(st.k0, qf[0], negm); bf16x8 va0 = ATT_VF(tv, 0, 0);
    f32x16 q1 = mfma32(st.k1, qf[0], negm); bf16x8 va1 = ATT_VF(tv, 0, 1);
    ATT_SB();
    q0 = mfma32(st.k2, qf[1], q0); bf16x8 va2 = ATT_VF(tv, 0, 2);
    q1 = mfma32(st.k3, qf[1], q1); bf16x8 va3 = ATT_VF(tv, 0, 3);
    ATT_SB();
    q0 = mfma32(st.k4, qf[2], q0); bf16x8 vb0 = ATT_VF(tv, 1, 0);
    q1 = mfma32(st.k5, qf[2], q1); bf16x8 vb1 = ATT_VF(tv, 1, 1);
    st.pf2 = pack8<0>(st.p1); ATT_PIN(st.pf2);
    ATT_SB();
    q0 = mfma32(st.k6, qf[3], q0); bf16x8 vb2 = ATT_VF(tv, 1, 2);
    q1 = mfma32(st.k7, qf[3], q1); bf16x8 vb3 = ATT_VF(tv, 1, 3);
    st.pf3 = pack8<8>(st.p1); ATT_PIN(st.pf3);
    ATT_SB();
    ATT_MASK(q0, q1, t);
    st.O0 = mfma32(va0, st.pf0, st.O0); va0 = ATT_VF(tv, 2, 0); ATT_EXP3(q0, q1, 0);
    ATT_SB();
    st.O1 = mfma32(va1, st.pf0, st.O1); va1 = ATT_VF(tv, 2, 1); ATT_EXP3(q0, q1, 3);
    ATT_SB();
    st.O2 = mfma32(va2, st.pf0, st.O2); va2 = ATT_VF(tv, 2, 2); ATT_EXP3(q0, q1, 6);
    ATT_SB();
    st.O3 = mfma32(va3, st.pf0, st.O3); va3 = ATT_VF(tv, 2, 3); ATT_EXP3(q0, q1, 9);
    ATT_SB();
    st.O0 = mfma32(vb0, st.pf1, st.O0); vb0 = ATT_VF(tv, 3, 0); ATT_EXP3(q0, q1, 12);
    ATT_SB();
    st.O1 = mfma32(vb1, st.pf1, st.O1); vb1 = ATT_VF(tv, 3, 1); ATT_EXP3(q0, q1, 15);
    ATT_PIN(q0);
    ATT_SB();
    st.O2 = mfma32(vb2, st.pf1, st.O2); vb2 = ATT_VF(tv, 3, 2); ATT_EXP3(q0, q1, 18);
    ATT_SB();
    st.O3 = mfma32(vb3, st.pf1, st.O3); vb3 = ATT_VF(tv, 3, 3); ATT_EXP3(q0, q1, 21);
    ATT_SB();
    st.O0 = mfma32(va0, st.pf2, st.O0); ATT_EXP3(q0, q1, 24); ATT_EXP1(q0, q1, 27);
    ATT_SB();
    st.O1 = mfma32(va1, st.pf2, st.O1); ATT_EXP3(q0, q1, 28); ATT_EXP1(q0, q1, 31);
    ATT_PIN(q1);
    ATT_SB();
    st.O2 = mfma32(va2, st.pf2, st.O2);
    f32x2 ps = attn_sum8<0>(q0, (f32x2){0.f, 0.f}); ps = attn_sum8<8>(q0, ps); ATT_PIN(ps);
    ATT_SB();
    st.O3 = mfma32(va3, st.pf2, st.O3);
    ps = attn_sum8<0>(q1, ps); ps = attn_sum8<8>(q1, ps);
    float psum = ps.x + ps.y; ATT_PIN(psum);
    ATT_SB();
    const bool resc = __any(psum > 256.0f);
    st.rp = resc; st.alpha = 1.f;
    if (resc) {
        const f32x16 nm2 = attn_splat(-st.mref);
        q0 = mfma32(st.k0, qf[0], nm2); q1 = mfma32(st.k1, qf[0], nm2);
        q0 = mfma32(st.k2, qf[1], q0); q1 = mfma32(st.k3, qf[1], q1);
        q0 = mfma32(st.k4, qf[2], q0); q1 = mfma32(st.k5, qf[2], q1);
        q0 = mfma32(st.k6, qf[3], q0); q1 = mfma32(st.k7, qf[3], q1);
        ATT_MASK(q0, q1, t);
        const float d = attn_rowmax(q0, q1);
        const float dl = fmaxf(d, 0.f); st.mref += dl; st.alpha = __builtin_amdgcn_exp2f(-dl); st.l *= st.alpha;
#pragma unroll
        for (int r = 0; r < 16; ++r) { q0[r] = __builtin_amdgcn_exp2f(q0[r] - dl); q1[r] = __builtin_amdgcn_exp2f(q1[r] - dl); }
        f32x2 p2 = attn_sum8<0>(q0, (f32x2){0.f, 0.f}); p2 = attn_sum8<8>(q0, p2); p2 = attn_sum8<0>(q1, p2); p2 = attn_sum8<8>(q1, p2); psum = p2.x + p2.y;
    }
    st.l += psum;
    st.O0 = mfma32(vb0, st.pf3, st.O0); st.k0 = ATT_KF(rn0, 0); st.k1 = ATT_KF(rn0, 8192);
    ATT_PIN(st.l);
    ATT_SB();
    st.O1 = mfma32(vb1, st.pf3, st.O1); st.k2 = ATT_KF(rn1, 0); st.k3 = ATT_KF(rn1, 8192);
    ATT_SB();
    st.O2 = mfma32(vb2, st.pf3, st.O2); st.k4 = ATT_KF(rn2, 0); st.k5 = ATT_KF(rn2, 8192);
    st.pf0 = pack8<0>(q0); ATT_PIN(st.pf0);
    ATT_SB();
    st.O3 = mfma32(vb3, st.pf3, st.O3); st.k6 = ATT_KF(rn3, 0); st.k7 = ATT_KF(rn3, 8192);
    st.pf1 = pack8<8>(q0); ATT_PIN(st.pf1);
    ATT_SB();
    st.p1 = q1;
}
struct AttAddr { unsigned oK0, oK1, oV0; const unsigned char* gb; };
__device__ __forceinline__ AttAddr attn_addr(const int lane, const int w, const int b, const int h, const bf16* proj) {
    const int hcol = h * 128;
    const int kr0 = 8 * w + (lane >> 4), kc0 = (lane & 15) ^ (((kr0 & 3) << 2) | ((kr0 >> 2) & 3)), kr1 = kr0 + 4, kc1 = (lane & 15) ^ (((kr1 & 3) << 2) | ((kr1 >> 2) & 3));
    AttAddr A;
    A.oK0 = 2u * (unsigned)pidx(kr0, C_KD + hcol + 8 * kc0); A.oK1 = 2u * (unsigned)pidx(kr1, C_KD + hcol + 8 * kc1);
    A.oV0 = 2u * (unsigned)pidx(32 * (w & 1) + (lane >> 2), C_VD + hcol + 32 * (w >> 1) + 8 * (lane & 3));
    A.gb = (const unsigned char*)(proj + (size_t)((b * SEQ) >> 4) * PBROW);
    return A;
}
#define ATT_GLDS(g_, d_) do { unsigned keep_; asm volatile("s_mov_b32 %0, m0\n\ts_mov_b32 m0, %2\n\ts_nop 0\n\tglobal_load_lds_dwordx4 %1, off\n\ts_mov_b32 m0, %0" : "=&s"(keep_) : "v"(g_), "s"(d_) : "memory"); } while (0)
#define ATT_DMA_K(A_, tk_, so_) do { const unsigned char* p_ = (A_).gb + (size_t)(4 * (tk_)) * (2 * PBROW); const unsigned d_ = ldsb + ATT_K0 + (so_) + dK; \
        ATT_GLDS(p_ + (A_).oK0, d_); ATT_GLDS(p_ + (A_).oK1, d_ + 1024u); } while (0)
#define ATT_DMA_V(A_, tv_, so_) do { const unsigned char* p_ = (A_).gb + (size_t)(4 * (tv_)) * (2 * PBROW); const unsigned d_ = ldsb + ATT_V0 + (so_) + dV; \
        ATT_GLDS(p_ + (A_).oV0, d_); ATT_GLDS(p_ + (A_).oV0 + 2 * PBROW, d_ + 1024u); } while (0)
__device__ __forceinline__ void attn_prefetch(const int tid, ldsp lds, const int item, const bf16* proj, bf16x8 (&qf)[4]) {
    const int lane = tid & 63, w = __builtin_amdgcn_readfirstlane(tid >> 6), r32 = lane & 31, hi = lane >> 5, c = w >> 2, it = w & 3;
    const int qb = 31 - (item >> 5), bh = item & 31, b = bh >> 3, h = bh & 7, TL = 2 * qb + 1;
    const AttAddr A = attn_addr(lane, w, b, h, proj);
    const int dK = 2048 * w, dV = 4096 * (w >> 1) + 2048 * (w & 1);
    const unsigned ldsb = (unsigned)__builtin_amdgcn_readfirstlane((int)(unsigned)(unsigned long long)lds);
    ATT_DMA_K(A, 0, 0);
    ATT_DMA_K(A, 1, ATT_SLOT);
    { const int t2 = 2 < TL ? 2 : TL; ATT_DMA_K(A, t2, 2 * ATT_SLOT); }
    ATT_DMA_V(A, 0, 0);
#pragma unroll
    for (int s = 0; s < 4; ++s) qf[s] = *(const bf16x8*)(proj + pidx(b * SEQ + qb * 128 + 32 * it + r32, C_QD + h * 128 + 64 * c + 16 * s + 8 * hi));
}
__device__ __forceinline__ int attn_unit(const int tid, ldsp lds, const int item, gu32* ctr, volatile LAS unsigned* slot, const int nitems, const bf16* proj, bf16* yc, const float* lamp, const float* subg, bf16x8 (&qf)[4]) {
    const int lane = tid & 63, w = __builtin_amdgcn_readfirstlane(tid >> 6), r32 = lane & 31, hi = lane >> 5;
    const int c = w >> 2, it = w & 3;
    const int qb = 31 - (item >> 5), bh = item & 31, b = bh >> 3, h = bh & 7;
    const int qw = qb * 128 + 32 * it, NT = 2 * qb + 2;
    const int row00 = b * SEQ, hcol = h * 128;
    ldsp rk0 = lds + ATT_K0 + offb(r32, 8 * c + 0 + hi), rk1 = lds + ATT_K0 + offb(r32, 8 * c + 2 + hi), rk2 = lds + ATT_K0 + offb(r32, 8 * c + 4 + hi), rk3 = lds + ATT_K0 + offb(r32, 8 * c + 6 + hi);
    ldsp tvb = lds + ATT_V0 + (4 * hi + ((lane & 15) >> 2)) * 64 + 32 * ((lane >> 4) & 1) + 8 * (lane & 3);
    const AttAddr AD = attn_addr(lane, w, b, h, proj);
    const int dK = 2048 * w, dV = 4096 * (w >> 1) + 2048 * (w & 1);
    const unsigned ldsb = (unsigned)__builtin_amdgcn_readfirstlane((int)(unsigned)(unsigned long long)lds);
#define ATT_WAITBAR() do { asm volatile("s_waitcnt vmcnt(4) lgkmcnt(0)" ::: "memory"); __builtin_amdgcn_s_barrier(); asm volatile("" ::: "memory"); } while (0)
    const int TL = NT - 1;
    AttS st; st.O0 = zero16(); st.O1 = zero16(); st.O2 = zero16(); st.O3 = zero16();
    st.mref = 0.f; st.l = 0.f; st.alpha = 1.f; st.rp = 0;
    asm volatile("s_waitcnt vmcnt(0)" ::: "memory"); __builtin_amdgcn_s_barrier(); asm volatile("" ::: "memory");
    unsigned pend = 0u; if (tid == 0) pend = __hip_atomic_fetch_add(ctr, 1u, RLX_AGENT);
    st.k0 = ATT_KF(rk0, 0); st.k1 = ATT_KF(rk0, 8192); st.k2 = ATT_KF(rk1, 0); st.k3 = ATT_KF(rk1, 8192);
    st.k4 = ATT_KF(rk2, 0); st.k5 = ATT_KF(rk2, 8192); st.k6 = ATT_KF(rk3, 0); st.k7 = ATT_KF(rk3, 8192);
    ATT_WAITBAR();
    { const int t3 = 3 < TL ? 3 : TL, t1 = 1 < TL ? 1 : TL; ATT_DMA_K(AD, t3, 0); ATT_DMA_V(AD, t1, ATT_SLOT); }
    st.p0 = mfma32(st.k0, qf[0], zero16()); st.p1 = mfma32(st.k1, qf[0], zero16());
    st.p0 = mfma32(st.k2, qf[1], st.p0); st.p1 = mfma32(st.k3, qf[1], st.p1);
    st.p0 = mfma32(st.k4, qf[2], st.p0); st.p1 = mfma32(st.k5, qf[2], st.p1);
    st.p0 = mfma32(st.k6, qf[3], st.p0); st.p1 = mfma32(st.k7, qf[3], st.p1);
    ATT_SB();
    st.k0 = ATT_KF(rk0, ATT_SLOT); st.k1 = ATT_KF(rk0, ATT_SLOT + 8192); st.k2 = ATT_KF(rk1, ATT_SLOT); st.k3 = ATT_KF(rk1, ATT_SLOT + 8192);
    st.k4 = ATT_KF(rk2, ATT_SLOT); st.k5 = ATT_KF(rk2, ATT_SLOT + 8192); st.k6 = ATT_KF(rk3, ATT_SLOT); st.k7 = ATT_KF(rk3, ATT_SLOT + 8192);
    ATT_MASK(st.p0, st.p1, 0);
    st.mref = attn_rowmax(st.p0, st.p1);
#pragma unroll
    for (int r = 0; r < 16; ++r) { st.p0[r] = __builtin_amdgcn_exp2f(st.p0[r] - st.mref); st.p1[r] = __builtin_amdgcn_exp2f(st.p1[r] - st.mref); }
    { f32x2 ps = attn_sum8<0>(st.p0, (f32x2){0.f, 0.f}); ps = attn_sum8<8>(st.p0, ps); ps = attn_sum8<0>(st.p1, ps); ps = attn_sum8<8>(st.p1, ps); st.l += ps.x + ps.y; }
    st.pf0 = pack8<0>(st.p0); st.pf1 = pack8<8>(st.p0);
    ATT_PIN(st.pf0); ATT_PIN(st.pf1); ATT_PIN(st.p1);
    int sa = ATT_SLOT, sb = 2 * ATT_SLOT, sc = 0;
    for (int t = 1; t <= TL; ++t) {
        ATT_WAITBAR();
        { const int tk = t + 3 < TL ? t + 3 : TL, tv = t + 1 < TL ? t + 1 : TL; ATT_DMA_K(AD, tk, sa); ATT_DMA_V(AD, tv, sb); }
        attn_step(st, t, qw, r32, hi, qf, tvb + sc, rk0 + sb, rk1 + sb, rk2 + sb, rk3 + sb);
        const int s0 = sa; sa = sb; sb = sc; sc = s0;
    }
    ATT_WAITBAR();
    ATT_OSCALE();
    st.pf2 = pack8<0>(st.p1); st.pf3 = pack8<8>(st.p1);
    { ldsp tv = tvb + sc;
      { const bf16x8 v0 = ATT_VF(tv, 0, 0), v1 = ATT_VF(tv, 0, 1), v2 = ATT_VF(tv, 0, 2), v3 = ATT_VF(tv, 0, 3);
        st.O0 = mfma32(v0, st.pf0, st.O0); st.O1 = mfma32(v1, st.pf0, st.O1); st.O2 = mfma32(v2, st.pf0, st.O2); st.O3 = mfma32(v3, st.pf0, st.O3); }
      { const bf16x8 v0 = ATT_VF(tv, 1, 0), v1 = ATT_VF(tv, 1, 1), v2 = ATT_VF(tv, 1, 2), v3 = ATT_VF(tv, 1, 3);
        st.O0 = mfma32(v0, st.pf1, st.O0); st.O1 = mfma32(v1, st.pf1, st.O1); st.O2 = mfma32(v2, st.pf1, st.O2); st.O3 = mfma32(v3, st.pf1, st.O3); }
      { const bf16x8 v0 = ATT_VF(tv, 2, 0), v1 = ATT_VF(tv, 2, 1), v2 = ATT_VF(tv, 2, 2), v3 = ATT_VF(tv, 2, 3);
        st.O0 = mfma32(v0, st.pf2, st.O0); st.O1 = mfma32(v1, st.pf2, st.O1); st.O2 = mfma32(v2, st.pf2, st.O2); st.O3 = mfma32(v3, st.pf2, st.O3); }
      { const bf16x8 v0 = ATT_VF(tv, 3, 0), v1 = ATT_VF(tv, 3, 1), v2 = ATT_VF(tv, 3, 2), v3 = ATT_VF(tv, 3, 3);
        st.O0 = mfma32(v0, st.pf3, st.O0); st.O1 = mfma32(v1, st.pf3, st.O1); st.O2 = mfma32(v2, st.pf3, st.O2); st.O3 = mfma32(v3, st.pf3, st.O3); } }
#undef ATT_WAITBAR
    const float l = half_sum(st.l);
    const float inv = 1.0f / l;
    int tid_e = tid; LAUNDER_V(tid_e);
    const int lane_e = tid_e & 63, r32e = lane_e & 31, hie = lane_e >> 5;
    u32x2 gpre[16]; f32x4 spre[16];
    if (tid_e == 0) *slot = pend;
    if (c == 0) { const bf16* grow = proj + pidx(row00 + qw + r32e, C_GD + hcol + 4 * hie); const float* sgp = subg + 4 * hie;
#pragma unroll
        for (int et = 0; et < 4; ++et)
#pragma unroll
            for (int q4 = 0; q4 < 4; ++q4) { gpre[4 * et + q4] = *(const u32x2*)(grow + 512 * et + 8 * q4); spre[4 * et + q4] = *(const f32x4*)(sgp + 32 * et + 8 * q4); }
        asm volatile("s_waitcnt vmcnt(32) lgkmcnt(0)" ::: "memory"); }
    else asm volatile("s_waitcnt vmcnt(0) lgkmcnt(0)" ::: "memory");
    __builtin_amdgcn_s_barrier(); asm volatile("" ::: "memory");
    const int nxt = __builtin_amdgcn_readfirstlane((int)*slot);
    if (nxt < nitems) attn_prefetch(tid_e, lds, nxt, proj, qf);
#define ATT_BAR() do { asm volatile("s_waitcnt lgkmcnt(0)" ::: "memory"); __builtin_amdgcn_s_barrier(); asm volatile("" ::: "memory"); } while (0)
    LAS float* XB = (LAS float*)(lds + 98304) + it * 2048 + lane_e;
    const float lam = lamp[0], oml = lamp[1];
    float ss = 0.f;
    if (c == 1) { const float f = lam * inv;
#pragma unroll
        for (int r = 0; r < 16; ++r) { XB[(0 * 16 + r) * 64] = st.O0[r] * f; XB[(1 * 16 + r) * 64] = st.O1[r] * f; } }
    ATT_BAR();
    if (c == 0) {
#pragma unroll
        for (int r = 0; r < 16; ++r) { st.O0[r] = st.O0[r] * inv - XB[(0 * 16 + r) * 64]; st.O1[r] = st.O1[r] * inv - XB[(1 * 16 + r) * 64]; ss += st.O0[r] * st.O0[r] + st.O1[r] * st.O1[r]; } }
    ATT_BAR();
    if (c == 1) { const float f = lam * inv;
#pragma unroll
        for (int r = 0; r < 16; ++r) { XB[(0 * 16 + r) * 64] = st.O2[r] * f; XB[(1 * 16 + r) * 64] = st.O3[r] * f; } }
    ATT_BAR();
    if (c == 0) {
#pragma unroll
        for (int r = 0; r < 16; ++r) { st.O2[r] = st.O2[r] * inv - XB[(0 * 16 + r) * 64]; st.O3[r] = st.O3[r] * inv - XB[(1 * 16 + r) * 64]; ss += st.O2[r] * st.O2[r] + st.O3[r] * st.O3[r]; }
        ss = half_sum(ss);
        const float rs = rsqrtf(ss * (1.f / 128.f) + EPS) * oml;
        const size_t rowl = (size_t)(qw + r32e);
        bf16* yrow = yc + ((size_t)b * SEQ + rowl) * 1024 + h * 128 + 4 * hie;
#pragma unroll
        for (int et = 0; et < 4; ++et)
#pragma unroll
            for (int q4 = 0; q4 < 4; ++q4) {
                const f32x16& A = et == 0 ? st.O0 : et == 1 ? st.O1 : et == 2 ? st.O2 : st.O3;
                const int e0 = 32 * et + 8 * q4;
                const f32x4 sg4 = spre[4 * et + q4]; const u32x2 g = gpre[4 * et + q4];
                u32x2 o; o.x = cvt_pk_bf16(A[4 * q4] * rs * sg4.x * bf_lo(g.x), A[4 * q4 + 1] * rs * sg4.y * bf_hi(g.x));
                o.y = cvt_pk_bf16(A[4 * q4 + 2] * rs * sg4.z * bf_lo(g.y), A[4 * q4 + 3] * rs * sg4.w * bf_hi(g.y));
                *(u32x2*)(yrow + e0) = o;
            }
    }
#undef ATT_BAR
#undef ATT_PIN
#undef ATT_SB
#undef ATT_EXP4
#undef ATT_SUB4
#undef ATT_EXP1
#undef ATT_EXP3
#undef ATT_VF
#undef ATT_KF
#undef ATT_MASK
#undef ATT_OSCALE
    return nxt;
}
#undef ATT_GLDS
#undef ATT_DMA_K
#undef ATT_DMA_V

__device__ __forceinline__ int fetch_item(const int tid, gu32* ctr, volatile LAS unsigned* slot) {
    __syncthreads();
    if (tid == 0) *slot = __hip_atomic_fetch_add(ctr, 1u, RLX_AGENT);
    __syncthreads();
    return __builtin_amdgcn_readfirstlane((int)*slot);
}

#ifndef G1_ALIGN
#define G1_ALIGN true
#endif
#ifndef G1_SP2
#define G1_SP2 true
#endif
#ifndef G3_ALIGN
#define G3_ALIGN true
#endif
#ifndef G3_SP2
#define G3_SP2 true
#endif
#ifndef G4_ALIGN
#define G4_ALIGN true
#endif
#ifndef G4_SP2
#define G4_SP2 true
#endif
#ifndef PROBE_DUP
#define PROBE_DUP 0
#endif
#ifndef PROBE_EMODE
#define PROBE_EMODE 0
#endif
#ifndef PROBE_AMODE
#define PROBE_AMODE 0
#endif
#ifndef PROBE_P2SEL
#define PROBE_P2SEL 0
#endif
#ifndef MK_N_LAUNCHES
#define MK_N_LAUNCHES 1
#endif
constexpr int N_PHASES = 1 + NGROUP * DEPTH * 5;
struct Args { const float* in[17]; float* out; unsigned char* ws; int ph_lo, ph_hi, li, pad; };
__global__ void __launch_bounds__(NWAVES * 64, 2) hyb_fwd(Args args) {
    extern __shared__ __attribute__((aligned(16))) unsigned char lds_raw[];
    ldsp lds = (ldsp)lds_raw;
    volatile LAS unsigned* MISC = (volatile LAS unsigned*)(lds + MISC_OFF);
    for (int u = threadIdx.x; u < (LDS_BYTES - LDSCTL_OFF) / 4; u += NWAVES * 64) ((LAS unsigned*)(lds + LDSCTL_OFF))[u] = 0u;
    __syncthreads();
    XcdBarrier bar = xcd_barrier_post((unsigned*)((gu32*)(args.ws + WS_CTL) + CW_BAR) + args.li * XCD_BAR_WORDS, MISC + 8, (unsigned)__builtin_amdgcn_readfirstlane((int)threadIdx.x >> 6));
    int tidc = threadIdx.x;
    const int lo = args.ph_lo, hi_ = args.ph_hi;
#define IN(k) (lo <= (k) && (k) < hi_)
#define BOTH(k) (IN(k) && IN((k) + 1))
#define PHASE_ENTRY() LAUNDER_V(tidc); const int tid = tidc; unsigned long long z_ = 0ull; LAUNDER_S(z_); unsigned char* ws = args.ws + z_; const int G = gridDim.x; \
    const int lane = tid & 63, wave = __builtin_amdgcn_readfirstlane(tid >> 6); (void)lane; (void)wave; (void)G

    if (IN(0)) {
        PHASE_ENTRY();
        const int gw = blockIdx.x * NWAVES + wave, NGW = G * NWAVES;
        float* lams = (float*)(ws + WS_LAMS);
        bf16* WIN = (bf16*)(ws + WS_WIN); bf16* WBR = (bf16*)(ws + WS_WBR); bf16* WOUT = (bf16*)(ws + WS_WOUT); bf16* HB = (bf16*)(ws + WS_H);
        LAS float* scr = (LAS float*)(lds + wave * 16384);
        constexpr int I_IN = (2048 / 64) * (16384 / 32), I_BR = (1024 / 64) * (2048 / 32), I_OUT = (2048 / 64) * (2048 / 32);
        constexpr int NITEMS = 2 * I_IN + 6 * I_BR + 2 * I_OUT;
        for (int it = gw; it < NITEMS; it += NGW) {
            int r = it;
            if (r < 2 * I_IN) { const int l = r / I_IN; r -= l * I_IN; p0_transpose_item(args.in[3] + (size_t)l * 2048 * 16384, 2048, 16384, WIN + (size_t)l * 16384 * 2048, scr, r, lane); continue; }
            r -= 2 * I_IN;
            if (r < 6 * I_BR) { const int lj = r / I_BR; r -= lj * I_BR; const int l = lj / 3, j = lj - 3 * l;
                const float* src = j == 0 ? args.in[13] : j == 1 ? args.in[14] : args.in[15];
                p0_transpose_item(src + (size_t)l * 1024 * 2048, 1024, 2048, WBR + (size_t)lj * 2048 * 1024, scr, r, lane); continue; }
            r -= 6 * I_BR;
            { const int l = r / I_OUT; r -= l * I_OUT; p0_transpose_item(args.in[16] + (size_t)l * 2048 * 2048, 2048, 2048, WOUT + (size_t)l * 2048 * 2048, scr, r, lane); }
        }
        if (blockIdx.x == 0 && wave == 0) {
            for (int l = 0; l < DEPTH; ++l) { const float* dl = args.in[11] + l * 256;
                const float s01 = wave_sum(dl[lane] * dl[64 + lane]), s23 = wave_sum(dl[128 + lane] * dl[192 + lane]);
                const float lam_init = 0.8f - 0.6f * __expf(-0.3f * (float)l);
                if (lane == 0) { lams[2 * l] = __expf(s01) - __expf(s23) + lam_init; lams[2 * l + 1] = 1.0f - lam_init; } }
        }
        { f32x4 gv[8];
#pragma unroll
          for (int j = 0; j < 4; ++j) { gv[2 * j] = *(const f32x4*)(args.in[1] + 512 * j + 8 * lane); gv[2 * j + 1] = *(const f32x4*)(args.in[1] + 512 * j + 8 * lane + 4); }
          for (int m = gw; m < M_ALL; m += NGW) rms_row_to_bf16(args.in[0] + (size_t)m * D_MODEL, gv, HB + (size_t)m * D_MODEL, lane); }
        if (BOTH(0)) xcd_barrier(bar);
    }

    for (int g = 0; g < NGROUP; ++g)
        for (int l = 0; l < DEPTH; ++l) {
            const int pb = 1 + (g * DEPTH + l) * 5;
            if (IN(pb)) {
                PHASE_ENTRY();
                pg8::SchedPlain S; S.so.init(TG, D_IN, G, (int)blockIdx.x); S.A = (const char*)(ws + WS_H) + (size_t)g * TG * D_MODEL * 2; S.Bt = (const char*)(ws + WS_WIN) + (size_t)l * D_IN * D_MODEL * 2;
                pg8::EpiProj E{(bf16*)(ws + WS_PROJ), (bf16*)(ws + WS_GM), (PROBE_DUP == 1 && args.li > 0 && pb == lo) ? PROBE_EMODE : 0};
#ifndef SKIP_P1
                pg8::gemm_phase<pg8::EpiProj, pg8::SchedPlain, G1_ALIGN, G1_SP2>(lds, D_MODEL, S, E, tid);
#endif
                if (BOTH(pb)) xcd_barrier(bar);
            }
            if (IN(pb + 1)) {
                const bool only = PROBE_DUP == 2 && PROBE_P2SEL != 0 && args.li > 0 && (pb + 1) == lo;
#ifndef SKIP_RET
                if (!only || PROBE_P2SEL == 1) { PHASE_ENTRY(); gu32* q = (gu32*)(ws + WS_CTL) + CW_Q + 64 * 3 * (g * DEPTH + l) + args.li * 1024;
                  const bf16* PROJ = (const bf16*)(ws + WS_PROJ); bf16* YB = (bf16*)(ws + WS_Y);
                  for (;;) { LAUNDER_V(tidc); const int t2 = tidc; const int it = fetch_item(t2, q, MISC + 16); if (it >= BG * 8) break; ret_unit(t2, lds, it >> 3, it & 7, PROJ, YB + (size_t)TG * 1024); } }
#endif
#ifndef SKIP_LRU
                if (!only || PROBE_P2SEL == 2) { PHASE_ENTRY(); gu32* q = (gu32*)(ws + WS_CTL) + CW_Q + 64 * 3 * (g * DEPTH + l) + args.li * 1024;
                  const bf16* PROJ = (const bf16*)(ws + WS_PROJ); bf16* YB = (bf16*)(ws + WS_Y);
                  for (;;) { LAUNDER_V(tidc); const int t2 = tidc; const int it = fetch_item(t2, q + 64, MISC + 16); if (it >= BG * 16) break;
                    lru_unit(t2, lds, it >> 4, it & 15, PROJ, YB, args.in[4] + l * 4096, args.in[5] + l * 1024, args.in[6] + (size_t)l * 65536, args.in[7] + l * 1024,
                             args.in[8] + (size_t)l * 65536, args.in[9] + l * 1024, args.in[10] + l * 1024); } }
#endif
#ifndef SKIP_ATT
                if (!only || PROBE_P2SEL == 3) { PHASE_ENTRY(); gu32* q = (gu32*)(ws + WS_CTL) + CW_Q + 64 * 3 * (g * DEPTH + l) + args.li * 1024;
                  const bf16* PROJ = (const bf16*)(ws + WS_PROJ); bf16* YB = (bf16*)(ws + WS_Y); const float* lams = (const float*)(ws + WS_LAMS);
                  int it; bf16x8 qfa[4];
                  { LAUNDER_V(tidc); const int t2 = tidc; it = fetch_item(t2, q + 128, MISC + 16); if (it < BG * 8 * 32) attn_prefetch(t2, lds, it, PROJ, qfa); }
                  while (it < BG * 8 * 32) { LAUNDER_V(tidc); const int t2 = tidc;
                    it = attn_unit(t2, lds, it, q + 128, MISC + 16, BG * 8 * 32, PROJ, YB + (size_t)2 * TG * 1024, lams + 2 * l, args.in[12] + l * 128, qfa); } }
#endif
                if (BOTH(pb + 1)) xcd_barrier(bar);
            }
            if (IN(pb + 2)) {
                PHASE_ENTRY();
                pg8::SchedBranch S; S.so.init(TG, D_MODEL, G, (int)blockIdx.x); S.A = (const char*)(ws + WS_Y); S.strideA = (size_t)TG * 1024 * 2;
                S.Bt = (const char*)(ws + WS_WBR) + (size_t)l * 3 * 2048 * 1024 * 2; S.strideB = (size_t)2048 * 1024 * 2;
                pg8::EpiMerge E{(const unsigned char*)(ws + WS_GM), (bf16*)(ws + WS_M)};
#ifndef SKIP_P3
                pg8::gemm_phase<pg8::EpiMerge, pg8::SchedBranch, G3_ALIGN, G3_SP2>(lds, 1024, S, E, tid);
#endif
                if (BOTH(pb + 2)) xcd_barrier(bar);
            }
            if (IN(pb + 3)) {
                PHASE_ENTRY();
                pg8::SchedPlain S; S.so.init(TG, D_MODEL, G, (int)blockIdx.x); S.A = (const char*)(ws + WS_M); S.Bt = (const char*)(ws + WS_WOUT) + (size_t)l * D_MODEL * D_MODEL * 2;
                pg8::EpiBf16Plain E{(bf16*)(ws + WS_O), D_MODEL};
#ifndef SKIP_P4
                pg8::gemm_phase<pg8::EpiBf16Plain, pg8::SchedPlain, G4_ALIGN, G4_SP2>(lds, D_MODEL, S, E, tid);
#endif
                if (BOTH(pb + 3)) xcd_barrier(bar);
            }
            if (IN(pb + 4)) {
                PHASE_ENTRY();
                const int gw = blockIdx.x * NWAVES + wave, NGW = G * NWAVES;
                const bool dead = __hip_atomic_load((gu32*)(ws + WS_CTL) + CW_BAR + XB_TMO, RLX_AGENT) != 0u;
                const bf16* OB = (const bf16*)(ws + WS_O); bf16* HB = (bf16*)(ws + WS_H); bf16* X1 = (bf16*)(ws + WS_X1);
                f32x4 pgv[8], ngv[8];
                { const float* pg = args.in[2] + l * D_MODEL + 8 * lane; const float* ng = args.in[1] + D_MODEL + 8 * lane;
#pragma unroll
                  for (int j = 0; j < 4; ++j) { pgv[2 * j] = *(const f32x4*)(pg + 512 * j); pgv[2 * j + 1] = *(const f32x4*)(pg + 512 * j + 4); ngv[2 * j] = *(const f32x4*)(ng + 512 * j); ngv[2 * j + 1] = *(const f32x4*)(ng + 512 * j + 4); } }
                for (int m = gw; m < TG; m += NGW) {
                    const size_t row = (size_t)g * TG + m;
                    const v4u* orow = (const v4u*)(OB + (size_t)m * D_MODEL) + lane;
                    f32x4 v[8]; float s = 0.f;
#pragma unroll
                    for (int j = 0; j < 4; ++j) { const v4u ow = orow[64 * j]; v[2 * j] = (f32x4){bf_lo(ow.x), bf_hi(ow.x), bf_lo(ow.y), bf_hi(ow.y)}; v[2 * j + 1] = (f32x4){bf_lo(ow.z), bf_hi(ow.z), bf_lo(ow.w), bf_hi(ow.w)}; }
#pragma unroll
                    for (int j = 0; j < 8; ++j) s += (v[j].x * v[j].x + v[j].y * v[j].y) + (v[j].z * v[j].z + v[j].w * v[j].w);
                    const float rs = rsqrtf(wave_sum(s) * (1.f / D_MODEL) + EPS);
                    if (l == 0) {
                        const float* xrow = args.in[0] + row * D_MODEL + 8 * lane; float s2 = 0.f;
                        v4u* x8 = (v4u*)(X1 + (size_t)m * D_MODEL) + lane;
#pragma unroll
                        for (int j = 0; j < 4; ++j) {
                            const f32x4 xa = *(const f32x4*)(xrow + 512 * j), xb = *(const f32x4*)(xrow + 512 * j + 4), ga = pgv[2 * j], gb = pgv[2 * j + 1];
                            v[2 * j] = xa + v[2 * j] * rs * ga; v[2 * j + 1] = xb + v[2 * j + 1] * rs * gb;
                            v4u wv; wv.x = cvt_pk_bf16(v[2 * j].x, v[2 * j].y); wv.y = cvt_pk_bf16(v[2 * j].z, v[2 * j].w); wv.z = cvt_pk_bf16(v[2 * j + 1].x, v[2 * j + 1].y); wv.w = cvt_pk_bf16(v[2 * j + 1].z, v[2 * j + 1].w);
                            x8[64 * j] = wv; }
#pragma unroll
                        for (int j = 0; j < 8; ++j) s2 += (v[j].x * v[j].x + v[j].y * v[j].y) + (v[j].z * v[j].z + v[j].w * v[j].w);
                        const float rs2 = rsqrtf(wave_sum(s2) * (1.f / D_MODEL) + EPS);
                        v4u* o8 = (v4u*)(HB + row * D_MODEL) + lane;
#pragma unroll
                        for (int j = 0; j < 4; ++j) { const f32x4 ga = ngv[2 * j], gb = ngv[2 * j + 1]; const f32x4 a = v[2 * j] * rs2 * ga, bq = v[2 * j + 1] * rs2 * gb;
                            v4u wv; wv.x = cvt_pk_bf16(a.x, a.y); wv.y = cvt_pk_bf16(a.z, a.w); wv.z = cvt_pk_bf16(bq.x, bq.y); wv.w = cvt_pk_bf16(bq.z, bq.w); o8[64 * j] = wv; }
                    } else {
                        const v4u* x8 = (const v4u*)(X1 + (size_t)m * D_MODEL) + lane;
                        float* drow = args.out + row * D_MODEL + 8 * lane;
#pragma unroll
                        for (int j = 0; j < 4; ++j) { const v4u xw = x8[64 * j]; const f32x4 ga = pgv[2 * j], gb = pgv[2 * j + 1];
                            f32x4 a = (f32x4){bf_lo(xw.x), bf_hi(xw.x), bf_lo(xw.y), bf_hi(xw.y)} + v[2 * j] * rs * ga, bq = (f32x4){bf_lo(xw.z), bf_hi(xw.z), bf_lo(xw.w), bf_hi(xw.w)} + v[2 * j + 1] * rs * gb;
                            if (dead) { const float qn = __builtin_nanf(""); a = (f32x4){qn, qn, qn, qn}; bq = a; }
                            *(f32x4*)(drow + 512 * j) = a; *(f32x4*)(drow + 512 * j + 4) = bq; }
                    }
                }
                if (BOTH(pb + 4)) xcd_barrier(bar);
            }
        }
#undef IN
#undef BOTH
#undef PHASE_ENTRY
}

extern "C" void kernel_launch(void* const* d_in, const int* in_sizes, int n_in, void* d_out, int out_size, void* d_ws, size_t ws_size, hipStream_t stream) {
    static int grid = 0;
    if (grid == 0) {
        if (n_in != 17 || in_sizes[0] != M_ALL * D_MODEL || out_size != M_ALL * D_MODEL || ws_size < WS_END) {
            fprintf(stderr, "kernel_launch: unexpected shapes (n_in %d, in0 %d, out %d, ws %zu < %zu); nothing launched\n", n_in, n_in > 0 ? in_sizes[0] : -1, out_size, ws_size, (size_t)WS_END); grid = -1; return; }
        int dev = 0, cus = 0, per_cu = 0;
        if (hipGetDevice(&dev) != hipSuccess || hipDeviceGetAttribute(&cus, hipDeviceAttributeMultiprocessorCount, dev) != hipSuccess) { grid = -1; return; }
        if (hipFuncSetAttribute((const void*)hyb_fwd, hipFuncAttributeMaxDynamicSharedMemorySize, LDS_BYTES) != hipSuccess) { fprintf(stderr, "kernel_launch: hipFuncSetAttribute failed\n"); grid = -1; return; }
        if (hipOccupancyMaxActiveBlocksPerMultiprocessor(&per_cu, (const void*)hyb_fwd, NWAVES * 64, LDS_BYTES) != hipSuccess || per_cu < 1)
            fprintf(stderr, "kernel_launch: note: occupancy query reports %d workgroups per CU\n", per_cu);
        (void)hipGetLastError();
        grid = cus;
    }
    if (grid < 0) return;
    if (hipMemsetAsync((char*)d_ws + WS_CTL, 0, CTL_ZERO_BYTES, stream) != hipSuccess) return;
    Args a{};
    for (int i = 0; i < 17; ++i) a.in[i] = (const float*)d_in[i];
    a.out = (float*)d_out; a.ws = (unsigned char*)d_ws;
#if PROBE_DUP > 0
    { int lo = 0; for (int k = 0; k <= NGROUP * DEPTH; ++k) { const int p = 1 + k * 5 + (PROBE_DUP - 1); const int hi = k < NGROUP * DEPTH ? p + 1 : N_PHASES;
        a.ph_lo = lo; a.ph_hi = hi; a.li = k; a.pad = 0; hipLaunchKernelGGL(hyb_fwd, dim3(grid), dim3(NWAVES * 64), LDS_BYTES, stream, a); lo = p; } }
#elif MK_N_LAUNCHES == 1
    a.ph_lo = 0; a.ph_hi = N_PHASES; a.li = 0; a.pad = 0;
    hipLaunchKernelGGL(hyb_fwd, dim3(grid), dim3(NWAVES * 64), LDS_BYTES, stream, a);
#else
    for (int p = 0; p < N_PHASES; ++p) { a.ph_lo = p; a.ph_hi = p + 1; a.li = 0; a.pad = 0;
        hipLaunchKernelGGL(hyb_fwd, dim3(grid), dim3(NWAVES * 64), LDS_BYTES, stream, a); }
#endif
}
```

```cpp
#include <hip/hip_runtime.h>
#include <cstdio>
#include <cstdint>

namespace pg8 {
#define PG8_LAS __attribute__((address_space(3)))
typedef unsigned short bf16_t;
typedef short bf16x8 __attribute__((ext_vector_type(8)));
typedef float f32x4 __attribute__((ext_vector_type(4)));
typedef unsigned u32x4 __attribute__((ext_vector_type(4)));
constexpr int BM = 256, BK = 64, HALF = 128, HTB = HALF * BK * 2  , STAGE_BYTES = 8 * HTB, NXCD = 8, WGM = 8;

__host__ __device__ __forceinline__ int lds_byte(int r, int c) { const int st = (r >> 4) * 2 + (c >> 5), rr = r & 15, cc = c & 31, ob = rr * 64 + cc * 2; return st * 1024 + (ob ^ (((ob >> 9) & 1) << 5)); }
__host__ __device__ __forceinline__ void stage_rc(int b, int& R, int& C) { const int st = b / 1024, sb = b % 1024, swz = sb ^ (((sb >> 9) & 1) << 5); R = (st >> 1) * 16 + swz / 64; C = (st & 1) * 32 + (swz % 64) / 2; }
__host__ __device__ __forceinline__ int perm32(int rho) { const int n = rho >> 4, i = rho & 15; return 8 * (i >> 2) + 4 * n + (i & 3); }

struct Unit { int pm, pn, sel; };

struct StaticOrder {
    int nM, nN, nwg, G, c;
    __host__ __device__ void init(int M, int N, int G_, int c_) { nM = M / BM; nN = N / BM; nwg = nM * nN; G = G_; c = c_; }
    __host__ __device__ bool next(int i, Unit& u) const {
        const long L = (long)i * G + c; if (L >= nwg) return false;
        int wgid = (int)L; { const int q = nwg / NXCD, r = nwg % NXCD, xcd = wgid % NXCD, off = wgid / NXCD; wgid = (xcd < r ? xcd * (q + 1) : r * (q + 1) + (xcd - r) * q) + off; }
        const int nig = WGM * nN, gid = wgid / nig, fm = gid * WGM, gsz = (nM - fm) < WGM ? (nM - fm) : WGM;
        u.pm = fm + ((wgid % nig) % gsz); u.pn = (wgid % nig) / gsz; u.sel = 0; return true;
    }
};
struct SchedPlain {
    StaticOrder so; const char* A; const char* Bt;
    __device__ __forceinline__ bool next(int i, Unit& u) const { return so.next(i, u); }
    __device__ __forceinline__ const char* a_base(const Unit& u, size_t tstep) const { return A + (size_t)u.pm * tstep; }
    __device__ __forceinline__ const char* b_base(const Unit& u, size_t tstep) const { return Bt + (size_t)u.pn * tstep; }
    __device__ __forceinline__ bool keep(const Unit&) const { return false; }
    __device__ __forceinline__ void a_ready(const Unit&) const {}
    __device__ __forceinline__ void done(const Unit&) const {}
};
struct SchedBranch {
    StaticOrder so; const char* A; const char* Bt; size_t strideA, strideB;
    __device__ __forceinline__ bool next(int i, Unit& u) const { const int t = i / 3; if (!so.next(t, u)) return false; u.sel = i - 3 * t; return true; }
    __device__ __forceinline__ const char* a_base(const Unit& u, size_t tstep) const { return A + (size_t)u.sel * strideA + (size_t)u.pm * tstep; }
    __device__ __forceinline__ const char* b_base(const Unit& u, size_t tstep) const { return Bt + (size_t)u.sel * strideB + (size_t)u.pn * tstep; }
    __device__ __forceinline__ bool keep(const Unit& u) const { return u.sel < 2; }
    __device__ __forceinline__ void a_ready(const Unit&) const {}
    __device__ __forceinline__ void done(const Unit&) const {}
};

typedef float f32x2_cv __attribute__((ext_vector_type(2))); typedef __bf16 bf16x2_cv __attribute__((ext_vector_type(2)));
__device__ __forceinline__ unsigned cvt_pk_bf16(float lo, float hi) { const f32x2_cv v = {lo, hi}; const bf16x2_cv b = __builtin_convertvector(v, bf16x2_cv); return __builtin_bit_cast(unsigned, b); }
__device__ __forceinline__ float bf_lo(unsigned w) { return __uint_as_float(w << 16); }
__device__ __forceinline__ float bf_hi(unsigned w) { return __uint_as_float(w & 0xffff0000u); }
__device__ __forceinline__ float fast_sigmoid(float x) { return __builtin_amdgcn_rcpf(1.0f + __expf(-x)); }
__device__ __forceinline__ float fast_silu(float x) { return x * fast_sigmoid(x); }
__device__ __forceinline__ float lg2_gamma(int h) {
    const float x = __builtin_amdgcn_exp2f((float)(-5 - h));
    const float s = x * (1.0f + x * (0.5f + x * (0.33333334f + x * (0.25f + x * 0.2f))));
    return -s * 1.4426950408889634f;
}

template <int MASK> __device__ __forceinline__ float swz_xor(float v) { return __builtin_bit_cast(float, __builtin_amdgcn_ds_swizzle(__builtin_bit_cast(int, v), (MASK << 10) | 0x1f)); }
__device__ __forceinline__ float swz_xor16(float v) { return swz_xor<16>(v); }
__device__ __forceinline__ void half_swap(unsigned& a, unsigned& b) { asm volatile("s_nop 1\n\tv_permlane32_swap_b32 %0, %1" : "+v"(a), "+v"(b)); }
__device__ __forceinline__ float half_sum(float v) { unsigned a = __builtin_bit_cast(unsigned, v), b = a; half_swap(a, b); return __builtin_bit_cast(float, a) + __builtin_bit_cast(float, b); }
__device__ __forceinline__ float half_max(float v) { unsigned a = __builtin_bit_cast(unsigned, v), b = a; half_swap(a, b); return fmaxf(__builtin_bit_cast(float, a), __builtin_bit_cast(float, b)); }

__host__ __device__ __forceinline__ size_t blk_idx(int row, int col, int nbc  ) { return ((size_t)(row >> 4) * nbc + (col >> 5)) * 512 + (size_t)((row & 15) * 32 + (col & 31)); }

struct EpiF32 {
    static constexpr bool PERM = false, AFTER_DRAIN = false;
    float* C; int ldc;
    __device__ __forceinline__ void operator()(f32x4 (&acc)[2][2][4][2], const Unit& u, int wr, int wc, int fr, int fq) const {
        const int row0 = u.pm * BM + wr * 64 + fr, col0 = u.pn * BM + wc * 32 + 4 * fq;
#pragma unroll
        for (int ai = 0; ai < 2; ++ai)
#pragma unroll
            for (int m = 0; m < 4; ++m) { float* rowp = C + (size_t)(row0 + ai * HALF + m * 16) * ldc + col0;
#pragma unroll
                for (int bj = 0; bj < 2; ++bj)
#pragma unroll
                    for (int n = 0; n < 2; ++n) *(f32x4*)(rowp + bj * HALF + n * 16) = acc[ai][bj][m][n]; }
    }
};

__host__ __device__ __forceinline__ size_t gm8_idx(int row, int bc) { return ((size_t)(row >> 4) * 96 + (bc >> 6)) * 1024 + (size_t)((row & 15) * 64 + (bc & 63)); }
__device__ __forceinline__ unsigned gate_q8x4(const f32x4& g) {
    const unsigned q0 = max((unsigned)(g[0] * 255.f + 0.5f), 1u), q1 = max((unsigned)(g[1] * 255.f + 0.5f), 1u), q2 = max((unsigned)(g[2] * 255.f + 0.5f), 1u), q3 = max((unsigned)(g[3] * 255.f + 0.5f), 1u);
    return q0 | (q1 << 8) | (q2 << 16) | (q3 << 24); }
__device__ __forceinline__ f32x4 gate_unq4(unsigned w) { return (f32x4){(float)(w & 0xffu), (float)((w >> 8) & 0xffu), (float)((w >> 16) & 0xffu), (float)(w >> 24)}; }
struct EpiProj {
    static constexpr bool PERM = true, AFTER_DRAIN = false;
    bf16_t* proj; bf16_t* gm; int mode;
    template <int KIND> __device__ __forceinline__ void run(f32x4 (&acc)[2][2][4][2], const Unit& u, int wr, int wc, int fr, int fq) const {
        const int row0 = u.pm * BM + wr * 64 + fr, colt = u.pn * BM, cl = wc * 32 + 8 * fq;
        constexpr double FRD[8] = {0.15915494309189535, 0.030863763158420102, 0.00598518567638293, 0.001160663620968869, 0.00022507907904105155, 4.3647954811733995e-05, 8.464331128654902e-06, 1.6414263867044143e-06};
#pragma unroll
        for (int ai = 0; ai < 2; ++ai)
#pragma unroll
            for (int m = 0; m < 4; ++m) {
                const int row = row0 + ai * HALF + m * 16, pos = row & 4095;
                float cs[8], sn[8];
                if constexpr (KIND == 2 || KIND == 3) {
                    int fqo = fq; asm volatile("" : "+v"(fqo));
#pragma unroll
                    for (int k = 0; k < 4; ++k) { const double fv = (double)__builtin_amdgcn_exp2f(-(float)(16 * wc + 4 * fqo + k) * (13.287712379549449f / 63.0f)) * 0.15915494309189535;
                        const double ph = (double)pos * fv; const float r = (float)(ph - __builtin_floor(ph)); cs[k] = __builtin_amdgcn_cosf(r); sn[k] = __builtin_amdgcn_sinf(r); }
                }
                if constexpr (KIND == 4 || KIND == 5) {
                    if ((wc & 1) == 0) {
#pragma unroll
                        for (int k = 0; k < 8; ++k) { const double ph = (double)pos * FRD[k]; const float r = (float)(ph - __builtin_floor(ph)); cs[k] = __builtin_amdgcn_cosf(r); sn[k] = __builtin_amdgcn_sinf(r); if (fq == 0) sn[k] = -sn[k]; }
                    }
                }
                u32x4 w8 = {0u, 0u, 0u, 0u};
#pragma unroll
                for (int bj = 0; bj < 2; ++bj) {
                    const int col = colt + bj * HALF + cl;
                    f32x4 v0 = acc[ai][bj][m][0], v1 = acc[ai][bj][m][1];
                    if constexpr (KIND == 0) {
#pragma unroll
                        for (int k = 0; k < 4; ++k) { v0[k] = fast_sigmoid(v0[k]); v1[k] = fast_sigmoid(v1[k]); }
                        if (bj == 0) { w8.x = gate_q8x4(v0); w8.y = gate_q8x4(v1); } else { w8.z = gate_q8x4(v0); w8.w = gate_q8x4(v1); }
                    } else if constexpr (KIND == 1) {
#pragma unroll
                        for (int k = 0; k < 4; ++k) { v0[k] = fast_silu(v0[k]); v1[k] = fast_silu(v1[k]); }
                    } else if constexpr (KIND == 2 || KIND == 3) {
                        float sc = 1.0f;
                        if constexpr (KIND == 3) { int hh = ((colt - 3072) >> 7) + bj; asm volatile("" : "+s"(hh));
                            sc = 0.08838834764831845f * __builtin_amdgcn_exp2f(lg2_gamma(hh) * (float)(127 - (pos & 127))); }
                        const f32x4 ca = {cs[0] * sc, cs[0] * sc, cs[1] * sc, cs[1] * sc}, sa = {sn[0] * sc, sn[0] * sc, sn[1] * sc, sn[1] * sc};
                        const f32x4 cb = {cs[2] * sc, cs[2] * sc, cs[3] * sc, cs[3] * sc}, sb = {sn[2] * sc, sn[2] * sc, sn[3] * sc, sn[3] * sc};
                        const f32x4 w0 = {-v0[1], v0[0], -v0[3], v0[2]}, w1 = {-v1[1], v1[0], -v1[3], v1[2]};
                        v0 = v0 * ca + w0 * sa; v1 = v1 * cb + w1 * sb;
                    } else if constexpr (KIND == 4 || KIND == 5) {
                        if ((wc & 1) == 0) {
                            f32x4 p0, p1;
#pragma unroll
                            for (int k = 0; k < 4; ++k) { p0[k] = swz_xor16(v0[k]); p1[k] = swz_xor16(v1[k]); }
                            if (fq < 2) {
#pragma unroll
                                for (int k = 0; k < 4; ++k) { v0[k] = v0[k] * cs[k] + p0[k] * sn[k]; v1[k] = v1[k] * cs[4 + k] + p1[k] * sn[4 + k]; }
                            }
                        }
                        if constexpr (KIND == 4) { v0 = v0 * 0.18033688011112042f; v1 = v1 * 0.18033688011112042f; }
                    }
                    if constexpr (KIND != 0) {
                        u32x4 w; w.x = cvt_pk_bf16(v0[0], v0[1]); w.y = cvt_pk_bf16(v0[2], v0[3]); w.z = cvt_pk_bf16(v1[0], v1[1]); w.w = cvt_pk_bf16(v1[2], v1[3]);
                        if constexpr (KIND == 7) *(u32x4*)(gm + blk_idx(row, col - 10240, 192)) = w;
                        else *(u32x4*)(proj + blk_idx(row, col, 320)) = w;
                    }
                }
                if constexpr (KIND == 0) *(u32x4*)((unsigned char*)gm + gm8_idx(row, colt - 10240 + 2 * cl)) = w8;
            }
    }
    __device__ __forceinline__ void operator()(f32x4 (&acc)[2][2][4][2], const Unit& u, int wr, int wc, int fr, int fq) const {
        const int seg = (u.pn * BM) >> 10;
        if (mode == 1) return;
        if (mode == 2) { if (seg >= 10) run<7>(acc, u, wr, wc, fr, fq); else run<6>(acc, u, wr, wc, fr, fq); return; }
        if (seg >= 10) run<0>(acc, u, wr, wc, fr, fq);
        else if (seg == 1 || seg == 5 || seg == 9) run<1>(acc, u, wr, wc, fr, fq);
        else if (seg == 2) run<2>(acc, u, wr, wc, fr, fq);
        else if (seg == 3) run<3>(acc, u, wr, wc, fr, fq);
        else if (seg == 6) run<4>(acc, u, wr, wc, fr, fq);
        else if (seg == 7) run<5>(acc, u, wr, wc, fr, fq);
        else run<6>(acc, u, wr, wc, fr, fq);
    }
};

struct EpiBf16Plain {
    static constexpr bool PERM = true, AFTER_DRAIN = false;
    bf16_t* O; int ldc;
    __device__ __forceinline__ void operator()(f32x4 (&acc)[2][2][4][2], const Unit& u, int wr, int wc, int fr, int fq) const {
        const int row0 = u.pm * BM + wr * 64 + fr, col0 = u.pn * BM + wc * 32 + 8 * fq;
#pragma unroll
        for (int ai = 0; ai < 2; ++ai)
#pragma unroll
            for (int m = 0; m < 4; ++m) { bf16_t* rowp = O + (size_t)(row0 + ai * HALF + m * 16) * ldc + col0;
#pragma unroll
                for (int bj = 0; bj < 2; ++bj) { const f32x4 v0 = acc[ai][bj][m][0], v1 = acc[ai][bj][m][1];
                    u32x4 w; w.x = cvt_pk_bf16(v0[0], v0[1]); w.y = cvt_pk_bf16(v0[2], v0[3]); w.z = cvt_pk_bf16(v1[0], v1[1]); w.w = cvt_pk_bf16(v1[2], v1[3]);
                    *(u32x4*)(rowp + bj * HALF) = w; } }
    }
};

struct EpiMerge {
    static constexpr bool PERM = true, AFTER_DRAIN = false;
    const unsigned char* gm; bf16_t* mo;
    __device__ __forceinline__ void load_batch(const int bt, const int row0, const int gbc, const int j, u32x4 (&gc)[2], u32x4 (&gn)[2]) const {
        const int ai = bt >> 1, mh = bt & 1;
#pragma unroll
        for (int mm = 0; mm < 2; ++mm) { const unsigned char* p = gm + gm8_idx(row0 + ai * HALF + (2 * mh + mm) * 16, gbc);
            gc[mm] = *(const u32x4*)p; if (j < 2) gn[mm] = *(const u32x4*)(p + (size_t)32 * 1024); else gn[mm] = gc[mm]; }
    }
    __device__ __forceinline__ void apply_batch(const int bt, f32x4 (&acc)[2][2][4][2], const int row0, const int col0, const int j, const u32x4 (&gc)[2], const u32x4 (&gn)[2]) const {
        const int ai = bt >> 1, mh = bt & 1;
#pragma unroll
        for (int mm = 0; mm < 2; ++mm)
#pragma unroll
            for (int bj = 0; bj < 2; ++bj) {
                const int m = 2 * mh + mm; const u32x4 c = gc[mm];
                f32x4 g0 = gate_unq4(bj == 0 ? c.x : c.z), g1 = gate_unq4(bj == 0 ? c.y : c.w);
                if (j < 2) {
                    const u32x4 n = gn[mm];
                    const f32x4 n0 = gate_unq4(bj == 0 ? n.x : n.z), n1 = gate_unq4(bj == 0 ? n.y : n.w);
#pragma unroll
                    for (int k = 0; k < 4; ++k) { g0[k] = g0[k] * __builtin_amdgcn_rcpf(n0[k]); g1[k] = g1[k] * __builtin_amdgcn_rcpf(n1[k]); }
                    acc[ai][bj][m][0] = acc[ai][bj][m][0] * g0; acc[ai][bj][m][1] = acc[ai][bj][m][1] * g1;
                } else {
                    const f32x4 v0 = acc[ai][bj][m][0] * (g0 * (1.0f / 255.0f)), v1 = acc[ai][bj][m][1] * (g1 * (1.0f / 255.0f));
                    u32x4 w; w.x = cvt_pk_bf16(v0[0], v0[1]); w.y = cvt_pk_bf16(v0[2], v0[3]); w.z = cvt_pk_bf16(v1[0], v1[1]); w.w = cvt_pk_bf16(v1[2], v1[3]);
                    *(u32x4*)(mo + (size_t)(row0 + ai * HALF + m * 16) * 2048 + col0 + bj * HALF) = w;
                }
            }
    }
    __device__ __forceinline__ void operator()(f32x4 (&acc)[2][2][4][2], const Unit& u, int wr, int wc, int fr, int fq) const {
        const int row0 = u.pm * BM + wr * 64 + fr, col0 = u.pn * BM + wc * 32 + 8 * fq, j = u.sel;
        const int gbc = j * 2048 + u.pn * 256 + 64 * wc + 16 * fq;
        u32x4 gcA[2], gnA[2], gcB[2], gnB[2], gcC[2], gnC[2], gcD[2], gnD[2];
        load_batch(0, row0, gbc, j, gcA, gnA);
        load_batch(1, row0, gbc, j, gcB, gnB);
        load_batch(2, row0, gbc, j, gcC, gnC);
        load_batch(3, row0, gbc, j, gcD, gnD);
        __builtin_amdgcn_sched_barrier(0);
        apply_batch(0, acc, row0, col0, j, gcA, gnA);
        __builtin_amdgcn_sched_barrier(0);
        apply_batch(1, acc, row0, col0, j, gcB, gnB);
        __builtin_amdgcn_sched_barrier(0);
        apply_batch(2, acc, row0, col0, j, gcC, gnC);
        __builtin_amdgcn_sched_barrier(0);
        apply_batch(3, acc, row0, col0, j, gcD, gnD);
    }
};

template <class Epi, class Sched, bool ALIGN_EPI = false, bool SP2 = false>
__device__ __forceinline__ void gemm_phase(PG8_LAS unsigned char* lds, const int K_, const Sched& S, const Epi& E, const int tid) {
    const int wid = __builtin_amdgcn_readfirstlane(tid >> 6), lane = tid & 63, wr = wid >> 2, wc = wid & 3, fr = lane & 15, fq = lane >> 4;
    const int K = K_, nt = K / BK;
    unsigned voffA[2], voffB[2];
#pragma unroll
    for (int i = 0; i < 2; ++i) { int R, C; stage_rc(tid * 16 + i * 8192, R, C); const int Rb = Epi::PERM ? ((R & ~31) + perm32(R & 31)) : R;
        voffA[i] = (unsigned)(R * K + C) * 2u; voffB[i] = (unsigned)(Rb * K + C) * 2u; }
    const size_t kstep = (size_t)(BK * 2);
    const size_t hstep = (size_t)HALF * K * 2;
    const size_t tstep = 2 * hstep;
    const unsigned ldsw = (unsigned)wid * 1024u;
    const int aoff = lds_byte(wr * 64 + fr, fq * 8), boff = lds_byte(wc * 32 + fr, fq * 8);
#define PG8_SA(b, h) (((b) * 2 + (h)) * HTB)
#define PG8_SB(b, h) ((4 + (b) * 2 + (h)) * HTB)
#define PG8_STAGE(bufoff, gbase, voff) do { _Pragma("unroll") for (int _i = 0; _i < 2; ++_i) \
        __builtin_amdgcn_global_load_lds((const unsigned*)((const char*)(gbase) + (voff)[_i]), (PG8_LAS unsigned*)(lds + (bufoff) + ldsw + _i * 8192), 16, 0, 0); } while (0)
#define PG8_LDA(dst, b, h) do { _Pragma("unroll") for (int m = 0; m < 4; ++m) _Pragma("unroll") for (int k = 0; k < 2; ++k) dst[m][k] = *(const PG8_LAS bf16x8*)(lds + PG8_SA(b, h) + aoff + m * 2048 + k * 1024); } while (0)
#define PG8_LDB(dst, b, h) do { _Pragma("unroll") for (int n = 0; n < 2; ++n) _Pragma("unroll") for (int k = 0; k < 2; ++k) dst[n][k] = *(const PG8_LAS bf16x8*)(lds + PG8_SB(b, h) + boff + n * 2048 + k * 1024); } while (0)
#define PG8_MMA(ai, bj, At, Bt) do { __builtin_amdgcn_s_setprio(1); _Pragma("unroll") for (int m = 0; m < 4; ++m) _Pragma("unroll") for (int n = 0; n < 2; ++n) _Pragma("unroll") for (int k = 0; k < 2; ++k) \
        acc[ai][bj][m][n] = __builtin_amdgcn_mfma_f32_16x16x32_bf16(Bt[n][k], At[m][k], acc[ai][bj][m][n], 0, 0, 0); __builtin_amdgcn_s_setprio(0); } while (0)
#define PG8_WAIT_V(n) asm volatile("s_waitcnt vmcnt(" #n ")" ::: "memory")
#define PG8_WAIT_L(n) asm volatile("s_waitcnt lgkmcnt(" #n ")" ::: "memory")
#define PG8_BAR __builtin_amdgcn_s_barrier()
#define PG8_SCHED __builtin_amdgcn_sched_barrier(0)
    Unit cur, nxt; int ui = 0;
    if (!S.next(0, cur)) return;
    f32x4 acc[2][2][4][2];
#pragma unroll
    for (int a = 0; a < 2; ++a)
#pragma unroll
        for (int b = 0; b < 2; ++b)
#pragma unroll
            for (int m = 0; m < 4; ++m)
#pragma unroll
                for (int n = 0; n < 2; ++n) acc[a][b][m][n] = (f32x4){0.f, 0.f, 0.f, 0.f};
    bf16x8 At[4][2], B0[2][2], B1[2][2];
    const char* cA = S.a_base(cur, tstep); const char* cB = S.b_base(cur, tstep);
    S.a_ready(cur);
    if constexpr (SP2) {
        PG8_STAGE(PG8_SB(0, 0), cB, voffB); PG8_STAGE(PG8_SB(0, 1), cB + hstep, voffB); PG8_STAGE(PG8_SA(0, 0), cA, voffA); PG8_STAGE(PG8_SA(0, 1), cA + hstep, voffA);
        if (wr == 1) PG8_BAR;
        PG8_WAIT_V(2); PG8_BAR;
        PG8_STAGE(PG8_SB(1, 0), cB + kstep, voffB); PG8_STAGE(PG8_SA(1, 0), cA + kstep, voffA); PG8_STAGE(PG8_SB(1, 1), cB + hstep + kstep, voffB);
        PG8_WAIT_V(6); PG8_BAR;
    } else {
        PG8_STAGE(PG8_SB(0, 0), cB, voffB); PG8_STAGE(PG8_SA(0, 0), cA, voffA); PG8_STAGE(PG8_SB(0, 1), cB + hstep, voffB); PG8_STAGE(PG8_SA(0, 1), cA + hstep, voffA);
        if (wr == 1) PG8_BAR;
        PG8_WAIT_V(4); PG8_BAR;
        PG8_STAGE(PG8_SB(1, 0), cB + kstep, voffB); PG8_STAGE(PG8_SA(1, 0), cA + kstep, voffA); PG8_STAGE(PG8_SB(1, 1), cB + hstep + kstep, voffB);
        PG8_WAIT_V(6); PG8_BAR;
    }
    for (;;) {
        const bool has_next = S.next(ui + 1, nxt);
        const char* nA = has_next ? S.a_base(nxt, tstep) : cA; const char* nB = has_next ? S.b_base(nxt, tstep) : cB;
        for (int t = 0; t < nt; t += 2) {
            const bool last = (t == nt - 2);
            const char* a1 = cA + (size_t)(t + 1) * kstep;
            const char* a2 = last ? nA : cA + (size_t)(t + 2) * kstep; const char* b2 = last ? nB : cB + (size_t)(t + 2) * kstep;
            const char* a3 = a2 + kstep; const char* b3 = b2 + kstep;
            if (last && has_next) S.a_ready(nxt);
            if constexpr (SP2) {
            PG8_LDB(B0, 0, 0); PG8_LDB(B1, 0, 1); PG8_SCHED; PG8_LDA(At, 0, 0); PG8_STAGE(PG8_SA(1, 1), a1 + hstep, voffA);
            PG8_WAIT_V(8); PG8_WAIT_L(0); PG8_BAR; PG8_MMA(0, 0, At, B0); PG8_MMA(0, 1, At, B1); PG8_BAR; PG8_SCHED;
            PG8_LDA(At, 0, 1); PG8_STAGE(PG8_SB(0, 0), b2, voffB); PG8_STAGE(PG8_SB(0, 1), b2 + hstep, voffB); PG8_STAGE(PG8_SA(0, 0), a2, voffA);
            PG8_WAIT_V(8); PG8_WAIT_L(0); PG8_BAR; PG8_MMA(1, 0, At, B0); PG8_MMA(1, 1, At, B1); PG8_BAR; PG8_SCHED;
            PG8_LDB(B0, 1, 0); PG8_LDB(B1, 1, 1); PG8_SCHED; PG8_LDA(At, 1, 0); PG8_STAGE(PG8_SA(0, 1), a2 + hstep, voffA);
            PG8_WAIT_V(8); PG8_WAIT_L(0); PG8_BAR; PG8_MMA(0, 0, At, B0); PG8_MMA(0, 1, At, B1); PG8_BAR; PG8_SCHED;
            PG8_LDA(At, 1, 1); PG8_STAGE(PG8_SB(1, 0), b3, voffB); PG8_STAGE(PG8_SB(1, 1), b3 + hstep, voffB); PG8_STAGE(PG8_SA(1, 0), a3, voffA);
            PG8_WAIT_V(8); PG8_WAIT_L(0); PG8_BAR; PG8_MMA(1, 0, At, B0); PG8_MMA(1, 1, At, B1); PG8_BAR; PG8_SCHED;
            } else {
            PG8_LDB(B0, 0, 0); PG8_SCHED; PG8_LDA(At, 0, 0); PG8_STAGE(PG8_SA(1, 1), a1 + hstep, voffA);
            PG8_WAIT_L(8); PG8_BAR; PG8_WAIT_L(0); PG8_MMA(0, 0, At, B0); PG8_BAR; PG8_SCHED;
            PG8_LDB(B1, 0, 1); PG8_STAGE(PG8_SB(0, 0), b2, voffB);
            PG8_BAR; PG8_WAIT_L(0); PG8_MMA(0, 1, At, B1); PG8_BAR;
            PG8_LDA(At, 0, 1); PG8_STAGE(PG8_SA(0, 0), a2, voffA);
            PG8_BAR; PG8_WAIT_L(0); PG8_MMA(1, 0, At, B0); PG8_BAR; PG8_SCHED;
            PG8_STAGE(PG8_SB(0, 1), b2 + hstep, voffB);
            PG8_WAIT_V(6); PG8_BAR; PG8_MMA(1, 1, At, B1); PG8_BAR;
            PG8_LDB(B0, 1, 0); PG8_SCHED; PG8_LDA(At, 1, 0); PG8_STAGE(PG8_SA(0, 1), a2 + hstep, voffA);
            PG8_WAIT_L(8); PG8_BAR; PG8_WAIT_L(0); PG8_MMA(0, 0, At, B0); PG8_BAR; PG8_SCHED;
            PG8_LDB(B1, 1, 1); PG8_STAGE(PG8_SB(1, 0), b3, voffB);
            PG8_BAR; PG8_WAIT_L(0); PG8_MMA(0, 1, At, B1); PG8_BAR;
            PG8_LDA(At, 1, 1); PG8_STAGE(PG8_SA(1, 0), a3, voffA);
            PG8_BAR; PG8_WAIT_L(0); PG8_MMA(1, 0, At, B0); PG8_BAR; PG8_SCHED;
            PG8_STAGE(PG8_SB(1, 1), b3 + hstep, voffB);
            PG8_WAIT_V(6); PG8_BAR; PG8_MMA(1, 1, At, B1); PG8_BAR;
            }
        }
        if constexpr (ALIGN_EPI) { if (wr == 0) PG8_BAR; }
        if constexpr (!Epi::AFTER_DRAIN) { E(acc, cur, wr, wc, fr, fq); S.done(cur); }
        if (!has_next) break;
        if (!S.keep(cur)) {
#pragma unroll
        for (int a = 0; a < 2; ++a)
#pragma unroll
            for (int b = 0; b < 2; ++b)
#pragma unroll
                for (int m = 0; m < 4; ++m)
#pragma unroll
                    for (int n = 0; n < 2; ++n) acc[a][b][m][n] = (f32x4){0.f, 0.f, 0.f, 0.f};
        }
        cur = nxt; cA = nA; cB = nB; ++ui;
        if constexpr (ALIGN_EPI) { if (wr == 1) PG8_BAR; }
    }
    PG8_WAIT_V(0);
    if constexpr (!ALIGN_EPI) { if (wr == 0) PG8_BAR; }
    PG8_BAR;
    if constexpr (Epi::AFTER_DRAIN) { E.fused(acc, cur, wr, wc, fr, fq, lds, wid, lane); S.done(cur); }
#undef PG8_SA
#undef PG8_SB
#undef PG8_STAGE
#undef PG8_LDA
#undef PG8_LDB
#undef PG8_MMA
#undef PG8_WAIT_V
#undef PG8_WAIT_L
#undef PG8_BAR
#undef PG8_SCHED
}
}
#define GAS __attribute__((address_space(1)))
#define LAS __attribute__((address_space(3)))
typedef unsigned short bf16;
typedef unsigned v4u __attribute__((ext_vector_type(4)));
typedef float f32x4 __attribute__((ext_vector_type(4)));
typedef short bf16x8 __attribute__((ext_vector_type(8)));
typedef GAS unsigned gu32;
typedef GAS unsigned long long gu64;
#define RLX_AGENT __ATOMIC_RELAXED, __HIP_MEMORY_SCOPE_AGENT
#define LDS_WAIT() asm volatile("s_waitcnt lgkmcnt(0)" ::: "memory")
#define VM_WAIT() asm volatile("s_waitcnt vmcnt(0)" ::: "memory")
__device__ __forceinline__ unsigned long long rt() { return __builtin_amdgcn_s_memrealtime(); }
__device__ __forceinline__ unsigned f2bf(float f) { unsigned u = __builtin_bit_cast(unsigned, f); return (u + 0x7fffu + ((u >> 16) & 1u)) >> 16; }
__device__ __forceinline__ unsigned pk2(float lo, float hi) { return f2bf(lo) | (f2bf(hi) << 16); }

#define XB_TMO      128
#define XB_XCNT(j)  (256  + 64 * (j))
#define XB_XSUB(j)  (1280 + 64 * (j))
#define XB_XGEN(j)  (2304 + 64 * (j))
#define XB_TOP      3328
#define XB_TOPGEN   3392
#define XCD_BAR_WORDS 3456
#define XB_SPIN_CAP (1u << 18)

__device__ __forceinline__ unsigned xb_ld(unsigned* p)              { return __hip_atomic_load(p, __ATOMIC_RELAXED, __HIP_MEMORY_SCOPE_AGENT); }
__device__ __forceinline__ unsigned xb_add(unsigned* p, unsigned v) { return __hip_atomic_fetch_add(p, v, __ATOMIC_RELAXED, __HIP_MEMORY_SCOPE_AGENT); }
__device__ __forceinline__ unsigned xb_xcc_id() { return (unsigned)__builtin_amdgcn_s_getreg((3 << 11) | 20) & 0xFu; }
#define XB_SPIN(cond, bar) do { unsigned _sp = 0; while (cond) { __builtin_amdgcn_s_sleep(1); \
    if ((++_sp & 255u) == 0u) { if (xb_ld(&(bar)[XB_TMO])) break; if (_sp > XB_SPIN_CAP) { atomicAdd(&(bar)[XB_TMO], 1u); break; } } } } while (0)

__device__ __forceinline__ unsigned xb_lane() { unsigned m = ~0u; asm volatile("" : "+s"(m)); return __builtin_amdgcn_mbcnt_hi(m, __builtin_amdgcn_mbcnt_lo(m, 0u)); }
struct XcdBarrier {
    unsigned wv;
    unsigned* bar; unsigned x;
    volatile LAS unsigned* st;
};

__device__ __forceinline__ XcdBarrier xcd_barrier_post(unsigned* bar, volatile LAS unsigned* st, unsigned wv) {
    XcdBarrier b; b.wv = wv; b.bar = bar; b.x = xb_xcc_id(); b.st = st;
    if (wv == 0u && xb_lane() == 0u) (void)xb_add(&bar[XB_XCNT(b.x)], 1u);
    return b;
}
__device__ __forceinline__ void xcd_barrier_complete(unsigned* bar, unsigned x, unsigned& nloc, unsigned& nx) {
    const unsigned G = gridDim.x * gridDim.y * gridDim.z;
    unsigned sum, cnt, mine, sp = 0u;
    for (;;) {
        sum = 0u; cnt = 0u; mine = 0u;
#pragma unroll
        for (unsigned j = 0; j < 16; ++j) { const unsigned c = xb_ld(&bar[XB_XCNT(j)]); sum += c; cnt += (c > 0u) ? 1u : 0u; mine = (j == x) ? c : mine; }
        if (sum == G) break;
        __builtin_amdgcn_s_sleep(1);
        if ((++sp & 255u) == 0u) { if (xb_ld(&bar[XB_TMO])) break; if (sp > XB_SPIN_CAP) { atomicAdd(&bar[XB_TMO], 1u); break; } }
    }
    nloc = mine > 0u ? mine : 1u; nx = cnt > 0u ? cnt : 1u;
}

__device__ __forceinline__ void xcd_barrier(const XcdBarrier& b) {
    asm volatile("s_waitcnt vmcnt(0)" ::: "memory");
    __syncthreads();
    if (b.wv == 0u && xb_lane() == 0u) {
        unsigned* bar = b.bar;
        __builtin_amdgcn_s_waitcnt(0);
        unsigned nloc = b.st[0], nx = b.st[1];
        if (nloc == 0u) { xcd_barrier_complete(bar, b.x, nloc, nx); b.st[0] = nloc; b.st[1] = nx; }
        const unsigned old = xb_add(&bar[XB_XSUB(b.x)], 1u);
        const unsigned gen = old / nloc;
        if (old + 1u == (gen + 1u) * nloc) {
            __builtin_amdgcn_fence(__ATOMIC_RELEASE, "agent");
            asm volatile("s_waitcnt vmcnt(0)" ::: "memory");
            const unsigned og = xb_add(&bar[XB_TOP], 1u);
            const unsigned tg = og / nx;
            if (og + 1u == (tg + 1u) * nx) xb_add(&bar[XB_TOPGEN], 1u);
            else XB_SPIN(xb_ld(&bar[XB_TOPGEN]) == tg, bar);
            __builtin_amdgcn_fence(__ATOMIC_ACQUIRE, "agent");
            xb_add(&bar[XB_XGEN(b.x)], 1u);
            asm volatile("s_waitcnt vmcnt(0)" ::: "memory");
        } else {
            XB_SPIN(xb_ld(&bar[XB_XGEN(b.x)]) == gen, bar);
            __builtin_amdgcn_fence(__ATOMIC_ACQUIRE, "agent");
            asm volatile("s_waitcnt vmcnt(0)" ::: "memory");
        }
    }
    __syncthreads();
}

constexpr int D_MODEL = 2048, SEQ = 4096, BATCH = 8, DEPTH = 2, M_ALL = BATCH * SEQ, D_IN = 16384;
constexpr int BG = 4, TG = BG * SEQ, NGROUP = BATCH / BG;
constexpr int PNBC = 320, PBROW = PNBC * 512;
__device__ __forceinline__ size_t pidx(int row, int col) { return pg8::blk_idx(row, col, PNBC); }
constexpr int C_XA = 0, C_GA = 1024, C_QR = 2048, C_KR = 3072, C_VR = 4096, C_GR = 5120, C_QD = 6144, C_KD = 7168, C_VD = 8192, C_GD = 9216;
constexpr float EPS = 1e-6f;
constexpr int NWAVES = 8;
constexpr size_t MiB = 1u << 20;
constexpr size_t WS_CTL = 0, CTL_ZERO_BYTES = 1 * MiB;
constexpr size_t WS_COSR = 1 * MiB, WS_SINR = 2 * MiB, WS_COSD = 3 * MiB, WS_SIND = 3 * MiB + 128 * 1024, WS_LAMS = 3 * MiB + 512 * 1024;
constexpr size_t WS_WIN = 4 * MiB;
constexpr size_t WS_WBR = 132 * MiB;
constexpr size_t WS_WOUT = 156 * MiB;
constexpr size_t WS_H = 172 * MiB;
constexpr size_t WS_Y = 300 * MiB;
constexpr size_t WS_GM = 396 * MiB;
constexpr size_t WS_PROJ = 588 * MiB;
constexpr size_t WS_O = 588 * MiB;
constexpr size_t WS_M = 716 * MiB;
constexpr size_t WS_X1 = 908 * MiB;
constexpr size_t WS_END = 972 * MiB;
static_assert(WS_M + (size_t)TG * 2048 * 2 <= WS_END && WS_O + (size_t)TG * 2048 * 4 <= WS_M && WS_PROJ + (size_t)TG * 10240 * 2 == WS_X1 && WS_X1 + (size_t)TG * 2048 * 2 == WS_END, "d_ws map");
constexpr int CW_TMO = 0;
constexpr int CW_BAR = 4096;
constexpr int CW_Q = 65536;
constexpr int RING_BYTES = 131072, LDSCTL_OFF = RING_BYTES, MISC_OFF = LDSCTL_OFF + 320, LDS_BYTES = 147456;

#define LAUNDER_V(x) asm volatile("" : "+v"(x))
#define LAUNDER_S(x) asm volatile("" : "+s"(x))
typedef float f32x16 __attribute__((ext_vector_type(16)));
typedef short s16x4 __attribute__((ext_vector_type(4)));
typedef short v4i16_t __attribute__((ext_vector_type(4)));
typedef unsigned u32x2 __attribute__((ext_vector_type(2)));
typedef LAS unsigned char* ldsp;
using pg8::blk_idx; using pg8::cvt_pk_bf16; using pg8::bf_lo; using pg8::bf_hi; using pg8::fast_sigmoid; using pg8::lg2_gamma;

using pg8::swz_xor; using pg8::half_sum; using pg8::half_max;
__device__ __forceinline__ float wave_sum(float v) {
    v += swz_xor<1>(v); v += swz_xor<2>(v); v += swz_xor<4>(v); v += swz_xor<8>(v); v += swz_xor<16>(v);
    return half_sum(v);
}
__device__ __forceinline__ unsigned offb(unsigned row, unsigned ch) { return 256u * row + 16u * (ch ^ (((row & 3u) << 2) | ((row >> 2) & 3u))); }
__device__ __forceinline__ unsigned tr_nat(int lane, int k0, int t, int c) { const int h = lane >> 5, blk = (lane >> 4) & 1, q = (lane & 15) >> 2, p = lane & 3; return offb(k0 + 8 * h + 4 * t + q, 4 * c + 2 * blk + (p >> 1)) + 8 * (p & 1); }
__device__ __forceinline__ unsigned tr_perm(int lane, int k0, int t, int c) { const int h = lane >> 5, blk = (lane >> 4) & 1, q = (lane & 15) >> 2, p = lane & 3; return offb(k0 + 8 * t + 4 * h + q, 4 * c + 2 * blk + (p >> 1)) + 8 * (p & 1); }
__device__ __forceinline__ f32x16 mfma32(bf16x8 a, bf16x8 b, f32x16 c) { return __builtin_amdgcn_mfma_f32_32x32x16_bf16(a, b, c, 0, 0, 0); }
__device__ __forceinline__ s16x4 trr(ldsp p) { return __builtin_bit_cast(s16x4, __builtin_amdgcn_ds_read_tr16_b64_v4i16((LAS v4i16_t*)p)); }
__device__ __forceinline__ bf16x8 cat8(s16x4 lo, s16x4 hi) { return (bf16x8){lo[0], lo[1], lo[2], lo[3], hi[0], hi[1], hi[2], hi[3]}; }
template <int B> __device__ __forceinline__ bf16x8 pack8(const f32x16& x) {
    v4u w = {cvt_pk_bf16(x[B], x[B + 1]), cvt_pk_bf16(x[B + 2], x[B + 3]), cvt_pk_bf16(x[B + 4], x[B + 5]), cvt_pk_bf16(x[B + 6], x[B + 7])};
    return __builtin_bit_cast(bf16x8, w);
}
__device__ __forceinline__ f32x16 zero16() { f32x16 z;
#pragma unroll
    for (int i = 0; i < 16; ++i) z[i] = 0.f; return z; }

__device__ __forceinline__ void p0_transpose_item(const float* W, int K, int N, bf16* WT, LAS float* scr, int item, int lane) {
    const int nkb = K / 64, grp = item / (nkb * 64), rem = item - grp * (nkb * 64), kb = rem >> 6, nb = 64 * grp + (rem & 63), k0 = 64 * kb, n0 = 32 * nb;
    { const int cg = lane & 7, rs = lane >> 3;
      f32x4 v[8];
#pragma unroll
      for (int i = 0; i < 8; ++i) v[i] = *(const f32x4*)(W + (size_t)(k0 + 8 * i + rs) * N + n0 + 4 * cg);
#pragma unroll
      for (int i = 0; i < 8; ++i) { LAS float* d = scr + (8 * i + rs) * 33 + 4 * cg; d[0] = v[i].x; d[1] = v[i].y; d[2] = v[i].z; d[3] = v[i].w; } }
    LDS_WAIT(); asm volatile("" ::: "memory");
    const int c = lane & 7;
#pragma unroll
    for (int j = 0; j < 4; ++j) { const int n = (lane >> 3) + 8 * j; const LAS float* s = scr + (8 * c) * 33 + n;
        v4u o; o.x = pk2(s[0 * 33], s[1 * 33]); o.y = pk2(s[2 * 33], s[3 * 33]); o.z = pk2(s[4 * 33], s[5 * 33]); o.w = pk2(s[6 * 33], s[7 * 33]);
        *(GAS v4u*)(WT + (size_t)(n0 + n) * K + k0 + 8 * c) = o; }
    LDS_WAIT(); asm volatile("" ::: "memory");
}
__device__ __forceinline__ void rms_row_to_bf16(const float* xrow, const f32x4 (&gv)[8], bf16* orow, int lane) {
    const float* xr = xrow + 8 * lane;
    f32x4 v[8]; float s = 0.f;
#pragma unroll
    for (int j = 0; j < 4; ++j) { v[2 * j] = *(const f32x4*)(xr + 512 * j); v[2 * j + 1] = *(const f32x4*)(xr + 512 * j + 4); }
#pragma unroll
    for (int j = 0; j < 8; ++j) s += (v[j].x * v[j].x + v[j].y * v[j].y) + (v[j].z * v[j].z + v[j].w * v[j].w);
    const float rs = rsqrtf(wave_sum(s) * (1.f / D_MODEL) + EPS);
    v4u* o16 = (v4u*)orow + lane;
#pragma unroll
    for (int j = 0; j < 4; ++j) { const f32x4 ga = gv[2 * j], gb = gv[2 * j + 1]; const f32x4 a = v[2 * j] * rs * ga, bq = v[2 * j + 1] * rs * gb;
        v4u w; w.x = cvt_pk_bf16(a.x, a.y); w.y = cvt_pk_bf16(a.z, a.w); w.z = cvt_pk_bf16(bq.x, bq.y); w.w = cvt_pk_bf16(bq.z, bq.w); o16[64 * j] = w; }
}

__device__ __forceinline__ void ret_unit(const int tid, ldsp lds, int b, int h, const bf16* proj, bf16* yb) {
    const int lane = tid & 63, w = __builtin_amdgcn_readfirstlane(tid >> 6), r32 = lane & 31, hi = lane >> 5;
    const int it = w >> 1, eh = w & 1;
    constexpr int O_ST = 0, O_KD = 32768, O_VV = 65536, O_Q = 98304;
    LAS float* STAT = (LAS float*)(lds + RING_BYTES + 1024);
    { unsigned z0 = 0u; LAUNDER_V(z0); for (int i = tid; i < 2048; i += 512) ((LAS v4u*)(lds + O_ST))[i] = (v4u){z0, z0, z0, z0}; }
    ldsp rb[8];
#pragma unroll
    for (int s = 0; s < 8; ++s) rb[s] = lds + offb(r32, 2 * s + hi);
    ldsp tnk0 = lds + O_KD + tr_perm(lane, 0, 0, it), tnk1 = lds + O_KD + tr_perm(lane, 0, 1, it);
    ldsp tpv00 = lds + O_VV + tr_perm(lane, 0, 0, 2 * eh), tpv01 = lds + O_VV + tr_perm(lane, 0, 1, 2 * eh), tpv10 = lds + O_VV + tr_perm(lane, 0, 0, 2 * eh + 1), tpv11 = lds + O_VV + tr_perm(lane, 0, 1, 2 * eh + 1);
    const int row00 = b * SEQ, hcol = h * 128;
    bf16* Yp = yb + (size_t)b * SEQ * 1024 + h * 128;
    const float lg = lg2_gamma(h), cd = __builtin_amdgcn_exp2f(128.f * lg), cout = __builtin_amdgcn_exp2f(lg * (float)(32 * it + r32 - 127));
    f32x16 Dacc0 = zero16(), Dacc1 = zero16();
#define RET_DMA(src_, n_, lane_, off_) do { _Pragma("unroll") for (int k_ = 0; k_ < 4; ++k_) { const int row_ = 16 * w + 4 * k_ + ((lane_) >> 4); \
        const int ch_ = ((lane_) & 15) ^ (((row_ & 3) << 2) | ((row_ >> 2) & 3)); \
        __builtin_amdgcn_global_load_lds((const unsigned*)(proj + pidx(row00 + (n_) * 128 + row_, (src_) + hcol + 8 * ch_)), (LAS unsigned*)(lds + (off_) + 4096 * w + 1024 * k_), 16, 0, 0); } } while (0)
#define RET_BAR() do { asm volatile("s_waitcnt lgkmcnt(0)" ::: "memory"); __builtin_amdgcn_s_barrier(); asm volatile("" ::: "memory"); } while (0)
    RET_DMA(C_KR, 0, lane, O_KD); RET_DMA(C_VR, 0, lane, O_VV); RET_DMA(C_QR, 0, lane, O_Q);
    for (int n = 0; n < 32; ++n) {
        int tid_c = tid; LAUNDER_V(tid_c);
        const int lane_c = tid_c & 63, r32c = lane_c & 31, hic = lane_c >> 5;
        const int rowi = n * 128 + 32 * it + r32c;
        const int nn = n + 1 < 32 ? n + 1 : 31;
        asm volatile("s_waitcnt vmcnt(0) lgkmcnt(0)" ::: "memory"); __builtin_amdgcn_s_barrier(); asm volatile("" ::: "memory");
        bf16x8 qf[8];
        { ldsp qb_ = lds + O_Q + 8192 * it;
#pragma unroll
          for (int s = 0; s < 8; ++s) qf[s] = *(const LAS bf16x8*)(qb_ + (unsigned)(rb[s] - lds)); }
#pragma unroll
        for (int ks = 0; ks < 8; ++ks) {
            const bf16x8 a = cat8(trr(tnk0 + 4096 * ks), trr(tnk1 + 4096 * ks));
            Dacc0 = mfma32(a, cat8(trr(tpv00 + 4096 * ks), trr(tpv01 + 4096 * ks)), Dacc0);
            Dacc1 = mfma32(a, cat8(trr(tpv10 + 4096 * ks), trr(tpv11 + 4096 * ks)), Dacc1);
            if (ks & 1) __builtin_amdgcn_sched_barrier(0);
        }
        f32x16 acc0 = zero16(), acc1 = zero16();
#pragma unroll
        for (int jt = 0; jt < 4; ++jt) if (jt <= it) {
            f32x16 X = zero16();
#pragma unroll
            for (int s = 0; s < 8; ++s) X = mfma32(*(const LAS bf16x8*)(rb[s] + O_KD + 8192 * jt), qf[s], X);
            __builtin_amdgcn_sched_barrier(0);
            if (jt == it) {
#pragma unroll
                for (int r = 0; r < 16; ++r) { const int j = (r & 3) + 8 * (r >> 2) + 4 * hic; if (j > r32c) X[r] = 0.f; }
            }
            const bf16x8 pf0 = pack8<0>(X), pf1 = pack8<8>(X);
            acc0 = mfma32(cat8(trr(tpv00 + 8192 * jt), trr(tpv01 + 8192 * jt)), pf0, acc0);
            acc1 = mfma32(cat8(trr(tpv10 + 8192 * jt), trr(tpv11 + 8192 * jt)), pf0, acc1);
            acc0 = mfma32(cat8(trr(tpv00 + 8192 * jt + 4096), trr(tpv01 + 8192 * jt + 4096)), pf1, acc0);
            acc1 = mfma32(cat8(trr(tpv10 + 8192 * jt + 4096), trr(tpv11 + 8192 * jt + 4096)), pf1, acc1);
            __builtin_amdgcn_sched_barrier(0);
        }
        RET_BAR();
        RET_DMA(C_KR, nn, lane_c, O_KD); RET_DMA(C_VR, nn, lane_c, O_VV); RET_DMA(C_QR, nn, lane_c, O_Q);
        u32x2 gg[8];
        { const bf16* grow = proj + pidx(row00 + rowi, C_GR + hcol + 64 * eh + 4 * hic);
#pragma unroll
          for (int e2 = 0; e2 < 2; ++e2)
#pragma unroll
              for (int q4 = 0; q4 < 4; ++q4) gg[4 * e2 + q4] = *(const u32x2*)(grow + 512 * e2 + 8 * q4); }
        {
            ldsp st0 = lds + 16384 * eh;
#pragma unroll
            for (int s = 0; s < 8; ++s) {
                const unsigned o_ = (unsigned)(rb[s] - lds);
                acc0 = mfma32(*(const LAS bf16x8*)(st0 + o_ + O_ST), qf[s], acc0);
                acc1 = mfma32(*(const LAS bf16x8*)(st0 + o_ + O_ST + 8192), qf[s], acc1);
                if ((s & 3) == 3) __builtin_amdgcn_sched_barrier(0);
            }
        }
        float s1 = 0.f, s2 = 0.f;
#pragma unroll
        for (int r = 0; r < 16; ++r) { s1 += acc0[r] + acc1[r]; s2 += acc0[r] * acc0[r] + acc1[r] * acc1[r]; }
        s1 = half_sum(s1); s2 = half_sum(s2);
        if (hic == 0) { STAT[(32 * it + r32c) * 4 + eh * 2] = s1; STAT[(32 * it + r32c) * 4 + eh * 2 + 1] = s2; }
        RET_BAR();
        {
            const LAS float* st = STAT + (32 * it + r32c) * 4;
            const float mean = (st[0] + st[2]) * (1.f / 128.f); float var = (st[1] + st[3]) * (1.f / 128.f) - mean * mean; var = fmaxf(var, 0.f);
            const float rs = cout * rsqrtf(cout * cout * var + EPS);
            bf16* yrow = Yp + (size_t)rowi * 1024 + 64 * eh + 4 * hic;
#pragma unroll
            for (int e2 = 0; e2 < 2; ++e2)
#pragma unroll
                for (int q4 = 0; q4 < 4; ++q4) {
                    const f32x16& A = e2 ? acc1 : acc0; const u32x2 g = gg[4 * e2 + q4];
                    u32x2 o; o.x = cvt_pk_bf16((A[4 * q4] - mean) * rs * bf_lo(g.x), (A[4 * q4 + 1] - mean) * rs * bf_hi(g.x));
                    o.y = cvt_pk_bf16((A[4 * q4 + 2] - mean) * rs * bf_lo(g.y), (A[4 * q4 + 3] - mean) * rs * bf_hi(g.y));
                    *(u32x2*)(yrow + 32 * e2 + 8 * q4) = o;
                }
        }
#pragma unroll
        for (int r = 0; r < 16; ++r) { Dacc0[r] *= cd; Dacc1[r] *= cd; }
        {
            ldsp sw0 = lds + O_ST + 16384 * eh + 256 * r32c + 8 * hic; const unsigned swr = ((r32c & 3) << 2) | ((r32c >> 2) & 3);
#pragma unroll
            for (int q4 = 0; q4 < 4; ++q4) {
                u32x2 o0, o1; o0.x = cvt_pk_bf16(Dacc0[4 * q4], Dacc0[4 * q4 + 1]); o0.y = cvt_pk_bf16(Dacc0[4 * q4 + 2], Dacc0[4 * q4 + 3]);
                o1.x = cvt_pk_bf16(Dacc1[4 * q4], Dacc1[4 * q4 + 1]); o1.y = cvt_pk_bf16(Dacc1[4 * q4 + 2], Dacc1[4 * q4 + 3]);
                const unsigned co = 16u * ((unsigned)(4 * it + q4) ^ swr);
                *(LAS u32x2*)(sw0 + co) = o0; *(LAS u32x2*)(sw0 + co + 8192) = o1;
            }
        }
    }
    asm volatile("s_waitcnt vmcnt(0)" ::: "memory");
#undef RET_DMA
#undef RET_BAR
}

__device__ __forceinline__ void lru_unit(const int tid, ldsp lds, int b, int nb, const bf16* proj, bf16* ya, const float* convw, const float* convb,
                                         const float* wa, const float* ba, const float* wx, const float* bx, const float* lam) {
    const int lane = tid & 63, w = __builtin_amdgcn_readfirstlane(tid >> 6), r32 = lane & 31, hi = lane >> 5;
    const int c0 = nb * 64;
    LAS bf16* XA = (LAS bf16*)lds; ldsp XC = lds + 17408; LAS float* XF = (LAS float*)(lds + 35840); LAS float* AF = (LAS float*)(lds + 68608);
    ldsp WT = lds + 101376; LAS float* SEG = (LAS float*)(lds + 119808); LAS float* PAR = (LAS float*)(lds + 123904);
    if (tid < 64) { const int c = c0 + tid;
        PAR[tid] = convw[c]; PAR[64 + tid] = convw[1024 + c]; PAR[128 + tid] = convw[2048 + c]; PAR[192 + tid] = convw[3072 + c];
        PAR[256 + tid] = convb[c]; PAR[320 + tid] = ba[c]; PAR[384 + tid] = bx[c];
        const float z = __expf(-lam[c]); PAR[448 + tid] = log1pf(z); }
    for (int idx = tid; idx < 4096; idx += 512) { const int d = idx >> 6, e = idx & 63;
        ((LAS bf16*)WT)[e * 72 + d] = (bf16)f2bf(wa[nb * 4096 + idx]); ((LAS bf16*)(WT + 9216))[e * 72 + d] = (bf16)f2bf(wx[nb * 4096 + idx]); }
    const int row00 = b * SEQ;
    bf16* yp = ya + (size_t)b * SEQ * 1024 + c0;
    const int e = tid & 63;
    float hcarry = 0.f;
    v4u xs[2][3];
#define LRU_ISSUE(S_, t0_) do { { const int r = tid >> 3, ch = tid & 7, t = (t0_) - 3 + r; { unsigned z0 = 0u; LAUNDER_V(z0); xs[S_][0] = (v4u){z0, z0, z0, z0}; } if (t >= 0) xs[S_][0] = *(const v4u*)(proj + pidx(row00 + t, C_XA + c0 + ch * 8)); } \
        { const int r = (tid + 512) >> 3, ch = tid & 7, t = (t0_) - 3 + r; xs[S_][1] = *(const v4u*)(proj + pidx(row00 + t, C_XA + c0 + ch * 8)); } \
        if (tid < 24) { const int r = (tid + 1024) >> 3, ch = tid & 7, t = (t0_) - 3 + r; xs[S_][2] = *(const v4u*)(proj + pidx(row00 + t, C_XA + c0 + ch * 8)); } } while (0)
    LRU_ISSUE(0, 0); LRU_ISSUE(1, 128);
    for (int n2 = 0; n2 < 32; n2 += 2)
#pragma unroll
      for (int sx = 0; sx < 2; ++sx) {
        const int n = n2 + sx;
        const int t0 = n * 128;
        __syncthreads();
        *(LAS v4u*)((ldsp)XA + tid * 16) = xs[sx][0]; *(LAS v4u*)((ldsp)XA + (tid + 512) * 16) = xs[sx][1]; if (tid < 24) *(LAS v4u*)((ldsp)XA + (tid + 1024) * 16) = xs[sx][2];
        if (n + 2 < 32) LRU_ISSUE(sx, t0 + 256);
        __syncthreads();
        { const int c = tid & 63; const float w0 = PAR[c], w1 = PAR[64 + c], w2 = PAR[128 + c], w3 = PAR[192 + c], cb = PAR[256 + c];
          const int tb = 16 * (tid >> 6);
          float x0 = __uint_as_float((unsigned)XA[tb * 64 + c] << 16), x1 = __uint_as_float((unsigned)XA[(tb + 1) * 64 + c] << 16), x2 = __uint_as_float((unsigned)XA[(tb + 2) * 64 + c] << 16);
#pragma unroll
          for (int k = 0; k < 16; ++k) { const int t = tb + k;
              const float x3 = __uint_as_float((unsigned)XA[(t + 3) * 64 + c] << 16);
              const float xc = cb + w0 * x0 + w1 * x1 + w2 * x2 + w3 * x3;
              XF[t * 64 + c] = xc; ((LAS bf16*)XC)[t * 72 + c] = (bf16)f2bf(xc);
              x0 = x1; x1 = x2; x2 = x3; } }
        __syncthreads();
        bf16 gt[16];
#pragma unroll
        for (int k = 0; k < 16; ++k) gt[k] = proj[pidx(row00 + t0 + 16 * w + k, C_GA + c0 + e)];
        { const int tt = w >> 1, et = w & 1;
          f32x16 gr = zero16(), gi = zero16();
#pragma unroll
          for (int s = 0; s < 4; ++s) {
              const bf16x8 a = *(const LAS bf16x8*)(XC + (32 * tt + r32) * 144 + (16 * s + 8 * hi) * 2);
              const bf16x8 br = *(const LAS bf16x8*)(WT + (32 * et + r32) * 144 + (16 * s + 8 * hi) * 2);
              const bf16x8 bi = *(const LAS bf16x8*)(WT + 9216 + (32 * et + r32) * 144 + (16 * s + 8 * hi) * 2);
              gr = mfma32(a, br, gr); gi = mfma32(a, bi, gi); }
          const int ee = 32 * et + r32; const float bar_ = PAR[320 + ee], bxr = PAR[384 + ee], sp = PAR[448 + ee];
#pragma unroll
          for (int r = 0; r < 16; ++r) { const int t = 32 * tt + (r & 3) + 8 * (r >> 2) + 4 * hi;
              const float xc = XF[t * 64 + ee];
              const float rg = fast_sigmoid(gr[r] + bar_), ig = fast_sigmoid(gi[r] + bxr);
              const float la = -8.0f * rg * sp, a = __expf(la), x2 = 2.0f * la;
              const float em_series = -x2 * (1.0f + x2 * (0.5f + x2 * (0.16666667f + x2 * (0.041666668f + x2 * (0.008333334f + x2 * 0.0013888889f)))));
              const float em = x2 < -0.25f ? 1.0f - a * a : em_series;
              AF[t * 64 + ee] = a; XF[t * 64 + ee] = __builtin_amdgcn_sqrtf(em) * ig * xc; } }
        __syncthreads();
        { float A = 1.f, H = 0.f;
#pragma unroll
          for (int k = 0; k < 16; ++k) { const int t = 16 * w + k; const float a = AF[t * 64 + e], u = XF[t * 64 + e]; H = a * H + u; A *= a; }
          SEG[(w * 64 + e) * 2] = A; SEG[(w * 64 + e) * 2 + 1] = H; }
        __syncthreads();
        float hs = hcarry, hst = 0.f;
#pragma unroll
        for (int s = 0; s < 8; ++s) { const float A = SEG[(s * 64 + e) * 2], H = SEG[(s * 64 + e) * 2 + 1]; if (s == w) hst = hs; hs = A * hs + H; }
        hcarry = hs;
        float hh = hst;
#pragma unroll
        for (int k = 0; k < 16; ++k) { const int t = 16 * w + k; hh = AF[t * 64 + e] * hh + XF[t * 64 + e];
            yp[(size_t)(t0 + t) * 1024 + e] = (bf16)f2bf(hh * __uint_as_float((unsigned)gt[k] << 16)); }
    }
#undef LRU_ISSUE
}

typedef float f32x2 __attribute__((ext_vector_type(2)));
struct AttS { f32x16 O0, O1, O2, O3, p0, p1; bf16x8 pf0, pf1, pf2, pf3; bf16x8 k0, k1, k2, k3, k4, k5, k6, k7; float mref, l, alpha; int rp; };
#define ATT_THR 8.0f
constexpr int ATT_V0 = 0, ATT_K0 = 49152, ATT_SLOT = 16384;
#define ATT_PIN(X_) asm volatile("" : "+v"(X_))
#define ATT_SB() __builtin_amdgcn_sched_barrier(0)
__device__ __forceinline__ float attn_rowmax(const f32x16& a, const f32x16& b) {
    float d = fmaxf(a[0], b[0]);
#pragma unroll
    for (int r = 1; r < 16; ++r) d = fmaxf(d, fmaxf(a[r], b[r]));
    return half_max(d);
}
__device__ __forceinline__ int attn_rowmax_bits(const f32x16& a, const f32x16& b) {
    int d = max(__float_as_int(a[0]), __float_as_int(b[0]));
#pragma unroll
    for (int r = 1; r < 16; ++r) d = max(d, max(__float_as_int(a[r]), __float_as_int(b[r])));
    unsigned x = (unsigned)d, y = x; pg8::half_swap(x, y);
    return max((int)x, (int)y);
}
template <int B> __device__ __forceinline__ f32x2 attn_sum8(const f32x16& a, f32x2 s) {
#pragma unroll
    for (int r = B; r < B + 8; r += 2) s += (f32x2){a[r], a[r + 1]};
    return s;
}
#define ATT_EXP4(P_, B_) do { _Pragma("unroll") for (int r_ = 0; r_ < 4; ++r_) P_[(B_) + r_] = __builtin_amdgcn_exp2f(P_[(B_) + r_]); } while (0)
#define ATT_SUB4(P_, B_) do { _Pragma("unroll") for (int r_ = 0; r_ < 4; ++r_) P_[(B_) + r_] -= st.mref; } while (0)
#define ATT_VF(TV_, KS, ET) cat8(trr((TV_) + 4096 * (ET) + 1024 * (KS)), trr((TV_) + 4096 * (ET) + 1024 * (KS) + 512))
#define ATT_KF(RK_, O_) (*(const LAS bf16x8*)((RK_) + (O_)))
#define ATT_MASK(Q0_, Q1_, t_) do { const int kb_ = 64 * (t_); \
        if (kb_ + 63 > qw) { const int dq_ = qw + r32 - kb_ - 4 * hi; const float NEG_ = -__builtin_inff(); \
            _Pragma("unroll") for (int r_ = 0; r_ < 16; ++r_) { const int cr_ = (r_ & 3) + 8 * (r_ >> 2); if (cr_ > dq_) Q0_[r_] = NEG_; if (cr_ + 32 > dq_) Q1_[r_] = NEG_; } } } while (0)
#define ATT_OSCALE() do { if (st.rp) { _Pragma("unroll") for (int r_ = 0; r_ < 16; ++r_) { st.O0[r_] *= st.alpha; st.O1[r_] *= st.alpha; st.O2[r_] *= st.alpha; st.O3[r_] *= st.alpha; } } } while (0)
#define ATT_EXP1(Q0_, Q1_, I_) do { if ((I_) < 16) Q0_[(I_) & 15] = __builtin_amdgcn_exp2f(Q0_[(I_) & 15]); else Q1_[(I_) & 15] = __builtin_amdgcn_exp2f(Q1_[(I_) & 15]); } while (0)
#define ATT_EXP3(Q0_, Q1_, I_) do { ATT_EXP1(Q0_, Q1_, (I_)); ATT_EXP1(Q0_, Q1_, (I_) + 1); ATT_EXP1(Q0_, Q1_, (I_) + 2); } while (0)
__device__ __forceinline__ f32x16 attn_splat(const float v) { f32x16 z;
#pragma unroll
    for (int i = 0; i < 16; ++i) z[i] = v; return z; }
__device__ __forceinline__ void attn_step(AttS& st, const int t, const int qw, const int r32, const int hi, const bf16x8 (&qf)[4], ldsp tv, ldsp rn0, ldsp rn1, ldsp rn2, ldsp rn3) {
    ATT_OSCALE();
    const f32x16 negm = attn_splat(-st.mref);
    f32x16 q0 = mfma32(st.k0, qf[0], negm); bf16x8 va0 = ATT_VF(tv, 0, 0);
    f32x16 q1 = mfma32(st.k1, qf[0], negm); bf16x8 va1 = ATT_VF(tv, 0, 1);
    ATT_SB();
    q0 = mfma32(st.k2, qf[1], q0); bf16x8 va2 = ATT_VF(tv, 0, 2);
    q1 = mfma32(st.k3, qf[1], q1); bf16x8 va3 = ATT_VF(tv, 0, 3);
    ATT_SB();
    q0 = mfma32(st.k4, qf[2], q0); bf16x8 vb0 = ATT_VF(tv, 1, 0);
    q1 = mfma32(st.k5, qf[2], q1); bf16x8 vb1 = ATT_VF(tv, 1, 1);
    st.pf2 = pack8<0>(st.p1); ATT_PIN(st.pf2);
    ATT_SB();
    q0 = mfma32(st.k6, qf[3], q0); bf16x8 vb2 = ATT_VF(tv, 1, 2);
    q1 = mfma32(st.k7, qf[3], q1); bf16x8 vb3 = ATT_VF(tv, 1, 3);
    st.pf3 = pack8<8>(st.p1); ATT_PIN(st.pf3);
    ATT_SB();
    ATT_MASK(q0, q1, t);
    st.O0 = mfma32(va0, st.pf0, st.O0); va0 = ATT_VF(tv, 2, 0); ATT_EXP3(q0, q1, 0);
    ATT_SB();
    st.O1 = mfma32(va1, st.pf0, st.O1); va1 = ATT_VF(tv, 2, 1); ATT_EXP3(q0, q1, 3);
    ATT_SB();
    st.O2 = mfma32(va2, st.pf0, st.O2); va2 = ATT_VF(tv, 2, 2); ATT_EXP3(q0, q1, 6);
    ATT_SB();
    st.O3 = mfma32(va3, st.pf0, st.O3); va3 = ATT_VF(tv, 2, 3); ATT_EXP3(q0, q1, 9);
    ATT_SB();
    st.O0 = mfma32(vb0, st.pf1, st.O0); vb0 = ATT_VF(tv, 3, 0); ATT_EXP3(q0, q1, 12);
    ATT_SB();
    st.O1 = mfma32(vb1, st.pf1, st.O1); vb1 = ATT_VF(tv, 3, 1); ATT_EXP3(q0, q1, 15);
    ATT_PIN(q0);
    ATT_SB();
    st.O2 = mfma32(vb2, st.pf1, st.O2); vb2 = ATT_VF(tv, 3, 2); ATT_EXP3(q0, q1, 18);
    ATT_SB();
    st.O3 = mfma32(vb3, st.pf1, st.O3); vb3 = ATT_VF(tv, 3, 3); ATT_EXP3(q0, q1, 21);
    ATT_SB();
    st.O0 = mfma32(va0, st.pf2, st.O0); ATT_EXP3(q0, q1, 24); ATT_EXP1(q0, q1, 27);
    ATT_SB();
    st.O1 = mfma32(va1, st.pf2, st.O1); ATT_EXP3(q0, q1, 28); ATT_EXP1(q0, q1, 31);
    ATT_PIN(q1);
    ATT_SB();
    st.O2 = mfma32(va2, st.pf2, st.O2);
    f32x2 ps = attn_sum8<0>(q0, (f32x2){0.f, 0.f}); ps = attn_sum8<8>(q0, ps); ATT_PIN(ps);
    ATT_SB();
    st.O3 = mfma32(va3, st.pf2, st.O3);
    ps = attn_sum8<0>(q1, ps); ps = attn_sum8<8>(q1, ps);
    float psum = ps.x + ps.y; ATT_PIN(psum);
    ATT_SB();
    const bool resc = __any(psum > 256.0f);
    st.rp = resc; st.alpha = 1.f;
    if (resc) {
        const f32x16 nm2 = attn_splat(-st.mref);
        q0 = mfma32(st.k0, qf[0], nm2); q1 = mfma32(st.k1, qf[0], nm2);
        q0 = mfma32(st.k2, qf[1], q0); q1 = mfma32(st.k3, qf[1], q1);
        q0 = mfma32(st.k4, qf[2], q0); q1 = mfma32(st.k5, qf[2], q1);
        q0 = mfma32(st.k6, qf[3], q0); q1 = mfma32(st.k7, qf[3], q1);
        ATT_MASK(q0, q1, t);
        const float d = attn_rowmax(q0, q1);
        const float dl = fmaxf(d, 0.f); st.mref += dl; st.alpha = __builtin_amdgcn_exp2f(-dl); st.l *= st.alpha;
#pragma unroll
        for (int r = 0; r < 16; ++r) { q0[r] = __builtin_amdgcn_exp2f(q0[r] - dl); q1[r] = __builtin_amdgcn_exp2f(q1[r] - dl); }
        f32x2 p2 = attn_sum8<0>(q0, (f32x2){0.f, 0.f}); p2 = attn_sum8<8>(q0, p2); p2 = attn_sum8<0>(q1, p2); p2 = attn_sum8<8>(q1, p2); psum = p2.x + p2.y;
    }
    st.l += psum;
    st.O0 = mfma32(vb0, st.pf3, st.O0); st.k0 = ATT_KF(rn0, 0); st.k1 = ATT_KF(rn0, 8192);
    ATT_PIN(st.l);
    ATT_SB();
    st.O1 = mfma32(vb1, st.pf3, st.O1); st.k2 = ATT_KF(rn1, 0); st.k3 = ATT_KF(rn1, 8192);
    ATT_SB();
    st.O2 = mfma32(vb2, st.pf3, st.O2); st.k4 = ATT_KF(rn2, 0); st.k5 = ATT_KF(rn2, 8192);
    st.pf0 = pack8<0>(q0); ATT_PIN(st.pf0);
    ATT_SB();
    st.O3 = mfma32(vb3, st.pf3, st.O3); st.k6 = ATT_KF(rn3, 0); st.k7 = ATT_KF(rn3, 8192);
    st.pf1 = pack8<8>(q0); ATT_PIN(st.pf1);
    ATT_SB();
    st.p1 = q1;
}
__device__ __forceinline__ void attn_unit(const int tid, ldsp lds, int b, int h, int qb, const bf16* proj, bf16* yc, const float* lamp, const float* subg) {
    const int lane = tid & 63, w = __builtin_amdgcn_readfirstlane(tid >> 6), r32 = lane & 31, hi = lane >> 5;
    const int c = w >> 2, it = w & 3;
    const int qw = qb * 128 + 32 * it, NT = 2 * qb + 2;
    const int row00 = b * SEQ, hcol = h * 128;
    bf16x8 qf[4];
#pragma unroll
    for (int s = 0; s < 4; ++s) qf[s] = *(const bf16x8*)(proj + pidx(row00 + qw + r32, C_QD + hcol + 64 * c + 16 * s + 8 * hi));
    ldsp rk0 = lds + ATT_K0 + offb(r32, 8 * c + 0 + hi), rk1 = lds + ATT_K0 + offb(r32, 8 * c + 2 + hi), rk2 = lds + ATT_K0 + offb(r32, 8 * c + 4 + hi), rk3 = lds + ATT_K0 + offb(r32, 8 * c + 6 + hi);
    ldsp tvb = lds + ATT_V0 + (4 * hi + ((lane & 15) >> 2)) * 64 + 32 * ((lane >> 4) & 1) + 8 * (lane & 3);
    const int kr0 = 8 * w + (lane >> 4), kc0 = (lane & 15) ^ (((kr0 & 3) << 2) | ((kr0 >> 2) & 3)), kr1 = kr0 + 4, kc1 = (lane & 15) ^ (((kr1 & 3) << 2) | ((kr1 >> 2) & 3));
    const unsigned oK0 = 2u * (unsigned)pidx(kr0, C_KD + hcol + 8 * kc0), oK1 = 2u * (unsigned)pidx(kr1, C_KD + hcol + 8 * kc1);
    const unsigned oV0 = 2u * (unsigned)pidx(32 * (w & 1) + (lane >> 2), C_VD + hcol + 32 * (w >> 1) + 8 * (lane & 3));
    const unsigned char* gb = (const unsigned char*)(proj + (size_t)(row00 >> 4) * PBROW);
    const int dK = 2048 * w, dV = 4096 * (w >> 1) + 2048 * (w & 1);
    const unsigned ldsb = (unsigned)__builtin_amdgcn_readfirstlane((int)(unsigned)(unsigned long long)lds);
#define ATT_GLDS(g_, d_) do { unsigned keep_; asm volatile("s_mov_b32 %0, m0\n\ts_mov_b32 m0, %2\n\ts_nop 0\n\tglobal_load_lds_dwordx4 %1, off\n\ts_mov_b32 m0, %0" : "=&s"(keep_) : "v"(g_), "s"(d_) : "memory"); } while (0)
#define ATT_DMA_K(tk_, so_) do { const unsigned char* p_ = gb + (size_t)(4 * (tk_)) * (2 * PBROW); const unsigned d_ = ldsb + ATT_K0 + (so_) + dK; \
        ATT_GLDS(p_ + oK0, d_); ATT_GLDS(p_ + oK1, d_ + 1024u); } while (0)
#define ATT_DMA_V(tv_, so_) do { const unsigned char* p_ = gb + (size_t)(4 * (tv_)) * (2 * PBROW); const unsigned d_ = ldsb + ATT_V0 + (so_) + dV; \
        ATT_GLDS(p_ + oV0, d_); ATT_GLDS(p_ + oV0 + 2 * PBROW, d_ + 1024u); } while (0)
#define ATT_WAITBAR() do { asm volatile("s_waitcnt vmcnt(4) lgkmcnt(0)" ::: "memory"); __builtin_amdgcn_s_barrier(); asm volatile("" ::: "memory"); } while (0)
    const int TL = NT - 1;
    ATT_DMA_K(0, 0);
    ATT_DMA_K(1, ATT_SLOT);
    { const int t2 = 2 < TL ? 2 : TL; ATT_DMA_K(t2, 2 * ATT_SLOT); }
    ATT_DMA_V(0, 0);
    AttS st; st.O0 = zero16(); st.O1 = zero16(); st.O2 = zero16(); st.O3 = zero16();
    st.mref = 0.f; st.l = 0.f; st.alpha = 1.f; st.rp = 0;
    asm volatile("s_waitcnt vmcnt(6)" ::: "memory"); __builtin_amdgcn_s_barrier(); asm volatile("" ::: "memory");
    st.k0 = ATT_KF(rk0, 0); st.k1 = ATT_KF(rk0, 8192); st.k2 = ATT_KF(rk1, 0); st.k3 = ATT_KF(rk1, 8192);
    st.k4 = ATT_KF(rk2, 0); st.k5 = ATT_KF(rk2, 8192); st.k6 = ATT_KF(rk3, 0); st.k7 = ATT_KF(rk3, 8192);
    ATT_WAITBAR();
    { const int t3 = 3 < TL ? 3 : TL, t1 = 1 < TL ? 1 : TL; ATT_DMA_K(t3, 0); ATT_DMA_V(t1, ATT_SLOT); }
    st.p0 = mfma32(st.k0, qf[0], zero16()); st.p1 = mfma32(st.k1, qf[0], zero16());
    st.p0 = mfma32(st.k2, qf[1], st.p0); st.p1 = mfma32(st.k3, qf[1], st.p1);
    st.p0 = mfma32(st.k4, qf[2], st.p0); st.p1 = mfma32(st.k5, qf[2], st.p1);
    st.p0 = mfma32(st.k6, qf[3], st.p0); st.p1 = mfma32(st.k7, qf[3], st.p1);
    ATT_SB();
    st.k0 = ATT_KF(rk0, ATT_SLOT); st.k1 = ATT_KF(rk0, ATT_SLOT + 8192); st.k2 = ATT_KF(rk1, ATT_SLOT); st.k3 = ATT_KF(rk1, ATT_SLOT + 8192);
    st.k4 = ATT_KF(rk2, ATT_SLOT); st.k5 = ATT_KF(rk2, ATT_SLOT + 8192); st.k6 = ATT_KF(rk3, ATT_SLOT); st.k7 = ATT_KF(rk3, ATT_SLOT + 8192);
    ATT_MASK(st.p0, st.p1, 0);
    st.mref = attn_rowmax(st.p0, st.p1);
#pragma unroll
    for (int r = 0; r < 16; ++r) { st.p0[r] = __builtin_amdgcn_exp2f(st.p0[r] - st.mref); st.p1[r] = __builtin_amdgcn_exp2f(st.p1[r] - st.mref); }
    { f32x2 ps = attn_sum8<0>(st.p0, (f32x2){0.f, 0.f}); ps = attn_sum8<8>(st.p0, ps); ps = attn_sum8<0>(st.p1, ps); ps = attn_sum8<8>(st.p1, ps); st.l += ps.x + ps.y; }
    st.pf0 = pack8<0>(st.p0); st.pf1 = pack8<8>(st.p0);
    ATT_PIN(st.pf0); ATT_PIN(st.pf1); ATT_PIN(st.p1);
    int sa = ATT_SLOT, sb = 2 * ATT_SLOT, sc = 0;
    for (int t = 1; t <= TL; ++t) {
        ATT_WAITBAR();
        { const int tk = t + 3 < TL ? t + 3 : TL, tv = t + 1 < TL ? t + 1 : TL; ATT_DMA_K(tk, sa); ATT_DMA_V(tv, sb); }
        attn_step(st, t, qw, r32, hi, qf, tvb + sc, rk0 + sb, rk1 + sb, rk2 + sb, rk3 + sb);
        const int s0 = sa; sa = sb; sb = sc; sc = s0;
    }
    ATT_WAITBAR();
    ATT_OSCALE();
    st.pf2 = pack8<0>(st.p1); st.pf3 = pack8<8>(st.p1);
    { ldsp tv = tvb + sc;
      { const bf16x8 v0 = ATT_VF(tv, 0, 0), v1 = ATT_VF(tv, 0, 1), v2 = ATT_VF(tv, 0, 2), v3 = ATT_VF(tv, 0, 3);
        st.O0 = mfma32(v0, st.pf0, st.O0); st.O1 = mfma32(v1, st.pf0, st.O1); st.O2 = mfma32(v2, st.pf0, st.O2); st.O3 = mfma32(v3, st.pf0, st.O3); }
      { const bf16x8 v0 = ATT_VF(tv, 1, 0), v1 = ATT_VF(tv, 1, 1), v2 = ATT_VF(tv, 1, 2), v3 = ATT_VF(tv, 1, 3);
        st.O0 = mfma32(v0, st.pf1, st.O0); st.O1 = mfma32(v1, st.pf1, st.O1); st.O2 = mfma32(v2, st.pf1, st.O2); st.O3 = mfma32(v3, st.pf1, st.O3); }
      { const bf16x8 v0 = ATT_VF(tv, 2, 0), v1 = ATT_VF(tv, 2, 1), v2 = ATT_VF(tv, 2, 2), v3 = ATT_VF(tv, 2, 3);
        st.O0 = mfma32(v0, st.pf2, st.O0); st.O1 = mfma32(v1, st.pf2, st.O1); st.O2 = mfma32(v2, st.pf2, st.O2); st.O3 = mfma32(v3, st.pf2, st.O3); }
      { const bf16x8 v0 = ATT_VF(tv, 3, 0), v1 = ATT_VF(tv, 3, 1), v2 = ATT_VF(tv, 3, 2), v3 = ATT_VF(tv, 3, 3);
        st.O0 = mfma32(v0, st.pf3, st.O0); st.O1 = mfma32(v1, st.pf3, st.O1); st.O2 = mfma32(v2, st.pf3, st.O2); st.O3 = mfma32(v3, st.pf3, st.O3); } }
#undef ATT_GLDS
#undef ATT_DMA_K
#undef ATT_DMA_V
#undef ATT_WAITBAR
    const float l = half_sum(st.l);
    const float inv = 1.0f / l;
    int tid_e = tid; LAUNDER_V(tid_e);
    const int lane_e = tid_e & 63, r32e = lane_e & 31, hie = lane_e >> 5;
    u32x2 gpre[16]; f32x4 spre[16];
    if (c == 0) { const bf16* grow = proj + pidx(row00 + qw + r32e, C_GD + hcol + 4 * hie); const float* sgp = subg + 4 * hie;
#pragma unroll
        for (int et = 0; et < 4; ++et)
#pragma unroll
            for (int q4 = 0; q4 < 4; ++q4) { gpre[4 * et + q4] = *(const u32x2*)(grow + 512 * et + 8 * q4); spre[4 * et + q4] = *(const f32x4*)(sgp + 32 * et + 8 * q4); }
        asm volatile("s_waitcnt vmcnt(32) lgkmcnt(0)" ::: "memory"); }
    else asm volatile("s_waitcnt vmcnt(0) lgkmcnt(0)" ::: "memory");
    __builtin_amdgcn_s_barrier(); asm volatile("" ::: "memory");
#define ATT_BAR() do { asm volatile("s_waitcnt lgkmcnt(0)" ::: "memory"); __builtin_amdgcn_s_barrier(); asm volatile("" ::: "memory"); } while (0)
    LAS float* XB = (LAS float*)lds + it * 4096 + lane_e;
    const float lam = lamp[0], oml = lamp[1];
    if (c == 1) { const float f = lam * inv;
#pragma unroll
        for (int r = 0; r < 16; ++r) { XB[(0 * 16 + r) * 64] = st.O0[r] * f; XB[(1 * 16 + r) * 64] = st.O1[r] * f; XB[(2 * 16 + r) * 64] = st.O2[r] * f; XB[(3 * 16 + r) * 64] = st.O3[r] * f; } }
    ATT_BAR();
    if (c == 0) {
        float ss = 0.f;
#pragma unroll
        for (int r = 0; r < 16; ++r) {
            st.O0[r] = st.O0[r] * inv - XB[(0 * 16 + r) * 64]; st.O1[r] = st.O1[r] * inv - XB[(1 * 16 + r) * 64];
            st.O2[r] = st.O2[r] * inv - XB[(2 * 16 + r) * 64]; st.O3[r] = st.O3[r] * inv - XB[(3 * 16 + r) * 64];
            ss += st.O0[r] * st.O0[r] + st.O1[r] * st.O1[r] + st.O2[r] * st.O2[r] + st.O3[r] * st.O3[r]; }
        ss = half_sum(ss);
        const float rs = rsqrtf(ss * (1.f / 128.f) + EPS) * oml;
        const size_t rowl = (size_t)(qw + r32e);
        bf16* yrow = yc + ((size_t)b * SEQ + rowl) * 1024 + h * 128 + 4 * hie;
#pragma unroll
        for (int et = 0; et < 4; ++et)
#pragma unroll
            for (int q4 = 0; q4 < 4; ++q4) {
                const f32x16& A = et == 0 ? st.O0 : et == 1 ? st.O1 : et == 2 ? st.O2 : st.O3;
                const int e0 = 32 * et + 8 * q4;
                const f32x4 sg4 = spre[4 * et + q4]; const u32x2 g = gpre[4 * et + q4];
                u32x2 o; o.x = cvt_pk_bf16(A[4 * q4] * rs * sg4.x * bf_lo(g.x), A[4 * q4 + 1] * rs * sg4.y * bf_hi(g.x));
                o.y = cvt_pk_bf16(A[4 * q4 + 2] * rs * sg4.z * bf_lo(g.y), A[4 * q4 + 3] * rs * sg4.w * bf_hi(g.y));
                *(u32x2*)(yrow + e0) = o;
            }
    }
#undef ATT_BAR
#undef ATT_PIN
#undef ATT_SB
#undef ATT_EXP4
#undef ATT_SUB4
#undef ATT_EXP1
#undef ATT_EXP3
#undef ATT_VF
#undef ATT_KF
#undef ATT_MASK
#undef ATT_OSCALE
}

__device__ __forceinline__ int fetch_item(const int tid, gu32* ctr, volatile LAS unsigned* slot) {
    __syncthreads();
    if (tid == 0) *slot = __hip_atomic_fetch_add(ctr, 1u, RLX_AGENT);
    __syncthreads();
    return __builtin_amdgcn_readfirstlane((int)*slot);
}

#ifndef G1_ALIGN
#define G1_ALIGN true
#endif
#ifndef G1_SP2
#define G1_SP2 true
#endif
#ifndef G3_ALIGN
#define G3_ALIGN true
#endif
#ifndef G3_SP2
#define G3_SP2 true
#endif
#ifndef G4_ALIGN
#define G4_ALIGN true
#endif
#ifndef G4_SP2
#define G4_SP2 true
#endif
#ifndef PROBE_DUP
#define PROBE_DUP 0
#endif
#ifndef PROBE_EMODE
#define PROBE_EMODE 0
#endif
#ifndef PROBE_AMODE
#define PROBE_AMODE 0
#endif
#ifndef PROBE_P2SEL
#define PROBE_P2SEL 0
#endif
#ifndef MK_N_LAUNCHES
#define MK_N_LAUNCHES 1
#endif
constexpr int N_PHASES = 1 + NGROUP * DEPTH * 5;
struct Args { const float* in[17]; float* out; unsigned char* ws; int ph_lo, ph_hi, li, pad; };
__global__ void __launch_bounds__(NWAVES * 64, 2) hyb_fwd(Args args) {
    extern __shared__ __attribute__((aligned(16))) unsigned char lds_raw[];
    ldsp lds = (ldsp)lds_raw;
    volatile LAS unsigned* MISC = (volatile LAS unsigned*)(lds + MISC_OFF);
    for (int u = threadIdx.x; u < (LDS_BYTES - LDSCTL_OFF) / 4; u += NWAVES * 64) ((LAS unsigned*)(lds + LDSCTL_OFF))[u] = 0u;
    __syncthreads();
    XcdBarrier bar = xcd_barrier_post((unsigned*)((gu32*)(args.ws + WS_CTL) + CW_BAR) + args.li * XCD_BAR_WORDS, MISC + 8, (unsigned)__builtin_amdgcn_readfirstlane((int)threadIdx.x >> 6));
    int tidc = threadIdx.x;
    const int lo = args.ph_lo, hi_ = args.ph_hi;
#define IN(k) (lo <= (k) && (k) < hi_)
#define BOTH(k) (IN(k) && IN((k) + 1))
#define PHASE_ENTRY() LAUNDER_V(tidc); const int tid = tidc; unsigned long long z_ = 0ull; LAUNDER_S(z_); unsigned char* ws = args.ws + z_; const int G = gridDim.x; \
    const int lane = tid & 63, wave = __builtin_amdgcn_readfirstlane(tid >> 6); (void)lane; (void)wave; (void)G

    if (IN(0)) {
        PHASE_ENTRY();
        const int gw = blockIdx.x * NWAVES + wave, NGW = G * NWAVES;
        float* lams = (float*)(ws + WS_LAMS);
        bf16* WIN = (bf16*)(ws + WS_WIN); bf16* WBR = (bf16*)(ws + WS_WBR); bf16* WOUT = (bf16*)(ws + WS_WOUT); bf16* HB = (bf16*)(ws + WS_H);
        LAS float* scr = (LAS float*)(lds + wave * 16384);
        constexpr int I_IN = (2048 / 64) * (16384 / 32), I_BR = (1024 / 64) * (2048 / 32), I_OUT = (2048 / 64) * (2048 / 32);
        constexpr int NITEMS = 2 * I_IN + 6 * I_BR + 2 * I_OUT;
        for (int it = gw; it < NITEMS; it += NGW) {
            int r = it;
            if (r < 2 * I_IN) { const int l = r / I_IN; r -= l * I_IN; p0_transpose_item(args.in[3] + (size_t)l * 2048 * 16384, 2048, 16384, WIN + (size_t)l * 16384 * 2048, scr, r, lane); continue; }
            r -= 2 * I_IN;
            if (r < 6 * I_BR) { const int lj = r / I_BR; r -= lj * I_BR; const int l = lj / 3, j = lj - 3 * l;
                const float* src = j == 0 ? args.in[13] : j == 1 ? args.in[14] : args.in[15];
                p0_transpose_item(src + (size_t)l * 1024 * 2048, 1024, 2048, WBR + (size_t)lj * 2048 * 1024, scr, r, lane); continue; }
            r -= 6 * I_BR;
            { const int l = r / I_OUT; r -= l * I_OUT; p0_transpose_item(args.in[16] + (size_t)l * 2048 * 2048, 2048, 2048, WOUT + (size_t)l * 2048 * 2048, scr, r, lane); }
        }
        if (blockIdx.x == 0 && wave == 0) {
            for (int l = 0; l < DEPTH; ++l) { const float* dl = args.in[11] + l * 256;
                const float s01 = wave_sum(dl[lane] * dl[64 + lane]), s23 = wave_sum(dl[128 + lane] * dl[192 + lane]);
                const float lam_init = 0.8f - 0.6f * __expf(-0.3f * (float)l);
                if (lane == 0) { lams[2 * l] = __expf(s01) - __expf(s23) + lam_init; lams[2 * l + 1] = 1.0f - lam_init; } }
        }
        { f32x4 gv[8];
#pragma unroll
          for (int j = 0; j < 4; ++j) { gv[2 * j] = *(const f32x4*)(args.in[1] + 512 * j + 8 * lane); gv[2 * j + 1] = *(const f32x4*)(args.in[1] + 512 * j + 8 * lane + 4); }
          for (int m = gw; m < M_ALL; m += NGW) rms_row_to_bf16(args.in[0] + (size_t)m * D_MODEL, gv, HB + (size_t)m * D_MODEL, lane); }
        if (BOTH(0)) xcd_barrier(bar);
    }

    for (int g = 0; g < NGROUP; ++g)
        for (int l = 0; l < DEPTH; ++l) {
            const int pb = 1 + (g * DEPTH + l) * 5;
            if (IN(pb)) {
                PHASE_ENTRY();
                pg8::SchedPlain S; S.so.init(TG, D_IN, G, (int)blockIdx.x); S.A = (const char*)(ws + WS_H) + (size_t)g * TG * D_MODEL * 2; S.Bt = (const char*)(ws + WS_WIN) + (size_t)l * D_IN * D_MODEL * 2;
                pg8::EpiProj E{(bf16*)(ws + WS_PROJ), (bf16*)(ws + WS_GM), (PROBE_DUP == 1 && args.li > 0 && pb == lo) ? PROBE_EMODE : 0};
#ifndef SKIP_P1
                pg8::gemm_phase<pg8::EpiProj, pg8::SchedPlain, G1_ALIGN, G1_SP2>(lds, D_MODEL, S, E, tid);
#endif
                if (BOTH(pb)) xcd_barrier(bar);
            }
            if (IN(pb + 1)) {
                const bool only = PROBE_DUP == 2 && PROBE_P2SEL != 0 && args.li > 0 && (pb + 1) == lo;
#ifndef SKIP_RET
                if (!only || PROBE_P2SEL == 1) { PHASE_ENTRY(); gu32* q = (gu32*)(ws + WS_CTL) + CW_Q + 64 * 3 * (g * DEPTH + l) + args.li * 1024;
                  const bf16* PROJ = (const bf16*)(ws + WS_PROJ); bf16* YB = (bf16*)(ws + WS_Y);
                  for (;;) { LAUNDER_V(tidc); const int t2 = tidc; const int it = fetch_item(t2, q, MISC + 16); if (it >= BG * 8) break; ret_unit(t2, lds, it >> 3, it & 7, PROJ, YB + (size_t)TG * 1024); } }
#endif
#ifndef SKIP_LRU
                if (!only || PROBE_P2SEL == 2) { PHASE_ENTRY(); gu32* q = (gu32*)(ws + WS_CTL) + CW_Q + 64 * 3 * (g * DEPTH + l) + args.li * 1024;
                  const bf16* PROJ = (const bf16*)(ws + WS_PROJ); bf16* YB = (bf16*)(ws + WS_Y);
                  for (;;) { LAUNDER_V(tidc); const int t2 = tidc; const int it = fetch_item(t2, q + 64, MISC + 16); if (it >= BG * 16) break;
                    lru_unit(t2, lds, it >> 4, it & 15, PROJ, YB, args.in[4] + l * 4096, args.in[5] + l * 1024, args.in[6] + (size_t)l * 65536, args.in[7] + l * 1024,
                             args.in[8] + (size_t)l * 65536, args.in[9] + l * 1024, args.in[10] + l * 1024); } }
#endif
#ifndef SKIP_ATT
                if (!only || PROBE_P2SEL == 3) { PHASE_ENTRY(); gu32* q = (gu32*)(ws + WS_CTL) + CW_Q + 64 * 3 * (g * DEPTH + l) + args.li * 1024;
                  const bf16* PROJ = (const bf16*)(ws + WS_PROJ); bf16* YB = (bf16*)(ws + WS_Y); const float* lams = (const float*)(ws + WS_LAMS);
                  int it; { LAUNDER_V(tidc); const int t2 = tidc; it = fetch_item(t2, q + 128, MISC + 16); }
                  while (it < BG * 8 * 32) { LAUNDER_V(tidc); const int t2 = tidc; const int qb = 31 - (it >> 5), bh = it & 31;
                    unsigned pend = 0u; if (t2 == 0) pend = __hip_atomic_fetch_add(q + 128, 1u, RLX_AGENT);
                    attn_unit(t2, lds, bh >> 3, bh & 7, qb, PROJ, YB + (size_t)2 * TG * 1024, lams + 2 * l, args.in[12] + l * 128);
                    LAUNDER_V(tidc); const int t3 = tidc; volatile LAS unsigned* slot = MISC + 16;
                    __syncthreads(); if (t3 == 0) *slot = pend; __syncthreads(); it = __builtin_amdgcn_readfirstlane((int)*slot); } }
#endif
                if (BOTH(pb + 1)) xcd_barrier(bar);
            }
            if (IN(pb + 2)) {
                PHASE_ENTRY();
                pg8::SchedBranch S; S.so.init(TG, D_MODEL, G, (int)blockIdx.x); S.A = (const char*)(ws + WS_Y); S.strideA = (size_t)TG * 1024 * 2;
                S.Bt = (const char*)(ws + WS_WBR) + (size_t)l * 3 * 2048 * 1024 * 2; S.strideB = (size_t)2048 * 1024 * 2;
                pg8::EpiMerge E{(const unsigned char*)(ws + WS_GM), (bf16*)(ws + WS_M)};
#ifndef SKIP_P3
                pg8::gemm_phase<pg8::EpiMerge, pg8::SchedBranch, G3_ALIGN, G3_SP2>(lds, 1024, S, E, tid);
#endif
                if (BOTH(pb + 2)) xcd_barrier(bar);
            }
            if (IN(pb + 3)) {
                PHASE_ENTRY();
                pg8::SchedPlain S; S.so.init(TG, D_MODEL, G, (int)blockIdx.x); S.A = (const char*)(ws + WS_M); S.Bt = (const char*)(ws + WS_WOUT) + (size_t)l * D_MODEL * D_MODEL * 2;
                pg8::EpiBf16Plain E{(bf16*)(ws + WS_O), D_MODEL};
#ifndef SKIP_P4
                pg8::gemm_phase<pg8::EpiBf16Plain, pg8::SchedPlain, G4_ALIGN, G4_SP2>(lds, D_MODEL, S, E, tid);
#endif
                if (BOTH(pb + 3)) xcd_barrier(bar);
            }
            if (IN(pb + 4)) {
                PHASE_ENTRY();
                const int gw = blockIdx.x * NWAVES + wave, NGW = G * NWAVES;
                const bool dead = __hip_atomic_load((gu32*)(ws + WS_CTL) + CW_BAR + XB_TMO, RLX_AGENT) != 0u;
                const bf16* OB = (const bf16*)(ws + WS_O); bf16* HB = (bf16*)(ws + WS_H); bf16* X1 = (bf16*)(ws + WS_X1);
                f32x4 pgv[8], ngv[8];
                { const float* pg = args.in[2] + l * D_MODEL + 8 * lane; const float* ng = args.in[1] + D_MODEL + 8 * lane;
#pragma unroll
                  for (int j = 0; j < 4; ++j) { pgv[2 * j] = *(const f32x4*)(pg + 512 * j); pgv[2 * j + 1] = *(const f32x4*)(pg + 512 * j + 4); ngv[2 * j] = *(const f32x4*)(ng + 512 * j); ngv[2 * j + 1] = *(const f32x4*)(ng + 512 * j + 4); } }
                for (int m = gw; m < TG; m += NGW) {
                    const size_t row = (size_t)g * TG + m;
                    const v4u* orow = (const v4u*)(OB + (size_t)m * D_MODEL) + lane;
                    f32x4 v[8]; float s = 0.f;
#pragma unroll
                    for (int j = 0; j < 4; ++j) { const v4u ow = orow[64 * j]; v[2 * j] = (f32x4){bf_lo(ow.x), bf_hi(ow.x), bf_lo(ow.y), bf_hi(ow.y)}; v[2 * j + 1] = (f32x4){bf_lo(ow.z), bf_hi(ow.z), bf_lo(ow.w), bf_hi(ow.w)}; }
#pragma unroll
                    for (int j = 0; j < 8; ++j) s += (v[j].x * v[j].x + v[j].y * v[j].y) + (v[j].z * v[j].z + v[j].w * v[j].w);
                    const float rs = rsqrtf(wave_sum(s) * (1.f / D_MODEL) + EPS);
                    if (l == 0) {
                        const float* xrow = args.in[0] + row * D_MODEL + 8 * lane; float s2 = 0.f;
                        v4u* x8 = (v4u*)(X1 + (size_t)m * D_MODEL) + lane;
#pragma unroll
                        for (int j = 0; j < 4; ++j) {
                            const f32x4 xa = *(const f32x4*)(xrow + 512 * j), xb = *(const f32x4*)(xrow + 512 * j + 4), ga = pgv[2 * j], gb = pgv[2 * j + 1];
                            v[2 * j] = xa + v[2 * j] * rs * ga; v[2 * j + 1] = xb + v[2 * j + 1] * rs * gb;
                            v4u wv; wv.x = cvt_pk_bf16(v[2 * j].x, v[2 * j].y); wv.y = cvt_pk_bf16(v[2 * j].z, v[2 * j].w); wv.z = cvt_pk_bf16(v[2 * j + 1].x, v[2 * j + 1].y); wv.w = cvt_pk_bf16(v[2 * j + 1].z, v[2 * j + 1].w);
                            x8[64 * j] = wv; }
#pragma unroll
                        for (int j = 0; j < 8; ++j) s2 += (v[j].x * v[j].x + v[j].y * v[j].y) + (v[j].z * v[j].z + v[j].w * v[j].w);
                        const float rs2 = rsqrtf(wave_sum(s2) * (1.f / D_MODEL) + EPS);
                        v4u* o8 = (v4u*)(HB + row * D_MODEL) + lane;
#pragma unroll
                        for (int j = 0; j < 4; ++j) { const f32x4 ga = ngv[2 * j], gb = ngv[2 * j + 1]; const f32x4 a = v[2 * j] * rs2 * ga, bq = v[2 * j + 1] * rs2 * gb;
                            v4u wv; wv.x = cvt_pk_bf16(a.x, a.y); wv.y = cvt_pk_bf16(a.z, a.w); wv.z = cvt_pk_bf16(bq.x, bq.y); wv.w = cvt_pk_bf16(bq.z, bq.w); o8[64 * j] = wv; }
                    } else {
                        const v4u* x8 = (const v4u*)(X1 + (size_t)m * D_MODEL) + lane;
                        float* drow = args.out + row * D_MODEL + 8 * lane;
#pragma unroll
                        for (int j = 0; j < 4; ++j) { const v4u xw = x8[64 * j]; const f32x4 ga = pgv[2 * j], gb = pgv[2 * j + 1];
                            f32x4 a = (f32x4){bf_lo(xw.x), bf_hi(xw.x), bf_lo(xw.y), bf_hi(xw.y)} + v[2 * j] * rs * ga, bq = (f32x4){bf_lo(xw.z), bf_hi(xw.z), bf_lo(xw.w), bf_hi(xw.w)} + v[2 * j + 1] * rs * gb;
                            if (dead) { const float qn = __builtin_nanf(""); a = (f32x4){qn, qn, qn, qn}; bq = a; }
                            *(f32x4*)(drow + 512 * j) = a; *(f32x4*)(drow + 512 * j + 4) = bq; }
                    }
                }
                if (BOTH(pb + 4)) xcd_barrier(bar);
            }
        }
#undef IN
#undef BOTH
#undef PHASE_ENTRY
}

extern "C" void kernel_launch(void* const* d_in, const int* in_sizes, int n_in, void* d_out, int out_size, void* d_ws, size_t ws_size, hipStream_t stream) {
    static int grid = 0;
    if (grid == 0) {
        if (n_in != 17 || in_sizes[0] != M_ALL * D_MODEL || out_size != M_ALL * D_MODEL || ws_size < WS_END) {
            fprintf(stderr, "kernel_launch: unexpected shapes (n_in %d, in0 %d, out %d, ws %zu < %zu); nothing launched\n", n_in, n_in > 0 ? in_sizes[0] : -1, out_size, ws_size, (size_t)WS_END); grid = -1; return; }
        int dev = 0, cus = 0, per_cu = 0;
        if (hipGetDevice(&dev) != hipSuccess || hipDeviceGetAttribute(&cus, hipDeviceAttributeMultiprocessorCount, dev) != hipSuccess) { grid = -1; return; }
        if (hipFuncSetAttribute((const void*)hyb_fwd, hipFuncAttributeMaxDynamicSharedMemorySize, LDS_BYTES) != hipSuccess) { fprintf(stderr, "kernel_launch: hipFuncSetAttribute failed\n"); grid = -1; return; }
        if (hipOccupancyMaxActiveBlocksPerMultiprocessor(&per_cu, (const void*)hyb_fwd, NWAVES * 64, LDS_BYTES) != hipSuccess || per_cu < 1)
            fprintf(stderr, "kernel_launch: note: occupancy query reports %d workgroups per CU\n", per_cu);
        (void)hipGetLastError();
        grid = cus;
    }
    if (grid < 0) return;
    if (hipMemsetAsync((char*)d_ws + WS_CTL, 0, CTL_ZERO_BYTES, stream) != hipSuccess) return;
    Args a{};
    for (int i = 0; i < 17; ++i) a.in[i] = (const float*)d_in[i];
    a.out = (float*)d_out; a.ws = (unsigned char*)d_ws;
#if PROBE_DUP > 0
    { int lo = 0; for (int k = 0; k <= NGROUP * DEPTH; ++k) { const int p = 1 + k * 5 + (PROBE_DUP - 1); const int hi = k < NGROUP * DEPTH ? p + 1 : N_PHASES;
        a.ph_lo = lo; a.ph_hi = hi; a.li = k; a.pad = 0; hipLaunchKernelGGL(hyb_fwd, dim3(grid), dim3(NWAVES * 64), LDS_BYTES, stream, a); lo = p; } }
#elif MK_N_LAUNCHES == 1
    a.ph_lo = 0; a.ph_hi = N_PHASES; a.li = 0; a.pad = 0;
    hipLaunchKernelGGL(hyb_fwd, dim3(grid), dim3(NWAVES * 64), LDS_BYTES, stream, a);
#else
    for (int p = 0; p < N_PHASES; ++p) { a.ph_lo = p; a.ph_hi = p + 1; a.li = 0; a.pad = 0;
        hipLaunchKernelGGL(hyb_fwd, dim3(grid), dim3(NWAVES * 64), LDS_BYTES, stream, a); }
#endif
}
```

```cpp
#include <hip/hip_runtime.h>
#include <cstdio>
#include <cstdint>

namespace pg8 {
#define PG8_LAS __attribute__((address_space(3)))
typedef unsigned short bf16_t;
typedef short bf16x8 __attribute__((ext_vector_type(8)));
typedef float f32x4 __attribute__((ext_vector_type(4)));
typedef unsigned u32x4 __attribute__((ext_vector_type(4)));
constexpr int BM = 256, BK = 64, HALF = 128, HTB = HALF * BK * 2  , STAGE_BYTES = 8 * HTB, NXCD = 8, WGM = 8;

__host__ __device__ __forceinline__ int lds_byte(int r, int c) { const int st = (r >> 4) * 2 + (c >> 5), rr = r & 15, cc = c & 31, ob = rr * 64 + cc * 2; return st * 1024 + (ob ^ (((ob >> 9) & 1) << 5)); }
__host__ __device__ __forceinline__ void stage_rc(int b, int& R, int& C) { const int st = b / 1024, sb = b % 1024, swz = sb ^ (((sb >> 9) & 1) << 5); R = (st >> 1) * 16 + swz / 64; C = (st & 1) * 32 + (swz % 64) / 2; }
__host__ __device__ __forceinline__ int perm32(int rho) { const int n = rho >> 4, i = rho & 15; return 8 * (i >> 2) + 4 * n + (i & 3); }

struct Unit { int pm, pn, sel; };

struct StaticOrder {
    int nM, nN, nwg, G, c;
    __host__ __device__ void init(int M, int N, int G_, int c_) { nM = M / BM; nN = N / BM; nwg = nM * nN; G = G_; c = c_; }
    __host__ __device__ bool next(int i, Unit& u) const {
        const long L = (long)i * G + c; if (L >= nwg) return false;
        int wgid = (int)L; { const int q = nwg / NXCD, r = nwg % NXCD, xcd = wgid % NXCD, off = wgid / NXCD; wgid = (xcd < r ? xcd * (q + 1) : r * (q + 1) + (xcd - r) * q) + off; }
        const int nig = WGM * nN, gid = wgid / nig, fm = gid * WGM, gsz = (nM - fm) < WGM ? (nM - fm) : WGM;
        u.pm = fm + ((wgid % nig) % gsz); u.pn = (wgid % nig) / gsz; u.sel = 0; return true;
    }
};
struct SchedPlain {
    StaticOrder so; const char* A; const char* Bt;
    __device__ __forceinline__ bool next(int i, Unit& u) const { return so.next(i, u); }
    __device__ __forceinline__ const char* a_base(const Unit& u, size_t tstep) const { return A + (size_t)u.pm * tstep; }
    __device__ __forceinline__ const char* b_base(const Unit& u, size_t tstep) const { return Bt + (size_t)u.pn * tstep; }
    __device__ __forceinline__ bool keep(const Unit&) const { return false; }
    __device__ __forceinline__ void a_ready(const Unit&) const {}
    __device__ __forceinline__ void done(const Unit&) const {}
};
struct SchedBranch {
    StaticOrder so; const char* A; const char* Bt; size_t strideA, strideB;
    __device__ __forceinline__ bool next(int i, Unit& u) const { const int t = i / 3; if (!so.next(t, u)) return false; u.sel = i - 3 * t; return true; }
    __device__ __forceinline__ const char* a_base(const Unit& u, size_t tstep) const { return A + (size_t)u.sel * strideA + (size_t)u.pm * tstep; }
    __device__ __forceinline__ const char* b_base(const Unit& u, size_t tstep) const { return Bt + (size_t)u.sel * strideB + (size_t)u.pn * tstep; }
    __device__ __forceinline__ bool keep(const Unit& u) const { return u.sel < 2; }
    __device__ __forceinline__ void a_ready(const Unit&) const {}
    __device__ __forceinline__ void done(const Unit&) const {}
};

typedef float f32x2_cv __attribute__((ext_vector_type(2))); typedef __bf16 bf16x2_cv __attribute__((ext_vector_type(2)));
__device__ __forceinline__ unsigned cvt_pk_bf16(float lo, float hi) { const f32x2_cv v = {lo, hi}; const bf16x2_cv b = __builtin_convertvector(v, bf16x2_cv); return __builtin_bit_cast(unsigned, b); }
__device__ __forceinline__ float bf_lo(unsigned w) { return __uint_as_float(w << 16); }
__device__ __forceinline__ float bf_hi(unsigned w) { return __uint_as_float(w & 0xffff0000u); }
__device__ __forceinline__ float fast_sigmoid(float x) { return __builtin_amdgcn_rcpf(1.0f + __expf(-x)); }
__device__ __forceinline__ float fast_silu(float x) { return x * fast_sigmoid(x); }
__device__ __forceinline__ float lg2_gamma(int h) {
    const float x = __builtin_amdgcn_exp2f((float)(-5 - h));
    const float s = x * (1.0f + x * (0.5f + x * (0.33333334f + x * (0.25f + x * 0.2f))));
    return -s * 1.4426950408889634f;
}

template <int MASK> __device__ __forceinline__ float swz_xor(float v) { return __builtin_bit_cast(float, __builtin_amdgcn_ds_swizzle(__builtin_bit_cast(int, v), (MASK << 10) | 0x1f)); }
__device__ __forceinline__ float swz_xor16(float v) { return swz_xor<16>(v); }
__device__ __forceinline__ void half_swap(unsigned& a, unsigned& b) { asm volatile("s_nop 1\n\tv_permlane32_swap_b32 %0, %1" : "+v"(a), "+v"(b)); }
__device__ __forceinline__ float half_sum(float v) { unsigned a = __builtin_bit_cast(unsigned, v), b = a; half_swap(a, b); return __builtin_bit_cast(float, a) + __builtin_bit_cast(float, b); }
__device__ __forceinline__ float half_max(float v) { unsigned a = __builtin_bit_cast(unsigned, v), b = a; half_swap(a, b); return fmaxf(__builtin_bit_cast(float, a), __builtin_bit_cast(float, b)); }

__host__ __device__ __forceinline__ size_t blk_idx(int row, int col, int nbc  ) { return ((size_t)(row >> 4) * nbc + (col >> 5)) * 512 + (size_t)((row & 15) * 32 + (col & 31)); }

struct EpiF32 {
    static constexpr bool PERM = false, AFTER_DRAIN = false;
    float* C; int ldc;
    __device__ __forceinline__ void operator()(f32x4 (&acc)[2][2][4][2], const Unit& u, int wr, int wc, int fr, int fq) const {
        const int row0 = u.pm * BM + wr * 64 + fr, col0 = u.pn * BM + wc * 32 + 4 * fq;
#pragma unroll
        for (int ai = 0; ai < 2; ++ai)
#pragma unroll
            for (int m = 0; m < 4; ++m) { float* rowp = C + (size_t)(row0 + ai * HALF + m * 16) * ldc + col0;
#pragma unroll
                for (int bj = 0; bj < 2; ++bj)
#pragma unroll
                    for (int n = 0; n < 2; ++n) *(f32x4*)(rowp + bj * HALF + n * 16) = acc[ai][bj][m][n]; }
    }
};

__host__ __device__ __forceinline__ size_t gm8_idx(int row, int bc) { return ((size_t)(row >> 4) * 96 + (bc >> 6)) * 1024 + (size_t)((row & 15) * 64 + (bc & 63)); }
__device__ __forceinline__ unsigned gate_q8x4(const f32x4& g) {
    const unsigned q0 = max((unsigned)(g[0] * 255.f + 0.5f), 1u), q1 = max((unsigned)(g[1] * 255.f + 0.5f), 1u), q2 = max((unsigned)(g[2] * 255.f + 0.5f), 1u), q3 = max((unsigned)(g[3] * 255.f + 0.5f), 1u);
    return q0 | (q1 << 8) | (q2 << 16) | (q3 << 24); }
__device__ __forceinline__ f32x4 gate_unq4(unsigned w) { return (f32x4){(float)(w & 0xffu), (float)((w >> 8) & 0xffu), (float)((w >> 16) & 0xffu), (float)(w >> 24)}; }
struct EpiProj {
    static constexpr bool PERM = true, AFTER_DRAIN = false;
    bf16_t* proj; bf16_t* gm; int mode;
    template <int KIND> __device__ __forceinline__ void run(f32x4 (&acc)[2][2][4][2], const Unit& u, int wr, int wc, int fr, int fq) const {
        const int row0 = u.pm * BM + wr * 64 + fr, colt = u.pn * BM, cl = wc * 32 + 8 * fq;
        constexpr double FRD[8] = {0.15915494309189535, 0.030863763158420102, 0.00598518567638293, 0.001160663620968869, 0.00022507907904105155, 4.3647954811733995e-05, 8.464331128654902e-06, 1.6414263867044143e-06};
#pragma unroll
        for (int ai = 0; ai < 2; ++ai)
#pragma unroll
            for (int m = 0; m < 4; ++m) {
                const int row = row0 + ai * HALF + m * 16, pos = row & 4095;
                float cs[8], sn[8];
                if constexpr (KIND == 2 || KIND == 3) {
                    int fqo = fq; asm volatile("" : "+v"(fqo));
#pragma unroll
                    for (int k = 0; k < 4; ++k) { const double fv = (double)__builtin_amdgcn_exp2f(-(float)(16 * wc + 4 * fqo + k) * (13.287712379549449f / 63.0f)) * 0.15915494309189535;
                        const double ph = (double)pos * fv; const float r = (float)(ph - __builtin_floor(ph)); cs[k] = __builtin_amdgcn_cosf(r); sn[k] = __builtin_amdgcn_sinf(r); }
                }
                if constexpr (KIND == 4 || KIND == 5) {
                    if ((wc & 1) == 0) {
#pragma unroll
                        for (int k = 0; k < 8; ++k) { const double ph = (double)pos * FRD[k]; const float r = (float)(ph - __builtin_floor(ph)); cs[k] = __builtin_amdgcn_cosf(r); sn[k] = __builtin_amdgcn_sinf(r); if (fq == 0) sn[k] = -sn[k]; }
                    }
                }
                u32x4 w8 = {0u, 0u, 0u, 0u};
#pragma unroll
                for (int bj = 0; bj < 2; ++bj) {
                    const int col = colt + bj * HALF + cl;
                    f32x4 v0 = acc[ai][bj][m][0], v1 = acc[ai][bj][m][1];
                    if constexpr (KIND == 0) {
#pragma unroll
                        for (int k = 0; k < 4; ++k) { v0[k] = fast_sigmoid(v0[k]); v1[k] = fast_sigmoid(v1[k]); }
                        if (bj == 0) { w8.x = gate_q8x4(v0); w8.y = gate_q8x4(v1); } else { w8.z = gate_q8x4(v0); w8.w = gate_q8x4(v1); }
                    } else if constexpr (KIND == 1) {
#pragma unroll
                        for (int k = 0; k < 4; ++k) { v0[k] = fast_silu(v0[k]); v1[k] = fast_silu(v1[k]); }
                    } else if constexpr (KIND == 2 || KIND == 3) {
                        float sc = 1.0f;
                        if constexpr (KIND == 3) { int hh = ((colt - 3072) >> 7) + bj; asm volatile("" : "+s"(hh));
                            sc = 0.08838834764831845f * __builtin_amdgcn_exp2f(lg2_gamma(hh) * (float)(127 - (pos & 127))); }
                        const f32x4 ca = {cs[0] * sc, cs[0] * sc, cs[1] * sc, cs[1] * sc}, sa = {sn[0] * sc, sn[0] * sc, sn[1] * sc, sn[1] * sc};
                        const f32x4 cb = {cs[2] * sc, cs[2] * sc, cs[3] * sc, cs[3] * sc}, sb = {sn[2] * sc, sn[2] * sc, sn[3] * sc, sn[3] * sc};
                        const f32x4 w0 = {-v0[1], v0[0], -v0[3], v0[2]}, w1 = {-v1[1], v1[0], -v1[3], v1[2]};
                        v0 = v0 * ca + w0 * sa; v1 = v1 * cb + w1 * sb;
                    } else if constexpr (KIND == 4 || KIND == 5) {
                        if ((wc & 1) == 0) {
                            f32x4 p0, p1;
#pragma unroll
                            for (int k = 0; k < 4; ++k) { p0[k] = swz_xor16(v0[k]); p1[k] = swz_xor16(v1[k]); }
                            if (fq < 2) {
#pragma unroll
                                for (int k = 0; k < 4; ++k) { v0[k] = v0[k] * cs[k] + p0[k] * sn[k]; v1[k] = v1[k] * cs[4 + k] + p1[k] * sn[4 + k]; }
                            }
                        }
                        if constexpr (KIND == 4) { v0 = v0 * 0.18033688011112042f; v1 = v1 * 0.18033688011112042f; }
                    }
                    if constexpr (KIND != 0) {
                        u32x4 w; w.x = cvt_pk_bf16(v0[0], v0[1]); w.y = cvt_pk_bf16(v0[2], v0[3]); w.z = cvt_pk_bf16(v1[0], v1[1]); w.w = cvt_pk_bf16(v1[2], v1[3]);
                        if constexpr (KIND == 7) *(u32x4*)(gm + blk_idx(row, col - 10240, 192)) = w;
                        else *(u32x4*)(proj + blk_idx(row, col, 320)) = w;
                    }
                }
                if constexpr (KIND == 0) *(u32x4*)((unsigned char*)gm + gm8_idx(row, colt - 10240 + 2 * cl)) = w8;
            }
    }
    __device__ __forceinline__ void operator()(f32x4 (&acc)[2][2][4][2], const Unit& u, int wr, int wc, int fr, int fq) const {
        const int seg = (u.pn * BM) >> 10;
        if (mode == 1) return;
        if (mode == 2) { if (seg >= 10) run<7>(acc, u, wr, wc, fr, fq); else run<6>(acc, u, wr, wc, fr, fq); return; }
        if (seg >= 10) run<0>(acc, u, wr, wc, fr, fq);
        else if (seg == 1 || seg == 5 || seg == 9) run<1>(acc, u, wr, wc, fr, fq);
        else if (seg == 2) run<2>(acc, u, wr, wc, fr, fq);
        else if (seg == 3) run<3>(acc, u, wr, wc, fr, fq);
        else if (seg == 6) run<4>(acc, u, wr, wc, fr, fq);
        else if (seg == 7) run<5>(acc, u, wr, wc, fr, fq);
        else run<6>(acc, u, wr, wc, fr, fq);
    }
};

struct EpiBf16Plain {
    static constexpr bool PERM = true, AFTER_DRAIN = false;
    bf16_t* O; int ldc;
    __device__ __forceinline__ void operator()(f32x4 (&acc)[2][2][4][2], const Unit& u, int wr, int wc, int fr, int fq) const {
        const int row0 = u.pm * BM + wr * 64 + fr, col0 = u.pn * BM + wc * 32 + 8 * fq;
#pragma unroll
        for (int ai = 0; ai < 2; ++ai)
#pragma unroll
            for (int m = 0; m < 4; ++m) { bf16_t* rowp = O + (size_t)(row0 + ai * HALF + m * 16) * ldc + col0;
#pragma unroll
                for (int bj = 0; bj < 2; ++bj) { const f32x4 v0 = acc[ai][bj][m][0], v1 = acc[ai][bj][m][1];
                    u32x4 w; w.x = cvt_pk_bf16(v0[0], v0[1]); w.y = cvt_pk_bf16(v0[2], v0[3]); w.z = cvt_pk_bf16(v1[0], v1[1]); w.w = cvt_pk_bf16(v1[2], v1[3]);
                    *(u32x4*)(rowp + bj * HALF) = w; } }
    }
};

struct EpiMerge {
    static constexpr bool PERM = true, AFTER_DRAIN = false;
    const unsigned char* gm; bf16_t* mo;
    __device__ __forceinline__ void load_batch(const int bt, const int row0, const int gbc, const int j, u32x4 (&gc)[2], u32x4 (&gn)[2]) const {
        const int ai = bt >> 1, mh = bt & 1;
#pragma unroll
        for (int mm = 0; mm < 2; ++mm) { const unsigned char* p = gm + gm8_idx(row0 + ai * HALF + (2 * mh + mm) * 16, gbc);
            gc[mm] = *(const u32x4*)p; if (j < 2) gn[mm] = *(const u32x4*)(p + (size_t)32 * 1024); else gn[mm] = gc[mm]; }
    }
    __device__ __forceinline__ void apply_batch(const int bt, f32x4 (&acc)[2][2][4][2], const int row0, const int col0, const int j, const u32x4 (&gc)[2], const u32x4 (&gn)[2]) const {
        const int ai = bt >> 1, mh = bt & 1;
#pragma unroll
        for (int mm = 0; mm < 2; ++mm)
#pragma unroll
            for (int bj = 0; bj < 2; ++bj) {
                const int m = 2 * mh + mm; const u32x4 c = gc[mm];
                f32x4 g0 = gate_unq4(bj == 0 ? c.x : c.z), g1 = gate_unq4(bj == 0 ? c.y : c.w);
                if (j < 2) {
                    const u32x4 n = gn[mm];
                    const f32x4 n0 = gate_unq4(bj == 0 ? n.x : n.z), n1 = gate_unq4(bj == 0 ? n.y : n.w);
#pragma unroll
                    for (int k = 0; k < 4; ++k) { g0[k] = g0[k] * __builtin_amdgcn_rcpf(n0[k]); g1[k] = g1[k] * __builtin_amdgcn_rcpf(n1[k]); }
                    acc[ai][bj][m][0] = acc[ai][bj][m][0] * g0; acc[ai][bj][m][1] = acc[ai][bj][m][1] * g1;
                } else {
                    const f32x4 v0 = acc[ai][bj][m][0] * (g0 * (1.0f / 255.0f)), v1 = acc[ai][bj][m][1] * (g1 * (1.0f / 255.0f));
                    u32x4 w; w.x = cvt_pk_bf16(v0[0], v0[1]); w.y = cvt_pk_bf16(v0[2], v0[3]); w.z = cvt_pk_bf16(v1[0], v1[1]); w.w = cvt_pk_bf16(v1[2], v1[3]);
                    *(u32x4*)(mo + (size_t)(row0 + ai * HALF + m * 16) * 2048 + col0 + bj * HALF) = w;
                }
            }
    }
    __device__ __forceinline__ void operator()(f32x4 (&acc)[2][2][4][2], const Unit& u, int wr, int wc, int fr, int fq) const {
        const int row0 = u.pm * BM + wr * 64 + fr, col0 = u.pn * BM + wc * 32 + 8 * fq, j = u.sel;
        const int gbc = j * 2048 + u.pn * 256 + 64 * wc + 16 * fq;
        u32x4 gcA[2], gnA[2], gcB[2], gnB[2], gcC[2], gnC[2], gcD[2], gnD[2];
        load_batch(0, row0, gbc, j, gcA, gnA);
        load_batch(1, row0, gbc, j, gcB, gnB);
        load_batch(2, row0, gbc, j, gcC, gnC);
        load_batch(3, row0, gbc, j, gcD, gnD);
        __builtin_amdgcn_sched_barrier(0);
        apply_batch(0, acc, row0, col0, j, gcA, gnA);
        __builtin_amdgcn_sched_barrier(0);
        apply_batch(1, acc, row0, col0, j, gcB, gnB);
        __builtin_amdgcn_sched_barrier(0);
        apply_batch(2, acc, row0, col0, j, gcC, gnC);
        __builtin_amdgcn_sched_barrier(0);
        apply_batch(3, acc, row0, col0, j, gcD, gnD);
    }
};

template <class Epi, class Sched, bool ALIGN_EPI = false, bool SP2 = false>
__device__ __forceinline__ void gemm_phase(PG8_LAS unsigned char* lds, const int K_, const Sched& S, const Epi& E, const int tid) {
    const int wid = __builtin_amdgcn_readfirstlane(tid >> 6), lane = tid & 63, wr = wid >> 2, wc = wid & 3, fr = lane & 15, fq = lane >> 4;
    const int K = K_, nt = K / BK;
    unsigned voffA[2], voffB[2];
#pragma unroll
    for (int i = 0; i < 2; ++i) { int R, C; stage_rc(tid * 16 + i * 8192, R, C); const int Rb = Epi::PERM ? ((R & ~31) + perm32(R & 31)) : R;
        voffA[i] = (unsigned)(R * K + C) * 2u; voffB[i] = (unsigned)(Rb * K + C) * 2u; }
    const size_t kstep = (size_t)(BK * 2);
    const size_t hstep = (size_t)HALF * K * 2;
    const size_t tstep = 2 * hstep;
    const unsigned ldsw = (unsigned)wid * 1024u;
    const int aoff = lds_byte(wr * 64 + fr, fq * 8), boff = lds_byte(wc * 32 + fr, fq * 8);
#define PG8_SA(b, h) (((b) * 2 + (h)) * HTB)
#define PG8_SB(b, h) ((4 + (b) * 2 + (h)) * HTB)
#define PG8_STAGE(bufoff, gbase, voff) do { _Pragma("unroll") for (int _i = 0; _i < 2; ++_i) \
        __builtin_amdgcn_global_load_lds((const unsigned*)((const char*)(gbase) + (voff)[_i]), (PG8_LAS unsigned*)(lds + (bufoff) + ldsw + _i * 8192), 16, 0, 0); } while (0)
#define PG8_LDA(dst, b, h) do { _Pragma("unroll") for (int m = 0; m < 4; ++m) _Pragma("unroll") for (int k = 0; k < 2; ++k) dst[m][k] = *(const PG8_LAS bf16x8*)(lds + PG8_SA(b, h) + aoff + m * 2048 + k * 1024); } while (0)
#define PG8_LDB(dst, b, h) do { _Pragma("unroll") for (int n = 0; n < 2; ++n) _Pragma("unroll") for (int k = 0; k < 2; ++k) dst[n][k] = *(const PG8_LAS bf16x8*)(lds + PG8_SB(b, h) + boff + n * 2048 + k * 1024); } while (0)
#define PG8_MMA(ai, bj, At, Bt) do { __builtin_amdgcn_s_setprio(1); _Pragma("unroll") for (int m = 0; m < 4; ++m) _Pragma("unroll") for (int n = 0; n < 2; ++n) _Pragma("unroll") for (int k = 0; k < 2; ++k) \
        acc[ai][bj][m][n] = __builtin_amdgcn_mfma_f32_16x16x32_bf16(Bt[n][k], At[m][k], acc[ai][bj][m][n], 0, 0, 0); __builtin_amdgcn_s_setprio(0); } while (0)
#define PG8_WAIT_V(n) asm volatile("s_waitcnt vmcnt(" #n ")" ::: "memory")
#define PG8_WAIT_L(n) asm volatile("s_waitcnt lgkmcnt(" #n ")" ::: "memory")
#define PG8_BAR __builtin_amdgcn_s_barrier()
#define PG8_SCHED __builtin_amdgcn_sched_barrier(0)
    Unit cur, nxt; int ui = 0;
    if (!S.next(0, cur)) return;
    f32x4 acc[2][2][4][2];
#pragma unroll
    for (int a = 0; a < 2; ++a)
#pragma unroll
        for (int b = 0; b < 2; ++b)
#pragma unroll
            for (int m = 0; m < 4; ++m)
#pragma unroll
                for (int n = 0; n < 2; ++n) acc[a][b][m][n] = (f32x4){0.f, 0.f, 0.f, 0.f};
    bf16x8 At[4][2], B0[2][2], B1[2][2];
    const char* cA = S.a_base(cur, tstep); const char* cB = S.b_base(cur, tstep);
    S.a_ready(cur);
    if constexpr (SP2) {
        PG8_STAGE(PG8_SB(0, 0), cB, voffB); PG8_STAGE(PG8_SB(0, 1), cB + hstep, voffB); PG8_STAGE(PG8_SA(0, 0), cA, voffA); PG8_STAGE(PG8_SA(0, 1), cA + hstep, voffA);
        if (wr == 1) PG8_BAR;
        PG8_WAIT_V(2); PG8_BAR;
        PG8_STAGE(PG8_SB(1, 0), cB + kstep, voffB); PG8_STAGE(PG8_SA(1, 0), cA + kstep, voffA); PG8_STAGE(PG8_SB(1, 1), cB + hstep + kstep, voffB);
        PG8_WAIT_V(6); PG8_BAR;
    } else {
        PG8_STAGE(PG8_SB(0, 0), cB, voffB); PG8_STAGE(PG8_SA(0, 0), cA, voffA); PG8_STAGE(PG8_SB(0, 1), cB + hstep, voffB); PG8_STAGE(PG8_SA(0, 1), cA + hstep, voffA);
        if (wr == 1) PG8_BAR;
        PG8_WAIT_V(4); PG8_BAR;
        PG8_STAGE(PG8_SB(1, 0), cB + kstep, voffB); PG8_STAGE(PG8_SA(1, 0), cA + kstep, voffA); PG8_STAGE(PG8_SB(1, 1), cB + hstep + kstep, voffB);
        PG8_WAIT_V(6); PG8_BAR;
    }
    for (;;) {
        const bool has_next = S.next(ui + 1, nxt);
        const char* nA = has_next ? S.a_base(nxt, tstep) : cA; const char* nB = has_next ? S.b_base(nxt, tstep) : cB;
        for (int t = 0; t < nt; t += 2) {
            const bool last = (t == nt - 2);
            const char* a1 = cA + (size_t)(t + 1) * kstep;
            const char* a2 = last ? nA : cA + (size_t)(t + 2) * kstep; const char* b2 = last ? nB : cB + (size_t)(t + 2) * kstep;
            const char* a3 = a2 + kstep; const char* b3 = b2 + kstep;
            if (last && has_next) S.a_ready(nxt);
            if constexpr (SP2) {
            PG8_LDB(B0, 0, 0); PG8_LDB(B1, 0, 1); PG8_SCHED; PG8_LDA(At, 0, 0); PG8_STAGE(PG8_SA(1, 1), a1 + hstep, voffA);
            PG8_WAIT_V(8); PG8_WAIT_L(0); PG8_BAR; PG8_MMA(0, 0, At, B0); PG8_MMA(0, 1, At, B1); PG8_BAR; PG8_SCHED;
            PG8_LDA(At, 0, 1); PG8_STAGE(PG8_SB(0, 0), b2, voffB); PG8_STAGE(PG8_SB(0, 1), b2 + hstep, voffB); PG8_STAGE(PG8_SA(0, 0), a2, voffA);
            PG8_WAIT_V(8); PG8_WAIT_L(0); PG8_BAR; PG8_MMA(1, 0, At, B0); PG8_MMA(1, 1, At, B1); PG8_BAR; PG8_SCHED;
            PG8_LDB(B0, 1, 0); PG8_LDB(B1, 1, 1); PG8_SCHED; PG8_LDA(At, 1, 0); PG8_STAGE(PG8_SA(0, 1), a2 + hstep, voffA);
            PG8_WAIT_V(8); PG8_WAIT_L(0); PG8_BAR; PG8_MMA(0, 0, At, B0); PG8_MMA(0, 1, At, B1); PG8_BAR; PG8_SCHED;
            PG8_LDA(At, 1, 1); PG8_STAGE(PG8_SB(1, 0), b3, voffB); PG8_STAGE(PG8_SB(1, 1), b3 + hstep, voffB); PG8_STAGE(PG8_SA(1, 0), a3, voffA);
            PG8_WAIT_V(8); PG8_WAIT_L(0); PG8_BAR; PG8_MMA(1, 0, At, B0); PG8_MMA(1, 1, At, B1); PG8_BAR; PG8_SCHED;
            } else {
            PG8_LDB(B0, 0, 0); PG8_SCHED; PG8_LDA(At, 0, 0); PG8_STAGE(PG8_SA(1, 1), a1 + hstep, voffA);
            PG8_WAIT_L(8); PG8_BAR; PG8_WAIT_L(0); PG8_MMA(0, 0, At, B0); PG8_BAR; PG8_SCHED;
            PG8_LDB(B1, 0, 1); PG8_STAGE(PG8_SB(0, 0), b2, voffB);
            PG8_BAR; PG8_WAIT_L(0); PG8_MMA(0, 1, At, B1); PG8_BAR;
            PG8_LDA(At, 0, 1); PG8_STAGE(PG8_SA(0, 0), a2, voffA);
            PG8_BAR; PG8_WAIT_L(0); PG8_MMA(1, 0, At, B0); PG8_BAR; PG8_SCHED;
            PG8_STAGE(PG8_SB(0, 1), b2 + hstep, voffB);
            PG8_WAIT_V(6); PG8_BAR; PG8_MMA(1, 1, At, B1); PG8_BAR;
            PG8_LDB(B0, 1, 0); PG8_SCHED; PG8_LDA(At, 1, 0); PG8_STAGE(PG8_SA(0, 1), a2 + hstep, voffA);
            PG8_WAIT_L(8); PG8_BAR; PG8_WAIT_L(0); PG8_MMA(0, 0, At, B0); PG8_BAR; PG8_SCHED;
            PG8_LDB(B1, 1, 1); PG8_STAGE(PG8_SB(1, 0), b3, voffB);
            PG8_BAR; PG8_WAIT_L(0); PG8_MMA(0, 1, At, B1); PG8_BAR;
            PG8_LDA(At, 1, 1); PG8_STAGE(PG8_SA(1, 0), a3, voffA);
            PG8_BAR; PG8_WAIT_L(0); PG8_MMA(1, 0, At, B0); PG8_BAR; PG8_SCHED;
            PG8_STAGE(PG8_SB(1, 1), b3 + hstep, voffB);
            PG8_WAIT_V(6); PG8_BAR; PG8_MMA(1, 1, At, B1); PG8_BAR;
            }
        }
        if constexpr (ALIGN_EPI) { if (wr == 0) PG8_BAR; }
        if constexpr (!Epi::AFTER_DRAIN) { E(acc, cur, wr, wc, fr, fq); S.done(cur); }
        if (!has_next) break;
        if (!S.keep(cur)) {
#pragma unroll
        for (int a = 0; a < 2; ++a)
#pragma unroll
            for (int b = 0; b < 2; ++b)
#pragma unroll
                for (int m = 0; m < 4; ++m)
#pragma unroll
                    for (int n = 0; n < 2; ++n) acc[a][b][m][n] = (f32x4){0.f, 0.f, 0.f, 0.f};
        }
        cur = nxt; cA = nA; cB = nB; ++ui;
        if constexpr (ALIGN_EPI) { if (wr == 1) PG8_BAR; }
    }
    PG8_WAIT_V(0);
    if constexpr (!ALIGN_EPI) { if (wr == 0) PG8_BAR; }
    PG8_BAR;
    if constexpr (Epi::AFTER_DRAIN) { E.fused(acc, cur, wr, wc, fr, fq, lds, wid, lane); S.done(cur); }
#undef PG8_SA
#undef PG8_SB
#undef PG8_STAGE
#undef PG8_LDA
#undef PG8_LDB
#undef PG8_MMA
#undef PG8_WAIT_V
#undef PG8_WAIT_L
#undef PG8_BAR
#undef PG8_SCHED
}
}
#define GAS __attribute__((address_space(1)))
#define LAS __attribute__((address_space(3)))
typedef unsigned short bf16;
typedef unsigned v4u __attribute__((ext_vector_type(4)));
typedef float f32x4 __attribute__((ext_vector_type(4)));
typedef short bf16x8 __attribute__((ext_vector_type(8)));
typedef GAS unsigned gu32;
typedef GAS unsigned long long gu64;
#define RLX_AGENT __ATOMIC_RELAXED, __HIP_MEMORY_SCOPE_AGENT
#define LDS_WAIT() asm volatile("s_waitcnt lgkmcnt(0)" ::: "memory")
#define VM_WAIT() asm volatile("s_waitcnt vmcnt(0)" ::: "memory")
__device__ __forceinline__ unsigned long long rt() { return __builtin_amdgcn_s_memrealtime(); }
__device__ __forceinline__ unsigned f2bf(float f) { unsigned u = __builtin_bit_cast(unsigned, f); return (u + 0x7fffu + ((u >> 16) & 1u)) >> 16; }
__device__ __forceinline__ unsigned pk2(float lo, float hi) { return f2bf(lo) | (f2bf(hi) << 16); }

#define XB_TMO      128
#define XB_XCNT(j)  (256  + 64 * (j))
#define XB_XSUB(j)  (1280 + 64 * (j))
#define XB_XGEN(j)  (2304 + 64 * (j))
#define XB_TOP      3328
#define XB_TOPGEN   3392
#define XCD_BAR_WORDS 3456
#define XB_SPIN_CAP (1u << 18)

__device__ __forceinline__ unsigned xb_ld(unsigned* p)              { return __hip_atomic_load(p, __ATOMIC_RELAXED, __HIP_MEMORY_SCOPE_AGENT); }
__device__ __forceinline__ unsigned xb_add(unsigned* p, unsigned v) { return __hip_atomic_fetch_add(p, v, __ATOMIC_RELAXED, __HIP_MEMORY_SCOPE_AGENT); }
__device__ __forceinline__ unsigned xb_xcc_id() { return (unsigned)__builtin_amdgcn_s_getreg((3 << 11) | 20) & 0xFu; }
#define XB_SPIN(cond, bar) do { unsigned _sp = 0; while (cond) { __builtin_amdgcn_s_sleep(1); \
    if ((++_sp & 255u) == 0u) { if (xb_ld(&(bar)[XB_TMO])) break; if (_sp > XB_SPIN_CAP) { atomicAdd(&(bar)[XB_TMO], 1u); break; } } } } while (0)

__device__ __forceinline__ unsigned xb_lane() { unsigned m = ~0u; asm volatile("" : "+s"(m)); return __builtin_amdgcn_mbcnt_hi(m, __builtin_amdgcn_mbcnt_lo(m, 0u)); }
struct XcdBarrier {
    unsigned wv;
    unsigned* bar; unsigned x;
    volatile LAS unsigned* st;
};

__device__ __forceinline__ XcdBarrier xcd_barrier_post(unsigned* bar, volatile LAS unsigned* st, unsigned wv) {
    XcdBarrier b; b.wv = wv; b.bar = bar; b.x = xb_xcc_id(); b.st = st;
    if (wv == 0u && xb_lane() == 0u) (void)xb_add(&bar[XB_XCNT(b.x)], 1u);
    return b;
}
__device__ __forceinline__ void xcd_barrier_complete(unsigned* bar, unsigned x, unsigned& nloc, unsigned& nx) {
    const unsigned G = gridDim.x * gridDim.y * gridDim.z;
    unsigned sum, cnt, mine, sp = 0u;
    for (;;) {
        sum = 0u; cnt = 0u; mine = 0u;
#pragma unroll
        for (unsigned j = 0; j < 16; ++j) { const unsigned c = xb_ld(&bar[XB_XCNT(j)]); sum += c; cnt += (c > 0u) ? 1u : 0u; mine = (j == x) ? c : mine; }
        if (sum == G) break;
        __builtin_amdgcn_s_sleep(1);
        if ((++sp & 255u) == 0u) { if (xb_ld(&bar[XB_TMO])) break; if (sp > XB_SPIN_CAP) { atomicAdd(&bar[XB_TMO], 1u); break; } }
    }
    nloc = mine > 0u ? mine : 1u; nx = cnt > 0u ? cnt : 1u;
}

__device__ __forceinline__ void xcd_barrier(const XcdBarrier& b) {
    asm volatile("s_waitcnt vmcnt(0)" ::: "memory");
    __syncthreads();
    if (b.wv == 0u && xb_lane() == 0u) {
        unsigned* bar = b.bar;
        __builtin_amdgcn_s_waitcnt(0);
        unsigned nloc = b.st[0], nx = b.st[1];
        if (nloc == 0u) { xcd_barrier_complete(bar, b.x, nloc, nx); b.st[0] = nloc; b.st[1] = nx; }
        const unsigned old = xb_add(&bar[XB_XSUB(b.x)], 1u);
        const unsigned gen = old / nloc;
        if (old + 1u == (gen + 1u) * nloc) {
            __builtin_amdgcn_fence(__ATOMIC_RELEASE, "agent");
            asm volatile("s_waitcnt vmcnt(0)" ::: "memory");
            const unsigned og = xb_add(&bar[XB_TOP], 1u);
            const unsigned tg = og / nx;
            if (og + 1u == (tg + 1u) * nx) xb_add(&bar[XB_TOPGEN], 1u);
            else XB_SPIN(xb_ld(&bar[XB_TOPGEN]) == tg, bar);
            __builtin_amdgcn_fence(__ATOMIC_ACQUIRE, "agent");
            xb_add(&bar[XB_XGEN(b.x)], 1u);
            asm volatile("s_waitcnt vmcnt(0)" ::: "memory");
        } else {
            XB_SPIN(xb_ld(&bar[XB_XGEN(b.x)]) == gen, bar);
            __builtin_amdgcn_fence(__ATOMIC_ACQUIRE, "agent");
            asm volatile("s_waitcnt vmcnt(0)" ::: "memory");
        }
    }
    __syncthreads();
}

constexpr int D_MODEL = 2048, SEQ = 4096, BATCH = 8, DEPTH = 2, M_ALL = BATCH * SEQ, D_IN = 16384;
constexpr int BG = 4, TG = BG * SEQ, NGROUP = BATCH / BG;
constexpr int PNBC = 320, PBROW = PNBC * 512;
__device__ __forceinline__ size_t pidx(int row, int col) { return pg8::blk_idx(row, col, PNBC); }
constexpr int C_XA = 0, C_GA = 1024, C_QR = 2048, C_KR = 3072, C_VR = 4096, C_GR = 5120, C_QD = 6144, C_KD = 7168, C_VD = 8192, C_GD = 9216;
constexpr float EPS = 1e-6f;
constexpr int NWAVES = 8;
constexpr size_t MiB = 1u << 20;
constexpr size_t WS_CTL = 0, CTL_ZERO_BYTES = 1 * MiB;
constexpr size_t WS_COSR = 1 * MiB, WS_SINR = 2 * MiB, WS_COSD = 3 * MiB, WS_SIND = 3 * MiB + 128 * 1024, WS_LAMS = 3 * MiB + 512 * 1024;
constexpr size_t WS_WIN = 4 * MiB;
constexpr size_t WS_WBR = 132 * MiB;
constexpr size_t WS_WOUT = 156 * MiB;
constexpr size_t WS_H = 172 * MiB;
constexpr size_t WS_Y = 300 * MiB;
constexpr size_t WS_GM = 396 * MiB;
constexpr size_t WS_PROJ = 588 * MiB;
constexpr size_t WS_O = 588 * MiB;
constexpr size_t WS_M = 716 * MiB;
constexpr size_t WS_X1 = 908 * MiB;
constexpr size_t WS_END = 972 * MiB;
static_assert(WS_M + (size_t)TG * 2048 * 2 <= WS_END && WS_O + (size_t)TG * 2048 * 4 <= WS_M && WS_PROJ + (size_t)TG * 10240 * 2 == WS_X1 && WS_X1 + (size_t)TG * 2048 * 2 == WS_END, "d_ws map");
constexpr int CW_TMO = 0;
constexpr int CW_BAR = 4096;
constexpr int CW_Q = 65536;
constexpr int RING_BYTES = 131072, LDSCTL_OFF = RING_BYTES, MISC_OFF = LDSCTL_OFF + 320, LDS_BYTES = 147456;

#define LAUNDER_V(x) asm volatile("" : "+v"(x))
#define LAUNDER_S(x) asm volatile("" : "+s"(x))
typedef float f32x16 __attribute__((ext_vector_type(16)));
typedef short s16x4 __attribute__((ext_vector_type(4)));
typedef short v4i16_t __attribute__((ext_vector_type(4)));
typedef unsigned u32x2 __attribute__((ext_vector_type(2)));
typedef LAS unsigned char* ldsp;
using pg8::blk_idx; using pg8::cvt_pk_bf16; using pg8::bf_lo; using pg8::bf_hi; using pg8::fast_sigmoid; using pg8::lg2_gamma;

using pg8::swz_xor; using pg8::half_sum; using pg8::half_max;
__device__ __forceinline__ float wave_sum(float v) {
    v += swz_xor<1>(v); v += swz_xor<2>(v); v += swz_xor<4>(v); v += swz_xor<8>(v); v += swz_xor<16>(v);
    return half_sum(v);
}
__device__ __forceinline__ unsigned offb(unsigned row, unsigned ch) { return 256u * row + 16u * (ch ^ (((row & 3u) << 2) | ((row >> 2) & 3u))); }
__device__ __forceinline__ unsigned tr_nat(int lane, int k0, int t, int c) { const int h = lane >> 5, blk = (lane >> 4) & 1, q = (lane & 15) >> 2, p = lane & 3; return offb(k0 + 8 * h + 4 * t + q, 4 * c + 2 * blk + (p >> 1)) + 8 * (p & 1); }
__device__ __forceinline__ unsigned tr_perm(int lane, int k0, int t, int c) { const int h = lane >> 5, blk = (lane >> 4) & 1, q = (lane & 15) >> 2, p = lane & 3; return offb(k0 + 8 * t + 4 * h + q, 4 * c + 2 * blk + (p >> 1)) + 8 * (p & 1); }
__device__ __forceinline__ f32x16 mfma32(bf16x8 a, bf16x8 b, f32x16 c) { return __builtin_amdgcn_mfma_f32_32x32x16_bf16(a, b, c, 0, 0, 0); }
__device__ __forceinline__ s16x4 trr(ldsp p) { return __builtin_bit_cast(s16x4, __builtin_amdgcn_ds_read_tr16_b64_v4i16((LAS v4i16_t*)p)); }
__device__ __forceinline__ bf16x8 cat8(s16x4 lo, s16x4 hi) { return (bf16x8){lo[0], lo[1], lo[2], lo[3], hi[0], hi[1], hi[2], hi[3]}; }
template <int B> __device__ __forceinline__ bf16x8 pack8(const f32x16& x) {
    v4u w = {cvt_pk_bf16(x[B], x[B + 1]), cvt_pk_bf16(x[B + 2], x[B + 3]), cvt_pk_bf16(x[B + 4], x[B + 5]), cvt_pk_bf16(x[B + 6], x[B + 7])};
    return __builtin_bit_cast(bf16x8, w);
}
__device__ __forceinline__ f32x16 zero16() { f32x16 z;
#pragma unroll
    for (int i = 0; i < 16; ++i) z[i] = 0.f; return z; }

__device__ __forceinline__ void p0_transpose_item(const float* W, int K, int N, bf16* WT, LAS float* scr, int item, int lane) {
    const int nkb = K / 64, grp = item / (nkb * 64), rem = item - grp * (nkb * 64), kb = rem >> 6, nb = 64 * grp + (rem & 63), k0 = 64 * kb, n0 = 32 * nb;
    { const int cg = lane & 7, rs = lane >> 3;
      f32x4 v[8];
#pragma unroll
      for (int i = 0; i < 8; ++i) v[i] = *(const f32x4*)(W + (size_t)(k0 + 8 * i + rs) * N + n0 + 4 * cg);
#pragma unroll
      for (int i = 0; i < 8; ++i) { LAS float* d = scr + (8 * i + rs) * 33 + 4 * cg; d[0] = v[i].x; d[1] = v[i].y; d[2] = v[i].z; d[3] = v[i].w; } }
    LDS_WAIT(); asm volatile("" ::: "memory");
    const int c = lane & 7;
#pragma unroll
    for (int j = 0; j < 4; ++j) { const int n = (lane >> 3) + 8 * j; const LAS float* s = scr + (8 * c) * 33 + n;
        v4u o; o.x = pk2(s[0 * 33], s[1 * 33]); o.y = pk2(s[2 * 33], s[3 * 33]); o.z = pk2(s[4 * 33], s[5 * 33]); o.w = pk2(s[6 * 33], s[7 * 33]);
        *(GAS v4u*)(WT + (size_t)(n0 + n) * K + k0 + 8 * c) = o; }
    LDS_WAIT(); asm volatile("" ::: "memory");
}
__device__ __forceinline__ void rms_row_to_bf16(const float* xrow, const f32x4 (&gv)[8], bf16* orow, int lane) {
    const float* xr = xrow + 8 * lane;
    f32x4 v[8]; float s = 0.f;
#pragma unroll
    for (int j = 0; j < 4; ++j) { v[2 * j] = *(const f32x4*)(xr + 512 * j); v[2 * j + 1] = *(const f32x4*)(xr + 512 * j + 4); }
#pragma unroll
    for (int j = 0; j < 8; ++j) s += (v[j].x * v[j].x + v[j].y * v[j].y) + (v[j].z * v[j].z + v[j].w * v[j].w);
    const float rs = rsqrtf(wave_sum(s) * (1.f / D_MODEL) + EPS);
    v4u* o16 = (v4u*)orow + lane;
#pragma unroll
    for (int j = 0; j < 4; ++j) { const f32x4 ga = gv[2 * j], gb = gv[2 * j + 1]; const f32x4 a = v[2 * j] * rs * ga, bq = v[2 * j + 1] * rs * gb;
        v4u w; w.x = cvt_pk_bf16(a.x, a.y); w.y = cvt_pk_bf16(a.z, a.w); w.z = cvt_pk_bf16(bq.x, bq.y); w.w = cvt_pk_bf16(bq.z, bq.w); o16[64 * j] = w; }
}

__device__ __forceinline__ void ret_unit(const int tid, ldsp lds, int b, int h, const bf16* proj, bf16* yb) {
    const int lane = tid & 63, w = __builtin_amdgcn_readfirstlane(tid >> 6), r32 = lane & 31, hi = lane >> 5;
    const int it = w >> 1, eh = w & 1;
    constexpr int O_ST = 0, O_KD = 32768, O_VV = 65536, O_Q = 98304;
    LAS float* STAT = (LAS float*)(lds + RING_BYTES + 1024);
    { unsigned z0 = 0u; LAUNDER_V(z0); for (int i = tid; i < 2048; i += 512) ((LAS v4u*)(lds + O_ST))[i] = (v4u){z0, z0, z0, z0}; }
    ldsp rb[8];
#pragma unroll
    for (int s = 0; s < 8; ++s) rb[s] = lds + offb(r32, 2 * s + hi);
    ldsp tnk0 = lds + O_KD + tr_perm(lane, 0, 0, it), tnk1 = lds + O_KD + tr_perm(lane, 0, 1, it);
    ldsp tpv00 = lds + O_VV + tr_perm(lane, 0, 0, 2 * eh), tpv01 = lds + O_VV + tr_perm(lane, 0, 1, 2 * eh), tpv10 = lds + O_VV + tr_perm(lane, 0, 0, 2 * eh + 1), tpv11 = lds + O_VV + tr_perm(lane, 0, 1, 2 * eh + 1);
    const int row00 = b * SEQ, hcol = h * 128;
    bf16* Yp = yb + (size_t)b * SEQ * 1024 + h * 128;
    const float lg = lg2_gamma(h), cd = __builtin_amdgcn_exp2f(128.f * lg), cout = __builtin_amdgcn_exp2f(lg * (float)(32 * it + r32 - 127));
    f32x16 Dacc0 = zero16(), Dacc1 = zero16();
#define RET_DMA(src_, n_, lane_, off_) do { _Pragma("unroll") for (int k_ = 0; k_ < 4; ++k_) { const int row_ = 16 * w + 4 * k_ + ((lane_) >> 4); \
        const int ch_ = ((lane_) & 15) ^ (((row_ & 3) << 2) | ((row_ >> 2) & 3)); \
        __builtin_amdgcn_global_load_lds((const unsigned*)(proj + pidx(row00 + (n_) * 128 + row_, (src_) + hcol + 8 * ch_)), (LAS unsigned*)(lds + (off_) + 4096 * w + 1024 * k_), 16, 0, 0); } } while (0)
#define RET_BAR() do { asm volatile("s_waitcnt lgkmcnt(0)" ::: "memory"); __builtin_amdgcn_s_barrier(); asm volatile("" ::: "memory"); } while (0)
    RET_DMA(C_KR, 0, lane, O_KD); RET_DMA(C_VR, 0, lane, O_VV); RET_DMA(C_QR, 0, lane, O_Q);
    for (int n = 0; n < 32; ++n) {
        int tid_c = tid; LAUNDER_V(tid_c);
        const int lane_c = tid_c & 63, r32c = lane_c & 31, hic = lane_c >> 5;
        const int rowi = n * 128 + 32 * it + r32c;
        const int nn = n + 1 < 32 ? n + 1 : 31;
        asm volatile("s_waitcnt vmcnt(0) lgkmcnt(0)" ::: "memory"); __builtin_amdgcn_s_barrier(); asm volatile("" ::: "memory");
        bf16x8 qf[8];
        { ldsp qb_ = lds + O_Q + 8192 * it;
#pragma unroll
          for (int s = 0; s < 8; ++s) qf[s] = *(const LAS bf16x8*)(qb_ + (unsigned)(rb[s] - lds)); }
#pragma unroll
        for (int ks = 0; ks < 8; ++ks) {
            const bf16x8 a = cat8(trr(tnk0 + 4096 * ks), trr(tnk1 + 4096 * ks));
            Dacc0 = mfma32(a, cat8(trr(tpv00 + 4096 * ks), trr(tpv01 + 4096 * ks)), Dacc0);
            Dacc1 = mfma32(a, cat8(trr(tpv10 + 4096 * ks), trr(tpv11 + 4096 * ks)), Dacc1);
            if (ks & 1) __builtin_amdgcn_sched_barrier(0);
        }
        f32x16 acc0 = zero16(), acc1 = zero16();
#pragma unroll
        for (int jt = 0; jt < 4; ++jt) if (jt <= it) {
            f32x16 X = zero16();
#pragma unroll
            for (int s = 0; s < 8; ++s) X = mfma32(*(const LAS bf16x8*)(rb[s] + O_KD + 8192 * jt), qf[s], X);
            __builtin_amdgcn_sched_barrier(0);
            if (jt == it) {
#pragma unroll
                for (int r = 0; r < 16; ++r) { const int j = (r & 3) + 8 * (r >> 2) + 4 * hic; if (j > r32c) X[r] = 0.f; }
            }
            const bf16x8 pf0 = pack8<0>(X), pf1 = pack8<8>(X);
            acc0 = mfma32(cat8(trr(tpv00 + 8192 * jt), trr(tpv01 + 8192 * jt)), pf0, acc0);
            acc1 = mfma32(cat8(trr(tpv10 + 8192 * jt), trr(tpv11 + 8192 * jt)), pf0, acc1);
            acc0 = mfma32(cat8(trr(tpv00 + 8192 * jt + 4096), trr(tpv01 + 8192 * jt + 4096)), pf1, acc0);
            acc1 = mfma32(cat8(trr(tpv10 + 8192 * jt + 4096), trr(tpv11 + 8192 * jt + 4096)), pf1, acc1);
            __builtin_amdgcn_sched_barrier(0);
        }
        RET_BAR();
        RET_DMA(C_KR, nn, lane_c, O_KD); RET_DMA(C_VR, nn, lane_c, O_VV); RET_DMA(C_QR, nn, lane_c, O_Q);
        u32x2 gg[8];
        { const bf16* grow = proj + pidx(row00 + rowi, C_GR + hcol + 64 * eh + 4 * hic);
#pragma unroll
          for (int e2 = 0; e2 < 2; ++e2)
#pragma unroll
              for (int q4 = 0; q4 < 4; ++q4) gg[4 * e2 + q4] = *(const u32x2*)(grow + 512 * e2 + 8 * q4); }
        {
            ldsp st0 = lds + 16384 * eh;
#pragma unroll
            for (int s = 0; s < 8; ++s) {
                const unsigned o_ = (unsigned)(rb[s] - lds);
                acc0 = mfma32(*(const LAS bf16x8*)(st0 + o_ + O_ST), qf[s], acc0);
                acc1 = mfma32(*(const LAS bf16x8*)(st0 + o_ + O_ST + 8192), qf[s], acc1);
                if ((s & 3) == 3) __builtin_amdgcn_sched_barrier(0);
            }
        }
        float s1 = 0.f, s2 = 0.f;
#pragma unroll
        for (int r = 0; r < 16; ++r) { s1 += acc0[r] + acc1[r]; s2 += acc0[r] * acc0[r] + acc1[r] * acc1[r]; }
        s1 = half_sum(s1); s2 = half_sum(s2);
        if (hic == 0) { STAT[(32 * it + r32c) * 4 + eh * 2] = s1; STAT[(32 * it + r32c) * 4 + eh * 2 + 1] = s2; }
        RET_BAR();
        {
            const LAS float* st = STAT + (32 * it + r32c) * 4;
            const float mean = (st[0] + st[2]) * (1.f / 128.f); float var = (st[1] + st[3]) * (1.f / 128.f) - mean * mean; var = fmaxf(var, 0.f);
            const float rs = cout * rsqrtf(cout * cout * var + EPS);
            bf16* yrow = Yp + (size_t)rowi * 1024 + 64 * eh + 4 * hic;
#pragma unroll
            for (int e2 = 0; e2 < 2; ++e2)
#pragma unroll
                for (int q4 = 0; q4 < 4; ++q4) {
                    const f32x16& A = e2 ? acc1 : acc0; const u32x2 g = gg[4 * e2 + q4];
                    u32x2 o; o.x = cvt_pk_bf16((A[4 * q4] - mean) * rs * bf_lo(g.x), (A[4 * q4 + 1] - mean) * rs * bf_hi(g.x));
                    o.y = cvt_pk_bf16((A[4 * q4 + 2] - mean) * rs * bf_lo(g.y), (A[4 * q4 + 3] - mean) * rs * bf_hi(g.y));
                    *(u32x2*)(yrow + 32 * e2 + 8 * q4) = o;
                }
        }
#pragma unroll
        for (int r = 0; r < 16; ++r) { Dacc0[r] *= cd; Dacc1[r] *= cd; }
        {
            ldsp sw0 = lds + O_ST + 16384 * eh + 256 * r32c + 8 * hic; const unsigned swr = ((r32c & 3) << 2) | ((r32c >> 2) & 3);
#pragma unroll
            for (int q4 = 0; q4 < 4; ++q4) {
                u32x2 o0, o1; o0.x = cvt_pk_bf16(Dacc0[4 * q4], Dacc0[4 * q4 + 1]); o0.y = cvt_pk_bf16(Dacc0[4 * q4 + 2], Dacc0[4 * q4 + 3]);
                o1.x = cvt_pk_bf16(Dacc1[4 * q4], Dacc1[4 * q4 + 1]); o1.y = cvt_pk_bf16(Dacc1[4 * q4 + 2], Dacc1[4 * q4 + 3]);
                const unsigned co = 16u * ((unsigned)(4 * it + q4) ^ swr);
                *(LAS u32x2*)(sw0 + co) = o0; *(LAS u32x2*)(sw0 + co + 8192) = o1;
            }
        }
    }
    asm volatile("s_waitcnt vmcnt(0)" ::: "memory");
#undef RET_DMA
#undef RET_BAR
}

__device__ __forceinline__ void lru_unit(const int tid, ldsp lds, int b, int nb, const bf16* proj, bf16* ya, const float* convw, const float* convb,
                                         const float* wa, const float* ba, const float* wx, const float* bx, const float* lam) {
    const int lane = tid & 63, w = __builtin_amdgcn_readfirstlane(tid >> 6), r32 = lane & 31, hi = lane >> 5;
    const int c0 = nb * 64;
    LAS bf16* XA = (LAS bf16*)lds; ldsp XC = lds + 17408; LAS float* XF = (LAS float*)(lds + 35840); LAS float* AF = (LAS float*)(lds + 68608);
    ldsp WT = lds + 101376; LAS float* SEG = (LAS float*)(lds + 119808); LAS float* PAR = (LAS float*)(lds + 123904);
    if (tid < 64) { const int c = c0 + tid;
        PAR[tid] = convw[c]; PAR[64 + tid] = convw[1024 + c]; PAR[128 + tid] = convw[2048 + c]; PAR[192 + tid] = convw[3072 + c];
        PAR[256 + tid] = convb[c]; PAR[320 + tid] = ba[c]; PAR[384 + tid] = bx[c];
        const float z = __expf(-lam[c]); PAR[448 + tid] = log1pf(z); }
    for (int idx = tid; idx < 4096; idx += 512) { const int d = idx >> 6, e = idx & 63;
        ((LAS bf16*)WT)[e * 72 + d] = (bf16)f2bf(wa[nb * 4096 + idx]); ((LAS bf16*)(WT + 9216))[e * 72 + d] = (bf16)f2bf(wx[nb * 4096 + idx]); }
    const int row00 = b * SEQ;
    bf16* yp = ya + (size_t)b * SEQ * 1024 + c0;
    const int e = tid & 63;
    float hcarry = 0.f;
    v4u xs[2][3];
#define LRU_ISSUE(S_, t0_) do { { const int r = tid >> 3, ch = tid & 7, t = (t0_) - 3 + r; { unsigned z0 = 0u; LAUNDER_V(z0); xs[S_][0] = (v4u){z0, z0, z0, z0}; } if (t >= 0) xs[S_][0] = *(const v4u*)(proj + pidx(row00 + t, C_XA + c0 + ch * 8)); } \
        { const int r = (tid + 512) >> 3, ch = tid & 7, t = (t0_) - 3 + r; xs[S_][1] = *(const v4u*)(proj + pidx(row00 + t, C_XA + c0 + ch * 8)); } \
        if (tid < 24) { const int r = (tid + 1024) >> 3, ch = tid & 7, t = (t0_) - 3 + r; xs[S_][2] = *(const v4u*)(proj + pidx(row00 + t, C_XA + c0 + ch * 8)); } } while (0)
    LRU_ISSUE(0, 0); LRU_ISSUE(1, 128);
    for (int n2 = 0; n2 < 32; n2 += 2)
#pragma unroll
      for (int sx = 0; sx < 2; ++sx) {
        const int n = n2 + sx;
        const int t0 = n * 128;
        *(LAS v4u*)((ldsp)XA + tid * 16) = xs[sx][0]; *(LAS v4u*)((ldsp)XA + (tid + 512) * 16) = xs[sx][1]; if (tid < 24) *(LAS v4u*)((ldsp)XA + (tid + 1024) * 16) = xs[sx][2];
        if (n + 2 < 32) LRU_ISSUE(sx, t0 + 256);
        __syncthreads();
        { const int c = tid & 63; const float w0 = PAR[c], w1 = PAR[64 + c], w2 = PAR[128 + c], w3 = PAR[192 + c], cb = PAR[256 + c];
          const int tb = 16 * (tid >> 6);
          float x0 = __uint_as_float((unsigned)XA[tb * 64 + c] << 16), x1 = __uint_as_float((unsigned)XA[(tb + 1) * 64 + c] << 16), x2 = __uint_as_float((unsigned)XA[(tb + 2) * 64 + c] << 16);
#pragma unroll
          for (int k = 0; k < 16; ++k) { const int t = tb + k;
              const float x3 = __uint_as_float((unsigned)XA[(t + 3) * 64 + c] << 16);
              const float xc = cb + w0 * x0 + w1 * x1 + w2 * x2 + w3 * x3;
              XF[t * 64 + c] = xc; ((LAS bf16*)XC)[t * 72 + c] = (bf16)f2bf(xc);
              x0 = x1; x1 = x2; x2 = x3; } }
        __syncthreads();
        bf16 gt[16];
#pragma unroll
        for (int k = 0; k < 16; ++k) gt[k] = proj[pidx(row00 + t0 + 16 * w + k, C_GA + c0 + e)];
        { const int tt = w >> 1, et = w & 1;
          f32x16 gr = zero16(), gi = zero16();
#pragma unroll
          for (int s = 0; s < 4; ++s) {
              const bf16x8 a = *(const LAS bf16x8*)(XC + (32 * tt + r32) * 144 + (16 * s + 8 * hi) * 2);
              const bf16x8 br = *(const LAS bf16x8*)(WT + (32 * et + r32) * 144 + (16 * s + 8 * hi) * 2);
              const bf16x8 bi = *(const LAS bf16x8*)(WT + 9216 + (32 * et + r32) * 144 + (16 * s + 8 * hi) * 2);
              gr = mfma32(a, br, gr); gi = mfma32(a, bi, gi); }
          const int ee = 32 * et + r32; const float sp = PAR[448 + ee];
          constexpr float L2E = 1.4426950408889634f;
          const float nbar = -PAR[320 + ee] * L2E, nbxr = -PAR[384 + ee] * L2E, c1 = -8.0f * L2E * sp, c2 = -16.0f * sp;
#pragma unroll
          for (int r = 0; r < 16; ++r) { const int t = 32 * tt + (r & 3) + 8 * (r >> 2) + 4 * hi;
              const float xc = XF[t * 64 + ee];
              const float rg = __builtin_amdgcn_rcpf(1.0f + __builtin_amdgcn_exp2f(__builtin_fmaf(gr[r], -L2E, nbar))), ig = __builtin_amdgcn_rcpf(1.0f + __builtin_amdgcn_exp2f(__builtin_fmaf(gi[r], -L2E, nbxr)));
              const float a = __builtin_amdgcn_exp2f(rg * c1), x2 = rg * c2;
              const float em_series = -x2 * (1.0f + x2 * (0.5f + x2 * (0.16666667f + x2 * (0.041666668f + x2 * (0.008333334f + x2 * 0.0013888889f)))));
              const float em = x2 < -0.25f ? 1.0f - a * a : em_series;
              AF[t * 64 + ee] = a; XF[t * 64 + ee] = __builtin_amdgcn_sqrtf(em) * ig * xc; } }
        __syncthreads();
        float av[16], uv[16];
        { float A = 1.f, H = 0.f;
#pragma unroll
          for (int k = 0; k < 16; ++k) { const int t = 16 * w + k; av[k] = AF[t * 64 + e]; uv[k] = XF[t * 64 + e]; H = av[k] * H + uv[k]; A *= av[k]; }
          SEG[(w * 64 + e) * 2] = A; SEG[(w * 64 + e) * 2 + 1] = H; }
        __syncthreads();
        float hs = hcarry, hst = 0.f;
#pragma unroll
        for (int s = 0; s < 8; ++s) { const float A = SEG[(s * 64 + e) * 2], H = SEG[(s * 64 + e) * 2 + 1]; if (s == w) hst = hs; hs = A * hs + H; }
        hcarry = hs;
        float hh = hst;
#pragma unroll
        for (int k = 0; k < 16; ++k) { const int t = 16 * w + k; hh = av[k] * hh + uv[k];
            yp[(size_t)(t0 + t) * 1024 + e] = (bf16)f2bf(hh * __uint_as_float((unsigned)gt[k] << 16)); }
    }
#undef LRU_ISSUE
}

typedef float f32x2 __attribute__((ext_vector_type(2)));
struct AttS { f32x16 O0, O1, O2, O3, p0, p1; bf16x8 pf0, pf1, pf2, pf3; bf16x8 k0, k1, k2, k3, k4, k5, k6, k7; float mref, l, alpha; int rp; };
#define ATT_THR 8.0f
constexpr int ATT_V0 = 0, ATT_K0 = 49152, ATT_SLOT = 16384;
#define ATT_PIN(X_) asm volatile("" : "+v"(X_))
#define ATT_SB() __builtin_amdgcn_sched_barrier(0)
__device__ __forceinline__ float attn_rowmax(const f32x16& a, const f32x16& b) {
    float d = fmaxf(a[0], b[0]);
#pragma unroll
    for (int r = 1; r < 16; ++r) d = fmaxf(d, fmaxf(a[r], b[r]));
    return half_max(d);
}
__device__ __forceinline__ int attn_rowmax_bits(const f32x16& a, const f32x16& b) {
    int d = max(__float_as_int(a[0]), __float_as_int(b[0]));
#pragma unroll
    for (int r = 1; r < 16; ++r) d = max(d, max(__float_as_int(a[r]), __float_as_int(b[r])));
    unsigned x = (unsigned)d, y = x; pg8::half_swap(x, y);
    return max((int)x, (int)y);
}
template <int B> __device__ __forceinline__ f32x2 attn_sum8(const f32x16& a, f32x2 s) {
#pragma unroll
    for (int r = B; r < B + 8; r += 2) s += (f32x2){a[r], a[r + 1]};
    return s;
}
#define ATT_EXP4(P_, B_) do { _Pragma("unroll") for (int r_ = 0; r_ < 4; ++r_) P_[(B_) + r_] = __builtin_amdgcn_exp2f(P_[(B_) + r_]); } while (0)
#define ATT_SUB4(P_, B_) do { _Pragma("unroll") for (int r_ = 0; r_ < 4; ++r_) P_[(B_) + r_] -= st.mref; } while (0)
#define ATT_VF(TV_, KS, ET) cat8(trr((TV_) + 4096 * (ET) + 1024 * (KS)), trr((TV_) + 4096 * (ET) + 1024 * (KS) + 512))
#define ATT_KF(RK_, O_) (*(const LAS bf16x8*)((RK_) + (O_)))
#define ATT_MASK(Q0_, Q1_, t_) do { const int kb_ = 64 * (t_); \
        if (kb_ + 63 > qw) { const int dq_ = qw + r32 - kb_ - 4 * hi; const float NEG_ = -__builtin_inff(); \
            _Pragma("unroll") for (int r_ = 0; r_ < 16; ++r_) { const int cr_ = (r_ & 3) + 8 * (r_ >> 2); if (cr_ > dq_) Q0_[r_] = NEG_; if (cr_ + 32 > dq_) Q1_[r_] = NEG_; } } } while (0)
#define ATT_OSCALE() do { if (st.rp) { _Pragma("unroll") for (int r_ = 0; r_ < 16; ++r_) { st.O0[r_] *= st.alpha; st.O1[r_] *= st.alpha; st.O2[r_] *= st.alpha; st.O3[r_] *= st.alpha; } } } while (0)
#define ATT_EXP1(Q0_, Q1_, I_) do { if ((I_) < 16) Q0_[(I_) & 15] = __builtin_amdgcn_exp2f(Q0_[(I_) & 15]); else Q1_[(I_) & 15] = __builtin_amdgcn_exp2f(Q1_[(I_) & 15]); } while (0)
#define ATT_EXP3(Q0_, Q1_, I_) do { ATT_EXP1(Q0_, Q1_, (I_)); ATT_EXP1(Q0_, Q1_, (I_) + 1); ATT_EXP1(Q0_, Q1_, (I_) + 2); } while (0)
__device__ __forceinline__ f32x16 attn_splat(const float v) { f32x16 z;
#pragma unroll
    for (int i = 0; i < 16; ++i) z[i] = v; return z; }
__device__ __forceinline__ void attn_step(AttS& st, const int t, const int qw, const int r32, const int hi, const bf16x8 (&qf)[4], ldsp tv, ldsp rn0, ldsp rn1, ldsp rn2, ldsp rn3) {
    ATT_OSCALE();
    const f32x16 negm = attn_splat(-st.mref);
    f32x16 q0 = mfma32(st.k0, qf[0], negm); bf16x8 va0 = ATT_VF(tv, 0, 0);
    f32x16 q1 = mfma32(st.k1, qf[0], negm); bf16x8 va1 = ATT_VF(tv, 0, 1);
    ATT_SB();
    q0 = mfma32(st.k2, qf[1], q0); bf16x8 va2 = ATT_VF(tv, 0, 2);
    q1 = mfma32(st.k3, qf[1], q1); bf16x8 va3 = ATT_VF(tv, 0, 3);
    ATT_SB();
    q0 = mfma32(st.k4, qf[2], q0); bf16x8 vb0 = ATT_VF(tv, 1, 0);
    q1 = mfma32(st.k5, qf[2], q1); bf16x8 vb1 = ATT_VF(tv, 1, 1);
    st.pf2 = pack8<0>(st.p1); ATT_PIN(st.pf2);
    ATT_SB();
    q0 = mfma32(st.k6, qf[3], q0); bf16x8 vb2 = ATT_VF(tv, 1, 2);
    q1 = mfma32(st.k7, qf[3], q1); bf16x8 vb3 = ATT_VF(tv, 1, 3);
    st.pf3 = pack8<8>(st.p1); ATT_PIN(st.pf3);
    ATT_SB();
    ATT_MASK(q0, q1, t);
    st.O0 = mfma32(va0, st.pf0, st.O0); va0 = ATT_VF(tv, 2, 0); ATT_EXP3(q0, q1, 0);
    ATT_SB();
    st.O1 = mfma32(va1, st.pf0, st.O1); va1 = ATT_VF(tv, 2, 1); ATT_EXP3(q0, q1, 3);
    ATT_SB();
    st.O2 = mfma32(va2, st.pf0, st.O2); va2 = ATT_VF(tv, 2, 2); ATT_EXP3(q0, q1, 6);
    ATT_SB();
    st.O3 = mfma32(va3, st.pf0, st.O3); va3 = ATT_VF(tv, 2, 3); ATT_EXP3(q0, q1, 9);
    ATT_SB();
    st.O0 = mfma32(vb0, st.pf1, st.O0); vb0 = ATT_VF(tv, 3, 0); ATT_EXP3(q0, q1, 12);
    ATT_SB();
    st.O1 = mfma32(vb1, st.pf1, st.O1); vb1 = ATT_VF(tv, 3, 1); ATT_EXP3(q0, q1, 15);
    ATT_PIN(q0);
    ATT_SB();
    st.O2 = mfma32(vb2, st.pf1, st.O2); vb2 = ATT_VF(tv, 3, 2); ATT_EXP3(q0, q1, 18);
    ATT_SB();
    st.O3 = mfma32(vb3, st.pf1, st.O3); vb3 = ATT_VF(tv, 3, 3); ATT_EXP3(q0, q1, 21);
    ATT_SB();
    st.O0 = mfma32(va0, st.pf2, st.O0); ATT_EXP3(q0, q1, 24); ATT_EXP1(q0, q1, 27);
    ATT_SB();
    st.O1 = mfma32(va1, st.pf2, st.O1); ATT_EXP3(q0, q1, 28); ATT_EXP1(q0, q1, 31);
    ATT_PIN(q1);
    ATT_SB();
    st.O2 = mfma32(va2, st.pf2, st.O2);
    f32x2 ps = attn_sum8<0>(q0, (f32x2){0.f, 0.f}); ps = attn_sum8<8>(q0, ps); ATT_PIN(ps);
    ATT_SB();
    st.O3 = mfma32(va3, st.pf2, st.O3);
    ps = attn_sum8<0>(q1, ps); ps = attn_sum8<8>(q1, ps);
    float psum = ps.x + ps.y; ATT_PIN(psum);
    ATT_SB();
    const bool resc = __any(psum > 256.0f);
    st.rp = resc; st.alpha = 1.f;
    if (resc) {
        const f32x16 nm2 = attn_splat(-st.mref);
        q0 = mfma32(st.k0, qf[0], nm2); q1 = mfma32(st.k1, qf[0], nm2);
        q0 = mfma32(st.k2, qf[1], q0); q1 = mfma32(st.k3, qf[1], q1);
        q0 = mfma32(st.k4, qf[2], q0); q1 = mfma32(st.k5, qf[2], q1);
        q0 = mfma32(st.k6, qf[3], q0); q1 = mfma32(st.k7, qf[3], q1);
        ATT_MASK(q0, q1, t);
        const float d = attn_rowmax(q0, q1);
        const float dl = fmaxf(d, 0.f); st.mref += dl; st.alpha = __builtin_amdgcn_exp2f(-dl); st.l *= st.alpha;
#pragma unroll
        for (int r = 0; r < 16; ++r) { q0[r] = __builtin_amdgcn_exp2f(q0[r] - dl); q1[r] = __builtin_amdgcn_exp2f(q1[r] - dl); }
        f32x2 p2 = attn_sum8<0>(q0, (f32x2){0.f, 0.f}); p2 = attn_sum8<8>(q0, p2); p2 = attn_sum8<0>(q1, p2); p2 = attn_sum8<8>(q1, p2); psum = p2.x + p2.y;
    }
    st.l += psum;
    st.O0 = mfma32(vb0, st.pf3, st.O0); st.k0 = ATT_KF(rn0, 0); st.k1 = ATT_KF(rn0, 8192);
    ATT_PIN(st.l);
    ATT_SB();
    st.O1 = mfma32(vb1, st.pf3, st.O1); st.k2 = ATT_KF(rn1, 0); st.k3 = ATT_KF(rn1, 8192);
    ATT_SB();
    st.O2 = mfma32(vb2, st.pf3, st.O2); st.k4 = ATT_KF(rn2, 0); st.k5 = ATT_KF(rn2, 8192);
    st.pf0 = pack8<0>(q0); ATT_PIN(st.pf0);
    ATT_SB();
    st.O3 = mfma32(vb3, st.pf3, st.O3); st.k6 = ATT_KF(rn3, 0); st.k7 = ATT_KF(rn3, 8192);
    st.pf1 = pack8<8>(q0); ATT_PIN(st.pf1);
    ATT_SB();
    st.p1 = q1;
}
__device__ __forceinline__ void attn_unit(const int tid, ldsp lds, int b, int h, int qb, const bf16* proj, bf16* yc, const float* lamp, const float* subg) {
    const int lane = tid & 63, w = __builtin_amdgcn_readfirstlane(tid >> 6), r32 = lane & 31, hi = lane >> 5;
    const int c = w >> 2, it = w & 3;
    const int qw = qb * 128 + 32 * it, NT = 2 * qb + 2;
    const int row00 = b * SEQ, hcol = h * 128;
    bf16x8 qf[4];
#pragma unroll
    for (int s = 0; s < 4; ++s) qf[s] = *(const bf16x8*)(proj + pidx(row00 + qw + r32, C_QD + hcol + 64 * c + 16 * s + 8 * hi));
    ldsp rk0 = lds + ATT_K0 + offb(r32, 8 * c + 0 + hi), rk1 = lds + ATT_K0 + offb(r32, 8 * c + 2 + hi), rk2 = lds + ATT_K0 + offb(r32, 8 * c + 4 + hi), rk3 = lds + ATT_K0 + offb(r32, 8 * c + 6 + hi);
    ldsp tvb = lds + ATT_V0 + (4 * hi + ((lane & 15) >> 2)) * 64 + 32 * ((lane >> 4) & 1) + 8 * (lane & 3);
    const int kr0 = 8 * w + (lane >> 4), kc0 = (lane & 15) ^ (((kr0 & 3) << 2) | ((kr0 >> 2) & 3)), kr1 = kr0 + 4, kc1 = (lane & 15) ^ (((kr1 & 3) << 2) | ((kr1 >> 2) & 3));
    const unsigned oK0 = 2u * (unsigned)pidx(kr0, C_KD + hcol + 8 * kc0), oK1 = 2u * (unsigned)pidx(kr1, C_KD + hcol + 8 * kc1);
    const unsigned oV0 = 2u * (unsigned)pidx(32 * (w & 1) + (lane >> 2), C_VD + hcol + 32 * (w >> 1) + 8 * (lane & 3));
    const unsigned char* gb = (const unsigned char*)(proj + (size_t)(row00 >> 4) * PBROW);
    const int dK = 2048 * w, dV = 4096 * (w >> 1) + 2048 * (w & 1);
    const unsigned ldsb = (unsigned)__builtin_amdgcn_readfirstlane((int)(unsigned)(unsigned long long)lds);
#define ATT_GLDS(g_, d_) do { unsigned keep_; asm volatile("s_mov_b32 %0, m0\n\ts_mov_b32 m0, %2\n\ts_nop 0\n\tglobal_load_lds_dwordx4 %1, off\n\ts_mov_b32 m0, %0" : "=&s"(keep_) : "v"(g_), "s"(d_) : "memory"); } while (0)
#define ATT_DMA_K(tk_, so_) do { const unsigned char* p_ = gb + (size_t)(4 * (tk_)) * (2 * PBROW); const unsigned d_ = ldsb + ATT_K0 + (so_) + dK; \
        ATT_GLDS(p_ + oK0, d_); ATT_GLDS(p_ + oK1, d_ + 1024u); } while (0)
#define ATT_DMA_V(tv_, so_) do { const unsigned char* p_ = gb + (size_t)(4 * (tv_)) * (2 * PBROW); const unsigned d_ = ldsb + ATT_V0 + (so_) + dV; \
        ATT_GLDS(p_ + oV0, d_); ATT_GLDS(p_ + oV0 + 2 * PBROW, d_ + 1024u); } while (0)
#define ATT_WAITBAR() do { asm volatile("s_waitcnt vmcnt(4) lgkmcnt(0)" ::: "memory"); __builtin_amdgcn_s_barrier(); asm volatile("" ::: "memory"); } while (0)
    const int TL = NT - 1;
    ATT_DMA_K(0, 0);
    ATT_DMA_K(1, ATT_SLOT);
    { const int t2 = 2 < TL ? 2 : TL; ATT_DMA_K(t2, 2 * ATT_SLOT); }
    ATT_DMA_V(0, 0);
    AttS st; st.O0 = zero16(); st.O1 = zero16(); st.O2 = zero16(); st.O3 = zero16();
    st.mref = 0.f; st.l = 0.f; st.alpha = 1.f; st.rp = 0;
    asm volatile("s_waitcnt vmcnt(6)" ::: "memory"); __builtin_amdgcn_s_barrier(); asm volatile("" ::: "memory");
    st.k0 = ATT_KF(rk0, 0); st.k1 = ATT_KF(rk0, 8192); st.k2 = ATT_KF(rk1, 0); st.k3 = ATT_KF(rk1, 8192);
    st.k4 = ATT_KF(rk2, 0); st.k5 = ATT_KF(rk2, 8192); st.k6 = ATT_KF(rk3, 0); st.k7 = ATT_KF(rk3, 8192);
    ATT_WAITBAR();
    { const int t3 = 3 < TL ? 3 : TL, t1 = 1 < TL ? 1 : TL; ATT_DMA_K(t3, 0); ATT_DMA_V(t1, ATT_SLOT); }
    st.p0 = mfma32(st.k0, qf[0], zero16()); st.p1 = mfma32(st.k1, qf[0], zero16());
    st.p0 = mfma32(st.k2, qf[1], st.p0); st.p1 = mfma32(st.k3, qf[1], st.p1);
    st.p0 = mfma32(st.k4, qf[2], st.p0); st.p1 = mfma32(st.k5, qf[2], st.p1);
    st.p0 = mfma32(st.k6, qf[3], st.p0); st.p1 = mfma32(st.k7, qf[3], st.p1);
    ATT_SB();
    st.k0 = ATT_KF(rk0, ATT_SLOT); st.k1 = ATT_KF(rk0, ATT_SLOT + 8192); st.k2 = ATT_KF(rk1, ATT_SLOT); st.k3 = ATT_KF(rk1, ATT_SLOT + 8192);
    st.k4 = ATT_KF(rk2, ATT_SLOT); st.k5 = ATT_KF(rk2, ATT_SLOT + 8192); st.k6 = ATT_KF(rk3, ATT_SLOT); st.k7 = ATT_KF(rk3, ATT_SLOT + 8192);
    ATT_MASK(st.p0, st.p1, 0);
    st.mref = attn_rowmax(st.p0, st.p1);
#pragma unroll
    for (int r = 0; r < 16; ++r) { st.p0[r] = __builtin_amdgcn_exp2f(st.p0[r] - st.mref); st.p1[r] = __builtin_amdgcn_exp2f(st.p1[r] - st.mref); }
    { f32x2 ps = attn_sum8<0>(st.p0, (f32x2){0.f, 0.f}); ps = attn_sum8<8>(st.p0, ps); ps = attn_sum8<0>(st.p1, ps); ps = attn_sum8<8>(st.p1, ps); st.l += ps.x + ps.y; }
    st.pf0 = pack8<0>(st.p0); st.pf1 = pack8<8>(st.p0);
    ATT_PIN(st.pf0); ATT_PIN(st.pf1); ATT_PIN(st.p1);
    int sa = ATT_SLOT, sb = 2 * ATT_SLOT, sc = 0;
    for (int t = 1; t <= TL; ++t) {
        ATT_WAITBAR();
        { const int tk = t + 3 < TL ? t + 3 : TL, tv = t + 1 < TL ? t + 1 : TL; ATT_DMA_K(tk, sa); ATT_DMA_V(tv, sb); }
        attn_step(st, t, qw, r32, hi, qf, tvb + sc, rk0 + sb, rk1 + sb, rk2 + sb, rk3 + sb);
        const int s0 = sa; sa = sb; sb = sc; sc = s0;
    }
    ATT_WAITBAR();
    ATT_OSCALE();
    st.pf2 = pack8<0>(st.p1); st.pf3 = pack8<8>(st.p1);
    { ldsp tv = tvb + sc;
      { const bf16x8 v0 = ATT_VF(tv, 0, 0), v1 = ATT_VF(tv, 0, 1), v2 = ATT_VF(tv, 0, 2), v3 = ATT_VF(tv, 0, 3);
        st.O0 = mfma32(v0, st.pf0, st.O0); st.O1 = mfma32(v1, st.pf0, st.O1); st.O2 = mfma32(v2, st.pf0, st.O2); st.O3 = mfma32(v3, st.pf0, st.O3); }
      { const bf16x8 v0 = ATT_VF(tv, 1, 0), v1 = ATT_VF(tv, 1, 1), v2 = ATT_VF(tv, 1, 2), v3 = ATT_VF(tv, 1, 3);
        st.O0 = mfma32(v0, st.pf1, st.O0); st.O1 = mfma32(v1, st.pf1, st.O1); st.O2 = mfma32(v2, st.pf1, st.O2); st.O3 = mfma32(v3, st.pf1, st.O3); }
      { const bf16x8 v0 = ATT_VF(tv, 2, 0), v1 = ATT_VF(tv, 2, 1), v2 = ATT_VF(tv, 2, 2), v3 = ATT_VF(tv, 2, 3);
        st.O0 = mfma32(v0, st.pf2, st.O0); st.O1 = mfma32(v1, st.pf2, st.O1); st.O2 = mfma32(v2, st.pf2, st.O2); st.O3 = mfma32(v3, st.pf2, st.O3); }
      { const bf16x8 v0 = ATT_VF(tv, 3, 0), v1 = ATT_VF(tv, 3, 1), v2 = ATT_VF(tv, 3, 2), v3 = ATT_VF(tv, 3, 3);
        st.O0 = mfma32(v0, st.pf3, st.O0); st.O1 = mfma32(v1, st.pf3, st.O1); st.O2 = mfma32(v2, st.pf3, st.O2); st.O3 = mfma32(v3, st.pf3, st.O3); } }
#undef ATT_GLDS
#undef ATT_DMA_K
#undef ATT_DMA_V
#undef ATT_WAITBAR
    const float l = half_sum(st.l);
    const float inv = 1.0f / l;
    int tid_e = tid; LAUNDER_V(tid_e);
    const int lane_e = tid_e & 63, r32e = lane_e & 31, hie = lane_e >> 5;
    u32x2 gpre[16]; f32x4 spre[16];
    if (c == 0) { const bf16* grow = proj + pidx(row00 + qw + r32e, C_GD + hcol + 4 * hie); const float* sgp = subg + 4 * hie;
#pragma unroll
        for (int et = 0; et < 4; ++et)
#pragma unroll
            for (int q4 = 0; q4 < 4; ++q4) { gpre[4 * et + q4] = *(const u32x2*)(grow + 512 * et + 8 * q4); spre[4 * et + q4] = *(const f32x4*)(sgp + 32 * et + 8 * q4); }
        asm volatile("s_waitcnt vmcnt(32) lgkmcnt(0)" ::: "memory"); }
    else asm volatile("s_waitcnt vmcnt(0) lgkmcnt(0)" ::: "memory");
    __builtin_amdgcn_s_barrier(); asm volatile("" ::: "memory");
#define ATT_BAR() do { asm volatile("s_waitcnt lgkmcnt(0)" ::: "memory"); __builtin_amdgcn_s_barrier(); asm volatile("" ::: "memory"); } while (0)
    LAS float* XB = (LAS float*)lds + it * 4096 + lane_e;
    const float lam = lamp[0], oml = lamp[1];
    if (c == 1) { const float f = lam * inv;
#pragma unroll
        for (int r = 0; r < 16; ++r) { XB[(0 * 16 + r) * 64] = st.O0[r] * f; XB[(1 * 16 + r) * 64] = st.O1[r] * f; XB[(2 * 16 + r) * 64] = st.O2[r] * f; XB[(3 * 16 + r) * 64] = st.O3[r] * f; } }
    ATT_BAR();
    if (c == 0) {
        float ss = 0.f;
#pragma unroll
        for (int r = 0; r < 16; ++r) {
            st.O0[r] = st.O0[r] * inv - XB[(0 * 16 + r) * 64]; st.O1[r] = st.O1[r] * inv - XB[(1 * 16 + r) * 64];
            st.O2[r] = st.O2[r] * inv - XB[(2 * 16 + r) * 64]; st.O3[r] = st.O3[r] * inv - XB[(3 * 16 + r) * 64];
            ss += st.O0[r] * st.O0[r] + st.O1[r] * st.O1[r] + st.O2[r] * st.O2[r] + st.O3[r] * st.O3[r]; }
        ss = half_sum(ss);
        const float rs = rsqrtf(ss * (1.f / 128.f) + EPS) * oml;
        const size_t rowl = (size_t)(qw + r32e);
        bf16* yrow = yc + ((size_t)b * SEQ + rowl) * 1024 + h * 128 + 4 * hie;
#pragma unroll
        for (int et = 0; et < 4; ++et)
#pragma unroll
            for (int q4 = 0; q4 < 4; ++q4) {
                const f32x16& A = et == 0 ? st.O0 : et == 1 ? st.O1 : et == 2 ? st.O2 : st.O3;
                const int e0 = 32 * et + 8 * q4;
                const f32x4 sg4 = spre[4 * et + q4]; const u32x2 g = gpre[4 * et + q4];
                u32x2 o; o.x = cvt_pk_bf16(A[4 * q4] * rs * sg4.x * bf_lo(g.x), A[4 * q4 + 1] * rs * sg4.y * bf_hi(g.x));
                o.y = cvt_pk_bf16(A[4 * q4 + 2] * rs * sg4.z * bf_lo(g.y), A[4 * q4 + 3] * rs * sg4.w * bf_hi(g.y));
                *(u32x2*)(yrow + e0) = o;
            }
    }
#undef ATT_BAR
#undef ATT_PIN
#undef ATT_SB
#undef ATT_EXP4
#undef ATT_SUB4
#undef ATT_EXP1
#undef ATT_EXP3
#undef ATT_VF
#undef ATT_KF
#undef ATT_MASK
#undef ATT_OSCALE
}

__device__ __forceinline__ int fetch_item(const int tid, gu32* ctr, volatile LAS unsigned* slot) {
    __syncthreads();
    if (tid == 0) *slot = __hip_atomic_fetch_add(ctr, 1u, RLX_AGENT);
    __syncthreads();
    return __builtin_amdgcn_readfirstlane((int)*slot);
}

#ifndef G1_ALIGN
#define G1_ALIGN true
#endif
#ifndef G1_SP2
#define G1_SP2 true
#endif
#ifndef G3_ALIGN
#define G3_ALIGN true
#endif
#ifndef G3_SP2
#define G3_SP2 true
#endif
#ifndef G4_ALIGN
#define G4_ALIGN true
#endif
#ifndef G4_SP2
#define G4_SP2 true
#endif
#ifndef PROBE_DUP
#define PROBE_DUP 0
#endif
#ifndef PROBE_EMODE
#define PROBE_EMODE 0
#endif
#ifndef PROBE_AMODE
#define PROBE_AMODE 0
#endif
#ifndef PROBE_P2SEL
#define PROBE_P2SEL 0
#endif
#ifndef MK_N_LAUNCHES
#define MK_N_LAUNCHES 1
#endif
constexpr int N_PHASES = 1 + NGROUP * DEPTH * 5;
struct Args { const float* in[17]; float* out; unsigned char* ws; int ph_lo, ph_hi, li, pad; };
__global__ void __launch_bounds__(NWAVES * 64, 2) hyb_fwd(Args args) {
    extern __shared__ __attribute__((aligned(16))) unsigned char lds_raw[];
    ldsp lds = (ldsp)lds_raw;
    volatile LAS unsigned* MISC = (volatile LAS unsigned*)(lds + MISC_OFF);
    for (int u = threadIdx.x; u < (LDS_BYTES - LDSCTL_OFF) / 4; u += NWAVES * 64) ((LAS unsigned*)(lds + LDSCTL_OFF))[u] = 0u;
    __syncthreads();
    XcdBarrier bar = xcd_barrier_post((unsigned*)((gu32*)(args.ws + WS_CTL) + CW_BAR) + args.li * XCD_BAR_WORDS, MISC + 8, (unsigned)__builtin_amdgcn_readfirstlane((int)threadIdx.x >> 6));
    int tidc = threadIdx.x;
    const int lo = args.ph_lo, hi_ = args.ph_hi;
#define IN(k) (lo <= (k) && (k) < hi_)
#define BOTH(k) (IN(k) && IN((k) + 1))
#define PHASE_ENTRY() LAUNDER_V(tidc); const int tid = tidc; unsigned long long z_ = 0ull; LAUNDER_S(z_); unsigned char* ws = args.ws + z_; const int G = gridDim.x; \
    const int lane = tid & 63, wave = __builtin_amdgcn_readfirstlane(tid >> 6); (void)lane; (void)wave; (void)G

    if (IN(0)) {
        PHASE_ENTRY();
        const int gw = blockIdx.x * NWAVES + wave, NGW = G * NWAVES;
        float* lams = (float*)(ws + WS_LAMS);
        bf16* WIN = (bf16*)(ws + WS_WIN); bf16* WBR = (bf16*)(ws + WS_WBR); bf16* WOUT = (bf16*)(ws + WS_WOUT); bf16* HB = (bf16*)(ws + WS_H);
        LAS float* scr = (LAS float*)(lds + wave * 16384);
        constexpr int I_IN = (2048 / 64) * (16384 / 32), I_BR = (1024 / 64) * (2048 / 32), I_OUT = (2048 / 64) * (2048 / 32);
        constexpr int NITEMS = 2 * I_IN + 6 * I_BR + 2 * I_OUT;
        for (int it = gw; it < NITEMS; it += NGW) {
            int r = it;
            if (r < 2 * I_IN) { const int l = r / I_IN; r -= l * I_IN; p0_transpose_item(args.in[3] + (size_t)l * 2048 * 16384, 2048, 16384, WIN + (size_t)l * 16384 * 2048, scr, r, lane); continue; }
            r -= 2 * I_IN;
            if (r < 6 * I_BR) { const int lj = r / I_BR; r -= lj * I_BR; const int l = lj / 3, j = lj - 3 * l;
                const float* src = j == 0 ? args.in[13] : j == 1 ? args.in[14] : args.in[15];
                p0_transpose_item(src + (size_t)l * 1024 * 2048, 1024, 2048, WBR + (size_t)lj * 2048 * 1024, scr, r, lane); continue; }
            r -= 6 * I_BR;
            { const int l = r / I_OUT; r -= l * I_OUT; p0_transpose_item(args.in[16] + (size_t)l * 2048 * 2048, 2048, 2048, WOUT + (size_t)l * 2048 * 2048, scr, r, lane); }
        }
        if (blockIdx.x == 0 && wave == 0) {
            for (int l = 0; l < DEPTH; ++l) { const float* dl = args.in[11] + l * 256;
                const float s01 = wave_sum(dl[lane] * dl[64 + lane]), s23 = wave_sum(dl[128 + lane] * dl[192 + lane]);
                const float lam_init = 0.8f - 0.6f * __expf(-0.3f * (float)l);
                if (lane == 0) { lams[2 * l] = __expf(s01) - __expf(s23) + lam_init; lams[2 * l + 1] = 1.0f - lam_init; } }
        }
        { f32x4 gv[8];
#pragma unroll
          for (int j = 0; j < 4; ++j) { gv[2 * j] = *(const f32x4*)(args.in[1] + 512 * j + 8 * lane); gv[2 * j + 1] = *(const f32x4*)(args.in[1] + 512 * j + 8 * lane + 4); }
          for (int m = gw; m < M_ALL; m += NGW) rms_row_to_bf16(args.in[0] + (size_t)m * D_MODEL, gv, HB + (size_t)m * D_MODEL, lane); }
        if (BOTH(0)) xcd_barrier(bar);
    }

    for (int g = 0; g < NGROUP; ++g)
        for (int l = 0; l < DEPTH; ++l) {
            const int pb = 1 + (g * DEPTH + l) * 5;
            if (IN(pb)) {
                PHASE_ENTRY();
                pg8::SchedPlain S; S.so.init(TG, D_IN, G, (int)blockIdx.x); S.A = (const char*)(ws + WS_H) + (size_t)g * TG * D_MODEL * 2; S.Bt = (const char*)(ws + WS_WIN) + (size_t)l * D_IN * D_MODEL * 2;
                pg8::EpiProj E{(bf16*)(ws + WS_PROJ), (bf16*)(ws + WS_GM), (PROBE_DUP == 1 && args.li > 0 && pb == lo) ? PROBE_EMODE : 0};
#ifndef SKIP_P1
                pg8::gemm_phase<pg8::EpiProj, pg8::SchedPlain, G1_ALIGN, G1_SP2>(lds, D_MODEL, S, E, tid);
#endif
                if (BOTH(pb)) xcd_barrier(bar);
            }
            if (IN(pb + 1)) {
                const bool only = PROBE_DUP == 2 && PROBE_P2SEL != 0 && args.li > 0 && (pb + 1) == lo;
#ifndef SKIP_RET
                if (!only || PROBE_P2SEL == 1) { PHASE_ENTRY(); gu32* q = (gu32*)(ws + WS_CTL) + CW_Q + 64 * 3 * (g * DEPTH + l) + args.li * 1024;
                  const bf16* PROJ = (const bf16*)(ws + WS_PROJ); bf16* YB = (bf16*)(ws + WS_Y);
                  for (;;) { LAUNDER_V(tidc); const int t2 = tidc; const int it = fetch_item(t2, q, MISC + 16); if (it >= BG * 8) break; ret_unit(t2, lds, it >> 3, it & 7, PROJ, YB + (size_t)TG * 1024); } }
#endif
#ifndef SKIP_LRU
                if (!only || PROBE_P2SEL == 2) { PHASE_ENTRY(); gu32* q = (gu32*)(ws + WS_CTL) + CW_Q + 64 * 3 * (g * DEPTH + l) + args.li * 1024;
                  const bf16* PROJ = (const bf16*)(ws + WS_PROJ); bf16* YB = (bf16*)(ws + WS_Y);
                  for (;;) { LAUNDER_V(tidc); const int t2 = tidc; const int it = fetch_item(t2, q + 64, MISC + 16); if (it >= BG * 16) break;
                    lru_unit(t2, lds, it >> 4, it & 15, PROJ, YB, args.in[4] + l * 4096, args.in[5] + l * 1024, args.in[6] + (size_t)l * 65536, args.in[7] + l * 1024,
                             args.in[8] + (size_t)l * 65536, args.in[9] + l * 1024, args.in[10] + l * 1024); } }
#endif
#ifndef SKIP_ATT
                if (!only || PROBE_P2SEL == 3) { PHASE_ENTRY(); gu32* q = (gu32*)(ws + WS_CTL) + CW_Q + 64 * 3 * (g * DEPTH + l) + args.li * 1024;
                  const bf16* PROJ = (const bf16*)(ws + WS_PROJ); bf16* YB = (bf16*)(ws + WS_Y); const float* lams = (const float*)(ws + WS_LAMS);
                  int it; { LAUNDER_V(tidc); const int t2 = tidc; it = fetch_item(t2, q + 128, MISC + 16); }
                  while (it < BG * 8 * 32) { LAUNDER_V(tidc); const int t2 = tidc; const int qb = 31 - (it >> 5), bh = it & 31;
                    unsigned pend = 0u; if (t2 == 0) pend = __hip_atomic_fetch_add(q + 128, 1u, RLX_AGENT);
                    attn_unit(t2, lds, bh >> 3, bh & 7, qb, PROJ, YB + (size_t)2 * TG * 1024, lams + 2 * l, args.in[12] + l * 128);
                    LAUNDER_V(tidc); const int t3 = tidc; volatile LAS unsigned* slot = MISC + 16;
                    __syncthreads(); if (t3 == 0) *slot = pend; __syncthreads(); it = __builtin_amdgcn_readfirstlane((int)*slot); } }
#endif
                if (BOTH(pb + 1)) xcd_barrier(bar);
            }
            if (IN(pb + 2)) {
                PHASE_ENTRY();
                pg8::SchedBranch S; S.so.init(TG, D_MODEL, G, (int)blockIdx.x); S.A = (const char*)(ws + WS_Y); S.strideA = (size_t)TG * 1024 * 2;
                S.Bt = (const char*)(ws + WS_WBR) + (size_t)l * 3 * 2048 * 1024 * 2; S.strideB = (size_t)2048 * 1024 * 2;
                pg8::EpiMerge E{(const unsigned char*)(ws + WS_GM), (bf16*)(ws + WS_M)};
#ifndef SKIP_P3
                pg8::gemm_phase<pg8::EpiMerge, pg8::SchedBranch, G3_ALIGN, G3_SP2>(lds, 1024, S, E, tid);
#endif
                if (BOTH(pb + 2)) xcd_barrier(bar);
            }
            if (IN(pb + 3)) {
                PHASE_ENTRY();
                pg8::SchedPlain S; S.so.init(TG, D_MODEL, G, (int)blockIdx.x); S.A = (const char*)(ws + WS_M); S.Bt = (const char*)(ws + WS_WOUT) + (size_t)l * D_MODEL * D_MODEL * 2;
                pg8::EpiBf16Plain E{(bf16*)(ws + WS_O), D_MODEL};
#ifndef SKIP_P4
                pg8::gemm_phase<pg8::EpiBf16Plain, pg8::SchedPlain, G4_ALIGN, G4_SP2>(lds, D_MODEL, S, E, tid);
#endif
                if (BOTH(pb + 3)) xcd_barrier(bar);
            }
            if (IN(pb + 4)) {
                PHASE_ENTRY();
                const int gw = blockIdx.x * NWAVES + wave, NGW = G * NWAVES;
                const bool dead = __hip_atomic_load((gu32*)(ws + WS_CTL) + CW_BAR + XB_TMO, RLX_AGENT) != 0u;
                const bf16* OB = (const bf16*)(ws + WS_O); bf16* HB = (bf16*)(ws + WS_H); bf16* X1 = (bf16*)(ws + WS_X1);
                f32x4 pgv[8], ngv[8];
                { const float* pg = args.in[2] + l * D_MODEL + 8 * lane; const float* ng = args.in[1] + D_MODEL + 8 * lane;
#pragma unroll
                  for (int j = 0; j < 4; ++j) { pgv[2 * j] = *(const f32x4*)(pg + 512 * j); pgv[2 * j + 1] = *(const f32x4*)(pg + 512 * j + 4); ngv[2 * j] = *(const f32x4*)(ng + 512 * j); ngv[2 * j + 1] = *(const f32x4*)(ng + 512 * j + 4); } }
                for (int m = gw; m < TG; m += NGW) {
                    const size_t row = (size_t)g * TG + m;
                    const v4u* orow = (const v4u*)(OB + (size_t)m * D_MODEL) + lane;
                    f32x4 v[8]; float s = 0.f;
#pragma unroll
                    for (int j = 0; j < 4; ++j) { const v4u ow = orow[64 * j]; v[2 * j] = (f32x4){bf_lo(ow.x), bf_hi(ow.x), bf_lo(ow.y), bf_hi(ow.y)}; v[2 * j + 1] = (f32x4){bf_lo(ow.z), bf_hi(ow.z), bf_lo(ow.w), bf_hi(ow.w)}; }
#pragma unroll
                    for (int j = 0; j < 8; ++j) s += (v[j].x * v[j].x + v[j].y * v[j].y) + (v[j].z * v[j].z + v[j].w * v[j].w);
                    const float rs = rsqrtf(wave_sum(s) * (1.f / D_MODEL) + EPS);
                    if (l == 0) {
                        const float* xrow = args.in[0] + row * D_MODEL + 8 * lane; float s2 = 0.f;
                        v4u* x8 = (v4u*)(X1 + (size_t)m * D_MODEL) + lane;
#pragma unroll
                        for (int j = 0; j < 4; ++j) {
                            const f32x4 xa = *(const f32x4*)(xrow + 512 * j), xb = *(const f32x4*)(xrow + 512 * j + 4), ga = pgv[2 * j], gb = pgv[2 * j + 1];
                            v[2 * j] = xa + v[2 * j] * rs * ga; v[2 * j + 1] = xb + v[2 * j + 1] * rs * gb;
                            v4u wv; wv.x = cvt_pk_bf16(v[2 * j].x, v[2 * j].y); wv.y = cvt_pk_bf16(v[2 * j].z, v[2 * j].w); wv.z = cvt_pk_bf16(v[2 * j + 1].x, v[2 * j + 1].y); wv.w = cvt_pk_bf16(v[2 * j + 1].z, v[2 * j + 1].w);
                            x8[64 * j] = wv; }
#pragma unroll
                        for (int j = 0; j < 8; ++j) s2 += (v[j].x * v[j].x + v[j].y * v[j].y) + (v[j].z * v[j].z + v[j].w * v[j].w);
                        const float rs2 = rsqrtf(wave_sum(s2) * (1.f / D_MODEL) + EPS);
                        v4u* o8 = (v4u*)(HB + row * D_MODEL) + lane;
#pragma unroll
                        for (int j = 0; j < 4; ++j) { const f32x4 ga = ngv[2 * j], gb = ngv[2 * j + 1]; const f32x4 a = v[2 * j] * rs2 * ga, bq = v[2 * j + 1] * rs2 * gb;
                            v4u wv; wv.x = cvt_pk_bf16(a.x, a.y); wv.y = cvt_pk_bf16(a.z, a.w); wv.z = cvt_pk_bf16(bq.x, bq.y); wv.w = cvt_pk_bf16(bq.z, bq.w); o8[64 * j] = wv; }
                    } else {
                        const v4u* x8 = (const v4u*)(X1 + (size_t)m * D_MODEL) + lane;
                        float* drow = args.out + row * D_MODEL + 8 * lane;
#pragma unroll
                        for (int j = 0; j < 4; ++j) { const v4u xw = x8[64 * j]; const f32x4 ga = pgv[2 * j], gb = pgv[2 * j + 1];
                            f32x4 a = (f32x4){bf_lo(xw.x), bf_hi(xw.x), bf_lo(xw.y), bf_hi(xw.y)} + v[2 * j] * rs * ga, bq = (f32x4){bf_lo(xw.z), bf_hi(xw.z), bf_lo(xw.w), bf_hi(xw.w)} + v[2 * j + 1] * rs * gb;
                            if (dead) { const float qn = __builtin_nanf(""); a = (f32x4){qn, qn, qn, qn}; bq = a; }
                            *(f32x4*)(drow + 512 * j) = a; *(f32x4*)(drow + 512 * j + 4) = bq; }
                    }
                }
                if (BOTH(pb + 4)) xcd_barrier(bar);
            }
        }
#undef IN
#undef BOTH
#undef PHASE_ENTRY
}

extern "C" void kernel_launch(void* const* d_in, const int* in_sizes, int n_in, void* d_out, int out_size, void* d_ws, size_t ws_size, hipStream_t stream) {
    static int grid = 0;
    if (grid == 0) {
        if (n_in != 17 || in_sizes[0] != M_ALL * D_MODEL || out_size != M_ALL * D_MODEL || ws_size < WS_END) {
            fprintf(stderr, "kernel_launch: unexpected shapes (n_in %d, in0 %d, out %d, ws %zu < %zu); nothing launched\n", n_in, n_in > 0 ? in_sizes[0] : -1, out_size, ws_size, (size_t)WS_END); grid = -1; return; }
        int dev = 0, cus = 0, per_cu = 0;
        if (hipGetDevice(&dev) != hipSuccess || hipDeviceGetAttribute(&cus, hipDeviceAttributeMultiprocessorCount, dev) != hipSuccess) { grid = -1; return; }
        if (hipFuncSetAttribute((const void*)hyb_fwd, hipFuncAttributeMaxDynamicSharedMemorySize, LDS_BYTES) != hipSuccess) { fprintf(stderr, "kernel_launch: hipFuncSetAttribute failed\n"); grid = -1; return; }
        if (hipOccupancyMaxActiveBlocksPerMultiprocessor(&per_cu, (const void*)hyb_fwd, NWAVES * 64, LDS_BYTES) != hipSuccess || per_cu < 1)
            fprintf(stderr, "kernel_launch: note: occupancy query reports %d workgroups per CU\n", per_cu);
        (void)hipGetLastError();
        grid = cus;
    }
    if (grid < 0) return;
    if (hipMemsetAsync((char*)d_ws + WS_CTL, 0, CTL_ZERO_BYTES, stream) != hipSuccess) return;
    Args a{};
    for (int i = 0; i < 17; ++i) a.in[i] = (const float*)d_in[i];
    a.out = (float*)d_out; a.ws = (unsigned char*)d_ws;
#if PROBE_DUP > 0
    { int lo = 0; for (int k = 0; k <= NGROUP * DEPTH; ++k) { const int p = 1 + k * 5 + (PROBE_DUP - 1); const int hi = k < NGROUP * DEPTH ? p + 1 : N_PHASES;
        a.ph_lo = lo; a.ph_hi = hi; a.li = k; a.pad = 0; hipLaunchKernelGGL(hyb_fwd, dim3(grid), dim3(NWAVES * 64), LDS_BYTES, stream, a); lo = p; } }
#elif MK_N_LAUNCHES == 1
    a.ph_lo = 0; a.ph_hi = N_PHASES; a.li = 0; a.pad = 0;
    hipLaunchKernelGGL(hyb_fwd, dim3(grid), dim3(NWAVES * 64), LDS_BYTES, stream, a);
#else
    for (int p = 0; p < N_PHASES; ++p) { a.ph_lo = p; a.ph_hi = p + 1; a.li = 0; a.pad = 0;
        hipLaunchKernelGGL(hyb_fwd, dim3(grid), dim3(NWAVES * 64), LDS_BYTES, stream, a); }
#endif
}
```
